# Optimizing an MI355X kernel written in HIP

```python
import jax, jax.numpy as jnp
from jax import lax
import numpy as np

D_MODEL = 1024
BATCH = 16
SEQ = 2048
DEPTH = 4

N_BRANCH = 4
MIX_W = D_MODEL // 2
RW_N = 64
RW_H = MIX_W // RW_N
RW_RANK_W = 64
RW_RANK_A = 64
RW_RANK_G = 128
RW_GN_EPS = 64e-5
RW_COLS = 3 * MIX_W + RW_RANK_W + RW_RANK_A + RW_RANK_G
ML_H = 4
ML_DV = MIX_W // ML_H
ML_DK = ML_DV // 2
ML_CHUNK = 64
ML_COLS = 2 * ML_H * ML_DK + 2 * MIX_W + 4 * ML_H
LRU_BLOCKS = 8
LRU_BW = MIX_W // LRU_BLOCKS
LRU_CONV = 4
RG_C = 8.0
LRU_COLS = 2 * MIX_W
HG_D = 128
HG_H = MIX_W // HG_D
HG_CHUNK = 64
HG_COLS = 5 * MIX_W
D_FF = 2816
FFN_CONV = 3

NEG_BIG = -1e30

IN_SPLITS = (RW_COLS, ML_COLS, LRU_COLS, HG_COLS, N_BRANCH * D_MODEL)
N_IN = sum(IN_SPLITS)

kernel_name = "hybrid_rwkv7_mlstm_rglru_hgrn2_encoder"


def _split(t, sizes):
    idx = [int(s) for s in np.cumsum(sizes)[:-1]]
    return jnp.split(t, idx, axis=-1)


def _rmsnorm(x, g, eps=1e-6):
    xf = x.astype(jnp.float32)
    return xf * lax.rsqrt(jnp.mean(xf * xf, axis=-1, keepdims=True) + eps) * g


def _head_rmsnorm(y, g, eps=1e-6):
    yf = y.astype(jnp.float32)
    yf = yf * lax.rsqrt(jnp.mean(yf * yf, axis=-1, keepdims=True) + eps)
    return yf.reshape(*y.shape[:-2], -1) * g


def _dwconv(x, w, b):
    k = w.shape[0]
    left = (k - 1) // 2
    s = x.shape[1]
    xp = jnp.pad(x, ((0, 0), (left, k - 1 - left), (0, 0)))
    out = xp[:, 0:s] * w[0]
    for j in range(1, k):
        out = out + xp[:, j:j + s] * w[j]
    return out + b


def _rwkv7_scan(r, logw, a, b, k, v):
    bsz, _, nh, n = r.shape

    def step(state, inp):
        r_t, lw_t, a_t, b_t, k_t, v_t = inp
        sa = jnp.einsum("bhvk,bhk->bhv", state, a_t)
        state = (state * jnp.exp(lw_t)[:, :, None, :]
                 + sa[..., None] * b_t[:, :, None, :]
                 + v_t[..., None] * k_t[:, :, None, :])
        return state, jnp.einsum("bhvk,bhk->bhv", state, r_t)

    xs = tuple(jnp.moveaxis(t, 1, 0) for t in (r, logw, a, b, k, v))
    _, y = lax.scan(step, jnp.zeros((bsz, nh, n, n), jnp.float32), xs)
    return jnp.moveaxis(y, 0, 1)


def _rwkv7_branch(p, mu, w0, w2, a0, a2, g2, k_k, k_a, r_k, ln_w, ln_b):
    bsz, s, _ = p.shape
    pf = p.astype(jnp.float32)
    prev = jnp.pad(pf, ((0, 0), (1, 0), (0, 0)))[:, :-1]
    nxt = jnp.pad(pf, ((0, 0), (0, 1), (0, 0)))[:, 1:]
    pf = pf + mu * (0.5 * (prev + nxt) - pf)
    r, k, v, xw, xa, xg = _split(pf, [MIX_W, MIX_W, MIX_W, RW_RANK_W, RW_RANK_A, RW_RANK_G])
    heads = lambda t: t.reshape(bsz, s, RW_H, RW_N)
    kk = heads(k * k_k)
    kk = kk * lax.rsqrt(jnp.maximum(jnp.sum(kk * kk, axis=-1, keepdims=True), 1e-24))
    r_h, v_h = heads(r), heads(v)
    ys, kts = [], []
    for d in range(2):
        w = -jax.nn.softplus(-(w0[d] + jnp.tanh(xw) @ w2[d])) - 0.5
        a = jax.nn.sigmoid(a0[d] + xa @ a2[d])
        kt = heads(k * (1.0 + (a - 1.0) * k_a))
        args = [r_h, heads(-jnp.exp(w)), -kk, kk * heads(a), kt, v_h]
        if d == 1:
            args = [jnp.flip(t, 1) for t in args]
        yd = _rwkv7_scan(*args)
        ys.append(yd if d == 0 else jnp.flip(yd, 1))
        kts.append(kt)
    y = ys[0] + ys[1]
    mean = jnp.mean(y, axis=-1, keepdims=True)
    var = jnp.mean(jnp.square(y - mean), axis=-1, keepdims=True)
    y = ((y - mean) * lax.rsqrt(var + RW_GN_EPS)).reshape(bsz, s, MIX_W) * ln_w + ln_b
    k_bonus = 0.5 * (kts[0] + kts[1])
    bonus = jnp.sum(r_h * k_bonus * r_k, axis=-1, keepdims=True) * v_h
    y = y + bonus.reshape(bsz, s, MIX_W)
    g = jax.nn.sigmoid(xg) @ g2
    return y * g


def _mlstm_chunkwise(q, k, v, i_pre, f_pre):
    bsz, nh, s, dk = q.shape
    dv = v.shape[-1]
    lc = ML_CHUNK
    nc = s // lc
    q = (q * dk ** -0.5).reshape(bsz, nh, nc, lc, dk)
    k = k.reshape(bsz, nh, nc, lc, dk)
    v = v.reshape(bsz, nh, nc, lc, dv)
    ig = i_pre.reshape(bsz, nh, nc, lc)
    bcum = jnp.cumsum(jax.nn.log_sigmoid(f_pre).reshape(bsz, nh, nc, lc), axis=-1)
    g_end = bcum[..., -1]
    a_end = g_end[..., None] - bcum + ig

    def step(carry, inp):
        c_st, n_st, m_st = carry
        k_c, v_c, a_c, g_c = inp
        m_new = jnp.maximum(g_c + m_st, jnp.max(a_c, axis=-1))
        w_c = jnp.exp(a_c - m_new[..., None])
        dec = jnp.exp(g_c + m_st - m_new)
        c_new = dec[..., None, None] * c_st + jnp.einsum("bhl,bhlk,bhlv->bhkv", w_c, k_c, v_c)
        n_new = dec[..., None] * n_st + jnp.einsum("bhl,bhlk->bhk", w_c, k_c)
        return (c_new, n_new, m_new), (c_st, n_st, m_st)

    init = (jnp.zeros((bsz, nh, dk, dv), jnp.float32),
            jnp.zeros((bsz, nh, dk), jnp.float32),
            jnp.zeros((bsz, nh), jnp.float32))
    xs = (jnp.moveaxis(k, 2, 0), jnp.moveaxis(v, 2, 0),
          jnp.moveaxis(a_end, 2, 0), jnp.moveaxis(g_end, 2, 0))
    _, (c_prev, n_prev, m_prev) = lax.scan(step, init, xs)
    c_prev = jnp.moveaxis(c_prev, 0, 2)
    n_prev = jnp.moveaxis(n_prev, 0, 2)
    m_prev = jnp.moveaxis(m_prev, 0, 2)
    lower = jnp.tril(jnp.ones((lc, lc), dtype=bool))
    log_d = jnp.where(lower, bcum[..., :, None] - bcum[..., None, :] + ig[..., None, :], NEG_BIG)
    m_inter = bcum + m_prev[..., None]
    m_t = jnp.maximum(m_inter, jnp.max(log_d, axis=-1))
    pw = (jnp.where(lower, jnp.exp(log_d - m_t[..., None]), 0.0)
          * jnp.einsum("bhcld,bhcsd->bhcls", q, k))
    s_inter = jnp.exp(m_inter - m_t)
    num = (s_inter[..., None] * jnp.einsum("bhcld,bhcdv->bhclv", q, c_prev)
           + jnp.einsum("bhcls,bhcsv->bhclv", pw, v))
    den = s_inter * jnp.einsum("bhcld,bhcd->bhcl", q, n_prev) + jnp.sum(pw, axis=-1)
    h = num / jnp.maximum(jnp.abs(den), jnp.exp(-m_t))[..., None]
    return h.reshape(bsz, nh, s, dv)


def _mlstm_branch(p, i_bias, f_bias, norm_g):
    bsz, s, _ = p.shape
    q, k, v, o, ig, fg = _split(p.astype(jnp.float32),
                                [ML_H * ML_DK, ML_H * ML_DK, MIX_W, MIX_W, 2 * ML_H, 2 * ML_H])
    heads = lambda t, d: t.reshape(bsz, s, ML_H, d).transpose(0, 2, 1, 3)
    q, k, v = heads(q, ML_DK), heads(k, ML_DK), heads(v, ML_DV)
    ig = (ig.reshape(bsz, s, 2, ML_H) + i_bias).transpose(2, 0, 3, 1)
    fg = (fg.reshape(bsz, s, 2, ML_H) + f_bias).transpose(2, 0, 3, 1)
    fl = lambda t: jnp.flip(t, 2)
    h = (_mlstm_chunkwise(q, k, v, ig[0], fg[0])
         + fl(_mlstm_chunkwise(fl(q), fl(k), fl(v), fl(ig[1]), fl(fg[1]))))
    h = h.transpose(0, 2, 1, 3)
    return jax.nn.sigmoid(o) * _head_rmsnorm(h, norm_g)


def _lin_comb(e1, e2):
    a1, b1 = e1
    a2, b2 = e2
    return a1 * a2, a2 * b1 + b2


def _rglru_branch(p, conv_w, conv_b, wa, ba, wx, bx, lam):
    bsz, s, _ = p.shape
    xb, gb = _split(p.astype(jnp.float32), [MIX_W, MIX_W])
    xc = _dwconv(xb, conv_w, conv_b)
    xblk = xc.reshape(bsz, s, LRU_BLOCKS, LRU_BW)
    y = None
    for d in range(2):
        ra = jnp.einsum("bsgi,gij->bsgj", xblk, wa[d]).reshape(bsz, s, MIX_W) + ba[d]
        rx = jnp.einsum("bsgi,gij->bsgj", xblk, wx[d]).reshape(bsz, s, MIX_W) + bx[d]
        log_a = -RG_C * jax.nn.softplus(-lam[d]) * jax.nn.sigmoid(ra)
        a = jnp.exp(log_a)
        mult = jnp.sqrt(jnp.maximum(-jnp.expm1(2.0 * log_a), 0.0))
        bin_ = mult * (jax.nn.sigmoid(rx) * xc)
        _, hd = lax.associative_scan(_lin_comb, (a, bin_), axis=1, reverse=(d == 1))
        y = hd if y is None else y + hd
    return y * jax.nn.gelu(gb)


def _hgrn2_chunkwise(q, k, v, logf):
    bsz, nh, s, dk = q.shape
    dv = v.shape[-1]
    lc = HG_CHUNK
    nc = s // lc
    chunks = lambda t: jnp.moveaxis(t.reshape(bsz, nh, nc, lc, t.shape[-1]), 2, 0)
    lower = jnp.tril(jnp.ones((lc, lc), dtype=bool))[:, :, None]

    def step(state, inp):
        q_c, k_c, v_c, lf_c = inp
        gc = jnp.cumsum(lf_c, axis=-2)
        diff = gc[:, :, :, None, :] - gc[:, :, None, :, :]
        dec = jnp.where(lower, jnp.exp(jnp.minimum(diff, 0.0)), 0.0)
        att = jnp.einsum("bhtd,bhsd,bhtsd->bhts", q_c, k_c, dec)
        o = (jnp.einsum("bhts,bhsv->bhtv", att, v_c)
             + jnp.einsum("bhtd,bhdv->bhtv", q_c * jnp.exp(gc), state))
        g_end = gc[:, :, -1:, :]
        state = (jnp.exp(g_end[:, :, 0, :, None]) * state
                 + jnp.einsum("bhsd,bhsv->bhdv", k_c * jnp.exp(g_end - gc), v_c))
        return state, o

    _, o = lax.scan(step, jnp.zeros((bsz, nh, dk, dv), jnp.float32),
                    (chunks(q), chunks(k), chunks(v), chunks(logf)))
    return jnp.moveaxis(o, 0, 2).reshape(bsz, nh, s, dv)


def _hgrn2_branch(p, lb, norm_g):
    bsz, s, _ = p.shape
    q, f_fw, f_bw, i, g = _split(p.astype(jnp.float32), [MIX_W] * 5)
    heads = lambda t: t.reshape(bsz, s, HG_H, HG_D).transpose(0, 2, 1, 3)
    qh, ih = heads(jax.nn.silu(q)), heads(i)
    fl = lambda t: jnp.flip(t, 2)
    outs = []
    for d, fp in enumerate((f_fw, f_bw)):
        f = lb[d] + (1.0 - lb[d]) * jax.nn.sigmoid(fp)
        logf = jnp.log(f)
        kd = (1.0 - lb[d]) * jax.nn.sigmoid(-fp)
        args = [qh, heads(kd), ih, heads(logf)]
        if d == 1:
            args = [fl(t) for t in args]
        od = _hgrn2_chunkwise(*args)
        outs.append(od if d == 0 else fl(od))
    o = (outs[0] + outs[1]).transpose(0, 2, 1, 3)
    return jax.nn.silu(g) * _head_rmsnorm(o, norm_g)


def _conv_ffn(u, w_up, cw, cb, w_down):
    z = _dwconv(u @ w_up, cw, cb)
    val, gate = jnp.split(z, 2, axis=-1)
    return (val * jax.nn.silu(gate)) @ w_down


def setup_inputs(seed: int = 0) -> dict:
    key = jax.random.key(seed)
    ks = iter(jax.random.split(key, 48))
    f32 = jnp.float32

    def nrm(shape, std=1.0):
        return std * jax.random.normal(next(ks), shape, f32)

    def unif(shape, lo, hi):
        return jax.random.uniform(next(ks), shape, f32, lo, hi)

    L, D, W = DEPTH, D_MODEL, MIX_W
    lam_s = unif((L, 2, W), 0.9, 0.999) ** (1.0 / RG_C)
    return {
        "x": nrm((BATCH, SEQ, D)),
        "c": nrm((BATCH, D)),
        "ada_w": nrm((L, D, 6 * D), D ** -0.5),
        "ada_b": nrm((L, 6 * D), 0.02),
        "norm1_g": 1.0 + nrm((L, D), 0.02),
        "w_in": nrm((L, D, N_IN), D ** -0.5),
        "rw_mu": unif((L, RW_COLS), 0.0, 1.0),
        "rw_w0": unif((L, 2, W), -5.0, 0.0),
        "rw_w2": nrm((L, 2, RW_RANK_W, W), 0.1 * RW_RANK_W ** -0.5),
        "rw_a0": nrm((L, 2, W), 0.1),
        "rw_a2": nrm((L, 2, RW_RANK_A, W), 0.1 * RW_RANK_A ** -0.5),
        "rw_g2": nrm((L, RW_RANK_G, W), RW_RANK_G ** -0.5),
        "rw_kk": 0.85 + nrm((L, W), 0.05),
        "rw_ka": 1.0 + nrm((L, W), 0.05),
        "rw_rk": nrm((L, RW_H, RW_N), 0.1),
        "rw_lnw": 1.0 + nrm((L, W), 0.02),
        "rw_lnb": nrm((L, W), 0.02),
        "ml_ibias": nrm((L, 2, ML_H), 0.5),
        "ml_fbias": unif((L, 2, ML_H), 3.0, 6.0),
        "ml_norm": 1.0 + nrm((L, W), 0.02),
        "lru_conv_w": nrm((L, LRU_CONV, W), LRU_CONV ** -0.5),
        "lru_conv_b": nrm((L, W), 0.02),
        "lru_wa": nrm((L, 2, LRU_BLOCKS, LRU_BW, LRU_BW), LRU_BW ** -0.5),
        "lru_ba": nrm((L, 2, W), 0.02),
        "lru_wx": nrm((L, 2, LRU_BLOCKS, LRU_BW, LRU_BW), LRU_BW ** -0.5),
        "lru_bx": nrm((L, 2, W), 0.02),
        "lru_lam": jnp.log(lam_s) - jnp.log1p(-lam_s),
        "hg_lb": nrm((L, 2, W)),
        "hg_norm": 1.0 + nrm((L, W), 0.02),
        "w_branch": nrm((L, N_BRANCH, W, D), W ** -0.5),
        "w_out": nrm((L, D, D), D ** -0.5),
        "norm2_g": 1.0 + nrm((L, D), 0.02),
        "ffn_up": nrm((L, D, 2 * D_FF), D ** -0.5),
        "ffn_conv_w": nrm((L, FFN_CONV, 2 * D_FF), FFN_CONV ** -0.5),
        "ffn_conv_b": nrm((L, 2 * D_FF), 0.02),
        "ffn_down": nrm((L, D_FF, D), D_FF ** -0.5),
        "final_g": 1.0 + nrm((D,), 0.02),
    }


def reference(x, c, ada_w, ada_b, norm1_g, w_in, rw_mu, rw_w0, rw_w2, rw_a0, rw_a2, rw_g2,
              rw_kk, rw_ka, rw_rk, rw_lnw, rw_lnb, ml_ibias, ml_fbias, ml_norm,
              lru_conv_w, lru_conv_b, lru_wa, lru_ba, lru_wx, lru_bx, lru_lam,
              hg_lb, hg_norm, w_branch, w_out, norm2_g, ffn_up, ffn_conv_w, ffn_conv_b,
              ffn_down, final_g):
    lb_soft = jax.nn.softmax(hg_lb.astype(jnp.float32), axis=0)
    lb_all = jnp.clip(jnp.cumsum(lb_soft, axis=0) - lb_soft[0], 0.0, 1.0)
    cond = jax.nn.silu(c.astype(jnp.float32))
    h = x.astype(jnp.float32)
    for l in range(DEPTH):
        mod = cond @ ada_w[l] + ada_b[l]
        sh1, sc1, gt1, sh2, sc2, gt2 = jnp.split(mod[:, None, :], 6, axis=-1)
        u = _rmsnorm(h, norm1_g[l]) * (1.0 + sc1) + sh1
        p_rw, p_ml, p_lru, p_hg, p_gate = _split(u @ w_in[l], IN_SPLITS)
        ys = (
            _rwkv7_branch(p_rw, rw_mu[l], rw_w0[l], rw_w2[l], rw_a0[l], rw_a2[l], rw_g2[l],
                          rw_kk[l], rw_ka[l], rw_rk[l], rw_lnw[l], rw_lnb[l]),
            _mlstm_branch(p_ml, ml_ibias[l], ml_fbias[l], ml_norm[l]),
            _rglru_branch(p_lru, lru_conv_w[l], lru_conv_b[l], lru_wa[l], lru_ba[l],
                          lru_wx[l], lru_bx[l], lru_lam[l]),
            _hgrn2_branch(p_hg, lb_all[l], hg_norm[l]),
        )
        gates = jnp.split(jax.nn.sigmoid(p_gate), N_BRANCH, axis=-1)
        merged = gates[0] * (ys[0] @ w_branch[l, 0])
        for n in range(1, N_BRANCH):
            merged = merged + gates[n] * (ys[n] @ w_branch[l, n])
        h = h + gt1 * (merged @ w_out[l])
        u2 = _rmsnorm(h, norm2_g[l]) * (1.0 + sc2) + sh2
        h = h + gt2 * _conv_ffn(u2, ffn_up[l], ffn_conv_w[l], ffn_conv_b[l], ffn_down[l])
    return _rmsnorm(h, final_g)
```

```cpp
#include <hip/hip_runtime.h>
#include <hip/hip_cooperative_groups.h>
#include <cstdio>
namespace cg = cooperative_groups;

typedef unsigned short bf16_t;
typedef short bf16x8 __attribute__((ext_vector_type(8)));
typedef float f32x4 __attribute__((ext_vector_type(4)));
typedef unsigned u32x4 __attribute__((ext_vector_type(4)));
typedef unsigned u32x2 __attribute__((ext_vector_type(2)));

#ifndef DBG_SKIP
#define DBG_SKIP 0
#endif
#ifndef DBG_NOFFN
#define DBG_NOFFN 0
#endif
#ifndef MULTI_LAUNCH
#define MULTI_LAUNCH 0
#endif

constexpr int NB = 16, SQ = 2048, DM = 1024, TT = NB * SQ, MW = 512, NL = 4;
constexpr int NT = 256;
constexpr int PRW_LD = 1792, PREST_LD = 5248;
constexpr int LRU_O = 1664, HG_O = 2688;
constexpr int GATE_ROW0 = 7040;
constexpr int DFF = 2816;
constexpr int LDS_BYTES = 73728;

constexpr size_t WT_WIN = 0;
constexpr size_t WT_WB = WT_WIN + (size_t)11136 * 1024 * 2;
constexpr size_t WT_WOUT = WT_WB + (size_t)4 * 1024 * 512 * 2;
constexpr size_t WT_WUP = WT_WOUT + (size_t)1024 * 1024 * 2;
constexpr size_t WT_WDN = WT_WUP + (size_t)5632 * 1024 * 2;
constexpr size_t WT_G2 = WT_WDN + (size_t)1024 * 2816 * 2;
constexpr size_t WT_W2 = WT_G2 + (size_t)512 * 128 * 2;
constexpr size_t WT_A2 = WT_W2 + (size_t)2 * 512 * 64 * 2;
constexpr size_t WT_LRU = WT_A2 + (size_t)2 * 512 * 64 * 2;
constexpr size_t WT_END = WT_LRU + (size_t)2 * 2 * 8 * 64 * 64 * 2;
constexpr size_t OFF_PRW = (size_t)48 << 20;
static_assert(WT_END <= OFF_PRW, "wt");
constexpr size_t OFF_PREST = OFF_PRW + (size_t)TT * PRW_LD * 2;
constexpr size_t OFF_Y = OFF_PREST + (size_t)TT * PREST_LD * 2;
constexpr size_t YSZ = (size_t)TT * 512 * 2;
constexpr size_t OFF_YB = OFF_Y, OFF_YC = OFF_Y + YSZ, OFF_YD = OFF_Y + 2 * YSZ, OFF_Y0 = OFF_Y + 3 * YSZ, OFF_Y1 = OFF_Y + 4 * YSZ;
constexpr size_t OFF_SMALL = OFF_Y + 5 * YSZ;
constexpr size_t OFF_MOD = OFF_SMALL;
constexpr size_t OFF_LB = OFF_MOD + (size_t)4 * 16 * 6144 * 4;
constexpr size_t OFF_BETA = OFF_LB + (size_t)4 * 2 * 512 * 4;
constexpr size_t WS_NEED = OFF_BETA + (size_t)2 * TT * 8 * 4;
constexpr size_t OFF_U = OFF_Y;
constexpr size_t OFF_URE = OFF_PREST;
constexpr size_t OFF_MERGED = OFF_PREST + (size_t)TT * 1024 * 2;
constexpr size_t OFF_U2 = OFF_Y;
constexpr size_t OFF_Z = OFF_PRW;
constexpr size_t OFF_ACT = OFF_PRW + (size_t)TT * 5632 * 2;
static_assert(OFF_ACT + (size_t)TT * 2816 * 2 <= OFF_SMALL, "act");

enum { I_X = 0, I_C, I_ADAW, I_ADAB, I_N1G, I_WIN, I_MU, I_W0, I_W2, I_A0, I_A2, I_G2, I_KK, I_KA, I_RK, I_LNW, I_LNB,
       I_MLIB, I_MLFB, I_MLN, I_LCW, I_LCB, I_LWA, I_LBA, I_LWX, I_LBX, I_LLAM, I_HGLB, I_HGN, I_WBR, I_WOUT, I_N2G,
       I_FUP, I_FCW, I_FCB, I_FDN, I_FING, N_INPUTS };

struct Params { const float* in[N_INPUTS]; float* out; char* ws; };

__device__ __forceinline__ int tid_() { int x = threadIdx.x; asm volatile("" : "+v"(x)); return x; }
__device__ __forceinline__ int bid_() { int x = blockIdx.x; asm volatile("" : "+s"(x)); return x; }
__device__ __forceinline__ bf16_t f2bf(float f) { unsigned u = __float_as_uint(f); u += 0x7fffu + ((u >> 16) & 1u); return (bf16_t)(u >> 16); }
__device__ __forceinline__ float bf2f(bf16_t h) { return __uint_as_float(((unsigned)h) << 16); }
__device__ __forceinline__ unsigned pack2(float a, float b) { return (unsigned)f2bf(a) | ((unsigned)f2bf(b) << 16); }
__device__ __forceinline__ float lo2f(unsigned u) { return __uint_as_float(u << 16); }
__device__ __forceinline__ float hi2f(unsigned u) { return __uint_as_float(u & 0xffff0000u); }
__device__ __forceinline__ float rcpf_(float x) { return __builtin_amdgcn_rcpf(x); }
__device__ __forceinline__ float sigm(float x) { return rcpf_(1.f + __expf(-x)); }
__device__ __forceinline__ float silu(float x) { return x * sigm(x); }
__device__ __forceinline__ float logsig(float x) { return fminf(x, 0.f) - log1pf(__expf(-fabsf(x))); }
__device__ __forceinline__ float tanh_f(float x) { return 1.f - 2.f * rcpf_(1.f + __expf(2.f * x)); }
__device__ __forceinline__ float gelu_t(float x) { return 0.5f * x * (1.f + tanh_f(0.7978845608f * (x + 0.044715f * x * x * x))); }
template <int CTRL> __device__ __forceinline__ float dppf(float x) { return __int_as_float(__builtin_amdgcn_update_dpp(0, __float_as_int(x), CTRL, 0xF, 0xF, false)); }
__device__ __forceinline__ float rowsum16(float x) { x += dppf<0x128>(x); x += dppf<0x124>(x); x += dppf<0x122>(x); x += dppf<0x121>(x); return x; }
__device__ __forceinline__ float rdlane(float x, int l) { return __int_as_float(__builtin_amdgcn_readlane(__float_as_int(x), l)); }
__device__ __forceinline__ float wsum64(float x) { x = rowsum16(x); return (rdlane(x, 0) + rdlane(x, 16)) + (rdlane(x, 32) + rdlane(x, 48)); }
__device__ __forceinline__ float bperm(float x, int srclane) { return __int_as_float(__builtin_amdgcn_ds_bpermute(srclane << 2, __float_as_int(x))); }
__device__ __forceinline__ float qsum(float x, int lane) { x += bperm(x, lane ^ 16); x += bperm(x, lane ^ 32); return x; }
__device__ __forceinline__ void unpack8(u32x4 v, float (&f)[8]) {
    f[0] = lo2f(v.x); f[1] = hi2f(v.x); f[2] = lo2f(v.y); f[3] = hi2f(v.y); f[4] = lo2f(v.z); f[5] = hi2f(v.z); f[6] = lo2f(v.w); f[7] = hi2f(v.w); }
__device__ __forceinline__ void unpack4(u32x2 v, float (&f)[4]) { f[0] = lo2f(v.x); f[1] = hi2f(v.x); f[2] = lo2f(v.y); f[3] = hi2f(v.y); }
__device__ __forceinline__ f32x4 mfma16(bf16x8 a, bf16x8 b, f32x4 c) { return __builtin_amdgcn_mfma_f32_16x16x32_bf16(a, b, c, 0, 0, 0); }
__device__ __forceinline__ bf16x8 ldfrag(const bf16_t* p) { return *reinterpret_cast<const bf16x8*>(p); }

__device__ __forceinline__ void gemm_acc(const bf16_t* __restrict__ A, long lda, const bf16_t* __restrict__ Bt, long ldb, int K, f32x4 (&acc)[4][4], char* lds) {
    const int tid = tid_(), wid = tid >> 6, lane = tid & 63, wr = wid >> 1, wc = wid & 1, fr = lane & 15, fq = lane >> 4;
    char* SA = lds; char* SB = lds + 8192;
    const int nk = K >> 5;
    for (int kt = 0; kt < nk; ++kt) {
#pragma unroll
        for (int i = 0; i < 2; ++i) {
            const int b = tid * 16 + i * 4096, r = b >> 6, c = (b & 63) >> 1;
            __builtin_amdgcn_global_load_lds((const unsigned*)(A + (long)r * lda + kt * 32 + c), (__attribute__((address_space(3))) unsigned*)(SA + b), 16, 0, 0);
            __builtin_amdgcn_global_load_lds((const unsigned*)(Bt + (long)r * ldb + kt * 32 + c), (__attribute__((address_space(3))) unsigned*)(SB + b), 16, 0, 0);
        }
        asm volatile("s_waitcnt vmcnt(0)" ::: "memory");
        __syncthreads();
        bf16x8 af[4], bfr[4];
#pragma unroll
        for (int m = 0; m < 4; ++m) af[m] = *reinterpret_cast<const bf16x8*>(SA + (wr * 64 + m * 16 + fr) * 64 + fq * 16);
#pragma unroll
        for (int n = 0; n < 4; ++n) bfr[n] = *reinterpret_cast<const bf16x8*>(SB + (wc * 64 + n * 16 + fr) * 64 + fq * 16);
#pragma unroll
        for (int m = 0; m < 4; ++m)
#pragma unroll
            for (int n = 0; n < 4; ++n) acc[m][n] = mfma16(bfr[n], af[m], acc[m][n]);
        __syncthreads();
    }
}
__device__ __forceinline__ void zero_acc(f32x4 (&acc)[4][4]) {
#pragma unroll
    for (int m = 0; m < 4; ++m)
#pragma unroll
        for (int n = 0; n < 4; ++n) acc[m][n] = (f32x4){0.f, 0.f, 0.f, 0.f};
}

__device__ void ph_init(const Params& P, char* lds) {
    const int tid = tid_();
    {
        const f32x4* src = (const f32x4*)P.in[I_X]; f32x4* dst = (f32x4*)P.out;
        const long n4 = (long)TT * DM / 4;
        for (long i = (long)bid_() * NT + tid; i < n4; i += (long)gridDim.x * NT) dst[i] = src[i];
    }
    float* mod = (float*)(P.ws + OFF_MOD);
    float* lbo = (float*)(P.ws + OFF_LB);
    for (int item = bid_(); item < 385; item += gridDim.x) {
        if (item < 384) {
            const int l = item / 96, j0 = (item % 96) * 64;
            const int col = tid & 63, kg = tid >> 6;
            float* CS = (float*)lds;
            float* RED = CS + 4096;
            float acc[16];
#pragma unroll
            for (int b = 0; b < 16; ++b) acc[b] = 0.f;
            const float* Wl = P.in[I_ADAW] + (size_t)l * DM * 6144;
            for (int sub = 0; sub < 4; ++sub) {
                __syncthreads();
                for (int e = tid; e < 4096; e += NT) {
                    const int kk = e & 63, b = (e >> 6) & 15, g = e >> 10;
                    CS[e] = silu(P.in[I_C][b * DM + g * 256 + sub * 64 + kk]);
                }
                __syncthreads();
                for (int kk = 0; kk < 64; ++kk) {
                    const float w = Wl[(size_t)(kg * 256 + sub * 64 + kk) * 6144 + j0 + col];
#pragma unroll
                    for (int b = 0; b < 16; ++b) acc[b] += CS[(kg * 16 + b) * 64 + kk] * w;
                }
            }
#pragma unroll
            for (int b = 0; b < 16; ++b) RED[(kg * 64 + col) * 16 + b] = acc[b];
            __syncthreads();
            {
                const int bg = tid >> 6;
#pragma unroll
                for (int bb = 0; bb < 4; ++bb) {
                    const int b = bg * 4 + bb;
                    float s = RED[(0 * 64 + col) * 16 + b] + RED[(1 * 64 + col) * 16 + b] + RED[(2 * 64 + col) * 16 + b] + RED[(3 * 64 + col) * 16 + b];
                    mod[((size_t)l * 16 + b) * 6144 + j0 + col] = s + P.in[I_ADAB][l * 6144 + j0 + col];
                }
            }
            __syncthreads();
        } else {
            for (int e = tid; e < 1024; e += NT) {
                float x[4], mx = -1e30f;
#pragma unroll
                for (int l = 0; l < 4; ++l) { x[l] = P.in[I_HGLB][l * 1024 + e]; mx = fmaxf(mx, x[l]); }
                float s = 0.f;
#pragma unroll
                for (int l = 0; l < 4; ++l) { x[l] = __expf(x[l] - mx); s += x[l]; }
                const float inv = rcpf_(s);
                float cum = 0.f;
                lbo[0 * 1024 + e] = 0.f;
#pragma unroll
                for (int l = 1; l < 4; ++l) { cum += x[l] * inv; lbo[l * 1024 + e] = fminf(fmaxf(cum, 0.f), 1.f); }
            }
        }
    }
}

__device__ __forceinline__ void tr_tile(const float* __restrict__ src, int ld, int N, int k0, int n0, bf16_t* __restrict__ dst, int dld, int drow0, bool winmap, char* lds) {
    float* Tl = (float*)lds;
    const int tid = tid_();
    __syncthreads();
#pragma unroll
    for (int i = 0; i < 4; ++i) {
        const int kk = (tid >> 4) + 16 * i, nn = (tid & 15) * 4;
        f32x4 v = (f32x4){0.f, 0.f, 0.f, 0.f};
        if (n0 + nn < N) v = *(const f32x4*)(src + (size_t)(k0 + kk) * ld + n0 + nn);
        Tl[kk * 65 + nn] = v[0]; Tl[kk * 65 + nn + 1] = v[1]; Tl[kk * 65 + nn + 2] = v[2]; Tl[kk * 65 + nn + 3] = v[3];
    }
    __syncthreads();
    {
        const int nn = tid >> 2, kb = (tid & 3) * 16;
        if (n0 + nn < N) {
            int drow = drow0 + nn;
            if (winmap) { const int n = n0 + nn; drow = n + (n >= 3344 ? 112 : 0); }
            unsigned w[8];
#pragma unroll
            for (int j = 0; j < 8; ++j) w[j] = pack2(Tl[(kb + 2 * j) * 65 + nn], Tl[(kb + 2 * j + 1) * 65 + nn]);
            u32x4* d = (u32x4*)(dst + (size_t)drow * dld + k0 + kb);
            d[0] = (u32x4){w[0], w[1], w[2], w[3]}; d[1] = (u32x4){w[4], w[5], w[6], w[7]};
        }
    }
}
__device__ void ph_wt(const Params& P, int l, char* lds) {
    char* ws = P.ws;
    const int NI = 2768 + 512 + 256 + 1408 + 704 + 16 + 16 + 16 + 16 + 16 + 7;
    for (int item = bid_(); item < NI; item += gridDim.x) {
        int it = item;
        if (it < 2768) { const int kt = it / 173, nt = it % 173;
            tr_tile(P.in[I_WIN] + (size_t)l * 1024 * 11024, 11024, 11024, kt * 64, nt * 64, (bf16_t*)(ws + WT_WIN), 1024, 0, true, lds); continue; }
        it -= 2768;
        if (it < 512) { const int n = it / 128, r = it % 128, kt = r / 16, nt = r % 16;
            tr_tile(P.in[I_WBR] + ((size_t)l * 4 + n) * 512 * 1024, 1024, 1024, kt * 64, nt * 64, (bf16_t*)(ws + WT_WB) + (size_t)n * 1024 * 512, 512, nt * 64, false, lds); continue; }
        it -= 512;
        if (it < 256) { const int kt = it / 16, nt = it % 16;
            tr_tile(P.in[I_WOUT] + (size_t)l * 1024 * 1024, 1024, 1024, kt * 64, nt * 64, (bf16_t*)(ws + WT_WOUT), 1024, nt * 64, false, lds); continue; }
        it -= 256;
        if (it < 1408) { const int kt = it / 88, nt = it % 88;
            tr_tile(P.in[I_FUP] + (size_t)l * 1024 * 5632, 5632, 5632, kt * 64, nt * 64, (bf16_t*)(ws + WT_WUP), 1024, nt * 64, false, lds); continue; }
        it -= 1408;
        if (it < 704) { const int kt = it / 16, nt = it % 16;
            tr_tile(P.in[I_FDN] + (size_t)l * 2816 * 1024, 1024, 1024, kt * 64, nt * 64, (bf16_t*)(ws + WT_WDN), 2816, nt * 64, false, lds); continue; }
        it -= 704;
        if (it < 16) { const int kt = it / 8, nt = it % 8;
            tr_tile(P.in[I_G2] + (size_t)l * 128 * 512, 512, 512, kt * 64, nt * 64, (bf16_t*)(ws + WT_G2), 128, nt * 64, false, lds); continue; }
        it -= 16;
        if (it < 16) { const int d = it / 8, nt = it % 8;
            tr_tile(P.in[I_W2] + ((size_t)l * 2 + d) * 64 * 512, 512, 512, 0, nt * 64, (bf16_t*)(ws + WT_W2) + (size_t)d * 512 * 64, 64, nt * 64, false, lds); continue; }
        it -= 16;
        if (it < 16) { const int d = it / 8, nt = it % 8;
            tr_tile(P.in[I_A2] + ((size_t)l * 2 + d) * 64 * 512, 512, 512, 0, nt * 64, (bf16_t*)(ws + WT_A2) + (size_t)d * 512 * 64, 64, nt * 64, false, lds); continue; }
        it -= 16;
        if (it < 32) { const int mat = it / 16, d = (it % 16) / 8, g = it % 8;
            const float* src = P.in[mat ? I_LWX : I_LWA] + (((size_t)l * 2 + d) * 8 + g) * 64 * 64;
            tr_tile(src, 64, 64, 0, 0, (bf16_t*)(ws + WT_LRU) + (((size_t)d * 2 + mat) * 8 + g) * 64 * 64, 64, 0, false, lds); continue; }
        it -= 32;
        {
            u32x4* d = (u32x4*)((bf16_t*)(ws + WT_WIN) + (size_t)(3344 + it * 16) * 1024);
            for (int e = tid_(); e < 16 * 1024 / 8; e += NT) d[e] = (u32x4){0u, 0u, 0u, 0u};
        }
    }
}

__device__ void ph_norm(const Params& P, const float* __restrict__ g, const float* __restrict__ modl, int sh_off, int sc_off, bf16_t* __restrict__ dst, bool final_) {
    const int tid = tid_(), wid = tid >> 6, lane = tid & 63;
    for (int item = bid_(); item < TT / 4; item += gridDim.x) {
        const int row = item * 4 + wid, b = row >> 11;
        float* hr = P.out + (size_t)row * DM;
        f32x4 v[4]; float ss = 0.f;
#pragma unroll
        for (int i = 0; i < 4; ++i) { v[i] = *(const f32x4*)(hr + i * 256 + lane * 4); ss += v[i][0] * v[i][0] + v[i][1] * v[i][1] + v[i][2] * v[i][2] + v[i][3] * v[i][3]; }
        ss = wsum64(ss);
        const float rs = rsqrtf(ss * (1.f / DM) + 1e-6f);
#pragma unroll
        for (int i = 0; i < 4; ++i) {
            const int c = i * 256 + lane * 4;
            const f32x4 gv = *(const f32x4*)(g + c);
            if (final_) {
                *(f32x4*)(hr + c) = v[i] * rs * gv;
            } else {
                const f32x4 sc = *(const f32x4*)(modl + (size_t)b * 6144 + sc_off + c), sh = *(const f32x4*)(modl + (size_t)b * 6144 + sh_off + c);
                const f32x4 o = v[i] * rs * gv * (sc + 1.f) + sh;
                *(u32x2*)(dst + (size_t)row * DM + c) = (u32x2){pack2(o[0], o[1]), pack2(o[2], o[3])};
            }
        }
    }
}

__device__ __forceinline__ void store_tile_bf16(const f32x4 (&acc)[4][4], bf16_t* __restrict__ dst, long ld) {
    const int tid = tid_(), wid = tid >> 6, lane = tid & 63, wr = wid >> 1, wc = wid & 1, fr = lane & 15, fq = lane >> 4;
#pragma unroll
    for (int m = 0; m < 4; ++m)
#pragma unroll
        for (int n = 0; n < 4; ++n) {
            const f32x4 v = acc[m][n];
            *(u32x2*)(dst + (long)(wr * 64 + m * 16 + fr) * ld + wc * 64 + n * 16 + fq * 4) = (u32x2){pack2(v[0], v[1]), pack2(v[2], v[3])};
        }
}
__device__ __forceinline__ void resid_tile(const f32x4 (&acc)[4][4], float* __restrict__ h, int row0, int col0, const float* __restrict__ gate) {
    const int tid = tid_(), wid = tid >> 6, lane = tid & 63, wr = wid >> 1, wc = wid & 1, fr = lane & 15, fq = lane >> 4;
    const int b = row0 >> 11;
#pragma unroll
    for (int n = 0; n < 4; ++n) {
        const int col = col0 + wc * 64 + n * 16 + fq * 4;
        const f32x4 gv = *(const f32x4*)(gate + (size_t)b * 6144 + col);
#pragma unroll
        for (int m = 0; m < 4; ++m) {
            float* hp = h + (size_t)(row0 + wr * 64 + m * 16 + fr) * DM + col;
            const f32x4 o = *(const f32x4*)hp + gv * acc[m][n];
            *(f32x4*)hp = o;
        }
    }
}
__device__ void ph_gemm_p(const Params& P, char* lds) {
    const bf16_t* U = (const bf16_t*)(P.ws + OFF_U); const bf16_t* Wt = (const bf16_t*)(P.ws + WT_WIN);
    bf16_t* prw = (bf16_t*)(P.ws + OFF_PRW); bf16_t* prest = (bf16_t*)(P.ws + OFF_PREST);
    for (int item = bid_(); item < 256 * 55; item += gridDim.x) {
        const int mt = item / 55, nt = item % 55;
        f32x4 acc[4][4]; zero_acc(acc);
        gemm_acc(U + (size_t)mt * 128 * DM, DM, Wt + (size_t)nt * 128 * DM, DM, DM, acc, lds);
        if (nt < 14) store_tile_bf16(acc, prw + (size_t)mt * 128 * PRW_LD + nt * 128, PRW_LD);
        else store_tile_bf16(acc, prest + (size_t)mt * 128 * PREST_LD + (nt - 14) * 128, PREST_LD);
    }
}
__device__ void ph_gemm_merge(const Params& P, char* lds) {
    const bf16_t* U = (const bf16_t*)(P.ws + OFF_URE); const bf16_t* Wt = (const bf16_t*)(P.ws + WT_WIN); const bf16_t* Wb = (const bf16_t*)(P.ws + WT_WB);
    bf16_t* mg = (bf16_t*)(P.ws + OFF_MERGED);
    for (int item = bid_(); item < 256 * 8; item += gridDim.x) {
        const int mt = item / 8, nt = item % 8;
        unsigned mpk[4][4][2];
#pragma unroll
        for (int m = 0; m < 4; ++m)
#pragma unroll
            for (int q = 0; q < 4; ++q) { mpk[m][q][0] = 0u; mpk[m][q][1] = 0u; }
#pragma unroll 1
        for (int n = 0; n < 4; ++n) {
            unsigned gpk[4][4][2];
            {
                f32x4 acc[4][4]; zero_acc(acc);
                gemm_acc(U + (size_t)mt * 128 * DM, DM, Wt + (size_t)(GATE_ROW0 + n * 1024 + nt * 128) * DM, DM, DM, acc, lds);
#pragma unroll
                for (int m = 0; m < 4; ++m)
#pragma unroll
                    for (int q = 0; q < 4; ++q) { gpk[m][q][0] = pack2(sigm(acc[m][q][0]), sigm(acc[m][q][1])); gpk[m][q][1] = pack2(sigm(acc[m][q][2]), sigm(acc[m][q][3])); }
            }
            const size_t yoff = (n == 0) ? OFF_Y0 : (n == 1 ? OFF_YB : (n == 2 ? OFF_YC : OFF_YD));
            const bf16_t* Y = (const bf16_t*)(P.ws + yoff);
            f32x4 acc[4][4]; zero_acc(acc);
            gemm_acc(Y + (size_t)mt * 128 * 512, 512, Wb + ((size_t)n * 1024 + nt * 128) * 512, 512, 512, acc, lds);
#pragma unroll
            for (int m = 0; m < 4; ++m)
#pragma unroll
                for (int q = 0; q < 4; ++q) {
                    mpk[m][q][0] = pack2(lo2f(mpk[m][q][0]) + lo2f(gpk[m][q][0]) * acc[m][q][0], hi2f(mpk[m][q][0]) + hi2f(gpk[m][q][0]) * acc[m][q][1]);
                    mpk[m][q][1] = pack2(lo2f(mpk[m][q][1]) + lo2f(gpk[m][q][1]) * acc[m][q][2], hi2f(mpk[m][q][1]) + hi2f(gpk[m][q][1]) * acc[m][q][3]);
                }
        }
        {
            const int tid = tid_(), wid = tid >> 6, lane = tid & 63, wr = wid >> 1, wc = wid & 1, fr = lane & 15, fq = lane >> 4;
            bf16_t* dst = mg + (size_t)mt * 128 * DM + nt * 128;
#pragma unroll
            for (int m = 0; m < 4; ++m)
#pragma unroll
                for (int q = 0; q < 4; ++q) *(u32x2*)(dst + (long)(wr * 64 + m * 16 + fr) * DM + wc * 64 + q * 16 + fq * 4) = (u32x2){mpk[m][q][0], mpk[m][q][1]};
        }
    }
}
__device__ void ph_gemm_out(const Params& P, int l, char* lds) {
    const bf16_t* A = (const bf16_t*)(P.ws + OFF_MERGED); const bf16_t* Wt = (const bf16_t*)(P.ws + WT_WOUT);
    const float* gate = (const float*)(P.ws + OFF_MOD) + (size_t)l * 16 * 6144 + 2048;
    for (int item = bid_(); item < 256 * 8; item += gridDim.x) {
        const int mt = item / 8, nt = item % 8;
        f32x4 acc[4][4]; zero_acc(acc);
        gemm_acc(A + (size_t)mt * 128 * DM, DM, Wt + (size_t)nt * 128 * DM, DM, DM, acc, lds);
        resid_tile(acc, P.out, mt * 128, nt * 128, gate);
    }
}
__device__ void ph_gemm_up(const Params& P, char* lds) {
    const bf16_t* A = (const bf16_t*)(P.ws + OFF_U2); const bf16_t* Wt = (const bf16_t*)(P.ws + WT_WUP);
    bf16_t* Z = (bf16_t*)(P.ws + OFF_Z);
    for (int item = bid_(); item < 256 * 44; item += gridDim.x) {
        const int mt = item / 44, nt = item % 44;
        f32x4 acc[4][4]; zero_acc(acc);
        gemm_acc(A + (size_t)mt * 128 * DM, DM, Wt + (size_t)nt * 128 * DM, DM, DM, acc, lds);
        store_tile_bf16(acc, Z + (size_t)mt * 128 * 5632 + nt * 128, 5632);
    }
}
__device__ void ph_gemm_down(const Params& P, int l, char* lds) {
    const bf16_t* A = (const bf16_t*)(P.ws + OFF_ACT); const bf16_t* Wt = (const bf16_t*)(P.ws + WT_WDN);
    const float* gate = (const float*)(P.ws + OFF_MOD) + (size_t)l * 16 * 6144 + 5120;
    for (int item = bid_(); item < 256 * 8; item += gridDim.x) {
        const int mt = item / 8, nt = item % 8;
        f32x4 acc[4][4]; zero_acc(acc);
        gemm_acc(A + (size_t)mt * 128 * DFF, DFF, Wt + (size_t)nt * 128 * DFF, DFF, DFF, acc, lds);
        resid_tile(acc, P.out, mt * 128, nt * 128, gate);
    }
}
__device__ void ph_convact(const Params& P, int l) {
    const bf16_t* Z = (const bf16_t*)(P.ws + OFF_Z); bf16_t* ACT = (bf16_t*)(P.ws + OFF_ACT);
    const float* cw = P.in[I_FCW] + (size_t)l * 3 * 5632; const float* cb = P.in[I_FCB] + (size_t)l * 5632;
    const long ntask = (long)(TT / 64) * 352;
    for (long task = (long)bid_() * NT + tid_(); task < ntask; task += (long)gridDim.x * NT) {
        const int tile = (int)(task / 352), cgp = (int)(task % 352), c0 = cgp * 8;
        const int t0 = tile * 64, s0 = t0 & (SQ - 1);
        float wv[3][8], wg[3][8], bv[8], bg[8];
#pragma unroll
        for (int j = 0; j < 3; ++j)
#pragma unroll
            for (int e = 0; e < 8; ++e) { wv[j][e] = cw[j * 5632 + c0 + e]; wg[j][e] = cw[j * 5632 + DFF + c0 + e]; }
#pragma unroll
        for (int e = 0; e < 8; ++e) { bv[e] = cb[c0 + e]; bg[e] = cb[DFF + c0 + e]; }
        float pv[8], pg[8], cv[8], cg_[8], nv[8], ng[8];
        const u32x4 zero4 = (u32x4){0u, 0u, 0u, 0u};
        {
            u32x4 a = zero4, b = zero4;
            if (s0 > 0) { a = *(const u32x4*)(Z + (size_t)(t0 - 1) * 5632 + c0); b = *(const u32x4*)(Z + (size_t)(t0 - 1) * 5632 + DFF + c0); }
            unpack8(a, pv); unpack8(b, pg);
            a = *(const u32x4*)(Z + (size_t)t0 * 5632 + c0); b = *(const u32x4*)(Z + (size_t)t0 * 5632 + DFF + c0);
            unpack8(a, cv); unpack8(b, cg_);
        }
        for (int r = 0; r < 64; ++r) {
            const int t = t0 + r;
            u32x4 a = zero4, b = zero4;
            if (s0 + r + 1 < SQ) { a = *(const u32x4*)(Z + (size_t)(t + 1) * 5632 + c0); b = *(const u32x4*)(Z + (size_t)(t + 1) * 5632 + DFF + c0); }
            unpack8(a, nv); unpack8(b, ng);
            float o[8];
#pragma unroll
            for (int e = 0; e < 8; ++e) {
                const float v = wv[0][e] * pv[e] + wv[1][e] * cv[e] + wv[2][e] * nv[e] + bv[e];
                const float g = wg[0][e] * pg[e] + wg[1][e] * cg_[e] + wg[2][e] * ng[e] + bg[e];
                o[e] = v * silu(g);
                pv[e] = cv[e]; cv[e] = nv[e]; pg[e] = cg_[e]; cg_[e] = ng[e];
            }
            *(u32x4*)(ACT + (size_t)t * DFF + c0) = (u32x4){pack2(o[0], o[1]), pack2(o[2], o[3]), pack2(o[4], o[5]), pack2(o[6], o[7])};
        }
    }
}

__device__ void mx_rwkv(const Params& P, int l, int item, char* lds) {
    const int tid = tid_(), wid = tid >> 6, lane = tid & 63, fr = lane & 15, fq = lane >> 4;
    const int d = item & 1, h = (item >> 1) & 7, b = item >> 4;
    const bf16_t* prw = (const bf16_t*)(P.ws + OFF_PRW) + (size_t)b * SQ * PRW_LD;
    bf16_t* Yd = (bf16_t*)(P.ws + (d ? OFF_Y1 : OFF_Y0)) + (size_t)b * SQ * 512 + h * 64;
    float* beta = (float*)(P.ws + OFF_BETA) + ((size_t)d * TT + (size_t)b * SQ) * 8 + h;
    float* VA = (float*)lds; float* VWR = VA + 1024; float* VW = VWR + 1024; float* VB = VW + 1024; float* VK = VB + 1024; float* VV = VK + 1024; float* VG = VV + 1024;
    float* SC = VG + 1024;
    bf16_t* RAW = (bf16_t*)(SC + 32);
    bf16_t* AT = RAW + 18 * 320;
    const int s = tid >> 4, jg = tid & 15, j0 = jg * 4;
    float mu[5][4], kkc[4], kac[4], rkc[4];
#pragma unroll
    for (int sg = 0; sg < 5; ++sg) {
        const int base = (sg < 3) ? sg * 512 + h * 64 : 1536 + (sg - 3) * 64;
#pragma unroll
        for (int i = 0; i < 4; ++i) mu[sg][i] = P.in[I_MU][l * 1792 + base + j0 + i];
    }
#pragma unroll
    for (int i = 0; i < 4; ++i) { kkc[i] = P.in[I_KK][l * 512 + h * 64 + j0 + i]; kac[i] = P.in[I_KA][l * 512 + h * 64 + j0 + i]; rkc[i] = P.in[I_RK][l * 512 + h * 64 + j0 + i]; }
    const int mt = wid >> 1, ntb = (wid & 1) * 2;
    bf16x8 bw[2][2]; float bsv[2][4];
    {
        const bf16_t* WT2 = (const bf16_t*)(P.ws + (mt ? WT_A2 : WT_W2)) + (size_t)d * 512 * 64;
        const float* bias = P.in[mt ? I_A0 : I_W0] + (size_t)(l * 2 + d) * 512 + h * 64;
#pragma unroll
        for (int nt = 0; nt < 2; ++nt) {
#pragma unroll
            for (int ks = 0; ks < 2; ++ks) bw[nt][ks] = ldfrag(WT2 + (size_t)(h * 64 + (ntb + nt) * 16 + fr) * 64 + ks * 32 + fq * 8);
#pragma unroll
            for (int jj = 0; jj < 4; ++jj) bsv[nt][jj] = bias[(ntb + nt) * 16 + fq * 4 + jj];
        }
    }
    float S[4][4];
#pragma unroll
    for (int i = 0; i < 4; ++i)
#pragma unroll
        for (int j = 0; j < 4; ++j) S[i][j] = 0.f;
    u32x4 pre[3];
    auto load_raw = [&](int c) {
        const int t0 = d ? SQ - 16 * (c + 1) : 16 * c;
#pragma unroll
        for (int i = 0; i < 3; ++i) {
            const int vi = tid + 256 * i;
            pre[i] = (u32x4){0u, 0u, 0u, 0u};
            if (vi < 720) {
                const int rr = vi / 40, rem = vi % 40, sg = rem >> 3, e = rem & 7, t = t0 - 1 + rr;
                const int col = ((sg < 3) ? sg * 512 + h * 64 : 1536 + (sg - 3) * 64) + e * 8;
                if (t >= 0 && t < SQ) pre[i] = *(const u32x4*)(prw + (size_t)t * PRW_LD + col);
            }
        }
    };
    __syncthreads();
    load_raw(0);
#pragma unroll 1
    for (int c = 0; c < 128; ++c) {
        const int t0 = d ? SQ - 16 * (c + 1) : 16 * c;
#pragma unroll
        for (int i = 0; i < 3; ++i) {
            const int vi = tid + 256 * i;
            if (vi < 720) { const int rr = vi / 40, rem = vi % 40; *(u32x4*)(RAW + rr * 320 + rem * 8) = pre[i]; }
        }
        __syncthreads();
        if (c + 1 < 128) load_raw(c + 1);
        float rs[4], ks_[4], vs[4], kk[4];
        {
            float sh[5][4];
#pragma unroll
            for (int sg = 0; sg < 5; ++sg) {
                float fm[4], f0[4], fp[4];
                unpack4(*(const u32x2*)(RAW + s * 320 + sg * 64 + j0), fm);
                unpack4(*(const u32x2*)(RAW + (s + 1) * 320 + sg * 64 + j0), f0);
                unpack4(*(const u32x2*)(RAW + (s + 2) * 320 + sg * 64 + j0), fp);
#pragma unroll
                for (int i = 0; i < 4; ++i) sh[sg][i] = f0[i] + mu[sg][i] * (0.5f * (fm[i] + fp[i]) - f0[i]);
            }
            float ssq = 0.f, q[4];
#pragma unroll
            for (int i = 0; i < 4; ++i) { rs[i] = sh[0][i]; ks_[i] = sh[1][i]; vs[i] = sh[2][i]; q[i] = ks_[i] * kkc[i]; ssq += q[i] * q[i]; }
            *(u32x2*)(AT + s * 72 + j0) = (u32x2){pack2(tanh_f(sh[3][0]), tanh_f(sh[3][1])), pack2(tanh_f(sh[3][2]), tanh_f(sh[3][3]))};
            *(u32x2*)(AT + 16 * 72 + s * 72 + j0) = (u32x2){pack2(sh[4][0], sh[4][1]), pack2(sh[4][2], sh[4][3])};
            ssq = rowsum16(ssq);
            const float inv = rsqrtf(fmaxf(ssq, 1e-24f));
#pragma unroll
            for (int i = 0; i < 4; ++i) kk[i] = q[i] * inv;
        }
        __syncthreads();
        {
            const bf16_t* At = AT + mt * 16 * 72;
            const bf16x8 a0 = ldfrag(At + fr * 72 + fq * 8), a1 = ldfrag(At + fr * 72 + 32 + fq * 8);
            float* dstv = mt ? VG : VW;
#pragma unroll
            for (int nt = 0; nt < 2; ++nt) {
                f32x4 acc = (f32x4){0.f, 0.f, 0.f, 0.f};
                acc = mfma16(bw[nt][0], a0, acc); acc = mfma16(bw[nt][1], a1, acc);
                f32x4 o;
#pragma unroll
                for (int jj = 0; jj < 4; ++jj) {
                    const float x = acc[jj] + bsv[nt][jj];
                    if (mt == 0) { const float wl = fminf(x, 0.f) - log1pf(__expf(-fabsf(x))) - 0.5f; o[jj] = __expf(-__expf(wl)); }
                    else o[jj] = sigm(x);
                }
                *(f32x4*)(dstv + fr * 64 + (ntb + nt) * 16 + fq * 4) = o;
            }
        }
        __syncthreads();
        {
            const f32x4 w4 = *(const f32x4*)(VW + s * 64 + j0), g4 = *(const f32x4*)(VG + s * 64 + j0);
            f32x4 bb, kt, wr, na, vv;
            float pbr = 0.f, pkr = 0.f, pbe = 0.f;
#pragma unroll
            for (int i = 0; i < 4; ++i) {
                bb[i] = kk[i] * g4[i]; kt[i] = ks_[i] * (1.f + (g4[i] - 1.f) * kac[i]); wr[i] = w4[i] * rs[i]; na[i] = -kk[i]; vv[i] = vs[i];
                pbr += bb[i] * rs[i]; pkr += kt[i] * rs[i]; pbe += rs[i] * kt[i] * rkc[i];
            }
            pbr = rowsum16(pbr); pkr = rowsum16(pkr); pbe = rowsum16(pbe);
            *(f32x4*)(VA + s * 64 + j0) = na; *(f32x4*)(VWR + s * 64 + j0) = wr; *(f32x4*)(VB + s * 64 + j0) = bb; *(f32x4*)(VK + s * 64 + j0) = kt; *(f32x4*)(VV + s * 64 + j0) = vv;
            if (jg == 0) { SC[s * 2] = pbr; SC[s * 2 + 1] = pkr; beta[(size_t)(t0 + s) * 8] = pbe; }
        }
        __syncthreads();
#pragma unroll 1
        for (int st = 0; st < 16; ++st) {
            const int sp = d ? 15 - st : st;
            const f32x4 a4 = *(const f32x4*)(VA + sp * 64 + j0), wr4 = *(const f32x4*)(VWR + sp * 64 + j0), w4 = *(const f32x4*)(VW + sp * 64 + j0);
            const f32x4 b4 = *(const f32x4*)(VB + sp * 64 + j0), k4 = *(const f32x4*)(VK + sp * 64 + j0), v4 = *(const f32x4*)(VV + sp * 64 + s * 4);
            const float br = SC[sp * 2], kr = SC[sp * 2 + 1];
            float psa[4], py[4];
#pragma unroll
            for (int i = 0; i < 4; ++i) {
                psa[i] = S[i][0] * a4[0] + S[i][1] * a4[1] + S[i][2] * a4[2] + S[i][3] * a4[3];
                py[i] = S[i][0] * wr4[0] + S[i][1] * wr4[1] + S[i][2] * wr4[2] + S[i][3] * wr4[3];
            }
#pragma unroll
            for (int i = 0; i < 4; ++i) { psa[i] = rowsum16(psa[i]); py[i] = rowsum16(py[i]); }
            float y[4];
#pragma unroll
            for (int i = 0; i < 4; ++i) {
                y[i] = py[i] + psa[i] * br + v4[i] * kr;
#pragma unroll
                for (int j = 0; j < 4; ++j) S[i][j] = S[i][j] * w4[j] + (psa[i] * b4[j] + v4[i] * k4[j]);
            }
            if (jg == 0) *(u32x2*)(Yd + (size_t)(t0 + sp) * 512 + s * 4) = (u32x2){pack2(y[0], y[1]), pack2(y[2], y[3])};
        }
    }
    __syncthreads();
}

__device__ void mx_mlstm(const Params& P, int l, int item, char* lds) {
    const int tid = tid_(), wid = tid >> 6, lane = tid & 63, fr = lane & 15, fq = lane >> 4;
    const int b = item >> 2, h = item & 3;
    const bf16_t* pr = (const bf16_t*)(P.ws + OFF_PREST) + (size_t)b * SQ * PREST_LD;
    bf16_t* YB = (bf16_t*)(P.ws + OFF_YB) + (size_t)b * SQ * 512 + h * 128;
    bf16_t* Q = (bf16_t*)lds; bf16_t* KP = Q + 64 * 72; bf16_t* KWT = KP + 64 * 72; bf16_t* VT = KWT + 64 * 72; bf16_t* CT = VT + 128 * 72;
    float* NS = (float*)(CT + 128 * 72); float* E = NS + 64; float* MM = E + 64; float* SI = MM + 64; float* WI = SI + 64; float* FL = WI + 64; float* DEC = FL + 64;
    const int i = wid * 16 + fr;
#pragma unroll 1
    for (int d = 0; d < 2; ++d) {
        f32x4 Cacc[8];
#pragma unroll
        for (int dt = 0; dt < 8; ++dt) Cacc[dt] = (f32x4){0.f, 0.f, 0.f, 0.f};
        __syncthreads();
        for (int e = tid; e < 128 * 72 / 2; e += NT) ((unsigned*)CT)[e] = 0u;
        if (tid < 64) NS[tid] = 0.f;
        float m_st = 0.f;
        const float ib = P.in[I_MLIB][(l * 2 + d) * 4 + h], fb = P.in[I_MLFB][(l * 2 + d) * 4 + h];
        __syncthreads();
#pragma unroll 1
        for (int c = 0; c < 32; ++c) {
            const int t0 = d ? SQ - 64 * (c + 1) : 64 * c;
#define TROW(ii) (d ? t0 + 63 - (ii) : t0 + (ii))
            if (wid == 0) {
                const int t = TROW(lane);
                const float fg = bf2f(pr[(size_t)t * PREST_LD + 1544 + d * 4 + h]) + fb, ig = bf2f(pr[(size_t)t * PREST_LD + 1536 + d * 4 + h]) + ib;
                float bc = logsig(fg);
#pragma unroll
                for (int o = 1; o < 64; o <<= 1) { const float x = bperm(bc, lane - o); if (lane >= o) bc += x; }
                const float e = ig - bc; float pm = e;
#pragma unroll
                for (int o = 1; o < 64; o <<= 1) { const float x = bperm(pm, lane - o); if (lane >= o) pm = fmaxf(pm, x); }
                const float gend = rdlane(bc, 63), pmax = rdlane(pm, 63);
                const float mnew = fmaxf(gend + m_st, gend + pmax);
                const float M = fmaxf(m_st, pm);
                E[lane] = e; MM[lane] = M; SI[lane] = __expf(m_st - M); WI[lane] = __expf(gend + e - mnew); FL[lane] = __expf(-(bc + M));
                if (lane == 0) DEC[0] = __expf(gend + m_st - mnew);
                m_st = mnew;
            }
            __syncthreads();
#pragma unroll
            for (int it = 0; it < 2; ++it) {
                const int vi = tid + 256 * it, ii = vi >> 3, e = vi & 7, t = TROW(ii);
                float f[8];
                unpack8(*(const u32x4*)(pr + (size_t)t * PREST_LD + h * 64 + e * 8), f);
                *(u32x4*)(Q + ii * 72 + e * 8) = (u32x4){pack2(f[0] * 0.125f, f[1] * 0.125f), pack2(f[2] * 0.125f, f[3] * 0.125f), pack2(f[4] * 0.125f, f[5] * 0.125f), pack2(f[6] * 0.125f, f[7] * 0.125f)};
                const u32x4 kv = *(const u32x4*)(pr + (size_t)t * PREST_LD + 256 + h * 64 + e * 8);
                *(u32x4*)(KP + ii * 72 + e * 8) = kv;
                unpack8(kv, f);
                const float wi = WI[ii];
#pragma unroll
                for (int x = 0; x < 8; ++x) KWT[(e * 8 + x) * 72 + ii] = f2bf(f[x] * wi);
            }
#pragma unroll
            for (int it = 0; it < 4; ++it) {
                const int vi = tid + 256 * it, ii = vi >> 4, e = vi & 15, t = TROW(ii);
                const u32x4 vv = *(const u32x4*)(pr + (size_t)t * PREST_LD + 512 + h * 128 + e * 8);
                VT[(e * 8 + 0) * 72 + ii] = (bf16_t)(vv.x & 0xffff); VT[(e * 8 + 1) * 72 + ii] = (bf16_t)(vv.x >> 16);
                VT[(e * 8 + 2) * 72 + ii] = (bf16_t)(vv.y & 0xffff); VT[(e * 8 + 3) * 72 + ii] = (bf16_t)(vv.y >> 16);
                VT[(e * 8 + 4) * 72 + ii] = (bf16_t)(vv.z & 0xffff); VT[(e * 8 + 5) * 72 + ii] = (bf16_t)(vv.z >> 16);
                VT[(e * 8 + 6) * 72 + ii] = (bf16_t)(vv.w & 0xffff); VT[(e * 8 + 7) * 72 + ii] = (bf16_t)(vv.w >> 16);
            }
            __syncthreads();
            f32x4 sacc[4];
#pragma unroll
            for (int st = 0; st < 4; ++st) sacc[st] = (f32x4){0.f, 0.f, 0.f, 0.f};
#pragma unroll
            for (int ks = 0; ks < 2; ++ks) {
                const bf16x8 qf = ldfrag(Q + i * 72 + ks * 32 + fq * 8);
#pragma unroll
                for (int st = 0; st < 4; ++st) sacc[st] = mfma16(ldfrag(KP + (st * 16 + fr) * 72 + ks * 32 + fq * 8), qf, sacc[st]);
            }
            const float Mi = MM[i], si = SI[i];
            float rsum = 0.f; unsigned pwp[4][2];
#pragma unroll
            for (int st = 0; st < 4; ++st) {
                float pw[4];
#pragma unroll
                for (int jj = 0; jj < 4; ++jj) { const int sx = st * 16 + fq * 4 + jj; pw[jj] = (sx <= i) ? __expf(E[sx] - Mi) * sacc[st][jj] : 0.f; rsum += pw[jj]; }
                pwp[st][0] = pack2(pw[0], pw[1]); pwp[st][1] = pack2(pw[2], pw[3]);
            }
            rsum = qsum(rsum, lane);
            float qn = 0.f;
            {
                float f[8];
                unpack8(*(const u32x4*)(Q + i * 72 + fq * 16), f);
#pragma unroll
                for (int x = 0; x < 8; ++x) qn += f[x] * NS[fq * 16 + x];
                unpack8(*(const u32x4*)(Q + i * 72 + fq * 16 + 8), f);
#pragma unroll
                for (int x = 0; x < 8; ++x) qn += f[x] * NS[fq * 16 + 8 + x];
            }
            qn = qsum(qn, lane);
            const float den = si * qn + rsum;
            const float rinv = rcpf_(fmaxf(fabsf(den), FL[i]));
            __syncthreads();
#pragma unroll
            for (int st = 0; st < 4; ++st) *(u32x2*)(KP + i * 72 + st * 16 + fq * 4) = (u32x2){pwp[st][0], pwp[st][1]};
            __syncthreads();
            f32x4 oacc[8];
#pragma unroll
            for (int dt = 0; dt < 8; ++dt) oacc[dt] = (f32x4){0.f, 0.f, 0.f, 0.f};
#pragma unroll
            for (int ks = 0; ks < 2; ++ks) {
                const bf16x8 qf = ldfrag(Q + i * 72 + ks * 32 + fq * 8);
#pragma unroll
                for (int dt = 0; dt < 8; ++dt) oacc[dt] = mfma16(ldfrag(CT + (dt * 16 + fr) * 72 + ks * 32 + fq * 8), qf, oacc[dt]);
            }
#pragma unroll
            for (int dt = 0; dt < 8; ++dt) oacc[dt] *= si;
#pragma unroll
            for (int ks = 0; ks < 2; ++ks) {
                const bf16x8 pf = ldfrag(KP + i * 72 + ks * 32 + fq * 8);
#pragma unroll
                for (int dt = 0; dt < 8; ++dt) oacc[dt] = mfma16(ldfrag(VT + (dt * 16 + fr) * 72 + ks * 32 + fq * 8), pf, oacc[dt]);
            }
            {
                const int t = TROW(i);
                bf16_t* yp = YB + (size_t)t * 512 + fq * 4;
                if (d == 0) {
#pragma unroll
                    for (int dt = 0; dt < 8; ++dt) { const f32x4 v = oacc[dt] * rinv; *(u32x2*)(yp + dt * 16) = (u32x2){pack2(v[0], v[1]), pack2(v[2], v[3])}; }
                } else {
                    float ssq = 0.f;
#pragma unroll
                    for (int dt = 0; dt < 8; ++dt) {
                        float pv[4]; unpack4(*(const u32x2*)(yp + dt * 16), pv);
#pragma unroll
                        for (int jj = 0; jj < 4; ++jj) { const float v = oacc[dt][jj] * rinv + pv[jj]; oacc[dt][jj] = v; ssq += v * v; }
                    }
                    ssq = qsum(ssq, lane);
                    const float rms = rsqrtf(ssq * (1.f / 128.f) + 1e-6f);
#pragma unroll
                    for (int dt = 0; dt < 8; ++dt) {
                        const int dv = dt * 16 + fq * 4;
                        const f32x4 ng = *(const f32x4*)(P.in[I_MLN] + l * 512 + h * 128 + dv);
                        float og[4]; unpack4(*(const u32x2*)(pr + (size_t)t * PREST_LD + 1024 + h * 128 + dv), og);
                        float o[4];
#pragma unroll
                        for (int jj = 0; jj < 4; ++jj) o[jj] = oacc[dt][jj] * rms * ng[jj] * sigm(og[jj]);
                        *(u32x2*)(yp + dt * 16) = (u32x2){pack2(o[0], o[1]), pack2(o[2], o[3])};
                    }
                }
            }
            __syncthreads();
            {
                const float dec = DEC[0];
#pragma unroll
                for (int dt = 0; dt < 8; ++dt) Cacc[dt] *= dec;
#pragma unroll
                for (int ks = 0; ks < 2; ++ks) {
                    const bf16x8 kf = ldfrag(KWT + (wid * 16 + fr) * 72 + ks * 32 + fq * 8);
#pragma unroll
                    for (int dt = 0; dt < 8; ++dt) Cacc[dt] = mfma16(kf, ldfrag(VT + (dt * 16 + fr) * 72 + ks * 32 + fq * 8), Cacc[dt]);
                }
#pragma unroll
                for (int dt = 0; dt < 8; ++dt) *(u32x2*)(CT + (dt * 16 + fr) * 72 + wid * 16 + fq * 4) = (u32x2){pack2(Cacc[dt][0], Cacc[dt][1]), pack2(Cacc[dt][2], Cacc[dt][3])};
                if (tid < 64) {
                    float n = dec * NS[tid];
#pragma unroll
                    for (int x = 0; x < 8; ++x) { float f[8]; unpack8(*(const u32x4*)(KWT + tid * 72 + x * 8), f); n += ((f[0] + f[1]) + (f[2] + f[3])) + ((f[4] + f[5]) + (f[6] + f[7])); }
                    NS[tid] = n;
                }
            }
            __syncthreads();
        }
    }
}

__device__ void mx_hgrn(const Params& P, int l, int item, char* lds) {
    const int tid = tid_(), wid = tid >> 6, lane = tid & 63, fr = lane & 15, fq = lane >> 4;
    const int b = item >> 3, h = (item >> 1) & 3, half = item & 1;
    const bf16_t* pr = (const bf16_t*)(P.ws + OFF_PREST) + (size_t)b * SQ * PREST_LD + HG_O;
    bf16_t* YD = (bf16_t*)(P.ws + OFF_YD) + (size_t)b * SQ * 512 + h * 128 + half * 64;
    bf16_t* QT = (bf16_t*)lds; bf16_t* KT = QT + 64 * 136; bf16_t* ATT = KT + 128 * 72; bf16_t* VT = ATT + 64 * 72; bf16_t* ST = VT + 64 * 72;
    float* TOT = (float*)(ST + 64 * 136);
    const int dk = tid & 127, hf = tid >> 7;
    const int i = wid * 16 + fr;
#pragma unroll 1
    for (int d = 0; d < 2; ++d) {
        const float lbv = ((const float*)(P.ws + OFF_LB))[(l * 2 + d) * 512 + h * 128 + dk], oml = 1.f - lbv;
        f32x4 Sacc[2][4];
#pragma unroll
        for (int a = 0; a < 2; ++a)
#pragma unroll
            for (int dt = 0; dt < 4; ++dt) Sacc[a][dt] = (f32x4){0.f, 0.f, 0.f, 0.f};
        __syncthreads();
        for (int e = tid; e < 64 * 136 / 2; e += NT) ((unsigned*)ST)[e] = 0u;
        __syncthreads();
#pragma unroll 1
        for (int c = 0; c < 32; ++c) {
            const int t0 = d ? SQ - 64 * (c + 1) : 64 * c;
#pragma unroll
            for (int it = 0; it < 4; ++it) {
                const int vi = tid + 256 * it, ii = vi >> 4, e = vi & 15, t = TROW(ii);
                *(u32x4*)(KT + ii * 136 + e * 8) = *(const u32x4*)(pr + (size_t)t * PREST_LD + 512 * (1 + d) + h * 128 + e * 8);
                *(u32x4*)(QT + ii * 136 + e * 8) = *(const u32x4*)(pr + (size_t)t * PREST_LD + h * 128 + e * 8);
            }
#pragma unroll
            for (int it = 0; it < 2; ++it) {
                const int vi = tid + 256 * it, ii = vi >> 3, e = vi & 7, t = TROW(ii);
                const u32x4 vv = *(const u32x4*)(pr + (size_t)t * PREST_LD + 1536 + h * 128 + half * 64 + e * 8);
                VT[(e * 8 + 0) * 72 + ii] = (bf16_t)(vv.x & 0xffff); VT[(e * 8 + 1) * 72 + ii] = (bf16_t)(vv.x >> 16);
                VT[(e * 8 + 2) * 72 + ii] = (bf16_t)(vv.y & 0xffff); VT[(e * 8 + 3) * 72 + ii] = (bf16_t)(vv.y >> 16);
                VT[(e * 8 + 4) * 72 + ii] = (bf16_t)(vv.z & 0xffff); VT[(e * 8 + 5) * 72 + ii] = (bf16_t)(vv.z >> 16);
                VT[(e * 8 + 6) * 72 + ii] = (bf16_t)(vv.w & 0xffff); VT[(e * 8 + 7) * 72 + ii] = (bf16_t)(vv.w >> 16);
            }
            __syncthreads();
            bf16_t* kp = KT + hf * 32 * 136 + dk; bf16_t* qp = QT + hf * 32 * 136 + dk;
            {
                float run = 0.f;
#pragma unroll 8
                for (int r = 0; r < 32; ++r) run += __logf(lbv + oml * sigm(bf2f(kp[r * 136])));
                TOT[hf * 128 + dk] = run;
            }
            __syncthreads();
            const float R = TOT[dk], gmR = TOT[128 + dk];
            {
                float g = hf ? R : 0.f;
#pragma unroll 8
                for (int r = 0; r < 32; ++r) {
                    const float sg = sigm(bf2f(kp[r * 136]));
                    g += __logf(lbv + oml * sg);
                    const float e1 = __expf(fminf(g - R, 80.f));
                    qp[r * 136] = f2bf(silu(bf2f(qp[r * 136])) * e1);
                    kp[r * 136] = f2bf(oml * (1.f - sg) * __expf(fminf(R - g, 80.f)));
                }
                const float eR = __expf(R);
                bf16_t* sp = ST + hf * 32 * 136 + dk;
#pragma unroll 8
                for (int r = 0; r < 32; ++r) sp[r * 136] = f2bf(bf2f(sp[r * 136]) * eR);
            }
            __syncthreads();
            f32x4 oacc[4];
            unsigned kw[16];
            {
                f32x4 aacc[4];
#pragma unroll
                for (int st = 0; st < 4; ++st) { aacc[st] = (f32x4){0.f, 0.f, 0.f, 0.f}; oacc[st] = (f32x4){0.f, 0.f, 0.f, 0.f}; }
#pragma unroll
                for (int ks = 0; ks < 4; ++ks) {
                    const bf16x8 qf = ldfrag(QT + i * 136 + ks * 32 + fq * 8);
#pragma unroll
                    for (int st = 0; st < 4; ++st) aacc[st] = mfma16(ldfrag(KT + (st * 16 + fr) * 136 + ks * 32 + fq * 8), qf, aacc[st]);
#pragma unroll
                    for (int dt = 0; dt < 4; ++dt) oacc[dt] = mfma16(ldfrag(ST + (dt * 16 + fr) * 136 + ks * 32 + fq * 8), qf, oacc[dt]);
                }
#pragma unroll
                for (int st = 0; st < 4; ++st) {
                    float a[4];
#pragma unroll
                    for (int jj = 0; jj < 4; ++jj) a[jj] = (st * 16 + fq * 4 + jj <= i) ? aacc[st][jj] : 0.f;
                    *(u32x2*)(ATT + i * 72 + st * 16 + fq * 4) = (u32x2){pack2(a[0], a[1]), pack2(a[2], a[3])};
                }
#pragma unroll
                for (int r = 0; r < 16; ++r) kw[r] = (unsigned)kp[(2 * r) * 136] | ((unsigned)kp[(2 * r + 1) * 136] << 16);
            }
            __syncthreads();
            {
                u32x4* dst = (u32x4*)(KT + dk * 72 + hf * 32);
                dst[0] = (u32x4){kw[0], kw[1], kw[2], kw[3]}; dst[1] = (u32x4){kw[4], kw[5], kw[6], kw[7]};
                dst[2] = (u32x4){kw[8], kw[9], kw[10], kw[11]}; dst[3] = (u32x4){kw[12], kw[13], kw[14], kw[15]};
            }
            __syncthreads();
            {
#pragma unroll
                for (int ks = 0; ks < 2; ++ks) {
                    const bf16x8 af = ldfrag(ATT + i * 72 + ks * 32 + fq * 8);
#pragma unroll
                    for (int dt = 0; dt < 4; ++dt) oacc[dt] = mfma16(ldfrag(VT + (dt * 16 + fr) * 72 + ks * 32 + fq * 8), af, oacc[dt]);
                }
                const int t = TROW(i);
                bf16_t* yp = YD + (size_t)t * 512 + fq * 4;
#pragma unroll
                for (int dt = 0; dt < 4; ++dt) {
                    f32x4 v = oacc[dt];
                    if (d == 1) { float pv[4]; unpack4(*(const u32x2*)(yp + dt * 16), pv); v[0] += pv[0]; v[1] += pv[1]; v[2] += pv[2]; v[3] += pv[3]; }
                    *(u32x2*)(yp + dt * 16) = (u32x2){pack2(v[0], v[1]), pack2(v[2], v[3])};
                }
            }
#pragma unroll
            for (int a = 0; a < 2; ++a) {
                const int ktile = 2 * wid + a;
                f32x4 e1, e2;
#pragma unroll
                for (int jj = 0; jj < 4; ++jj) { const int dkk = ktile * 16 + fq * 4 + jj; e1[jj] = __expf(TOT[dkk]); e2[jj] = __expf(TOT[128 + dkk]); }
#pragma unroll
                for (int dt = 0; dt < 4; ++dt) Sacc[a][dt] *= e1;
#pragma unroll
                for (int ks = 0; ks < 2; ++ks) {
                    const bf16x8 kf = ldfrag(KT + (ktile * 16 + fr) * 72 + ks * 32 + fq * 8);
#pragma unroll
                    for (int dt = 0; dt < 4; ++dt) Sacc[a][dt] = mfma16(kf, ldfrag(VT + (dt * 16 + fr) * 72 + ks * 32 + fq * 8), Sacc[a][dt]);
                }
#pragma unroll
                for (int dt = 0; dt < 4; ++dt) {
                    Sacc[a][dt] *= e2;
                    *(u32x2*)(ST + (dt * 16 + fr) * 136 + ktile * 16 + fq * 4) = (u32x2){pack2(Sacc[a][dt][0], Sacc[a][dt][1]), pack2(Sacc[a][dt][2], Sacc[a][dt][3])};
                }
            }
            __syncthreads();
        }
    }
}

__device__ void mx_lru(const Params& P, int l, int item, char* lds) {
    const int tid = tid_(), wid = tid >> 6, lane = tid & 63, fr = lane & 15, fq = lane >> 4;
    const int b = item >> 3, g = item & 7;
    const bf16_t* pr = (const bf16_t*)(P.ws + OFF_PREST) + (size_t)b * SQ * PREST_LD + LRU_O;
    bf16_t* YC = (bf16_t*)(P.ws + OFF_YC) + (size_t)b * SQ * 512 + g * 64;
    bf16_t* XC = (bf16_t*)lds; float* AA = (float*)(lds + 9216); float* BB = AA + 64 * 65;
    const int ch = tid & 63, tq = tid >> 6;
    float cwv[4];
#pragma unroll
    for (int j = 0; j < 4; ++j) cwv[j] = P.in[I_LCW][(l * 4 + j) * 512 + g * 64 + ch];
    const float cbv = P.in[I_LCB][l * 512 + g * 64 + ch];
    const int i = wid * 16 + fr;
#pragma unroll 1
    for (int d = 0; d < 2; ++d) {
        bf16x8 waf[4][2], wxf[4][2]; f32x4 ba4[4], bx4[4], c8[4];
        {
            const bf16_t* Wa = (const bf16_t*)(P.ws + WT_LRU) + (((size_t)d * 2 + 0) * 8 + g) * 4096;
            const bf16_t* Wx = (const bf16_t*)(P.ws + WT_LRU) + (((size_t)d * 2 + 1) * 8 + g) * 4096;
#pragma unroll
            for (int jt = 0; jt < 4; ++jt) {
#pragma unroll
                for (int ks = 0; ks < 2; ++ks) { waf[jt][ks] = ldfrag(Wa + (jt * 16 + fr) * 64 + ks * 32 + fq * 8); wxf[jt][ks] = ldfrag(Wx + (jt * 16 + fr) * 64 + ks * 32 + fq * 8); }
                const int j = (l * 2 + d) * 512 + g * 64 + jt * 16 + fq * 4;
                ba4[jt] = *(const f32x4*)(P.in[I_LBA] + j); bx4[jt] = *(const f32x4*)(P.in[I_LBX] + j);
                const f32x4 lam = *(const f32x4*)(P.in[I_LLAM] + j);
#pragma unroll
                for (int jj = 0; jj < 4; ++jj) c8[jt][jj] = -8.f * (fmaxf(-lam[jj], 0.f) + log1pf(__expf(-fabsf(lam[jj]))));
            }
        }
        float hst = 0.f;
#pragma unroll 1
        for (int c = 0; c < 32; ++c) {
            const int t0 = d ? SQ - 64 * (c + 1) : 64 * c;
            {
                float xw[19];
#pragma unroll
                for (int k = 0; k < 19; ++k) { const int t = t0 + tq * 16 - 1 + k; xw[k] = (t >= 0 && t < SQ) ? bf2f(pr[(size_t)t * PREST_LD + g * 64 + ch]) : 0.f; }
#pragma unroll
                for (int r = 0; r < 16; ++r) XC[(tq * 16 + r) * 72 + ch] = f2bf(cbv + cwv[0] * xw[r] + cwv[1] * xw[r + 1] + cwv[2] * xw[r + 2] + cwv[3] * xw[r + 3]);
            }
            __syncthreads();
            {
                f32x4 ra[4], rx[4];
#pragma unroll
                for (int jt = 0; jt < 4; ++jt) { ra[jt] = (f32x4){0.f, 0.f, 0.f, 0.f}; rx[jt] = (f32x4){0.f, 0.f, 0.f, 0.f}; }
#pragma unroll
                for (int ks = 0; ks < 2; ++ks) {
                    const bf16x8 xf = ldfrag(XC + i * 72 + ks * 32 + fq * 8);
#pragma unroll
                    for (int jt = 0; jt < 4; ++jt) { ra[jt] = mfma16(waf[jt][ks], xf, ra[jt]); rx[jt] = mfma16(wxf[jt][ks], xf, rx[jt]); }
                }
#pragma unroll
                for (int jt = 0; jt < 4; ++jt) {
                    float xc[4]; unpack4(*(const u32x2*)(XC + i * 72 + jt * 16 + fq * 4), xc);
#pragma unroll
                    for (int jj = 0; jj < 4; ++jj) {
                        const float la = c8[jt][jj] * sigm(ra[jt][jj] + ba4[jt][jj]);
                        const float mult = sqrtf(fmaxf(-expm1f(2.f * la), 0.f));
                        AA[i * 65 + jt * 16 + fq * 4 + jj] = __expf(la);
                        BB[i * 65 + jt * 16 + fq * 4 + jj] = mult * sigm(rx[jt][jj] + bx4[jt][jj]) * xc[jj];
                    }
                }
            }
            __syncthreads();
            if (tid < 64) {
#pragma unroll 8
                for (int rr = 0; rr < 64; ++rr) { const int r = d ? 63 - rr : rr; hst = AA[r * 65 + ch] * hst + BB[r * 65 + ch]; BB[r * 65 + ch] = hst; }
            }
            __syncthreads();
#pragma unroll 4
            for (int r = 0; r < 16; ++r) {
                const int ii = tq * 16 + r, t = t0 + ii;
                const float hv = BB[ii * 65 + ch];
                if (d == 0) YC[(size_t)t * 512 + ch] = f2bf(hv);
                else { const float prev = bf2f(YC[(size_t)t * 512 + ch]), gb = bf2f(pr[(size_t)t * PREST_LD + 512 + g * 64 + ch]); YC[(size_t)t * 512 + ch] = f2bf((prev + hv) * gelu_t(gb)); }
            }
        }
        __syncthreads();
    }
}

__device__ void dbg_zero(bf16_t* p, size_t n, int part, int nparts) {
    u32x4* q = (u32x4*)p; const size_t n8 = n / 8, per = (n8 + nparts - 1) / nparts, lo = per * part, hi = (lo + per < n8) ? lo + per : n8;
    for (size_t e = lo + tid_(); e < hi; e += NT) q[e] = (u32x4){0u, 0u, 0u, 0u};
}
__device__ void ph_mixers(const Params& P, int l, char* lds, int which) {
    for (int item = bid_(); item < 576; item += gridDim.x) {
        const bool isrw = (item >= 64 && item < 320);
        if (which == 0 && isrw) continue;
        if (which == 1 && !isrw) continue;
        if (item < 64) { if (DBG_SKIP & 2) dbg_zero((bf16_t*)(P.ws + OFF_YB), (size_t)TT * 512, item, 64); else mx_mlstm(P, l, item, lds); }
        else if (item < 320) { if (DBG_SKIP & 1) { dbg_zero((bf16_t*)(P.ws + OFF_Y0), (size_t)TT * 1024, item - 64, 256); dbg_zero((bf16_t*)(P.ws + OFF_BETA), (size_t)TT * 32, item - 64, 256); } else mx_rwkv(P, l, item - 64, lds); }
        else if (item < 448) { if (DBG_SKIP & 8) dbg_zero((bf16_t*)(P.ws + OFF_YD), (size_t)TT * 512, item - 320, 128); else mx_hgrn(P, l, item - 320, lds); }
        else { if (DBG_SKIP & 4) dbg_zero((bf16_t*)(P.ws + OFF_YC), (size_t)TT * 512, item - 448, 128); else mx_lru(P, l, item - 448, lds); }
        __syncthreads();
    }
}

__device__ void ph_rwpost(const Params& P, int l, char* lds) {
    const int tid = tid_(), wid = tid >> 6, lane = tid & 63, fr = lane & 15, fq = lane >> 4;
    bf16_t* SG = (bf16_t*)lds; float* STAT = (float*)(lds + 64 * 136 * 2);
    const bf16_t* G2T = (const bf16_t*)(P.ws + WT_G2);
    const float* mu = P.in[I_MU] + l * 1792;
    for (int item = bid_(); item < TT / 64; item += gridDim.x) {
        const int tok0 = item * 64, s0 = tok0 & (SQ - 1);
        const bf16_t* prw = (const bf16_t*)(P.ws + OFF_PRW);
        bf16_t* Y0 = (bf16_t*)(P.ws + OFF_Y0); const bf16_t* Y1 = (const bf16_t*)(P.ws + OFF_Y1);
        const float* be0 = (const float*)(P.ws + OFF_BETA); const float* be1 = be0 + (size_t)TT * 8;
        __syncthreads();
        {
            const int r = tid >> 2, part = tid & 3, t = tok0 + r, sp = s0 + r;
#pragma unroll
            for (int v = 0; v < 4; ++v) {
                const int c = part * 32 + v * 8;
                float f0[8], fm[8], fp[8];
                unpack8(*(const u32x4*)(prw + (size_t)t * PRW_LD + 1664 + c), f0);
                if (sp > 0) unpack8(*(const u32x4*)(prw + (size_t)(t - 1) * PRW_LD + 1664 + c), fm); else { for (int x = 0; x < 8; ++x) fm[x] = 0.f; }
                if (sp < SQ - 1) unpack8(*(const u32x4*)(prw + (size_t)(t + 1) * PRW_LD + 1664 + c), fp); else { for (int x = 0; x < 8; ++x) fp[x] = 0.f; }
                float o[8];
#pragma unroll
                for (int x = 0; x < 8; ++x) o[x] = sigm(f0[x] + mu[1664 + c + x] * (0.5f * (fm[x] + fp[x]) - f0[x]));
                *(u32x4*)(SG + r * 136 + c) = (u32x4){pack2(o[0], o[1]), pack2(o[2], o[3]), pack2(o[4], o[5]), pack2(o[6], o[7])};
            }
#pragma unroll
            for (int hh = 0; hh < 2; ++hh) {
                const int head = part * 2 + hh;
                float sm = 0.f, sq = 0.f;
#pragma unroll
                for (int v = 0; v < 8; ++v) {
                    float a[8], bq[8];
                    unpack8(*(const u32x4*)(Y0 + (size_t)t * 512 + head * 64 + v * 8), a); unpack8(*(const u32x4*)(Y1 + (size_t)t * 512 + head * 64 + v * 8), bq);
#pragma unroll
                    for (int x = 0; x < 8; ++x) { const float y = a[x] + bq[x]; sm += y; sq += y * y; }
                }
                const float mean = sm * (1.f / 64.f), var = fmaxf(sq * (1.f / 64.f) - mean * mean, 0.f);
                STAT[(r * 8 + head) * 2] = mean; STAT[(r * 8 + head) * 2 + 1] = rsqrtf(var + 64e-5f);
            }
        }
        __syncthreads();
#pragma unroll 1
        for (int np = 0; np < 4; ++np) {
            const int nt0 = wid * 8 + np * 2;
#pragma unroll 1
            for (int tt = 0; tt < 4; ++tt) {
                f32x4 acc[2];
                acc[0] = (f32x4){0.f, 0.f, 0.f, 0.f}; acc[1] = (f32x4){0.f, 0.f, 0.f, 0.f};
#pragma unroll
                for (int ks = 0; ks < 4; ++ks) {
                    const bf16x8 b0 = ldfrag(G2T + (size_t)(nt0 * 16 + fr) * 128 + ks * 32 + fq * 8), b1 = ldfrag(G2T + (size_t)((nt0 + 1) * 16 + fr) * 128 + ks * 32 + fq * 8);
                    const bf16x8 af = ldfrag(SG + (tt * 16 + fr) * 136 + ks * 32 + fq * 8);
                    acc[0] = mfma16(b0, af, acc[0]); acc[1] = mfma16(b1, af, acc[1]);
                }
#pragma unroll
                for (int q = 0; q < 2; ++q) {
                    const int r = tt * 16 + fr, t = tok0 + r, sp = s0 + r, n = (nt0 + q) * 16 + fq * 4, head = n >> 6;
                    float y0[4], y1[4], v0[4], vm[4], vp[4];
                    unpack4(*(const u32x2*)(Y0 + (size_t)t * 512 + n), y0); unpack4(*(const u32x2*)(Y1 + (size_t)t * 512 + n), y1);
                    unpack4(*(const u32x2*)(prw + (size_t)t * PRW_LD + 1024 + n), v0);
                    if (sp > 0) unpack4(*(const u32x2*)(prw + (size_t)(t - 1) * PRW_LD + 1024 + n), vm); else { vm[0] = vm[1] = vm[2] = vm[3] = 0.f; }
                    if (sp < SQ - 1) unpack4(*(const u32x2*)(prw + (size_t)(t + 1) * PRW_LD + 1024 + n), vp); else { vp[0] = vp[1] = vp[2] = vp[3] = 0.f; }
                    const float mean = STAT[(r * 8 + head) * 2], rstd = STAT[(r * 8 + head) * 2 + 1];
                    const float be = 0.5f * (be0[(size_t)t * 8 + head] + be1[(size_t)t * 8 + head]);
                    const f32x4 lw = *(const f32x4*)(P.in[I_LNW] + l * 512 + n), lb = *(const f32x4*)(P.in[I_LNB] + l * 512 + n), m4 = *(const f32x4*)(mu + 1024 + n);
                    float o[4];
#pragma unroll
                    for (int jj = 0; jj < 4; ++jj) {
                        const float vs = v0[jj] + m4[jj] * (0.5f * (vm[jj] + vp[jj]) - v0[jj]);
                        o[jj] = (((y0[jj] + y1[jj]) - mean) * rstd * lw[jj] + lb[jj] + be * vs) * acc[q][jj];
                    }
                    *(u32x2*)(Y0 + (size_t)t * 512 + n) = (u32x2){pack2(o[0], o[1]), pack2(o[2], o[3])};
                }
            }
        }
    }
    __syncthreads();
}
__device__ void ph_hgpost(const Params& P, int l) {
    const int tid = tid_();
    bf16_t* YD = (bf16_t*)(P.ws + OFF_YD); const bf16_t* pr = (const bf16_t*)(P.ws + OFF_PREST) + HG_O + 2048;
    for (int item = bid_(); item < TT / 64; item += gridDim.x) {
        const int t = item * 64 + (tid >> 2), part = tid & 3;
#pragma unroll 1
        for (int hh = 0; hh < 4; ++hh) {
            const int c0 = hh * 128 + part * 32;
            float v[32]; float ss = 0.f;
#pragma unroll
            for (int q = 0; q < 4; ++q) { float f[8]; unpack8(*(const u32x4*)(YD + (size_t)t * 512 + c0 + q * 8), f);
#pragma unroll
                for (int x = 0; x < 8; ++x) { v[q * 8 + x] = f[x]; ss += f[x] * f[x]; } }
            ss += dppf<0xB1>(ss); ss += dppf<0x4E>(ss);
            const float rms = rsqrtf(ss * (1.f / 128.f) + 1e-6f);
#pragma unroll
            for (int q = 0; q < 4; ++q) {
                float gq[8]; unpack8(*(const u32x4*)(pr + (size_t)t * PREST_LD + c0 + q * 8), gq);
                float o[8];
#pragma unroll
                for (int x = 0; x < 8; ++x) o[x] = silu(gq[x]) * v[q * 8 + x] * rms * P.in[I_HGN][l * 512 + c0 + q * 8 + x];
                *(u32x4*)(YD + (size_t)t * 512 + c0 + q * 8) = (u32x4){pack2(o[0], o[1]), pack2(o[2], o[3]), pack2(o[4], o[5]), pack2(o[6], o[7])};
            }
        }
    }
}

constexpr int N_PHASES = 2 + NL * 12;
__device__ void run_phase(const Params& P, int ph, char* lds) {
    if (ph == 0) { ph_init(P, lds); return; }
    if (ph == N_PHASES - 1) { ph_norm(P, P.in[I_FING], nullptr, 0, 0, nullptr, true); return; }
    const int l = (ph - 1) / 12; int sp = (ph - 1) % 12;
    const float* modl = (const float*)(P.ws + OFF_MOD) + (size_t)l * 16 * 6144;
    if (sp == 2) { ph_mixers(P, l, lds, 0); return; }
    if (sp == 3) { ph_mixers(P, l, lds, 1); return; }
    if (sp > 3) sp -= 1;
    switch (sp) {
        case 0: ph_wt(P, l, lds); ph_norm(P, P.in[I_N1G] + l * DM, modl, 0, 1024, (bf16_t*)(P.ws + OFF_U), false); break;
        case 1: ph_gemm_p(P, lds); break;
        case 3: ph_rwpost(P, l, lds); ph_hgpost(P, l); break;
        case 4: ph_norm(P, P.in[I_N1G] + l * DM, modl, 0, 1024, (bf16_t*)(P.ws + OFF_URE), false); break;
        case 5: ph_gemm_merge(P, lds); break;
        case 6: ph_gemm_out(P, l, lds); break;
        case 7: ph_norm(P, P.in[I_N2G] + l * DM, modl, 3072, 4096, (bf16_t*)(P.ws + OFF_U2), false); break;
        case 8: ph_gemm_up(P, lds); break;
        case 9: ph_convact(P, l); break;
        default: ph_gemm_down(P, l, lds); break;
    }
}

__global__ void __launch_bounds__(NT, 2) mega(Params P, int ph_lo, int ph_hi) {
    extern __shared__ __attribute__((aligned(16))) char smem[];
    cg::grid_group grid = cg::this_grid();
    for (int ph = ph_lo; ph < ph_hi; ++ph) {
        run_phase(P, ph, smem);
        if (ph + 1 < ph_hi) grid.sync();
    }
}

extern "C" void kernel_launch(void* const* d_in, const int* in_sizes, int n_in, void* d_out, int out_size, void* d_ws, size_t ws_size, hipStream_t stream) {
    static int grid_blocks = 0;
    if (grid_blocks == 0) {
        if (n_in != N_INPUTS || ws_size < WS_NEED || out_size != TT * DM) { fprintf(stderr, "kernel_launch: unexpected shapes (n_in %d ws %zu need %zu)\n", n_in, ws_size, (size_t)WS_NEED); grid_blocks = -1; return; }
        int dev = 0, cus = 0, per_cu = 0;
        hipGetDevice(&dev);
        hipDeviceGetAttribute(&cus, hipDeviceAttributeMultiprocessorCount, dev);
        if (hipFuncSetAttribute((const void*)mega, hipFuncAttributeMaxDynamicSharedMemorySize, LDS_BYTES) != hipSuccess) { fprintf(stderr, "kernel_launch: hipFuncSetAttribute failed\n"); grid_blocks = -1; return; }
        hipOccupancyMaxActiveBlocksPerMultiprocessor(&per_cu, (const void*)mega, NT, LDS_BYTES);
        if (per_cu < 1) per_cu = 1;
        if (per_cu > 2) per_cu = 2;
        grid_blocks = cus * per_cu;
    }
    if (grid_blocks < 0) return;
    Params p{};
    for (int i = 0; i < N_INPUTS; ++i) p.in[i] = (const float*)d_in[i];
    p.out = (float*)d_out; p.ws = (char*)d_ws;
#if MULTI_LAUNCH
    for (int ph = 0; ph < N_PHASES; ++ph) hipLaunchKernelGGL(mega, dim3(grid_blocks), dim3(NT), LDS_BYTES, stream, p, ph, ph + 1);
#else
    int lo = 0, hi = N_PHASES;
    void* args[] = {&p, &lo, &hi};
    hipError_t e = hipLaunchCooperativeKernel((const void*)mega, dim3(grid_blocks), dim3(NT), args, LDS_BYTES, stream);
    if (e != hipSuccess) fprintf(stderr, "cooperative launch failed: %s (grid %d)\n", hipGetErrorString(e), grid_blocks);
#endif
}
```

```cpp
#include <hip/hip_runtime.h>
#include <hip/hip_cooperative_groups.h>
#include <cstdio>
namespace cg = cooperative_groups;

typedef unsigned short bf16_t;
typedef short bf16x8 __attribute__((ext_vector_type(8)));
typedef float f32x4 __attribute__((ext_vector_type(4)));
typedef unsigned u32x4 __attribute__((ext_vector_type(4)));
typedef unsigned u32x2 __attribute__((ext_vector_type(2)));

#ifndef DBG_SKIP
#define DBG_SKIP 0
#endif
#ifndef DBG_NOFFN
#define DBG_NOFFN 0
#endif
#ifndef MULTI_LAUNCH
#define MULTI_LAUNCH 0
#endif

constexpr int NB = 16, SQ = 2048, DM = 1024, TT = NB * SQ, MW = 512, NL = 4;
constexpr int NT = 256;
constexpr int PRW_LD = 1792, PREST_LD = 5248;
constexpr int LRU_O = 1664, HG_O = 2688;
constexpr int GATE_ROW0 = 7040;
constexpr int DFF = 2816;
constexpr int LDS_BYTES = 73728;

constexpr size_t WT_WIN = 0;
constexpr size_t WT_WB = WT_WIN + (size_t)11136 * 1024 * 2;
constexpr size_t WT_WOUT = WT_WB + (size_t)4 * 1024 * 512 * 2;
constexpr size_t WT_WUP = WT_WOUT + (size_t)1024 * 1024 * 2;
constexpr size_t WT_WDN = WT_WUP + (size_t)5632 * 1024 * 2;
constexpr size_t WT_G2 = WT_WDN + (size_t)1024 * 2816 * 2;
constexpr size_t WT_W2 = WT_G2 + (size_t)512 * 128 * 2;
constexpr size_t WT_A2 = WT_W2 + (size_t)2 * 512 * 64 * 2;
constexpr size_t WT_LRU = WT_A2 + (size_t)2 * 512 * 64 * 2;
constexpr size_t WT_END = WT_LRU + (size_t)2 * 2 * 8 * 64 * 64 * 2;
constexpr size_t OFF_PRW = (size_t)48 << 20;
static_assert(WT_END <= OFF_PRW, "wt");
constexpr size_t OFF_PREST = OFF_PRW + (size_t)TT * PRW_LD * 2;
constexpr size_t OFF_Y = OFF_PREST + (size_t)TT * PREST_LD * 2;
constexpr size_t YSZ = (size_t)TT * 512 * 2;
constexpr size_t OFF_YB = OFF_Y, OFF_YC = OFF_Y + YSZ, OFF_YD = OFF_Y + 2 * YSZ, OFF_Y0 = OFF_Y + 3 * YSZ, OFF_Y1 = OFF_Y + 4 * YSZ;
constexpr size_t OFF_SMALL = OFF_Y + 5 * YSZ;
constexpr size_t OFF_MOD = OFF_SMALL;
constexpr size_t OFF_LB = OFF_MOD + (size_t)4 * 16 * 6144 * 4;
constexpr size_t OFF_BETA = OFF_LB + (size_t)4 * 2 * 512 * 4;
constexpr size_t OFF_BAR = OFF_BETA + (size_t)2 * TT * 8 * 4;
constexpr size_t BAR_BYTES = 16384;
constexpr size_t WS_NEED = OFF_BAR + BAR_BYTES;
constexpr size_t OFF_U = OFF_Y;
constexpr size_t OFF_URE = OFF_PREST;
constexpr size_t OFF_MERGED = OFF_PREST + (size_t)TT * 1024 * 2;
constexpr size_t OFF_U2 = OFF_Y;
constexpr size_t OFF_Z = OFF_PRW;
constexpr size_t OFF_ACT = OFF_PRW + (size_t)TT * 5632 * 2;
static_assert(OFF_ACT + (size_t)TT * 2816 * 2 <= OFF_SMALL, "act");

enum { I_X = 0, I_C, I_ADAW, I_ADAB, I_N1G, I_WIN, I_MU, I_W0, I_W2, I_A0, I_A2, I_G2, I_KK, I_KA, I_RK, I_LNW, I_LNB,
       I_MLIB, I_MLFB, I_MLN, I_LCW, I_LCB, I_LWA, I_LBA, I_LWX, I_LBX, I_LLAM, I_HGLB, I_HGN, I_WBR, I_WOUT, I_N2G,
       I_FUP, I_FCW, I_FCB, I_FDN, I_FING, N_INPUTS };

struct Params { const float* in[N_INPUTS]; float* out; char* ws; };

__device__ __forceinline__ int tid_() { int x = threadIdx.x; asm volatile("" : "+v"(x)); return x; }
__device__ __forceinline__ int bid_() { int x = blockIdx.x; asm volatile("" : "+s"(x)); return x; }
__device__ __forceinline__ bf16_t f2bf(float f) { unsigned u = __float_as_uint(f); u += 0x7fffu + ((u >> 16) & 1u); return (bf16_t)(u >> 16); }
__device__ __forceinline__ float bf2f(bf16_t h) { return __uint_as_float(((unsigned)h) << 16); }
__device__ __forceinline__ unsigned pack2(float a, float b) { return (unsigned)f2bf(a) | ((unsigned)f2bf(b) << 16); }
__device__ __forceinline__ float lo2f(unsigned u) { return __uint_as_float(u << 16); }
__device__ __forceinline__ float hi2f(unsigned u) { return __uint_as_float(u & 0xffff0000u); }
__device__ __forceinline__ float rcpf_(float x) { return __builtin_amdgcn_rcpf(x); }
__device__ __forceinline__ float sigm(float x) { return rcpf_(1.f + __expf(-x)); }
__device__ __forceinline__ float silu(float x) { return x * sigm(x); }
__device__ __forceinline__ float logsig(float x) { return fminf(x, 0.f) - log1pf(__expf(-fabsf(x))); }
__device__ __forceinline__ float tanh_f(float x) { return 1.f - 2.f * rcpf_(1.f + __expf(2.f * x)); }
__device__ __forceinline__ float gelu_t(float x) { return 0.5f * x * (1.f + tanh_f(0.7978845608f * (x + 0.044715f * x * x * x))); }
template <int CTRL> __device__ __forceinline__ float dppf(float x) { return __int_as_float(__builtin_amdgcn_update_dpp(0, __float_as_int(x), CTRL, 0xF, 0xF, false)); }
__device__ __forceinline__ float rowsum16(float x) { x += dppf<0x128>(x); x += dppf<0x124>(x); x += dppf<0x122>(x); x += dppf<0x121>(x); return x; }
__device__ __forceinline__ float rdlane(float x, int l) { return __int_as_float(__builtin_amdgcn_readlane(__float_as_int(x), l)); }
__device__ __forceinline__ float wsum64(float x) { x = rowsum16(x); return (rdlane(x, 0) + rdlane(x, 16)) + (rdlane(x, 32) + rdlane(x, 48)); }
__device__ __forceinline__ float bperm(float x, int srclane) { return __int_as_float(__builtin_amdgcn_ds_bpermute(srclane << 2, __float_as_int(x))); }
__device__ __forceinline__ float qsum(float x, int lane) { x += bperm(x, lane ^ 16); x += bperm(x, lane ^ 32); return x; }
__device__ __forceinline__ void unpack8(u32x4 v, float (&f)[8]) {
    f[0] = lo2f(v.x); f[1] = hi2f(v.x); f[2] = lo2f(v.y); f[3] = hi2f(v.y); f[4] = lo2f(v.z); f[5] = hi2f(v.z); f[6] = lo2f(v.w); f[7] = hi2f(v.w); }
__device__ __forceinline__ void unpack4(u32x2 v, float (&f)[4]) { f[0] = lo2f(v.x); f[1] = hi2f(v.x); f[2] = lo2f(v.y); f[3] = hi2f(v.y); }
__device__ __forceinline__ f32x4 mfma16(bf16x8 a, bf16x8 b, f32x4 c) { return __builtin_amdgcn_mfma_f32_16x16x32_bf16(a, b, c, 0, 0, 0); }
__device__ __forceinline__ bf16x8 ldfrag(const bf16_t* p) { return *reinterpret_cast<const bf16x8*>(p); }

__device__ __forceinline__ void gemm_stage(const bf16_t* __restrict__ A, long lda, const bf16_t* __restrict__ Bt, long ldb, int kt, char* buf, int tid) {
#pragma unroll
    for (int i = 0; i < 4; ++i) {
        const int b = tid * 16 + i * 4096, r = b >> 7, c = ((b & 127) >> 4) ^ (r & 7);
        __builtin_amdgcn_global_load_lds((const unsigned*)(A + (long)r * lda + kt * 64 + c * 8), (__attribute__((address_space(3))) unsigned*)(buf + b), 16, 0, 0);
        __builtin_amdgcn_global_load_lds((const unsigned*)(Bt + (long)r * ldb + kt * 64 + c * 8), (__attribute__((address_space(3))) unsigned*)(buf + 16384 + b), 16, 0, 0);
    }
}
__device__ __forceinline__ void gemm_acc(const bf16_t* __restrict__ A, long lda, const bf16_t* __restrict__ Bt, long ldb, int K, f32x4 (&acc)[4][4], char* lds) {
    const int tid = tid_(), wid = tid >> 6, lane = tid & 63, wr = wid >> 1, wc = wid & 1, fr = lane & 15, fq = lane >> 4;
    const int nk = K >> 6;
    gemm_stage(A, lda, Bt, ldb, 0, lds, tid);
    asm volatile("s_waitcnt vmcnt(0)" ::: "memory");
    __syncthreads();
    for (int kt = 0; kt < nk; ++kt) {
        char* cur = lds + (kt & 1) * 32768;
        if (kt + 1 < nk) gemm_stage(A, lda, Bt, ldb, kt + 1, lds + ((kt + 1) & 1) * 32768, tid);
#pragma unroll
        for (int ks = 0; ks < 2; ++ks) {
            bf16x8 af[4], bfr[4];
#pragma unroll
            for (int m = 0; m < 4; ++m) { const int row = wr * 64 + m * 16 + fr; af[m] = *reinterpret_cast<const bf16x8*>(cur + row * 128 + (((ks * 4 + fq) ^ (row & 7)) << 4)); }
#pragma unroll
            for (int n = 0; n < 4; ++n) { const int row = wc * 64 + n * 16 + fr; bfr[n] = *reinterpret_cast<const bf16x8*>(cur + 16384 + row * 128 + (((ks * 4 + fq) ^ (row & 7)) << 4)); }
            __builtin_amdgcn_s_setprio(1);
#pragma unroll
            for (int m = 0; m < 4; ++m)
#pragma unroll
                for (int n = 0; n < 4; ++n) acc[m][n] = mfma16(bfr[n], af[m], acc[m][n]);
            __builtin_amdgcn_s_setprio(0);
        }
        asm volatile("s_waitcnt vmcnt(0)" ::: "memory");
        __syncthreads();
    }
}
__device__ __forceinline__ void gemm2_stage(const bf16_t* __restrict__ A, long lda, const bf16_t* __restrict__ Bt, long ldb, int kt, char* buf, int tid) {
#pragma unroll
    for (int i = 0; i < 4; ++i) {
        const int b = tid * 16 + i * 4096, r = b >> 6, c = ((b & 63) >> 4) ^ ((r >> 2) & 3);
        __builtin_amdgcn_global_load_lds((const unsigned*)(A + (long)r * lda + kt * 32 + c * 8), (__attribute__((address_space(3))) unsigned*)(buf + b), 16, 0, 0);
    }
#pragma unroll
    for (int i = 0; i < 2; ++i) {
        const int b = tid * 16 + i * 4096, r = b >> 6, c = ((b & 63) >> 4) ^ ((r >> 2) & 3);
        __builtin_amdgcn_global_load_lds((const unsigned*)(Bt + (long)r * ldb + kt * 32 + c * 8), (__attribute__((address_space(3))) unsigned*)(buf + 16384 + b), 16, 0, 0);
    }
}
__device__ __forceinline__ void gemm_acc2(const bf16_t* __restrict__ A, long lda, const bf16_t* __restrict__ Bt, long ldb, int K, f32x4 (&acc)[8][4], char* lds) {
    const int tid = tid_(), wid = tid >> 6, lane = tid & 63, wr = wid >> 1, wc = wid & 1, fr = lane & 15, fq = lane >> 4;
    const int nk = K >> 5;
    gemm2_stage(A, lda, Bt, ldb, 0, lds, tid);
    asm volatile("s_waitcnt vmcnt(0)" ::: "memory");
    __syncthreads();
    for (int kt = 0; kt < nk; ++kt) {
        char* cur = lds + (kt & 1) * 24576;
        if (kt + 1 < nk) gemm2_stage(A, lda, Bt, ldb, kt + 1, lds + ((kt + 1) & 1) * 24576, tid);
        bf16x8 bfr[4];
#pragma unroll
        for (int n = 0; n < 4; ++n) { const int row = wc * 64 + n * 16 + fr; bfr[n] = *reinterpret_cast<const bf16x8*>(cur + 16384 + row * 64 + ((fq ^ ((row >> 2) & 3)) << 4)); }
#pragma unroll
        for (int m = 0; m < 8; ++m) {
            const int row = wr * 128 + m * 16 + fr;
            const bf16x8 af = *reinterpret_cast<const bf16x8*>(cur + row * 64 + ((fq ^ ((row >> 2) & 3)) << 4));
            __builtin_amdgcn_s_setprio(1);
#pragma unroll
            for (int n = 0; n < 4; ++n) acc[m][n] = mfma16(bfr[n], af, acc[m][n]);
            __builtin_amdgcn_s_setprio(0);
        }
        asm volatile("s_waitcnt vmcnt(0)" ::: "memory");
        __syncthreads();
    }
}
__device__ __forceinline__ void zero_acc2(f32x4 (&acc)[8][4]) {
#pragma unroll
    for (int m = 0; m < 8; ++m)
#pragma unroll
        for (int n = 0; n < 4; ++n) acc[m][n] = (f32x4){0.f, 0.f, 0.f, 0.f};
}
__device__ __forceinline__ void zero_acc(f32x4 (&acc)[4][4]) {
#pragma unroll
    for (int m = 0; m < 4; ++m)
#pragma unroll
        for (int n = 0; n < 4; ++n) acc[m][n] = (f32x4){0.f, 0.f, 0.f, 0.f};
}

__device__ void ph_init(const Params& P, char* lds) {
    const int tid = tid_();
    {
        const f32x4* src = (const f32x4*)P.in[I_X]; f32x4* dst = (f32x4*)P.out;
        const long n4 = (long)TT * DM / 4;
        for (long i = (long)bid_() * NT + tid; i < n4; i += (long)gridDim.x * NT) dst[i] = src[i];
    }
    float* mod = (float*)(P.ws + OFF_MOD);
    float* lbo = (float*)(P.ws + OFF_LB);
    for (int item = bid_(); item < 385; item += gridDim.x) {
        if (item < 384) {
            const int l = item / 96, j0 = (item % 96) * 64;
            const int col = tid & 63, kg = tid >> 6;
            float* CS = (float*)lds;
            float* RED = CS + 4096;
            float acc[16];
#pragma unroll
            for (int b = 0; b < 16; ++b) acc[b] = 0.f;
            const float* Wl = P.in[I_ADAW] + (size_t)l * DM * 6144;
            for (int sub = 0; sub < 4; ++sub) {
                __syncthreads();
                for (int e = tid; e < 4096; e += NT) {
                    const int kk = e & 63, b = (e >> 6) & 15, g = e >> 10;
                    CS[e] = silu(P.in[I_C][b * DM + g * 256 + sub * 64 + kk]);
                }
                __syncthreads();
                for (int kk = 0; kk < 64; ++kk) {
                    const float w = Wl[(size_t)(kg * 256 + sub * 64 + kk) * 6144 + j0 + col];
#pragma unroll
                    for (int b = 0; b < 16; ++b) acc[b] += CS[(kg * 16 + b) * 64 + kk] * w;
                }
            }
#pragma unroll
            for (int b = 0; b < 16; ++b) RED[(kg * 64 + col) * 16 + b] = acc[b];
            __syncthreads();
            {
                const int bg = tid >> 6;
#pragma unroll
                for (int bb = 0; bb < 4; ++bb) {
                    const int b = bg * 4 + bb;
                    float s = RED[(0 * 64 + col) * 16 + b] + RED[(1 * 64 + col) * 16 + b] + RED[(2 * 64 + col) * 16 + b] + RED[(3 * 64 + col) * 16 + b];
                    mod[((size_t)l * 16 + b) * 6144 + j0 + col] = s + P.in[I_ADAB][l * 6144 + j0 + col];
                }
            }
            __syncthreads();
        } else {
            for (int e = tid; e < 1024; e += NT) {
                float x[4], mx = -1e30f;
#pragma unroll
                for (int l = 0; l < 4; ++l) { x[l] = P.in[I_HGLB][l * 1024 + e]; mx = fmaxf(mx, x[l]); }
                float s = 0.f;
#pragma unroll
                for (int l = 0; l < 4; ++l) { x[l] = __expf(x[l] - mx); s += x[l]; }
                const float inv = rcpf_(s);
                float cum = 0.f;
                lbo[0 * 1024 + e] = 0.f;
#pragma unroll
                for (int l = 1; l < 4; ++l) { cum += x[l] * inv; lbo[l * 1024 + e] = fminf(fmaxf(cum, 0.f), 1.f); }
            }
        }
    }
}

__device__ __forceinline__ void tr_tile(const float* __restrict__ src, int ld, int N, int k0, int n0, bf16_t* __restrict__ dst, int dld, int drow0, bool winmap, char* lds) {
    float* Tl = (float*)lds;
    const int tid = tid_();
    __syncthreads();
#pragma unroll
    for (int i = 0; i < 4; ++i) {
        const int kk = (tid >> 4) + 16 * i, nn = (tid & 15) * 4;
        f32x4 v = (f32x4){0.f, 0.f, 0.f, 0.f};
        if (n0 + nn < N) v = *(const f32x4*)(src + (size_t)(k0 + kk) * ld + n0 + nn);
        Tl[kk * 65 + nn] = v[0]; Tl[kk * 65 + nn + 1] = v[1]; Tl[kk * 65 + nn + 2] = v[2]; Tl[kk * 65 + nn + 3] = v[3];
    }
    __syncthreads();
    {
        const int nn = tid >> 2, kb = (tid & 3) * 16;
        if (n0 + nn < N) {
            int drow = drow0 + nn;
            if (winmap) { const int n = n0 + nn; drow = n + (n >= 3344 ? 112 : 0); }
            unsigned w[8];
#pragma unroll
            for (int j = 0; j < 8; ++j) w[j] = pack2(Tl[(kb + 2 * j) * 65 + nn], Tl[(kb + 2 * j + 1) * 65 + nn]);
            u32x4* d = (u32x4*)(dst + (size_t)drow * dld + k0 + kb);
            d[0] = (u32x4){w[0], w[1], w[2], w[3]}; d[1] = (u32x4){w[4], w[5], w[6], w[7]};
        }
    }
}
__device__ void ph_wt(const Params& P, int l, char* lds) {
    char* ws = P.ws;
    const int NI = 2768 + 512 + 256 + 1408 + 704 + 16 + 16 + 16 + 16 + 16 + 7;
    for (int item = bid_(); item < NI; item += gridDim.x) {
        int it = item;
        if (it < 2768) { const int kt = it / 173, nt = it % 173;
            tr_tile(P.in[I_WIN] + (size_t)l * 1024 * 11024, 11024, 11024, kt * 64, nt * 64, (bf16_t*)(ws + WT_WIN), 1024, 0, true, lds); continue; }
        it -= 2768;
        if (it < 512) { const int n = it / 128, r = it % 128, kt = r / 16, nt = r % 16;
            tr_tile(P.in[I_WBR] + ((size_t)l * 4 + n) * 512 * 1024, 1024, 1024, kt * 64, nt * 64, (bf16_t*)(ws + WT_WB) + (size_t)n * 1024 * 512, 512, nt * 64, false, lds); continue; }
        it -= 512;
        if (it < 256) { const int kt = it / 16, nt = it % 16;
            tr_tile(P.in[I_WOUT] + (size_t)l * 1024 * 1024, 1024, 1024, kt * 64, nt * 64, (bf16_t*)(ws + WT_WOUT), 1024, nt * 64, false, lds); continue; }
        it -= 256;
        if (it < 1408) { const int kt = it / 88, nt = it % 88;
            tr_tile(P.in[I_FUP] + (size_t)l * 1024 * 5632, 5632, 5632, kt * 64, nt * 64, (bf16_t*)(ws + WT_WUP), 1024, nt * 64, false, lds); continue; }
        it -= 1408;
        if (it < 704) { const int kt = it / 16, nt = it % 16;
            tr_tile(P.in[I_FDN] + (size_t)l * 2816 * 1024, 1024, 1024, kt * 64, nt * 64, (bf16_t*)(ws + WT_WDN), 2816, nt * 64, false, lds); continue; }
        it -= 704;
        if (it < 16) { const int kt = it / 8, nt = it % 8;
            tr_tile(P.in[I_G2] + (size_t)l * 128 * 512, 512, 512, kt * 64, nt * 64, (bf16_t*)(ws + WT_G2), 128, nt * 64, false, lds); continue; }
        it -= 16;
        if (it < 16) { const int d = it / 8, nt = it % 8;
            tr_tile(P.in[I_W2] + ((size_t)l * 2 + d) * 64 * 512, 512, 512, 0, nt * 64, (bf16_t*)(ws + WT_W2) + (size_t)d * 512 * 64, 64, nt * 64, false, lds); continue; }
        it -= 16;
        if (it < 16) { const int d = it / 8, nt = it % 8;
            tr_tile(P.in[I_A2] + ((size_t)l * 2 + d) * 64 * 512, 512, 512, 0, nt * 64, (bf16_t*)(ws + WT_A2) + (size_t)d * 512 * 64, 64, nt * 64, false, lds); continue; }
        it -= 16;
        if (it < 32) { const int mat = it / 16, d = (it % 16) / 8, g = it % 8;
            const float* src = P.in[mat ? I_LWX : I_LWA] + (((size_t)l * 2 + d) * 8 + g) * 64 * 64;
            tr_tile(src, 64, 64, 0, 0, (bf16_t*)(ws + WT_LRU) + (((size_t)d * 2 + mat) * 8 + g) * 64 * 64, 64, 0, false, lds); continue; }
        it -= 32;
        {
            u32x4* d = (u32x4*)((bf16_t*)(ws + WT_WIN) + (size_t)(3344 + it * 16) * 1024);
            for (int e = tid_(); e < 16 * 1024 / 8; e += NT) d[e] = (u32x4){0u, 0u, 0u, 0u};
        }
    }
}

__device__ void ph_norm(const Params& P, const float* __restrict__ g, const float* __restrict__ modl, int sh_off, int sc_off, bf16_t* __restrict__ dst, bool final_) {
    const int tid = tid_(), wid = tid >> 6, lane = tid & 63;
    for (int item = bid_(); item < TT / 16; item += gridDim.x) {
        const int row0 = item * 16 + wid * 4, b = row0 >> 11;
        f32x4 v[4][4];
#pragma unroll
        for (int r = 0; r < 4; ++r)
#pragma unroll
            for (int i = 0; i < 4; ++i) v[r][i] = *(const f32x4*)(P.out + (size_t)(row0 + r) * DM + i * 256 + lane * 4);
        f32x4 gv[4], sc[4], sh[4];
#pragma unroll
        for (int i = 0; i < 4; ++i) {
            const int c = i * 256 + lane * 4;
            gv[i] = *(const f32x4*)(g + c);
            if (!final_) { sc[i] = *(const f32x4*)(modl + (size_t)b * 6144 + sc_off + c); sh[i] = *(const f32x4*)(modl + (size_t)b * 6144 + sh_off + c); }
        }
#pragma unroll
        for (int r = 0; r < 4; ++r) {
            float ss = 0.f;
#pragma unroll
            for (int i = 0; i < 4; ++i) ss += v[r][i][0] * v[r][i][0] + v[r][i][1] * v[r][i][1] + v[r][i][2] * v[r][i][2] + v[r][i][3] * v[r][i][3];
            ss = wsum64(ss);
            const float rs = rsqrtf(ss * (1.f / DM) + 1e-6f);
            float* hr = P.out + (size_t)(row0 + r) * DM;
#pragma unroll
            for (int i = 0; i < 4; ++i) {
                const int c = i * 256 + lane * 4;
                if (final_) {
                    *(f32x4*)(hr + c) = v[r][i] * rs * gv[i];
                } else {
                    const f32x4 o = v[r][i] * rs * gv[i] * (sc[i] + 1.f) + sh[i];
                    *(u32x2*)(dst + (size_t)(row0 + r) * DM + c) = (u32x2){pack2(o[0], o[1]), pack2(o[2], o[3])};
                }
            }
        }
    }
}

__device__ __forceinline__ void store_tile_bf16(const f32x4 (&acc)[4][4], bf16_t* __restrict__ dst, long ld) {
    const int tid = tid_(), wid = tid >> 6, lane = tid & 63, wr = wid >> 1, wc = wid & 1, fr = lane & 15, fq = lane >> 4;
#pragma unroll
    for (int m = 0; m < 4; ++m)
#pragma unroll
        for (int n = 0; n < 4; ++n) {
            const f32x4 v = acc[m][n];
            *(u32x2*)(dst + (long)(wr * 64 + m * 16 + fr) * ld + wc * 64 + n * 16 + fq * 4) = (u32x2){pack2(v[0], v[1]), pack2(v[2], v[3])};
        }
}
__device__ __forceinline__ void resid_tile(const f32x4 (&acc)[4][4], float* __restrict__ h, int row0, int col0, const float* __restrict__ gate) {
    const int tid = tid_(), wid = tid >> 6, lane = tid & 63, wr = wid >> 1, wc = wid & 1, fr = lane & 15, fq = lane >> 4;
    const int b = row0 >> 11;
#pragma unroll
    for (int n = 0; n < 4; ++n) {
        const int col = col0 + wc * 64 + n * 16 + fq * 4;
        const f32x4 gv = *(const f32x4*)(gate + (size_t)b * 6144 + col);
#pragma unroll
        for (int m = 0; m < 4; ++m) {
            float* hp = h + (size_t)(row0 + wr * 64 + m * 16 + fr) * DM + col;
            const f32x4 o = *(const f32x4*)hp + gv * acc[m][n];
            *(f32x4*)hp = o;
        }
    }
}
__device__ __forceinline__ void store_tile2_bf16(const f32x4 (&acc)[8][4], bf16_t* __restrict__ dst, long ld) {
    const int tid = tid_(), wid = tid >> 6, lane = tid & 63, wr = wid >> 1, wc = wid & 1, fr = lane & 15, fq = lane >> 4;
#pragma unroll
    for (int m = 0; m < 8; ++m)
#pragma unroll
        for (int n = 0; n < 4; ++n) {
            const f32x4 v = acc[m][n];
            *(u32x2*)(dst + (long)(wr * 128 + m * 16 + fr) * ld + wc * 64 + n * 16 + fq * 4) = (u32x2){pack2(v[0], v[1]), pack2(v[2], v[3])};
        }
}
__device__ __forceinline__ void resid_tile2(const f32x4 (&acc)[8][4], float* __restrict__ h, int row0, int col0, const float* __restrict__ gate) {
    const int tid = tid_(), wid = tid >> 6, lane = tid & 63, wr = wid >> 1, wc = wid & 1, fr = lane & 15, fq = lane >> 4;
    const int b = row0 >> 11;
#pragma unroll
    for (int n = 0; n < 4; ++n) {
        const int col = col0 + wc * 64 + n * 16 + fq * 4;
        const f32x4 gv = *(const f32x4*)(gate + (size_t)b * 6144 + col);
#pragma unroll
        for (int m = 0; m < 8; ++m) {
            float* hp = h + (size_t)(row0 + wr * 128 + m * 16 + fr) * DM + col;
            const f32x4 o = *(const f32x4*)hp + gv * acc[m][n];
            *(f32x4*)hp = o;
        }
    }
}
__device__ void ph_gemm_p(const Params& P, char* lds) {
    const bf16_t* U = (const bf16_t*)(P.ws + OFF_U); const bf16_t* Wt = (const bf16_t*)(P.ws + WT_WIN);
    bf16_t* prw = (bf16_t*)(P.ws + OFF_PRW); bf16_t* prest = (bf16_t*)(P.ws + OFF_PREST);
    for (int item = bid_(); item < 128 * 55; item += gridDim.x) {
        const int mt = item / 55, nt = item % 55;
        f32x4 acc[8][4]; zero_acc2(acc);
        gemm_acc2(U + (size_t)mt * 256 * DM, DM, Wt + (size_t)nt * 128 * DM, DM, DM, acc, lds);
        if (nt < 14) store_tile2_bf16(acc, prw + (size_t)mt * 256 * PRW_LD + nt * 128, PRW_LD);
        else store_tile2_bf16(acc, prest + (size_t)mt * 256 * PREST_LD + (nt - 14) * 128, PREST_LD);
    }
}
__device__ void ph_gemm_merge(const Params& P, char* lds) {
    const bf16_t* U = (const bf16_t*)(P.ws + OFF_URE); const bf16_t* Wt = (const bf16_t*)(P.ws + WT_WIN); const bf16_t* Wb = (const bf16_t*)(P.ws + WT_WB);
    bf16_t* mg = (bf16_t*)(P.ws + OFF_MERGED);
    for (int item = bid_(); item < 256 * 8; item += gridDim.x) {
        const int mt = item / 8, nt = item % 8;
        unsigned mpk[4][4][2];
#pragma unroll
        for (int m = 0; m < 4; ++m)
#pragma unroll
            for (int q = 0; q < 4; ++q) { mpk[m][q][0] = 0u; mpk[m][q][1] = 0u; }
#pragma unroll 1
        for (int n = 0; n < 4; ++n) {
            unsigned gpk[4][4][2];
            {
                f32x4 acc[4][4]; zero_acc(acc);
                gemm_acc(U + (size_t)mt * 128 * DM, DM, Wt + (size_t)(GATE_ROW0 + n * 1024 + nt * 128) * DM, DM, DM, acc, lds);
#pragma unroll
                for (int m = 0; m < 4; ++m)
#pragma unroll
                    for (int q = 0; q < 4; ++q) { gpk[m][q][0] = pack2(sigm(acc[m][q][0]), sigm(acc[m][q][1])); gpk[m][q][1] = pack2(sigm(acc[m][q][2]), sigm(acc[m][q][3])); }
            }
            const size_t yoff = (n == 0) ? OFF_Y0 : (n == 1 ? OFF_YB : (n == 2 ? OFF_YC : OFF_YD));
            const bf16_t* Y = (const bf16_t*)(P.ws + yoff);
            f32x4 acc[4][4]; zero_acc(acc);
            gemm_acc(Y + (size_t)mt * 128 * 512, 512, Wb + ((size_t)n * 1024 + nt * 128) * 512, 512, 512, acc, lds);
#pragma unroll
            for (int m = 0; m < 4; ++m)
#pragma unroll
                for (int q = 0; q < 4; ++q) {
                    mpk[m][q][0] = pack2(lo2f(mpk[m][q][0]) + lo2f(gpk[m][q][0]) * acc[m][q][0], hi2f(mpk[m][q][0]) + hi2f(gpk[m][q][0]) * acc[m][q][1]);
                    mpk[m][q][1] = pack2(lo2f(mpk[m][q][1]) + lo2f(gpk[m][q][1]) * acc[m][q][2], hi2f(mpk[m][q][1]) + hi2f(gpk[m][q][1]) * acc[m][q][3]);
                }
        }
        {
            const int tid = tid_(), wid = tid >> 6, lane = tid & 63, wr = wid >> 1, wc = wid & 1, fr = lane & 15, fq = lane >> 4;
            bf16_t* dst = mg + (size_t)mt * 128 * DM + nt * 128;
#pragma unroll
            for (int m = 0; m < 4; ++m)
#pragma unroll
                for (int q = 0; q < 4; ++q) *(u32x2*)(dst + (long)(wr * 64 + m * 16 + fr) * DM + wc * 64 + q * 16 + fq * 4) = (u32x2){mpk[m][q][0], mpk[m][q][1]};
        }
    }
}
__device__ void ph_gemm_out(const Params& P, int l, char* lds) {
    const bf16_t* A = (const bf16_t*)(P.ws + OFF_MERGED); const bf16_t* Wt = (const bf16_t*)(P.ws + WT_WOUT);
    const float* gate = (const float*)(P.ws + OFF_MOD) + (size_t)l * 16 * 6144 + 2048;
    for (int item = bid_(); item < 256 * 8; item += gridDim.x) {
        const int mt = item / 8, nt = item % 8;
        f32x4 acc[4][4]; zero_acc(acc);
        gemm_acc(A + (size_t)mt * 128 * DM, DM, Wt + (size_t)nt * 128 * DM, DM, DM, acc, lds);
        resid_tile(acc, P.out, mt * 128, nt * 128, gate);
    }
}
__device__ void ph_gemm_up(const Params& P, char* lds) {
    const bf16_t* A = (const bf16_t*)(P.ws + OFF_U2); const bf16_t* Wt = (const bf16_t*)(P.ws + WT_WUP);
    bf16_t* Z = (bf16_t*)(P.ws + OFF_Z);
    for (int item = bid_(); item < 128 * 44; item += gridDim.x) {
        const int mt = item / 44, nt = item % 44;
        f32x4 acc[8][4]; zero_acc2(acc);
        gemm_acc2(A + (size_t)mt * 256 * DM, DM, Wt + (size_t)nt * 128 * DM, DM, DM, acc, lds);
        store_tile2_bf16(acc, Z + (size_t)mt * 256 * 5632 + nt * 128, 5632);
    }
}
__device__ void ph_gemm_down(const Params& P, int l, char* lds) {
    const bf16_t* A = (const bf16_t*)(P.ws + OFF_ACT); const bf16_t* Wt = (const bf16_t*)(P.ws + WT_WDN);
    const float* gate = (const float*)(P.ws + OFF_MOD) + (size_t)l * 16 * 6144 + 5120;
    for (int item = bid_(); item < 128 * 8; item += gridDim.x) {
        const int mt = item / 8, nt = item % 8;
        f32x4 acc[8][4]; zero_acc2(acc);
        gemm_acc2(A + (size_t)mt * 256 * DFF, DFF, Wt + (size_t)nt * 128 * DFF, DFF, DFF, acc, lds);
        resid_tile2(acc, P.out, mt * 256, nt * 128, gate);
    }
}
__device__ void ph_convact(const Params& P, int l) {
    const bf16_t* Z = (const bf16_t*)(P.ws + OFF_Z); bf16_t* ACT = (bf16_t*)(P.ws + OFF_ACT);
    const float* cw = P.in[I_FCW] + (size_t)l * 3 * 5632; const float* cb = P.in[I_FCB] + (size_t)l * 5632;
    const long ntask = (long)(TT / 64) * 352;
    for (long task = (long)bid_() * NT + tid_(); task < ntask; task += (long)gridDim.x * NT) {
        const int tile = (int)(task / 352), cgp = (int)(task % 352), c0 = cgp * 8;
        const int t0 = tile * 64, s0 = t0 & (SQ - 1);
        float wv[3][8], wg[3][8], bv[8], bg[8];
#pragma unroll
        for (int j = 0; j < 3; ++j)
#pragma unroll
            for (int e = 0; e < 8; ++e) { wv[j][e] = cw[j * 5632 + c0 + e]; wg[j][e] = cw[j * 5632 + DFF + c0 + e]; }
#pragma unroll
        for (int e = 0; e < 8; ++e) { bv[e] = cb[c0 + e]; bg[e] = cb[DFF + c0 + e]; }
        float pv[8], pg[8], cv[8], cg_[8], nv[8], ng[8];
        const u32x4 zero4 = (u32x4){0u, 0u, 0u, 0u};
        {
            u32x4 a = zero4, b = zero4;
            if (s0 > 0) { a = *(const u32x4*)(Z + (size_t)(t0 - 1) * 5632 + c0); b = *(const u32x4*)(Z + (size_t)(t0 - 1) * 5632 + DFF + c0); }
            unpack8(a, pv); unpack8(b, pg);
            a = *(const u32x4*)(Z + (size_t)t0 * 5632 + c0); b = *(const u32x4*)(Z + (size_t)t0 * 5632 + DFF + c0);
            unpack8(a, cv); unpack8(b, cg_);
        }
#pragma unroll 8
        for (int r = 0; r < 64; ++r) {
            const int t = t0 + r;
            u32x4 a = zero4, b = zero4;
            if (s0 + r + 1 < SQ) { a = *(const u32x4*)(Z + (size_t)(t + 1) * 5632 + c0); b = *(const u32x4*)(Z + (size_t)(t + 1) * 5632 + DFF + c0); }
            unpack8(a, nv); unpack8(b, ng);
            float o[8];
#pragma unroll
            for (int e = 0; e < 8; ++e) {
                const float v = wv[0][e] * pv[e] + wv[1][e] * cv[e] + wv[2][e] * nv[e] + bv[e];
                const float g = wg[0][e] * pg[e] + wg[1][e] * cg_[e] + wg[2][e] * ng[e] + bg[e];
                o[e] = v * silu(g);
                pv[e] = cv[e]; cv[e] = nv[e]; pg[e] = cg_[e]; cg_[e] = ng[e];
            }
            *(u32x4*)(ACT + (size_t)t * DFF + c0) = (u32x4){pack2(o[0], o[1]), pack2(o[2], o[3]), pack2(o[4], o[5]), pack2(o[6], o[7])};
        }
    }
}

__device__ void mx_rwkv(const Params& P, int l, int item, char* lds) {
    const int tid = tid_(), wid = tid >> 6, lane = tid & 63, fr = lane & 15, fq = lane >> 4;
    const int d = item & 1, h = (item >> 1) & 7, b = item >> 4;
    const bf16_t* prw = (const bf16_t*)(P.ws + OFF_PRW) + (size_t)b * SQ * PRW_LD;
    bf16_t* Yd = (bf16_t*)(P.ws + (d ? OFF_Y1 : OFF_Y0)) + (size_t)b * SQ * 512 + h * 64;
    float* beta = (float*)(P.ws + OFF_BETA) + ((size_t)d * TT + (size_t)b * SQ) * 8 + h;
    float* VA = (float*)lds; float* VWR = VA + 1024; float* VW = VWR + 1024; float* VB = VW + 1024; float* VK = VB + 1024; float* VV = VK + 1024; float* VG = VV + 1024;
    float* SC = VG + 1024;
    bf16_t* RAW = (bf16_t*)(SC + 32);
    bf16_t* AT = RAW + 18 * 320;
    const int s = tid >> 4, jg = tid & 15, j0 = jg * 4;
    float mu[5][4], kkc[4], kac[4], rkc[4];
#pragma unroll
    for (int sg = 0; sg < 5; ++sg) {
        const int base = (sg < 3) ? sg * 512 + h * 64 : 1536 + (sg - 3) * 64;
#pragma unroll
        for (int i = 0; i < 4; ++i) mu[sg][i] = P.in[I_MU][l * 1792 + base + j0 + i];
    }
#pragma unroll
    for (int i = 0; i < 4; ++i) { kkc[i] = P.in[I_KK][l * 512 + h * 64 + j0 + i]; kac[i] = P.in[I_KA][l * 512 + h * 64 + j0 + i]; rkc[i] = P.in[I_RK][l * 512 + h * 64 + j0 + i]; }
    const int mt = wid >> 1, ntb = (wid & 1) * 2;
    bf16x8 bw[2][2]; float bsv[2][4];
    {
        const bf16_t* WT2 = (const bf16_t*)(P.ws + (mt ? WT_A2 : WT_W2)) + (size_t)d * 512 * 64;
        const float* bias = P.in[mt ? I_A0 : I_W0] + (size_t)(l * 2 + d) * 512 + h * 64;
#pragma unroll
        for (int nt = 0; nt < 2; ++nt) {
#pragma unroll
            for (int ks = 0; ks < 2; ++ks) bw[nt][ks] = ldfrag(WT2 + (size_t)(h * 64 + (ntb + nt) * 16 + fr) * 64 + ks * 32 + fq * 8);
#pragma unroll
            for (int jj = 0; jj < 4; ++jj) bsv[nt][jj] = bias[(ntb + nt) * 16 + fq * 4 + jj];
        }
    }
    float S[4][4];
#pragma unroll
    for (int i = 0; i < 4; ++i)
#pragma unroll
        for (int j = 0; j < 4; ++j) S[i][j] = 0.f;
    u32x4 pre[3];
    auto load_raw = [&](int c) {
        const int t0 = d ? SQ - 16 * (c + 1) : 16 * c;
#pragma unroll
        for (int i = 0; i < 3; ++i) {
            const int vi = tid + 256 * i;
            pre[i] = (u32x4){0u, 0u, 0u, 0u};
            if (vi < 720) {
                const int rr = vi / 40, rem = vi % 40, sg = rem >> 3, e = rem & 7, t = t0 - 1 + rr;
                const int col = ((sg < 3) ? sg * 512 + h * 64 : 1536 + (sg - 3) * 64) + e * 8;
                if (t >= 0 && t < SQ) pre[i] = *(const u32x4*)(prw + (size_t)t * PRW_LD + col);
            }
        }
    };
    __syncthreads();
    load_raw(0);
#pragma unroll 1
    for (int c = 0; c < 128; ++c) {
        const int t0 = d ? SQ - 16 * (c + 1) : 16 * c;
#pragma unroll
        for (int i = 0; i < 3; ++i) {
            const int vi = tid + 256 * i;
            if (vi < 720) { const int rr = vi / 40, rem = vi % 40; *(u32x4*)(RAW + rr * 320 + rem * 8) = pre[i]; }
        }
        __syncthreads();
        if (c + 1 < 128) load_raw(c + 1);
        float rs[4], ks_[4], vs[4], kk[4];
        {
            float sh[5][4];
#pragma unroll
            for (int sg = 0; sg < 5; ++sg) {
                float fm[4], f0[4], fp[4];
                unpack4(*(const u32x2*)(RAW + s * 320 + sg * 64 + j0), fm);
                unpack4(*(const u32x2*)(RAW + (s + 1) * 320 + sg * 64 + j0), f0);
                unpack4(*(const u32x2*)(RAW + (s + 2) * 320 + sg * 64 + j0), fp);
#pragma unroll
                for (int i = 0; i < 4; ++i) sh[sg][i] = f0[i] + mu[sg][i] * (0.5f * (fm[i] + fp[i]) - f0[i]);
            }
            float ssq = 0.f, q[4];
#pragma unroll
            for (int i = 0; i < 4; ++i) { rs[i] = sh[0][i]; ks_[i] = sh[1][i]; vs[i] = sh[2][i]; q[i] = ks_[i] * kkc[i]; ssq += q[i] * q[i]; }
            *(u32x2*)(AT + s * 72 + j0) = (u32x2){pack2(tanh_f(sh[3][0]), tanh_f(sh[3][1])), pack2(tanh_f(sh[3][2]), tanh_f(sh[3][3]))};
            *(u32x2*)(AT + 16 * 72 + s * 72 + j0) = (u32x2){pack2(sh[4][0], sh[4][1]), pack2(sh[4][2], sh[4][3])};
            ssq = rowsum16(ssq);
            const float inv = rsqrtf(fmaxf(ssq, 1e-24f));
#pragma unroll
            for (int i = 0; i < 4; ++i) kk[i] = q[i] * inv;
        }
        __syncthreads();
        {
            const bf16_t* At = AT + mt * 16 * 72;
            const bf16x8 a0 = ldfrag(At + fr * 72 + fq * 8), a1 = ldfrag(At + fr * 72 + 32 + fq * 8);
            float* dstv = mt ? VG : VW;
#pragma unroll
            for (int nt = 0; nt < 2; ++nt) {
                f32x4 acc = (f32x4){0.f, 0.f, 0.f, 0.f};
                acc = mfma16(bw[nt][0], a0, acc); acc = mfma16(bw[nt][1], a1, acc);
                f32x4 o;
#pragma unroll
                for (int jj = 0; jj < 4; ++jj) {
                    const float x = acc[jj] + bsv[nt][jj];
                    if (mt == 0) { const float wl = fminf(x, 0.f) - log1pf(__expf(-fabsf(x))) - 0.5f; o[jj] = __expf(-__expf(wl)); }
                    else o[jj] = sigm(x);
                }
                *(f32x4*)(dstv + fr * 64 + (ntb + nt) * 16 + fq * 4) = o;
            }
        }
        __syncthreads();
        {
            const f32x4 w4 = *(const f32x4*)(VW + s * 64 + j0), g4 = *(const f32x4*)(VG + s * 64 + j0);
            f32x4 bb, kt, wr, na, vv;
            float pbr = 0.f, pkr = 0.f, pbe = 0.f;
#pragma unroll
            for (int i = 0; i < 4; ++i) {
                bb[i] = kk[i] * g4[i]; kt[i] = ks_[i] * (1.f + (g4[i] - 1.f) * kac[i]); wr[i] = w4[i] * rs[i]; na[i] = -kk[i]; vv[i] = vs[i];
                pbr += bb[i] * rs[i]; pkr += kt[i] * rs[i]; pbe += rs[i] * kt[i] * rkc[i];
            }
            pbr = rowsum16(pbr); pkr = rowsum16(pkr); pbe = rowsum16(pbe);
            *(f32x4*)(VA + s * 64 + j0) = na; *(f32x4*)(VWR + s * 64 + j0) = wr; *(f32x4*)(VB + s * 64 + j0) = bb; *(f32x4*)(VK + s * 64 + j0) = kt; *(f32x4*)(VV + s * 64 + j0) = vv;
            if (jg == 0) { SC[s * 2] = pbr; SC[s * 2 + 1] = pkr; beta[(size_t)(t0 + s) * 8] = pbe; }
        }
        __syncthreads();
#pragma unroll 1
        for (int st = 0; st < 16; ++st) {
            const int sp = d ? 15 - st : st;
            const f32x4 a4 = *(const f32x4*)(VA + sp * 64 + j0), wr4 = *(const f32x4*)(VWR + sp * 64 + j0), w4 = *(const f32x4*)(VW + sp * 64 + j0);
            const f32x4 b4 = *(const f32x4*)(VB + sp * 64 + j0), k4 = *(const f32x4*)(VK + sp * 64 + j0), v4 = *(const f32x4*)(VV + sp * 64 + s * 4);
            const float br = SC[sp * 2], kr = SC[sp * 2 + 1];
            float psa[4], py[4];
            typedef float f32x2 __attribute__((ext_vector_type(2)));
            const f32x2 a01 = {a4[0], a4[1]}, a23 = {a4[2], a4[3]}, r01 = {wr4[0], wr4[1]}, r23 = {wr4[2], wr4[3]};
#pragma unroll
            for (int i = 0; i < 4; ++i) {
                const f32x2 s01 = {S[i][0], S[i][1]}, s23 = {S[i][2], S[i][3]};
                f32x2 ta = s01 * a01; ta = s23 * a23 + ta;
                f32x2 ty = s01 * r01; ty = s23 * r23 + ty;
                psa[i] = ta.x + ta.y; py[i] = ty.x + ty.y;
            }
#define RS8(CTRL) asm volatile("s_nop 1\n\tv_add_f32_dpp %0, %0, %0 " CTRL " row_mask:0xf bank_mask:0xf\n\tv_add_f32_dpp %1, %1, %1 " CTRL " row_mask:0xf bank_mask:0xf\n\tv_add_f32_dpp %2, %2, %2 " CTRL " row_mask:0xf bank_mask:0xf\n\tv_add_f32_dpp %3, %3, %3 " CTRL " row_mask:0xf bank_mask:0xf\n\tv_add_f32_dpp %4, %4, %4 " CTRL " row_mask:0xf bank_mask:0xf\n\tv_add_f32_dpp %5, %5, %5 " CTRL " row_mask:0xf bank_mask:0xf\n\tv_add_f32_dpp %6, %6, %6 " CTRL " row_mask:0xf bank_mask:0xf\n\tv_add_f32_dpp %7, %7, %7 " CTRL " row_mask:0xf bank_mask:0xf" : "+v"(psa[0]), "+v"(psa[1]), "+v"(psa[2]), "+v"(psa[3]), "+v"(py[0]), "+v"(py[1]), "+v"(py[2]), "+v"(py[3]))
            RS8("row_ror:8"); RS8("row_ror:4"); RS8("row_ror:2"); RS8("row_ror:1");
            asm volatile("s_nop 1" ::: "memory");
            float y[4];
#pragma unroll
            for (int i = 0; i < 4; ++i) {
                y[i] = py[i] + psa[i] * br + v4[i] * kr;
#pragma unroll
                for (int j = 0; j < 4; ++j) S[i][j] = S[i][j] * w4[j] + (psa[i] * b4[j] + v4[i] * k4[j]);
            }
            if (jg == 0) *(u32x2*)(Yd + (size_t)(t0 + sp) * 512 + s * 4) = (u32x2){pack2(y[0], y[1]), pack2(y[2], y[3])};
        }
    }
    __syncthreads();
}

__device__ void mx_mlstm(const Params& P, int l, int item, char* lds) {
    const int tid = tid_(), wid = tid >> 6, lane = tid & 63, fr = lane & 15, fq = lane >> 4;
    const int b = item >> 3, h = (item >> 1) & 3, dsel = item & 1;
    const bf16_t* pr = (const bf16_t*)(P.ws + OFF_PREST) + (size_t)b * SQ * PREST_LD;
    bf16_t* YB = (bf16_t*)(P.ws + (dsel ? OFF_YB : OFF_Y1)) + (size_t)b * SQ * 512 + h * 128;
    bf16_t* Q = (bf16_t*)lds; bf16_t* KP = Q + 64 * 72; bf16_t* KWT = KP + 64 * 72; bf16_t* VT = KWT + 64 * 72; bf16_t* CT = VT + 128 * 72;
    float* NS = (float*)(CT + 128 * 72); float* E = NS + 64; float* MM = E + 64; float* SI = MM + 64; float* WI = SI + 64; float* FL = WI + 64; float* DEC = FL + 64;
    const int i = wid * 16 + fr;
#pragma unroll 1
    for (int d = dsel; d <= dsel; ++d) {
        f32x4 Cacc[8];
#pragma unroll
        for (int dt = 0; dt < 8; ++dt) Cacc[dt] = (f32x4){0.f, 0.f, 0.f, 0.f};
        __syncthreads();
        for (int e = tid; e < 128 * 72 / 2; e += NT) ((unsigned*)CT)[e] = 0u;
        if (tid < 64) NS[tid] = 0.f;
        float m_st = 0.f;
        const float ib = P.in[I_MLIB][(l * 2 + d) * 4 + h], fb = P.in[I_MLFB][(l * 2 + d) * 4 + h];
        __syncthreads();
#pragma unroll 1
        for (int c = 0; c < 32; ++c) {
            const int t0 = d ? SQ - 64 * (c + 1) : 64 * c;
#define TROW(ii) (d ? t0 + 63 - (ii) : t0 + (ii))
            if (wid == 0) {
                const int t = TROW(lane);
                const float fg = bf2f(pr[(size_t)t * PREST_LD + 1544 + d * 4 + h]) + fb, ig = bf2f(pr[(size_t)t * PREST_LD + 1536 + d * 4 + h]) + ib;
                float bc = logsig(fg);
#pragma unroll
                for (int o = 1; o < 64; o <<= 1) { const float x = bperm(bc, lane - o); if (lane >= o) bc += x; }
                const float e = ig - bc; float pm = e;
#pragma unroll
                for (int o = 1; o < 64; o <<= 1) { const float x = bperm(pm, lane - o); if (lane >= o) pm = fmaxf(pm, x); }
                const float gend = rdlane(bc, 63), pmax = rdlane(pm, 63);
                const float mnew = fmaxf(gend + m_st, gend + pmax);
                const float M = fmaxf(m_st, pm);
                E[lane] = e; MM[lane] = M; SI[lane] = __expf(m_st - M); WI[lane] = __expf(gend + e - mnew); FL[lane] = __expf(-(bc + M));
                if (lane == 0) DEC[0] = __expf(gend + m_st - mnew);
                m_st = mnew;
            }
            __syncthreads();
#pragma unroll
            for (int it = 0; it < 2; ++it) {
                const int vi = tid + 256 * it, ii = vi >> 3, e = vi & 7, t = TROW(ii);
                float f[8];
                unpack8(*(const u32x4*)(pr + (size_t)t * PREST_LD + h * 64 + e * 8), f);
                *(u32x4*)(Q + ii * 72 + e * 8) = (u32x4){pack2(f[0] * 0.125f, f[1] * 0.125f), pack2(f[2] * 0.125f, f[3] * 0.125f), pack2(f[4] * 0.125f, f[5] * 0.125f), pack2(f[6] * 0.125f, f[7] * 0.125f)};
                const u32x4 kv = *(const u32x4*)(pr + (size_t)t * PREST_LD + 256 + h * 64 + e * 8);
                *(u32x4*)(KP + ii * 72 + e * 8) = kv;
                unpack8(kv, f);
                const float wi = WI[ii];
#pragma unroll
                for (int x = 0; x < 8; ++x) KWT[(e * 8 + x) * 72 + ii] = f2bf(f[x] * wi);
            }
#pragma unroll
            for (int it = 0; it < 4; ++it) {
                const int vi = tid + 256 * it, ii = vi >> 4, e = vi & 15, t = TROW(ii);
                const u32x4 vv = *(const u32x4*)(pr + (size_t)t * PREST_LD + 512 + h * 128 + e * 8);
                VT[(e * 8 + 0) * 72 + ii] = (bf16_t)(vv.x & 0xffff); VT[(e * 8 + 1) * 72 + ii] = (bf16_t)(vv.x >> 16);
                VT[(e * 8 + 2) * 72 + ii] = (bf16_t)(vv.y & 0xffff); VT[(e * 8 + 3) * 72 + ii] = (bf16_t)(vv.y >> 16);
                VT[(e * 8 + 4) * 72 + ii] = (bf16_t)(vv.z & 0xffff); VT[(e * 8 + 5) * 72 + ii] = (bf16_t)(vv.z >> 16);
                VT[(e * 8 + 6) * 72 + ii] = (bf16_t)(vv.w & 0xffff); VT[(e * 8 + 7) * 72 + ii] = (bf16_t)(vv.w >> 16);
            }
            __syncthreads();
            f32x4 sacc[4];
#pragma unroll
            for (int st = 0; st < 4; ++st) sacc[st] = (f32x4){0.f, 0.f, 0.f, 0.f};
#pragma unroll
            for (int ks = 0; ks < 2; ++ks) {
                const bf16x8 qf = ldfrag(Q + i * 72 + ks * 32 + fq * 8);
#pragma unroll
                for (int st = 0; st < 4; ++st) sacc[st] = mfma16(ldfrag(KP + (st * 16 + fr) * 72 + ks * 32 + fq * 8), qf, sacc[st]);
            }
            const float Mi = MM[i], si = SI[i];
            float rsum = 0.f; unsigned pwp[4][2];
#pragma unroll
            for (int st = 0; st < 4; ++st) {
                float pw[4];
#pragma unroll
                for (int jj = 0; jj < 4; ++jj) { const int sx = st * 16 + fq * 4 + jj; pw[jj] = (sx <= i) ? __expf(E[sx] - Mi) * sacc[st][jj] : 0.f; rsum += pw[jj]; }
                pwp[st][0] = pack2(pw[0], pw[1]); pwp[st][1] = pack2(pw[2], pw[3]);
            }
            rsum = qsum(rsum, lane);
            float qn = 0.f;
            {
                float f[8];
                unpack8(*(const u32x4*)(Q + i * 72 + fq * 16), f);
#pragma unroll
                for (int x = 0; x < 8; ++x) qn += f[x] * NS[fq * 16 + x];
                unpack8(*(const u32x4*)(Q + i * 72 + fq * 16 + 8), f);
#pragma unroll
                for (int x = 0; x < 8; ++x) qn += f[x] * NS[fq * 16 + 8 + x];
            }
            qn = qsum(qn, lane);
            const float den = si * qn + rsum;
            const float rinv = rcpf_(fmaxf(fabsf(den), FL[i]));
            __syncthreads();
#pragma unroll
            for (int st = 0; st < 4; ++st) *(u32x2*)(KP + i * 72 + st * 16 + fq * 4) = (u32x2){pwp[st][0], pwp[st][1]};
            __syncthreads();
            f32x4 oacc[8];
#pragma unroll
            for (int dt = 0; dt < 8; ++dt) oacc[dt] = (f32x4){0.f, 0.f, 0.f, 0.f};
#pragma unroll
            for (int ks = 0; ks < 2; ++ks) {
                const bf16x8 qf = ldfrag(Q + i * 72 + ks * 32 + fq * 8);
#pragma unroll
                for (int dt = 0; dt < 8; ++dt) oacc[dt] = mfma16(ldfrag(CT + (dt * 16 + fr) * 72 + ks * 32 + fq * 8), qf, oacc[dt]);
            }
#pragma unroll
            for (int dt = 0; dt < 8; ++dt) oacc[dt] *= si;
#pragma unroll
            for (int ks = 0; ks < 2; ++ks) {
                const bf16x8 pf = ldfrag(KP + i * 72 + ks * 32 + fq * 8);
#pragma unroll
                for (int dt = 0; dt < 8; ++dt) oacc[dt] = mfma16(ldfrag(VT + (dt * 16 + fr) * 72 + ks * 32 + fq * 8), pf, oacc[dt]);
            }
            {
                const int t = TROW(i);
                bf16_t* yp = YB + (size_t)t * 512 + fq * 4;
                {
#pragma unroll
                    for (int dt = 0; dt < 8; ++dt) { const f32x4 v = oacc[dt] * rinv; *(u32x2*)(yp + dt * 16) = (u32x2){pack2(v[0], v[1]), pack2(v[2], v[3])}; }
                }
            }
            __syncthreads();
            {
                const float dec = DEC[0];
#pragma unroll
                for (int dt = 0; dt < 8; ++dt) Cacc[dt] *= dec;
#pragma unroll
                for (int ks = 0; ks < 2; ++ks) {
                    const bf16x8 kf = ldfrag(KWT + (wid * 16 + fr) * 72 + ks * 32 + fq * 8);
#pragma unroll
                    for (int dt = 0; dt < 8; ++dt) Cacc[dt] = mfma16(kf, ldfrag(VT + (dt * 16 + fr) * 72 + ks * 32 + fq * 8), Cacc[dt]);
                }
#pragma unroll
                for (int dt = 0; dt < 8; ++dt) *(u32x2*)(CT + (dt * 16 + fr) * 72 + wid * 16 + fq * 4) = (u32x2){pack2(Cacc[dt][0], Cacc[dt][1]), pack2(Cacc[dt][2], Cacc[dt][3])};
                if (tid < 64) {
                    float n = dec * NS[tid];
#pragma unroll
                    for (int x = 0; x < 8; ++x) { float f[8]; unpack8(*(const u32x4*)(KWT + tid * 72 + x * 8), f); n += ((f[0] + f[1]) + (f[2] + f[3])) + ((f[4] + f[5]) + (f[6] + f[7])); }
                    NS[tid] = n;
                }
            }
            __syncthreads();
        }
    }
}

__device__ void mx_hgrn(const Params& P, int l, int item, char* lds) {
    const int tid = tid_(), wid = tid >> 6, lane = tid & 63, fr = lane & 15, fq = lane >> 4;
    const int b = item >> 4, h = (item >> 2) & 3, half = (item >> 1) & 1, dsel = item & 1;
    const bf16_t* pr = (const bf16_t*)(P.ws + OFF_PREST) + (size_t)b * SQ * PREST_LD + HG_O;
    bf16_t* YD = (bf16_t*)(P.ws + (dsel ? OFF_YD : OFF_Y0)) + (size_t)b * SQ * 512 + h * 128 + half * 64;
    bf16_t* QT = (bf16_t*)lds; bf16_t* KT = QT + 64 * 136; bf16_t* ATT = KT + 128 * 72; bf16_t* VT = ATT + 64 * 72; bf16_t* ST = VT + 64 * 72;
    float* TOT = (float*)(ST + 64 * 136);
    const int dk = tid & 127, hf = tid >> 7;
    const int i = wid * 16 + fr;
#pragma unroll 1
    for (int d = dsel; d <= dsel; ++d) {
        const float lbv = ((const float*)(P.ws + OFF_LB))[(l * 2 + d) * 512 + h * 128 + dk], oml = 1.f - lbv;
        f32x4 Sacc[2][4];
#pragma unroll
        for (int a = 0; a < 2; ++a)
#pragma unroll
            for (int dt = 0; dt < 4; ++dt) Sacc[a][dt] = (f32x4){0.f, 0.f, 0.f, 0.f};
        __syncthreads();
        for (int e = tid; e < 64 * 136 / 2; e += NT) ((unsigned*)ST)[e] = 0u;
        __syncthreads();
        u32x4 pff[4], pfq[4], pfv[2];
        auto hg_load = [&](int cc) {
            const int t0 = d ? SQ - 64 * (cc + 1) : 64 * cc;
#pragma unroll
            for (int it = 0; it < 4; ++it) {
                const int vi = tid + 256 * it, ii = vi >> 4, e = vi & 15, t = TROW(ii);
                pff[it] = *(const u32x4*)(pr + (size_t)t * PREST_LD + 512 * (1 + d) + h * 128 + e * 8);
                pfq[it] = *(const u32x4*)(pr + (size_t)t * PREST_LD + h * 128 + e * 8);
            }
#pragma unroll
            for (int it = 0; it < 2; ++it) {
                const int vi = tid + 256 * it, ii = vi >> 3, e = vi & 7, t = TROW(ii);
                pfv[it] = *(const u32x4*)(pr + (size_t)t * PREST_LD + 1536 + h * 128 + half * 64 + e * 8);
            }
        };
        hg_load(0);
#pragma unroll 1
        for (int c = 0; c < 32; ++c) {
            const int t0 = d ? SQ - 64 * (c + 1) : 64 * c;
#pragma unroll
            for (int it = 0; it < 4; ++it) {
                const int vi = tid + 256 * it, ii = vi >> 4, e = vi & 15;
                *(u32x4*)(KT + ii * 136 + e * 8) = pff[it];
                *(u32x4*)(QT + ii * 136 + e * 8) = pfq[it];
            }
#pragma unroll
            for (int it = 0; it < 2; ++it) {
                const int vi = tid + 256 * it, ii = vi >> 3, e = vi & 7;
                const u32x4 vv = pfv[it];
                VT[(e * 8 + 0) * 72 + ii] = (bf16_t)(vv.x & 0xffff); VT[(e * 8 + 1) * 72 + ii] = (bf16_t)(vv.x >> 16);
                VT[(e * 8 + 2) * 72 + ii] = (bf16_t)(vv.y & 0xffff); VT[(e * 8 + 3) * 72 + ii] = (bf16_t)(vv.y >> 16);
                VT[(e * 8 + 4) * 72 + ii] = (bf16_t)(vv.z & 0xffff); VT[(e * 8 + 5) * 72 + ii] = (bf16_t)(vv.z >> 16);
                VT[(e * 8 + 6) * 72 + ii] = (bf16_t)(vv.w & 0xffff); VT[(e * 8 + 7) * 72 + ii] = (bf16_t)(vv.w >> 16);
            }
            if (c + 1 < 32) hg_load(c + 1);
            __syncthreads();
            bf16_t* kp = KT + hf * 32 * 136 + dk; bf16_t* qp = QT + hf * 32 * 136 + dk;
            {
                float run = 0.f;
#pragma unroll 8
                for (int r = 0; r < 32; ++r) { const bf16_t fb = f2bf(lbv + oml * sigm(bf2f(kp[r * 136]))); kp[r * 136] = fb; run += __logf(bf2f(fb)); }
                TOT[hf * 128 + dk] = run;
            }
            __syncthreads();
            const float R = TOT[dk], gmR = TOT[128 + dk];
            {
                float g = hf ? R : 0.f;
#pragma unroll 8
                for (int r = 0; r < 32; ++r) {
                    const float fv = bf2f(kp[r * 136]);
                    g += __logf(fv);
                    const float e1 = __expf(fminf(g - R, 80.f));
                    qp[r * 136] = f2bf(silu(bf2f(qp[r * 136])) * e1);
                    kp[r * 136] = f2bf((1.f - fv) * __expf(fminf(R - g, 80.f)));
                }
                const float eR = __expf(R);
                bf16_t* sp = ST + hf * 32 * 136 + dk;
#pragma unroll 8
                for (int r = 0; r < 32; ++r) sp[r * 136] = f2bf(bf2f(sp[r * 136]) * eR);
            }
            __syncthreads();
            f32x4 oacc[4];
            unsigned kw[16];
            {
                f32x4 aacc[4];
#pragma unroll
                for (int st = 0; st < 4; ++st) { aacc[st] = (f32x4){0.f, 0.f, 0.f, 0.f}; oacc[st] = (f32x4){0.f, 0.f, 0.f, 0.f}; }
#pragma unroll
                for (int ks = 0; ks < 4; ++ks) {
                    const bf16x8 qf = ldfrag(QT + i * 136 + ks * 32 + fq * 8);
#pragma unroll
                    for (int st = 0; st < 4; ++st) aacc[st] = mfma16(ldfrag(KT + (st * 16 + fr) * 136 + ks * 32 + fq * 8), qf, aacc[st]);
#pragma unroll
                    for (int dt = 0; dt < 4; ++dt) oacc[dt] = mfma16(ldfrag(ST + (dt * 16 + fr) * 136 + ks * 32 + fq * 8), qf, oacc[dt]);
                }
#pragma unroll
                for (int st = 0; st < 4; ++st) {
                    float a[4];
#pragma unroll
                    for (int jj = 0; jj < 4; ++jj) a[jj] = (st * 16 + fq * 4 + jj <= i) ? aacc[st][jj] : 0.f;
                    *(u32x2*)(ATT + i * 72 + st * 16 + fq * 4) = (u32x2){pack2(a[0], a[1]), pack2(a[2], a[3])};
                }
#pragma unroll
                for (int r = 0; r < 16; ++r) kw[r] = (unsigned)kp[(2 * r) * 136] | ((unsigned)kp[(2 * r + 1) * 136] << 16);
            }
            __syncthreads();
            {
                u32x4* dst = (u32x4*)(KT + dk * 72 + hf * 32);
                dst[0] = (u32x4){kw[0], kw[1], kw[2], kw[3]}; dst[1] = (u32x4){kw[4], kw[5], kw[6], kw[7]};
                dst[2] = (u32x4){kw[8], kw[9], kw[10], kw[11]}; dst[3] = (u32x4){kw[12], kw[13], kw[14], kw[15]};
            }
            __syncthreads();
            {
#pragma unroll
                for (int ks = 0; ks < 2; ++ks) {
                    const bf16x8 af = ldfrag(ATT + i * 72 + ks * 32 + fq * 8);
#pragma unroll
                    for (int dt = 0; dt < 4; ++dt) oacc[dt] = mfma16(ldfrag(VT + (dt * 16 + fr) * 72 + ks * 32 + fq * 8), af, oacc[dt]);
                }
                const int t = TROW(i);
                bf16_t* yp = YD + (size_t)t * 512 + fq * 4;
#pragma unroll
                for (int dt = 0; dt < 4; ++dt) {
                    f32x4 v = oacc[dt];
                    *(u32x2*)(yp + dt * 16) = (u32x2){pack2(v[0], v[1]), pack2(v[2], v[3])};
                }
            }
#pragma unroll
            for (int a = 0; a < 2; ++a) {
                const int ktile = 2 * wid + a;
                f32x4 e1, e2;
#pragma unroll
                for (int jj = 0; jj < 4; ++jj) { const int dkk = ktile * 16 + fq * 4 + jj; e1[jj] = __expf(TOT[dkk]); e2[jj] = __expf(TOT[128 + dkk]); }
#pragma unroll
                for (int dt = 0; dt < 4; ++dt) Sacc[a][dt] *= e1;
#pragma unroll
                for (int ks = 0; ks < 2; ++ks) {
                    const bf16x8 kf = ldfrag(KT + (ktile * 16 + fr) * 72 + ks * 32 + fq * 8);
#pragma unroll
                    for (int dt = 0; dt < 4; ++dt) Sacc[a][dt] = mfma16(kf, ldfrag(VT + (dt * 16 + fr) * 72 + ks * 32 + fq * 8), Sacc[a][dt]);
                }
#pragma unroll
                for (int dt = 0; dt < 4; ++dt) {
                    Sacc[a][dt] *= e2;
                    *(u32x2*)(ST + (dt * 16 + fr) * 136 + ktile * 16 + fq * 4) = (u32x2){pack2(Sacc[a][dt][0], Sacc[a][dt][1]), pack2(Sacc[a][dt][2], Sacc[a][dt][3])};
                }
            }
            __syncthreads();
        }
    }
}

__device__ void mx_lru(const Params& P, int l, int item, char* lds) {
    const int tid = tid_(), wid = tid >> 6, lane = tid & 63, fr = lane & 15, fq = lane >> 4;
    const int b = item >> 4, g = (item >> 1) & 7, dsel = item & 1;
    const bf16_t* pr = (const bf16_t*)(P.ws + OFF_PREST) + (size_t)b * SQ * PREST_LD + LRU_O;
    bf16_t* YC = dsel ? (bf16_t*)(P.ws + OFF_YC) + (size_t)b * SQ * 512 + g * 64 : (bf16_t*)(P.ws + OFF_PREST) + (size_t)b * SQ * PREST_LD + HG_O + g * 64;
    const int ystride = dsel ? 512 : PREST_LD;
    bf16_t* XC = (bf16_t*)lds; float* AA = (float*)(lds + 9216); float* BB = AA + 64 * 65; float* HH = BB + 64 * 65;
    const int ch = tid & 63, tq = tid >> 6;
    float cwv[4];
#pragma unroll
    for (int j = 0; j < 4; ++j) cwv[j] = P.in[I_LCW][(l * 4 + j) * 512 + g * 64 + ch];
    const float cbv = P.in[I_LCB][l * 512 + g * 64 + ch];
    const int i = wid * 16 + fr;
#pragma unroll 1
    for (int d = dsel; d <= dsel; ++d) {
        bf16x8 waf[4][2], wxf[4][2]; f32x4 ba4[4], bx4[4], c8[4];
        {
            const bf16_t* Wa = (const bf16_t*)(P.ws + WT_LRU) + (((size_t)d * 2 + 0) * 8 + g) * 4096;
            const bf16_t* Wx = (const bf16_t*)(P.ws + WT_LRU) + (((size_t)d * 2 + 1) * 8 + g) * 4096;
#pragma unroll
            for (int jt = 0; jt < 4; ++jt) {
#pragma unroll
                for (int ks = 0; ks < 2; ++ks) { waf[jt][ks] = ldfrag(Wa + (jt * 16 + fr) * 64 + ks * 32 + fq * 8); wxf[jt][ks] = ldfrag(Wx + (jt * 16 + fr) * 64 + ks * 32 + fq * 8); }
                const int j = (l * 2 + d) * 512 + g * 64 + jt * 16 + fq * 4;
                ba4[jt] = *(const f32x4*)(P.in[I_LBA] + j); bx4[jt] = *(const f32x4*)(P.in[I_LBX] + j);
                const f32x4 lam = *(const f32x4*)(P.in[I_LLAM] + j);
#pragma unroll
                for (int jj = 0; jj < 4; ++jj) c8[jt][jj] = -8.f * (fmaxf(-lam[jj], 0.f) + log1pf(__expf(-fabsf(lam[jj]))));
            }
        }
        float hst = 0.f;
        bf16_t xr[19];
        auto lru_load = [&](int cc) {
            const int t0 = d ? SQ - 64 * (cc + 1) : 64 * cc;
#pragma unroll
            for (int k = 0; k < 19; ++k) { const int t = t0 + tq * 16 - 1 + k; xr[k] = (t >= 0 && t < SQ) ? pr[(size_t)t * PREST_LD + g * 64 + ch] : (bf16_t)0; }
        };
        lru_load(0);
#pragma unroll 1
        for (int c = 0; c < 32; ++c) {
            const int t0 = d ? SQ - 64 * (c + 1) : 64 * c;
            {
                float xw[19];
#pragma unroll
                for (int k = 0; k < 19; ++k) xw[k] = bf2f(xr[k]);
                if (c + 1 < 32) lru_load(c + 1);
#pragma unroll
                for (int r = 0; r < 16; ++r) XC[(tq * 16 + r) * 72 + ch] = f2bf(cbv + cwv[0] * xw[r] + cwv[1] * xw[r + 1] + cwv[2] * xw[r + 2] + cwv[3] * xw[r + 3]);
            }
            __syncthreads();
            {
                f32x4 ra[4], rx[4];
#pragma unroll
                for (int jt = 0; jt < 4; ++jt) { ra[jt] = (f32x4){0.f, 0.f, 0.f, 0.f}; rx[jt] = (f32x4){0.f, 0.f, 0.f, 0.f}; }
#pragma unroll
                for (int ks = 0; ks < 2; ++ks) {
                    const bf16x8 xf = ldfrag(XC + i * 72 + ks * 32 + fq * 8);
#pragma unroll
                    for (int jt = 0; jt < 4; ++jt) { ra[jt] = mfma16(waf[jt][ks], xf, ra[jt]); rx[jt] = mfma16(wxf[jt][ks], xf, rx[jt]); }
                }
#pragma unroll
                for (int jt = 0; jt < 4; ++jt) {
                    float xc[4]; unpack4(*(const u32x2*)(XC + i * 72 + jt * 16 + fq * 4), xc);
#pragma unroll
                    for (int jj = 0; jj < 4; ++jj) {
                        const float la = c8[jt][jj] * sigm(ra[jt][jj] + ba4[jt][jj]);
                        const float av = __expf(la);
                        const float mult = __builtin_amdgcn_sqrtf(fmaxf(1.f - av * av, 0.f));
                        AA[i * 65 + jt * 16 + fq * 4 + jj] = av;
                        BB[i * 65 + jt * 16 + fq * 4 + jj] = mult * sigm(rx[jt][jj] + bx4[jt][jj]) * xc[jj];
                    }
                }
            }
            __syncthreads();
            if (tid < 64) {
#pragma unroll 1
                for (int r8 = 0; r8 < 8; ++r8) {
                    float av[8], bv[8];
#pragma unroll
                    for (int x = 0; x < 8; ++x) { const int r = d ? 63 - (r8 * 8 + x) : r8 * 8 + x; av[x] = AA[r * 65 + ch]; bv[x] = BB[r * 65 + ch]; }
#pragma unroll
                    for (int x = 0; x < 8; ++x) { const int r = d ? 63 - (r8 * 8 + x) : r8 * 8 + x; hst = av[x] * hst + bv[x]; HH[r * 65 + ch] = hst; }
                }
            }
            __syncthreads();
#pragma unroll
            for (int r = 0; r < 16; ++r) {
                const int ii = tq * 16 + r, t = t0 + ii;
                const float hv = HH[ii * 65 + ch];
                YC[(size_t)t * ystride + ch] = f2bf(hv);
            }
        }
        __syncthreads();
    }
}

__device__ void dbg_zero(bf16_t* p, size_t n, int part, int nparts) {
    u32x4* q = (u32x4*)p; const size_t n8 = n / 8, per = (n8 + nparts - 1) / nparts, lo = per * part, hi = (lo + per < n8) ? lo + per : n8;
    for (size_t e = lo + tid_(); e < hi; e += NT) q[e] = (u32x4){0u, 0u, 0u, 0u};
}
__device__ void ph_mixers(const Params& P, int l, char* lds, int which) {
    const int nitems = which ? 512 : 384;
    for (int item = bid_(); item < nitems; item += gridDim.x) {
        if (which) { if (item < 256) mx_rwkv(P, l, item, lds); else mx_lru(P, l, item - 256, lds); }
        else if (item < 256) mx_hgrn(P, l, item, lds);
        else mx_mlstm(P, l, item - 256, lds);
        __syncthreads();
    }
}

__device__ void ph_rwpost(const Params& P, int l, char* lds) {
    const int tid = tid_(), wid = tid >> 6, lane = tid & 63, fr = lane & 15, fq = lane >> 4;
    bf16_t* SG = (bf16_t*)lds; float* STAT = (float*)(lds + 64 * 136 * 2);
    const bf16_t* G2T = (const bf16_t*)(P.ws + WT_G2);
    const float* mu = P.in[I_MU] + l * 1792;
    for (int item = bid_(); item < TT / 64; item += gridDim.x) {
        const int tok0 = item * 64, s0 = tok0 & (SQ - 1);
        const bf16_t* prw = (const bf16_t*)(P.ws + OFF_PRW);
        bf16_t* Y0 = (bf16_t*)(P.ws + OFF_Y0); const bf16_t* Y1 = (const bf16_t*)(P.ws + OFF_Y1);
        const float* be0 = (const float*)(P.ws + OFF_BETA); const float* be1 = be0 + (size_t)TT * 8;
        __syncthreads();
        {
            const int r = tid >> 2, part = tid & 3, t = tok0 + r, sp = s0 + r;
#pragma unroll
            for (int v = 0; v < 4; ++v) {
                const int c = part * 32 + v * 8;
                float f0[8], fm[8], fp[8];
                unpack8(*(const u32x4*)(prw + (size_t)t * PRW_LD + 1664 + c), f0);
                if (sp > 0) unpack8(*(const u32x4*)(prw + (size_t)(t - 1) * PRW_LD + 1664 + c), fm); else { for (int x = 0; x < 8; ++x) fm[x] = 0.f; }
                if (sp < SQ - 1) unpack8(*(const u32x4*)(prw + (size_t)(t + 1) * PRW_LD + 1664 + c), fp); else { for (int x = 0; x < 8; ++x) fp[x] = 0.f; }
                float o[8];
#pragma unroll
                for (int x = 0; x < 8; ++x) o[x] = sigm(f0[x] + mu[1664 + c + x] * (0.5f * (fm[x] + fp[x]) - f0[x]));
                *(u32x4*)(SG + r * 136 + c) = (u32x4){pack2(o[0], o[1]), pack2(o[2], o[3]), pack2(o[4], o[5]), pack2(o[6], o[7])};
            }
#pragma unroll
            for (int hh = 0; hh < 2; ++hh) {
                const int head = part * 2 + hh;
                float sm = 0.f, sq = 0.f;
#pragma unroll
                for (int v = 0; v < 8; ++v) {
                    float a[8], bq[8];
                    unpack8(*(const u32x4*)(Y0 + (size_t)t * 512 + head * 64 + v * 8), a); unpack8(*(const u32x4*)(Y1 + (size_t)t * 512 + head * 64 + v * 8), bq);
#pragma unroll
                    for (int x = 0; x < 8; ++x) { const float y = a[x] + bq[x]; sm += y; sq += y * y; }
                }
                const float mean = sm * (1.f / 64.f), var = fmaxf(sq * (1.f / 64.f) - mean * mean, 0.f);
                STAT[(r * 8 + head) * 2] = mean; STAT[(r * 8 + head) * 2 + 1] = rsqrtf(var + 64e-5f);
            }
        }
        __syncthreads();
#pragma unroll 1
        for (int np = 0; np < 4; ++np) {
            const int nt0 = wid * 8 + np * 2;
#pragma unroll 1
            for (int tt = 0; tt < 4; ++tt) {
                f32x4 acc[2];
                acc[0] = (f32x4){0.f, 0.f, 0.f, 0.f}; acc[1] = (f32x4){0.f, 0.f, 0.f, 0.f};
#pragma unroll
                for (int ks = 0; ks < 4; ++ks) {
                    const bf16x8 b0 = ldfrag(G2T + (size_t)(nt0 * 16 + fr) * 128 + ks * 32 + fq * 8), b1 = ldfrag(G2T + (size_t)((nt0 + 1) * 16 + fr) * 128 + ks * 32 + fq * 8);
                    const bf16x8 af = ldfrag(SG + (tt * 16 + fr) * 136 + ks * 32 + fq * 8);
                    acc[0] = mfma16(b0, af, acc[0]); acc[1] = mfma16(b1, af, acc[1]);
                }
#pragma unroll
                for (int q = 0; q < 2; ++q) {
                    const int r = tt * 16 + fr, t = tok0 + r, sp = s0 + r, n = (nt0 + q) * 16 + fq * 4, head = n >> 6;
                    float y0[4], y1[4], v0[4], vm[4], vp[4];
                    unpack4(*(const u32x2*)(Y0 + (size_t)t * 512 + n), y0); unpack4(*(const u32x2*)(Y1 + (size_t)t * 512 + n), y1);
                    unpack4(*(const u32x2*)(prw + (size_t)t * PRW_LD + 1024 + n), v0);
                    if (sp > 0) unpack4(*(const u32x2*)(prw + (size_t)(t - 1) * PRW_LD + 1024 + n), vm); else { vm[0] = vm[1] = vm[2] = vm[3] = 0.f; }
                    if (sp < SQ - 1) unpack4(*(const u32x2*)(prw + (size_t)(t + 1) * PRW_LD + 1024 + n), vp); else { vp[0] = vp[1] = vp[2] = vp[3] = 0.f; }
                    const float mean = STAT[(r * 8 + head) * 2], rstd = STAT[(r * 8 + head) * 2 + 1];
                    const float be = 0.5f * (be0[(size_t)t * 8 + head] + be1[(size_t)t * 8 + head]);
                    const f32x4 lw = *(const f32x4*)(P.in[I_LNW] + l * 512 + n), lb = *(const f32x4*)(P.in[I_LNB] + l * 512 + n), m4 = *(const f32x4*)(mu + 1024 + n);
                    float o[4];
#pragma unroll
                    for (int jj = 0; jj < 4; ++jj) {
                        const float vs = v0[jj] + m4[jj] * (0.5f * (vm[jj] + vp[jj]) - v0[jj]);
                        o[jj] = (((y0[jj] + y1[jj]) - mean) * rstd * lw[jj] + lb[jj] + be * vs) * acc[q][jj];
                    }
                    *(u32x2*)(Y0 + (size_t)t * 512 + n) = (u32x2){pack2(o[0], o[1]), pack2(o[2], o[3])};
                }
            }
        }
    }
    __syncthreads();
}
__device__ void ph_lrupost(const Params& P) {
    bf16_t* YC = (bf16_t*)(P.ws + OFF_YC); const bf16_t* pr = (const bf16_t*)(P.ws + OFF_PREST);
    const long n = (long)TT * 64;
    for (long task = (long)bid_() * NT + tid_(); task < n; task += (long)gridDim.x * NT) {
        const long t = task >> 6; const int c = (int)(task & 63) * 8;
        float a[8], b2[8], gq[8];
        unpack8(*(const u32x4*)(YC + t * 512 + c), a); unpack8(*(const u32x4*)(pr + t * PREST_LD + HG_O + c), b2); unpack8(*(const u32x4*)(pr + t * PREST_LD + LRU_O + 512 + c), gq);
        float o[8];
#pragma unroll
        for (int x = 0; x < 8; ++x) o[x] = (a[x] + b2[x]) * gelu_t(gq[x]);
        *(u32x4*)(YC + t * 512 + c) = (u32x4){pack2(o[0], o[1]), pack2(o[2], o[3]), pack2(o[4], o[5]), pack2(o[6], o[7])};
    }
}

template <bool ML> __device__ void ph_headpost(const Params& P, int l) {
    const int tid = tid_();
    bf16_t* YO = (bf16_t*)(P.ws + (ML ? OFF_YB : OFF_YD)); const bf16_t* SDF = (const bf16_t*)(P.ws + (ML ? OFF_Y1 : OFF_Y0));
    const bf16_t* pr = (const bf16_t*)(P.ws + OFF_PREST) + (ML ? 1024 : HG_O + 2048);
    const float* ng = P.in[ML ? I_MLN : I_HGN] + l * 512;
    for (int item = bid_(); item < TT / 64; item += gridDim.x) {
        const int t = item * 64 + (tid >> 2), part = tid & 3;
#pragma unroll 2
        for (int hh = 0; hh < 4; ++hh) {
            const int c0 = hh * 128 + part * 32;
            float v[32]; float ss = 0.f;
#pragma unroll
            for (int q = 0; q < 4; ++q) { float f[8], f2[8]; unpack8(*(const u32x4*)(YO + (size_t)t * 512 + c0 + q * 8), f); unpack8(*(const u32x4*)(SDF + (size_t)t * 512 + c0 + q * 8), f2);
#pragma unroll
                for (int x = 0; x < 8; ++x) { const float y = f[x] + f2[x]; v[q * 8 + x] = y; ss += y * y; } }
            ss += dppf<0xB1>(ss); ss += dppf<0x4E>(ss);
            const float rms = rsqrtf(ss * (1.f / 128.f) + 1e-6f);
#pragma unroll
            for (int q = 0; q < 4; ++q) {
                float gq[8]; unpack8(*(const u32x4*)(pr + (size_t)t * PREST_LD + c0 + q * 8), gq);
                float o[8];
#pragma unroll
                for (int x = 0; x < 8; ++x) o[x] = (ML ? sigm(gq[x]) : silu(gq[x])) * v[q * 8 + x] * rms * ng[c0 + q * 8 + x];
                *(u32x4*)(YO + (size_t)t * 512 + c0 + q * 8) = (u32x4){pack2(o[0], o[1]), pack2(o[2], o[3]), pack2(o[4], o[5]), pack2(o[6], o[7])};
            }
        }
    }
}

#define XB_TMO      128
#define XB_XCNT(j)  (256  + 64 * (j))
#define XB_XSUB(j)  (1280 + 64 * (j))
#define XB_XGEN(j)  (2304 + 64 * (j))
#define XB_TOP      3328
#define XB_TOPGEN   3392
#define XCD_BAR_WORDS 3456
#define XB_SPIN_CAP (1u << 18)
#define LAS __attribute__((address_space(3)))

__device__ __forceinline__ unsigned xb_ld(unsigned* p)              { return __hip_atomic_load(p, __ATOMIC_RELAXED, __HIP_MEMORY_SCOPE_AGENT); }
__device__ __forceinline__ unsigned xb_add(unsigned* p, unsigned v) { return __hip_atomic_fetch_add(p, v, __ATOMIC_RELAXED, __HIP_MEMORY_SCOPE_AGENT); }
__device__ __forceinline__ unsigned xb_xcc_id() { return (unsigned)__builtin_amdgcn_s_getreg((3 << 11) | 20) & 0xFu; }
#define XB_SPIN(cond, bar) do { unsigned _sp = 0; while (cond) { __builtin_amdgcn_s_sleep(1); \
    if ((++_sp & 255u) == 0u) { if (xb_ld(&(bar)[XB_TMO])) break; if (_sp > XB_SPIN_CAP) { atomicAdd(&(bar)[XB_TMO], 1u); break; } } } } while (0)

struct XcdBarrier {
    unsigned* bar; unsigned x;
    volatile LAS unsigned* st;
};

__device__ __forceinline__ XcdBarrier xcd_barrier_post(unsigned* bar, volatile LAS unsigned* st) {
    XcdBarrier b; b.bar = bar; b.x = xb_xcc_id(); b.st = st;
    if (threadIdx.x == 0) (void)xb_add(&bar[XB_XCNT(b.x)], 1u);
    return b;
}
__device__ __forceinline__ void xcd_barrier_complete(unsigned* bar, unsigned x, unsigned& nloc, unsigned& nx) {
    const unsigned G = gridDim.x * gridDim.y * gridDim.z;
    unsigned sum, cnt, mine, sp = 0u;
    for (;;) {
        sum = 0u; cnt = 0u; mine = 0u;
#pragma unroll
        for (unsigned j = 0; j < 16; ++j) { const unsigned c = xb_ld(&bar[XB_XCNT(j)]); sum += c; cnt += (c > 0u) ? 1u : 0u; mine = (j == x) ? c : mine; }
        if (sum == G) break;
        __builtin_amdgcn_s_sleep(1);
        if ((++sp & 255u) == 0u) { if (xb_ld(&bar[XB_TMO])) break; if (sp > XB_SPIN_CAP) { atomicAdd(&bar[XB_TMO], 1u); break; } }
    }
    nloc = mine > 0u ? mine : 1u; nx = cnt > 0u ? cnt : 1u;
}

__device__ __forceinline__ void xcd_barrier(const XcdBarrier& b) {
    asm volatile("s_waitcnt vmcnt(0)" ::: "memory");
    __syncthreads();
    if (threadIdx.x == 0) {
        unsigned* bar = b.bar;
        __builtin_amdgcn_s_waitcnt(0);
        unsigned nloc = b.st[0], nx = b.st[1];
        if (nloc == 0u) { xcd_barrier_complete(bar, b.x, nloc, nx); b.st[0] = nloc; b.st[1] = nx; }
        const unsigned old = xb_add(&bar[XB_XSUB(b.x)], 1u);
        const unsigned gen = old / nloc;
        if (old + 1u == (gen + 1u) * nloc) {
            __builtin_amdgcn_fence(__ATOMIC_RELEASE, "agent");
            asm volatile("s_waitcnt vmcnt(0)" ::: "memory");
            const unsigned og = xb_add(&bar[XB_TOP], 1u);
            const unsigned tg = og / nx;
            if (og + 1u == (tg + 1u) * nx) xb_add(&bar[XB_TOPGEN], 1u);
            else XB_SPIN(xb_ld(&bar[XB_TOPGEN]) == tg, bar);
            __builtin_amdgcn_fence(__ATOMIC_ACQUIRE, "agent");
            xb_add(&bar[XB_XGEN(b.x)], 1u);
            asm volatile("s_waitcnt vmcnt(0)" ::: "memory");
        } else {
            XB_SPIN(xb_ld(&bar[XB_XGEN(b.x)]) == gen, bar);
            __builtin_amdgcn_fence(__ATOMIC_ACQUIRE, "agent");
            asm volatile("s_waitcnt vmcnt(0)" ::: "memory");
        }
    }
    __syncthreads();
}


constexpr int N_PHASES = 2 + NL * 13;
__device__ void run_phase(const Params& P, int ph, char* lds) {
    if (ph == 0) { ph_init(P, lds); return; }
    if (ph == N_PHASES - 1) { ph_norm(P, P.in[I_FING], nullptr, 0, 0, nullptr, true); return; }
    const int l = (ph - 1) / 13; int sp = (ph - 1) % 13;
    const float* modl = (const float*)(P.ws + OFF_MOD) + (size_t)l * 16 * 6144;
    if (sp == 2) { ph_mixers(P, l, lds, 0); return; }
    if (sp == 3) { ph_headpost<false>(P, l); ph_headpost<true>(P, l); return; }
    if (sp == 4) { ph_mixers(P, l, lds, 1); return; }
    if (sp > 4) sp -= 2;
    switch (sp) {
        case 0: ph_wt(P, l, lds); ph_norm(P, P.in[I_N1G] + l * DM, modl, 0, 1024, (bf16_t*)(P.ws + OFF_U), false); break;
        case 1: ph_gemm_p(P, lds); break;
        case 3: ph_rwpost(P, l, lds); ph_lrupost(P); break;
        case 4: ph_norm(P, P.in[I_N1G] + l * DM, modl, 0, 1024, (bf16_t*)(P.ws + OFF_URE), false); break;
        case 5: ph_gemm_merge(P, lds); break;
        case 6: ph_gemm_out(P, l, lds); break;
        case 7: ph_norm(P, P.in[I_N2G] + l * DM, modl, 3072, 4096, (bf16_t*)(P.ws + OFF_U2), false); break;
        case 8: ph_gemm_up(P, lds); break;
        case 9: ph_convact(P, l); break;
        default: ph_gemm_down(P, l, lds); break;
    }
}

__global__ void __launch_bounds__(NT, 2) mega(Params P, int ph_lo, int ph_hi) {
    extern __shared__ __attribute__((aligned(16))) char smem[];
    cg::grid_group grid = cg::this_grid();
    volatile LAS unsigned* xst = (volatile LAS unsigned*)(smem + LDS_BYTES - 16);
    if (threadIdx.x == 0) { xst[0] = 0u; xst[1] = 0u; }
    __syncthreads();
    XcdBarrier xb = xcd_barrier_post((unsigned*)(P.ws + OFF_BAR), xst);
    for (int ph = ph_lo; ph < ph_hi; ++ph) {
        run_phase(P, ph, smem);
        if (ph + 1 < ph_hi) { if (ph == ph_lo) grid.sync(); else xcd_barrier(xb); }
    }
}

extern "C" void kernel_launch(void* const* d_in, const int* in_sizes, int n_in, void* d_out, int out_size, void* d_ws, size_t ws_size, hipStream_t stream) {
    static int grid_blocks = 0;
    if (grid_blocks == 0) {
        if (n_in != N_INPUTS || ws_size < WS_NEED || out_size != TT * DM) { fprintf(stderr, "kernel_launch: unexpected shapes (n_in %d ws %zu need %zu)\n", n_in, ws_size, (size_t)WS_NEED); grid_blocks = -1; return; }
        int dev = 0, cus = 0, per_cu = 0;
        hipGetDevice(&dev);
        hipDeviceGetAttribute(&cus, hipDeviceAttributeMultiprocessorCount, dev);
        if (hipFuncSetAttribute((const void*)mega, hipFuncAttributeMaxDynamicSharedMemorySize, LDS_BYTES) != hipSuccess) { fprintf(stderr, "kernel_launch: hipFuncSetAttribute failed\n"); grid_blocks = -1; return; }
        hipOccupancyMaxActiveBlocksPerMultiprocessor(&per_cu, (const void*)mega, NT, LDS_BYTES);
        if (per_cu < 1) per_cu = 1;
        if (per_cu > 2) per_cu = 2;
        grid_blocks = cus * per_cu;
    }
    if (grid_blocks < 0) return;
    if (hipMemsetAsync((char*)d_ws + OFF_BAR, 0, BAR_BYTES, stream) != hipSuccess) { fprintf(stderr, "kernel_launch: memset of the barrier words failed\n"); return; }
    Params p{};
    for (int i = 0; i < N_INPUTS; ++i) p.in[i] = (const float*)d_in[i];
    p.out = (float*)d_out; p.ws = (char*)d_ws;
#if MULTI_LAUNCH
    for (int ph = 0; ph < N_PHASES; ++ph) hipLaunchKernelGGL(mega, dim3(grid_blocks), dim3(NT), LDS_BYTES, stream, p, ph, ph + 1);
#else
    int lo = 0, hi = N_PHASES;
    void* args[] = {&p, &lo, &hi};
    hipError_t e = hipLaunchCooperativeKernel((const void*)mega, dim3(grid_blocks), dim3(NT), args, LDS_BYTES, stream);
    if (e != hipSuccess) fprintf(stderr, "cooperative launch failed: %s (grid %d)\n", hipGetErrorString(e), grid_blocks);
#endif
}
```

```cpp
#include <hip/hip_runtime.h>
#include <hip/hip_cooperative_groups.h>
#include <cstdio>
namespace cg = cooperative_groups;

typedef unsigned short bf16_t;
typedef short bf16x8 __attribute__((ext_vector_type(8)));
typedef float f32x4 __attribute__((ext_vector_type(4)));
typedef unsigned u32x4 __attribute__((ext_vector_type(4)));
typedef unsigned u32x2 __attribute__((ext_vector_type(2)));

#ifndef DBG_SKIP
#define DBG_SKIP 0
#endif
#ifndef DBG_NOFFN
#define DBG_NOFFN 0
#endif
#ifndef MULTI_LAUNCH
#define MULTI_LAUNCH 0
#endif

constexpr int NB = 16, SQ = 2048, DM = 1024, TT = NB * SQ, MW = 512, NL = 4;
constexpr int NT = 256;
constexpr int PRW_LD = 1792, PREST_LD = 5248;
constexpr int LRU_O = 1664, HG_O = 2688;
constexpr int GATE_ROW0 = 7040;
constexpr int DFF = 2816;
constexpr int LDS_BYTES = 73728;

constexpr size_t WT_WIN = 0;
constexpr size_t WT_WB = WT_WIN + (size_t)11136 * 1024 * 2;
constexpr size_t WT_WOUT = WT_WB + (size_t)4 * 1024 * 512 * 2;
constexpr size_t WT_WUP = WT_WOUT + (size_t)1024 * 1024 * 2;
constexpr size_t WT_WDN = WT_WUP + (size_t)5632 * 1024 * 2;
constexpr size_t WT_G2 = WT_WDN + (size_t)1024 * 2816 * 2;
constexpr size_t WT_W2 = WT_G2 + (size_t)512 * 128 * 2;
constexpr size_t WT_A2 = WT_W2 + (size_t)2 * 512 * 64 * 2;
constexpr size_t WT_LRU = WT_A2 + (size_t)2 * 512 * 64 * 2;
constexpr size_t WT_END = WT_LRU + (size_t)2 * 2 * 8 * 64 * 64 * 2;
constexpr size_t OFF_PRW = (size_t)48 << 20;
static_assert(WT_END <= OFF_PRW, "wt");
constexpr size_t OFF_PREST = OFF_PRW + (size_t)TT * PRW_LD * 2;
constexpr size_t OFF_Y = OFF_PREST + (size_t)TT * PREST_LD * 2;
constexpr size_t YSZ = (size_t)TT * 512 * 2;
constexpr size_t OFF_YB = OFF_Y, OFF_YC = OFF_Y + YSZ, OFF_YD = OFF_Y + 2 * YSZ, OFF_Y0 = OFF_Y + 3 * YSZ, OFF_Y1 = OFF_Y + 4 * YSZ;
constexpr size_t OFF_SMALL = OFF_Y + 5 * YSZ;
constexpr size_t OFF_MOD = OFF_SMALL;
constexpr size_t OFF_LB = OFF_MOD + (size_t)4 * 16 * 6144 * 4;
constexpr size_t OFF_BETA = OFF_LB + (size_t)4 * 2 * 512 * 4;
constexpr size_t OFF_BAR = OFF_BETA + (size_t)2 * TT * 8 * 4;
constexpr size_t BAR_BYTES = 16384;
constexpr size_t WS_NEED = OFF_BAR + BAR_BYTES;
constexpr size_t OFF_U = OFF_Y;
constexpr size_t OFF_URE = OFF_PREST;
constexpr size_t OFF_MERGED = OFF_PREST + (size_t)TT * 1024 * 2;
constexpr size_t OFF_U2 = OFF_Y;
constexpr size_t OFF_Z = OFF_PRW;
constexpr size_t OFF_ACT = OFF_PRW + (size_t)TT * 5632 * 2;
static_assert(OFF_ACT + (size_t)TT * 2816 * 2 <= OFF_SMALL, "act");

enum { I_X = 0, I_C, I_ADAW, I_ADAB, I_N1G, I_WIN, I_MU, I_W0, I_W2, I_A0, I_A2, I_G2, I_KK, I_KA, I_RK, I_LNW, I_LNB,
       I_MLIB, I_MLFB, I_MLN, I_LCW, I_LCB, I_LWA, I_LBA, I_LWX, I_LBX, I_LLAM, I_HGLB, I_HGN, I_WBR, I_WOUT, I_N2G,
       I_FUP, I_FCW, I_FCB, I_FDN, I_FING, N_INPUTS };

struct Params { const float* in[N_INPUTS]; float* out; char* ws; };

__device__ __forceinline__ int tid_() { int x = threadIdx.x; asm volatile("" : "+v"(x)); return x; }
__device__ __forceinline__ int bid_() { int x = blockIdx.x; asm volatile("" : "+s"(x)); return x; }
__device__ __forceinline__ bf16_t f2bf(float f) { unsigned u = __float_as_uint(f); u += 0x7fffu + ((u >> 16) & 1u); return (bf16_t)(u >> 16); }
__device__ __forceinline__ float bf2f(bf16_t h) { return __uint_as_float(((unsigned)h) << 16); }
__device__ __forceinline__ unsigned pack2(float a, float b) { return (unsigned)f2bf(a) | ((unsigned)f2bf(b) << 16); }
__device__ __forceinline__ float lo2f(unsigned u) { return __uint_as_float(u << 16); }
__device__ __forceinline__ float hi2f(unsigned u) { return __uint_as_float(u & 0xffff0000u); }
__device__ __forceinline__ float rcpf_(float x) { return __builtin_amdgcn_rcpf(x); }
__device__ __forceinline__ float sigm(float x) { return rcpf_(1.f + __expf(-x)); }
__device__ __forceinline__ float silu(float x) { return x * sigm(x); }
__device__ __forceinline__ float logsig(float x) { return fminf(x, 0.f) - __logf(1.f + __expf(-fabsf(x))); }
__device__ __forceinline__ float tanh_f(float x) { return 1.f - 2.f * rcpf_(1.f + __expf(2.f * x)); }
__device__ __forceinline__ float gelu_t(float x) { return 0.5f * x * (1.f + tanh_f(0.7978845608f * (x + 0.044715f * x * x * x))); }
template <int CTRL> __device__ __forceinline__ float dppf(float x) { return __int_as_float(__builtin_amdgcn_update_dpp(0, __float_as_int(x), CTRL, 0xF, 0xF, false)); }
__device__ __forceinline__ float rowsum16(float x) { x += dppf<0x128>(x); x += dppf<0x124>(x); x += dppf<0x122>(x); x += dppf<0x121>(x); return x; }
__device__ __forceinline__ float rdlane(float x, int l) { return __int_as_float(__builtin_amdgcn_readlane(__float_as_int(x), l)); }
__device__ __forceinline__ float wsum64(float x) { x = rowsum16(x); return (rdlane(x, 0) + rdlane(x, 16)) + (rdlane(x, 32) + rdlane(x, 48)); }
__device__ __forceinline__ float bperm(float x, int srclane) { return __int_as_float(__builtin_amdgcn_ds_bpermute(srclane << 2, __float_as_int(x))); }
__device__ __forceinline__ float qsum(float x, int lane) { x += bperm(x, lane ^ 16); x += bperm(x, lane ^ 32); return x; }
__device__ __forceinline__ void unpack8(u32x4 v, float (&f)[8]) {
    f[0] = lo2f(v.x); f[1] = hi2f(v.x); f[2] = lo2f(v.y); f[3] = hi2f(v.y); f[4] = lo2f(v.z); f[5] = hi2f(v.z); f[6] = lo2f(v.w); f[7] = hi2f(v.w); }
__device__ __forceinline__ void unpack4(u32x2 v, float (&f)[4]) { f[0] = lo2f(v.x); f[1] = hi2f(v.x); f[2] = lo2f(v.y); f[3] = hi2f(v.y); }
__device__ __forceinline__ f32x4 mfma16(bf16x8 a, bf16x8 b, f32x4 c) { return __builtin_amdgcn_mfma_f32_16x16x32_bf16(a, b, c, 0, 0, 0); }
__device__ __forceinline__ bf16x8 ldfrag(const bf16_t* p) { return *reinterpret_cast<const bf16x8*>(p); }

__device__ __forceinline__ void gemm_stage(const bf16_t* __restrict__ A, long lda, const bf16_t* __restrict__ Bt, long ldb, int kt, char* buf, int tid) {
#pragma unroll
    for (int i = 0; i < 4; ++i) {
        const int b = tid * 16 + i * 4096, r = b >> 7, c = ((b & 127) >> 4) ^ (r & 7);
        __builtin_amdgcn_global_load_lds((const unsigned*)(A + (long)r * lda + kt * 64 + c * 8), (__attribute__((address_space(3))) unsigned*)(buf + b), 16, 0, 0);
        __builtin_amdgcn_global_load_lds((const unsigned*)(Bt + (long)r * ldb + kt * 64 + c * 8), (__attribute__((address_space(3))) unsigned*)(buf + 16384 + b), 16, 0, 0);
    }
}
__device__ __forceinline__ void gemm_acc(const bf16_t* __restrict__ A, long lda, const bf16_t* __restrict__ Bt, long ldb, int K, f32x4 (&acc)[4][4], char* lds) {
    const int tid = tid_(), wid = tid >> 6, lane = tid & 63, wr = wid >> 1, wc = wid & 1, fr = lane & 15, fq = lane >> 4;
    const int nk = K >> 6;
    gemm_stage(A, lda, Bt, ldb, 0, lds, tid);
    asm volatile("s_waitcnt vmcnt(0)" ::: "memory");
    __syncthreads();
    for (int kt = 0; kt < nk; ++kt) {
        char* cur = lds + (kt & 1) * 32768;
        if (kt + 1 < nk) gemm_stage(A, lda, Bt, ldb, kt + 1, lds + ((kt + 1) & 1) * 32768, tid);
#pragma unroll
        for (int ks = 0; ks < 2; ++ks) {
            bf16x8 af[4], bfr[4];
#pragma unroll
            for (int m = 0; m < 4; ++m) { const int row = wr * 64 + m * 16 + fr; af[m] = *reinterpret_cast<const bf16x8*>(cur + row * 128 + (((ks * 4 + fq) ^ (row & 7)) << 4)); }
#pragma unroll
            for (int n = 0; n < 4; ++n) { const int row = wc * 64 + n * 16 + fr; bfr[n] = *reinterpret_cast<const bf16x8*>(cur + 16384 + row * 128 + (((ks * 4 + fq) ^ (row & 7)) << 4)); }
            __builtin_amdgcn_s_setprio(1);
#pragma unroll
            for (int m = 0; m < 4; ++m)
#pragma unroll
                for (int n = 0; n < 4; ++n) acc[m][n] = mfma16(bfr[n], af[m], acc[m][n]);
            __builtin_amdgcn_s_setprio(0);
        }
        asm volatile("s_waitcnt vmcnt(0)" ::: "memory");
        __syncthreads();
    }
}
__device__ __forceinline__ void gemm2_stage(const bf16_t* __restrict__ A, long lda, const bf16_t* __restrict__ Bt, long ldb, int kt, char* buf, int tid) {
#pragma unroll
    for (int i = 0; i < 4; ++i) {
        const int b = tid * 16 + i * 4096, r = b >> 6, c = ((b & 63) >> 4) ^ ((r >> 2) & 3);
        __builtin_amdgcn_global_load_lds((const unsigned*)(A + (long)r * lda + kt * 32 + c * 8), (__attribute__((address_space(3))) unsigned*)(buf + b), 16, 0, 0);
    }
#pragma unroll
    for (int i = 0; i < 2; ++i) {
        const int b = tid * 16 + i * 4096, r = b >> 6, c = ((b & 63) >> 4) ^ ((r >> 2) & 3);
        __builtin_amdgcn_global_load_lds((const unsigned*)(Bt + (long)r * ldb + kt * 32 + c * 8), (__attribute__((address_space(3))) unsigned*)(buf + 16384 + b), 16, 0, 0);
    }
}
__device__ __forceinline__ void gemm_acc2(const bf16_t* __restrict__ A, long lda, const bf16_t* __restrict__ Bt, long ldb, int K, f32x4 (&acc)[8][4], char* lds) {
    const int tid = tid_(), wid = tid >> 6, lane = tid & 63, wr = wid >> 1, wc = wid & 1, fr = lane & 15, fq = lane >> 4;
    const int nk = K >> 5;
    gemm2_stage(A, lda, Bt, ldb, 0, lds, tid);
    asm volatile("s_waitcnt vmcnt(0)" ::: "memory");
    __syncthreads();
    for (int kt = 0; kt < nk; ++kt) {
        char* cur = lds + (kt & 1) * 24576;
        if (kt + 1 < nk) gemm2_stage(A, lda, Bt, ldb, kt + 1, lds + ((kt + 1) & 1) * 24576, tid);
        bf16x8 bfr[4];
#pragma unroll
        for (int n = 0; n < 4; ++n) { const int row = wc * 64 + n * 16 + fr; bfr[n] = *reinterpret_cast<const bf16x8*>(cur + 16384 + row * 64 + ((fq ^ ((row >> 2) & 3)) << 4)); }
#pragma unroll
        for (int m = 0; m < 8; ++m) {
            const int row = wr * 128 + m * 16 + fr;
            const bf16x8 af = *reinterpret_cast<const bf16x8*>(cur + row * 64 + ((fq ^ ((row >> 2) & 3)) << 4));
            __builtin_amdgcn_s_setprio(1);
#pragma unroll
            for (int n = 0; n < 4; ++n) acc[m][n] = mfma16(bfr[n], af, acc[m][n]);
            __builtin_amdgcn_s_setprio(0);
        }
        asm volatile("s_waitcnt vmcnt(0)" ::: "memory");
        __syncthreads();
    }
}
__device__ __forceinline__ void zero_acc2(f32x4 (&acc)[8][4]) {
#pragma unroll
    for (int m = 0; m < 8; ++m)
#pragma unroll
        for (int n = 0; n < 4; ++n) acc[m][n] = (f32x4){0.f, 0.f, 0.f, 0.f};
}
__device__ __forceinline__ void zero_acc(f32x4 (&acc)[4][4]) {
#pragma unroll
    for (int m = 0; m < 4; ++m)
#pragma unroll
        for (int n = 0; n < 4; ++n) acc[m][n] = (f32x4){0.f, 0.f, 0.f, 0.f};
}

__device__ void ph_init(const Params& P, char* lds) {
    const int tid = tid_();
    {
        const f32x4* src = (const f32x4*)P.in[I_X]; f32x4* dst = (f32x4*)P.out;
        const long n4 = (long)TT * DM / 4;
        for (long i = (long)bid_() * NT + tid; i < n4; i += (long)gridDim.x * NT) dst[i] = src[i];
    }
    float* mod = (float*)(P.ws + OFF_MOD);
    float* lbo = (float*)(P.ws + OFF_LB);
    for (int item = bid_(); item < 385; item += gridDim.x) {
        if (item < 384) {
            const int l = item / 96, j0 = (item % 96) * 64;
            const int col = tid & 63, kg = tid >> 6;
            float* CS = (float*)lds;
            float* RED = CS + 4096;
            float acc[16];
#pragma unroll
            for (int b = 0; b < 16; ++b) acc[b] = 0.f;
            const float* Wl = P.in[I_ADAW] + (size_t)l * DM * 6144;
            for (int sub = 0; sub < 4; ++sub) {
                __syncthreads();
                for (int e = tid; e < 4096; e += NT) {
                    const int kk = e & 63, b = (e >> 6) & 15, g = e >> 10;
                    CS[e] = silu(P.in[I_C][b * DM + g * 256 + sub * 64 + kk]);
                }
                __syncthreads();
                for (int kk = 0; kk < 64; ++kk) {
                    const float w = Wl[(size_t)(kg * 256 + sub * 64 + kk) * 6144 + j0 + col];
#pragma unroll
                    for (int b = 0; b < 16; ++b) acc[b] += CS[(kg * 16 + b) * 64 + kk] * w;
                }
            }
#pragma unroll
            for (int b = 0; b < 16; ++b) RED[(kg * 64 + col) * 16 + b] = acc[b];
            __syncthreads();
            {
                const int bg = tid >> 6;
#pragma unroll
                for (int bb = 0; bb < 4; ++bb) {
                    const int b = bg * 4 + bb;
                    float s = RED[(0 * 64 + col) * 16 + b] + RED[(1 * 64 + col) * 16 + b] + RED[(2 * 64 + col) * 16 + b] + RED[(3 * 64 + col) * 16 + b];
                    mod[((size_t)l * 16 + b) * 6144 + j0 + col] = s + P.in[I_ADAB][l * 6144 + j0 + col];
                }
            }
            __syncthreads();
        } else {
            for (int e = tid; e < 1024; e += NT) {
                float x[4], mx = -1e30f;
#pragma unroll
                for (int l = 0; l < 4; ++l) { x[l] = P.in[I_HGLB][l * 1024 + e]; mx = fmaxf(mx, x[l]); }
                float s = 0.f;
#pragma unroll
                for (int l = 0; l < 4; ++l) { x[l] = __expf(x[l] - mx); s += x[l]; }
                const float inv = rcpf_(s);
                float cum = 0.f;
                lbo[0 * 1024 + e] = 0.f;
#pragma unroll
                for (int l = 1; l < 4; ++l) { cum += x[l] * inv; lbo[l * 1024 + e] = fminf(fmaxf(cum, 0.f), 1.f); }
            }
        }
    }
}

__device__ __forceinline__ void tr_tile(const float* __restrict__ src, int ld, int N, int k0, int n0, bf16_t* __restrict__ dst, int dld, int drow0, bool winmap, char* lds) {
    float* Tl = (float*)lds;
    const int tid = tid_();
    __syncthreads();
#pragma unroll
    for (int i = 0; i < 4; ++i) {
        const int kk = (tid >> 4) + 16 * i, nn = (tid & 15) * 4;
        f32x4 v = (f32x4){0.f, 0.f, 0.f, 0.f};
        if (n0 + nn < N) v = *(const f32x4*)(src + (size_t)(k0 + kk) * ld + n0 + nn);
        Tl[kk * 65 + nn] = v[0]; Tl[kk * 65 + nn + 1] = v[1]; Tl[kk * 65 + nn + 2] = v[2]; Tl[kk * 65 + nn + 3] = v[3];
    }
    __syncthreads();
    {
        const int nn = tid >> 2, kb = (tid & 3) * 16;
        if (n0 + nn < N) {
            int drow = drow0 + nn;
            if (winmap) { const int n = n0 + nn; drow = n + (n >= 3344 ? 112 : 0); }
            unsigned w[8];
#pragma unroll
            for (int j = 0; j < 8; ++j) w[j] = pack2(Tl[(kb + 2 * j) * 65 + nn], Tl[(kb + 2 * j + 1) * 65 + nn]);
            u32x4* d = (u32x4*)(dst + (size_t)drow * dld + k0 + kb);
            d[0] = (u32x4){w[0], w[1], w[2], w[3]}; d[1] = (u32x4){w[4], w[5], w[6], w[7]};
        }
    }
}
__device__ void ph_wt(const Params& P, int l, char* lds) {
    char* ws = P.ws;
    const int NI = 2768 + 512 + 256 + 1408 + 704 + 16 + 16 + 16 + 16 + 16 + 7;
    for (int item = bid_(); item < NI; item += gridDim.x) {
        int it = item;
        if (it < 2768) { const int kt = it / 173, nt = it % 173;
            tr_tile(P.in[I_WIN] + (size_t)l * 1024 * 11024, 11024, 11024, kt * 64, nt * 64, (bf16_t*)(ws + WT_WIN), 1024, 0, true, lds); continue; }
        it -= 2768;
        if (it < 512) { const int n = it / 128, r = it % 128, kt = r / 16, nt = r % 16;
            tr_tile(P.in[I_WBR] + ((size_t)l * 4 + n) * 512 * 1024, 1024, 1024, kt * 64, nt * 64, (bf16_t*)(ws + WT_WB) + (size_t)n * 1024 * 512, 512, nt * 64, false, lds); continue; }
        it -= 512;
        if (it < 256) { const int kt = it / 16, nt = it % 16;
            tr_tile(P.in[I_WOUT] + (size_t)l * 1024 * 1024, 1024, 1024, kt * 64, nt * 64, (bf16_t*)(ws + WT_WOUT), 1024, nt * 64, false, lds); continue; }
        it -= 256;
        if (it < 1408) { const int kt = it / 88, nt = it % 88;
            tr_tile(P.in[I_FUP] + (size_t)l * 1024 * 5632, 5632, 5632, kt * 64, nt * 64, (bf16_t*)(ws + WT_WUP), 1024, nt * 64, false, lds); continue; }
        it -= 1408;
        if (it < 704) { const int kt = it / 16, nt = it % 16;
            tr_tile(P.in[I_FDN] + (size_t)l * 2816 * 1024, 1024, 1024, kt * 64, nt * 64, (bf16_t*)(ws + WT_WDN), 2816, nt * 64, false, lds); continue; }
        it -= 704;
        if (it < 16) { const int kt = it / 8, nt = it % 8;
            tr_tile(P.in[I_G2] + (size_t)l * 128 * 512, 512, 512, kt * 64, nt * 64, (bf16_t*)(ws + WT_G2), 128, nt * 64, false, lds); continue; }
        it -= 16;
        if (it < 16) { const int d = it / 8, nt = it % 8;
            tr_tile(P.in[I_W2] + ((size_t)l * 2 + d) * 64 * 512, 512, 512, 0, nt * 64, (bf16_t*)(ws + WT_W2) + (size_t)d * 512 * 64, 64, nt * 64, false, lds); continue; }
        it -= 16;
        if (it < 16) { const int d = it / 8, nt = it % 8;
            tr_tile(P.in[I_A2] + ((size_t)l * 2 + d) * 64 * 512, 512, 512, 0, nt * 64, (bf16_t*)(ws + WT_A2) + (size_t)d * 512 * 64, 64, nt * 64, false, lds); continue; }
        it -= 16;
        if (it < 32) { const int mat = it / 16, d = (it % 16) / 8, g = it % 8;
            const float* src = P.in[mat ? I_LWX : I_LWA] + (((size_t)l * 2 + d) * 8 + g) * 64 * 64;
            tr_tile(src, 64, 64, 0, 0, (bf16_t*)(ws + WT_LRU) + (((size_t)d * 2 + mat) * 8 + g) * 64 * 64, 64, 0, false, lds); continue; }
        it -= 32;
        {
            u32x4* d = (u32x4*)((bf16_t*)(ws + WT_WIN) + (size_t)(3344 + it * 16) * 1024);
            for (int e = tid_(); e < 16 * 1024 / 8; e += NT) d[e] = (u32x4){0u, 0u, 0u, 0u};
        }
    }
}

__device__ void ph_norm(const Params& P, const float* __restrict__ g, const float* __restrict__ modl, int sh_off, int sc_off, bf16_t* __restrict__ dst, bool final_) {
    const int tid = tid_(), wid = tid >> 6, lane = tid & 63;
    for (int item = bid_(); item < TT / 16; item += gridDim.x) {
        const int row0 = item * 16 + wid * 4, b = row0 >> 11;
        f32x4 v[4][4];
#pragma unroll
        for (int r = 0; r < 4; ++r)
#pragma unroll
            for (int i = 0; i < 4; ++i) v[r][i] = *(const f32x4*)(P.out + (size_t)(row0 + r) * DM + i * 256 + lane * 4);
        f32x4 gv[4], sc[4], sh[4];
#pragma unroll
        for (int i = 0; i < 4; ++i) {
            const int c = i * 256 + lane * 4;
            gv[i] = *(const f32x4*)(g + c);
            if (!final_) { sc[i] = *(const f32x4*)(modl + (size_t)b * 6144 + sc_off + c); sh[i] = *(const f32x4*)(modl + (size_t)b * 6144 + sh_off + c); }
        }
#pragma unroll
        for (int r = 0; r < 4; ++r) {
            float ss = 0.f;
#pragma unroll
            for (int i = 0; i < 4; ++i) ss += v[r][i][0] * v[r][i][0] + v[r][i][1] * v[r][i][1] + v[r][i][2] * v[r][i][2] + v[r][i][3] * v[r][i][3];
            ss = wsum64(ss);
            const float rs = rsqrtf(ss * (1.f / DM) + 1e-6f);
            float* hr = P.out + (size_t)(row0 + r) * DM;
#pragma unroll
            for (int i = 0; i < 4; ++i) {
                const int c = i * 256 + lane * 4;
                if (final_) {
                    *(f32x4*)(hr + c) = v[r][i] * rs * gv[i];
                } else {
                    const f32x4 o = v[r][i] * rs * gv[i] * (sc[i] + 1.f) + sh[i];
                    *(u32x2*)(dst + (size_t)(row0 + r) * DM + c) = (u32x2){pack2(o[0], o[1]), pack2(o[2], o[3])};
                }
            }
        }
    }
}

__device__ __forceinline__ void store_tile_bf16(const f32x4 (&acc)[4][4], bf16_t* __restrict__ dst, long ld) {
    const int tid = tid_(), wid = tid >> 6, lane = tid & 63, wr = wid >> 1, wc = wid & 1, fr = lane & 15, fq = lane >> 4;
#pragma unroll
    for (int m = 0; m < 4; ++m)
#pragma unroll
        for (int n = 0; n < 4; ++n) {
            const f32x4 v = acc[m][n];
            *(u32x2*)(dst + (long)(wr * 64 + m * 16 + fr) * ld + wc * 64 + n * 16 + fq * 4) = (u32x2){pack2(v[0], v[1]), pack2(v[2], v[3])};
        }
}
__device__ __forceinline__ void resid_tile(const f32x4 (&acc)[4][4], float* __restrict__ h, int row0, int col0, const float* __restrict__ gate) {
    const int tid = tid_(), wid = tid >> 6, lane = tid & 63, wr = wid >> 1, wc = wid & 1, fr = lane & 15, fq = lane >> 4;
    const int b = row0 >> 11;
#pragma unroll
    for (int n = 0; n < 4; ++n) {
        const int col = col0 + wc * 64 + n * 16 + fq * 4;
        const f32x4 gv = *(const f32x4*)(gate + (size_t)b * 6144 + col);
#pragma unroll
        for (int m = 0; m < 4; ++m) {
            float* hp = h + (size_t)(row0 + wr * 64 + m * 16 + fr) * DM + col;
            const f32x4 o = *(const f32x4*)hp + gv * acc[m][n];
            *(f32x4*)hp = o;
        }
    }
}
__device__ __forceinline__ void store_tile2_bf16(const f32x4 (&acc)[8][4], bf16_t* __restrict__ dst, long ld) {
    const int tid = tid_(), wid = tid >> 6, lane = tid & 63, wr = wid >> 1, wc = wid & 1, fr = lane & 15, fq = lane >> 4;
#pragma unroll
    for (int m = 0; m < 8; ++m)
#pragma unroll
        for (int n = 0; n < 4; ++n) {
            const f32x4 v = acc[m][n];
            *(u32x2*)(dst + (long)(wr * 128 + m * 16 + fr) * ld + wc * 64 + n * 16 + fq * 4) = (u32x2){pack2(v[0], v[1]), pack2(v[2], v[3])};
        }
}
__device__ __forceinline__ void resid_tile2(const f32x4 (&acc)[8][4], float* __restrict__ h, int row0, int col0, const float* __restrict__ gate) {
    const int tid = tid_(), wid = tid >> 6, lane = tid & 63, wr = wid >> 1, wc = wid & 1, fr = lane & 15, fq = lane >> 4;
    const int b = row0 >> 11;
#pragma unroll
    for (int n = 0; n < 4; ++n) {
        const int col = col0 + wc * 64 + n * 16 + fq * 4;
        const f32x4 gv = *(const f32x4*)(gate + (size_t)b * 6144 + col);
#pragma unroll
        for (int m = 0; m < 8; ++m) {
            float* hp = h + (size_t)(row0 + wr * 128 + m * 16 + fr) * DM + col;
            const f32x4 o = *(const f32x4*)hp + gv * acc[m][n];
            *(f32x4*)hp = o;
        }
    }
}
__device__ void ph_gemm_p(const Params& P, char* lds) {
    const bf16_t* U = (const bf16_t*)(P.ws + OFF_U); const bf16_t* Wt = (const bf16_t*)(P.ws + WT_WIN);
    bf16_t* prw = (bf16_t*)(P.ws + OFF_PRW); bf16_t* prest = (bf16_t*)(P.ws + OFF_PREST);
    for (int item = bid_(); item < 128 * 55; item += gridDim.x) {
        const int mt = item / 55, nt = item % 55;
        f32x4 acc[8][4]; zero_acc2(acc);
        gemm_acc2(U + (size_t)mt * 256 * DM, DM, Wt + (size_t)nt * 128 * DM, DM, DM, acc, lds);
        if (nt < 14) store_tile2_bf16(acc, prw + (size_t)mt * 256 * PRW_LD + nt * 128, PRW_LD);
        else store_tile2_bf16(acc, prest + (size_t)mt * 256 * PREST_LD + (nt - 14) * 128, PREST_LD);
    }
}
__device__ void ph_gemm_merge(const Params& P, char* lds) {
    const bf16_t* U = (const bf16_t*)(P.ws + OFF_URE); const bf16_t* Wt = (const bf16_t*)(P.ws + WT_WIN); const bf16_t* Wb = (const bf16_t*)(P.ws + WT_WB);
    bf16_t* mg = (bf16_t*)(P.ws + OFF_MERGED);
    for (int item = bid_(); item < 256 * 8; item += gridDim.x) {
        const int mt = item / 8, nt = item % 8;
        unsigned mpk[4][4][2];
#pragma unroll
        for (int m = 0; m < 4; ++m)
#pragma unroll
            for (int q = 0; q < 4; ++q) { mpk[m][q][0] = 0u; mpk[m][q][1] = 0u; }
#pragma unroll 1
        for (int n = 0; n < 4; ++n) {
            unsigned gpk[4][4][2];
            {
                f32x4 acc[4][4]; zero_acc(acc);
                gemm_acc(U + (size_t)mt * 128 * DM, DM, Wt + (size_t)(GATE_ROW0 + n * 1024 + nt * 128) * DM, DM, DM, acc, lds);
#pragma unroll
                for (int m = 0; m < 4; ++m)
#pragma unroll
                    for (int q = 0; q < 4; ++q) { gpk[m][q][0] = pack2(sigm(acc[m][q][0]), sigm(acc[m][q][1])); gpk[m][q][1] = pack2(sigm(acc[m][q][2]), sigm(acc[m][q][3])); }
            }
            const size_t yoff = (n == 0) ? OFF_Y0 : (n == 1 ? OFF_YB : (n == 2 ? OFF_YC : OFF_YD));
            const bf16_t* Y = (const bf16_t*)(P.ws + yoff);
            f32x4 acc[4][4]; zero_acc(acc);
            gemm_acc(Y + (size_t)mt * 128 * 512, 512, Wb + ((size_t)n * 1024 + nt * 128) * 512, 512, 512, acc, lds);
#pragma unroll
            for (int m = 0; m < 4; ++m)
#pragma unroll
                for (int q = 0; q < 4; ++q) {
                    mpk[m][q][0] = pack2(lo2f(mpk[m][q][0]) + lo2f(gpk[m][q][0]) * acc[m][q][0], hi2f(mpk[m][q][0]) + hi2f(gpk[m][q][0]) * acc[m][q][1]);
                    mpk[m][q][1] = pack2(lo2f(mpk[m][q][1]) + lo2f(gpk[m][q][1]) * acc[m][q][2], hi2f(mpk[m][q][1]) + hi2f(gpk[m][q][1]) * acc[m][q][3]);
                }
        }
        {
            const int tid = tid_(), wid = tid >> 6, lane = tid & 63, wr = wid >> 1, wc = wid & 1, fr = lane & 15, fq = lane >> 4;
            bf16_t* dst = mg + (size_t)mt * 128 * DM + nt * 128;
#pragma unroll
            for (int m = 0; m < 4; ++m)
#pragma unroll
                for (int q = 0; q < 4; ++q) *(u32x2*)(dst + (long)(wr * 64 + m * 16 + fr) * DM + wc * 64 + q * 16 + fq * 4) = (u32x2){mpk[m][q][0], mpk[m][q][1]};
        }
    }
}
__device__ void ph_gemm_out(const Params& P, int l, char* lds) {
    const bf16_t* A = (const bf16_t*)(P.ws + OFF_MERGED); const bf16_t* Wt = (const bf16_t*)(P.ws + WT_WOUT);
    const float* gate = (const float*)(P.ws + OFF_MOD) + (size_t)l * 16 * 6144 + 2048;
    for (int item = bid_(); item < 256 * 8; item += gridDim.x) {
        const int mt = item / 8, nt = item % 8;
        f32x4 acc[4][4]; zero_acc(acc);
        gemm_acc(A + (size_t)mt * 128 * DM, DM, Wt + (size_t)nt * 128 * DM, DM, DM, acc, lds);
        resid_tile(acc, P.out, mt * 128, nt * 128, gate);
    }
}
__device__ void ph_gemm_up(const Params& P, char* lds) {
    const bf16_t* A = (const bf16_t*)(P.ws + OFF_U2); const bf16_t* Wt = (const bf16_t*)(P.ws + WT_WUP);
    bf16_t* Z = (bf16_t*)(P.ws + OFF_Z);
    for (int item = bid_(); item < 128 * 44; item += gridDim.x) {
        const int mt = item / 44, nt = item % 44;
        f32x4 acc[8][4]; zero_acc2(acc);
        gemm_acc2(A + (size_t)mt * 256 * DM, DM, Wt + (size_t)nt * 128 * DM, DM, DM, acc, lds);
        store_tile2_bf16(acc, Z + (size_t)mt * 256 * 5632 + nt * 128, 5632);
    }
}
__device__ void ph_gemm_down(const Params& P, int l, char* lds) {
    const bf16_t* A = (const bf16_t*)(P.ws + OFF_ACT); const bf16_t* Wt = (const bf16_t*)(P.ws + WT_WDN);
    const float* gate = (const float*)(P.ws + OFF_MOD) + (size_t)l * 16 * 6144 + 5120;
    for (int item = bid_(); item < 128 * 8; item += gridDim.x) {
        const int mt = item / 8, nt = item % 8;
        f32x4 acc[8][4]; zero_acc2(acc);
        gemm_acc2(A + (size_t)mt * 256 * DFF, DFF, Wt + (size_t)nt * 128 * DFF, DFF, DFF, acc, lds);
        resid_tile2(acc, P.out, mt * 256, nt * 128, gate);
    }
}
__device__ void ph_convact(const Params& P, int l) {
    const bf16_t* Z = (const bf16_t*)(P.ws + OFF_Z); bf16_t* ACT = (bf16_t*)(P.ws + OFF_ACT);
    const float* cw = P.in[I_FCW] + (size_t)l * 3 * 5632; const float* cb = P.in[I_FCB] + (size_t)l * 5632;
    const long ntask = (long)(TT / 64) * 352;
    for (long task = (long)bid_() * NT + tid_(); task < ntask; task += (long)gridDim.x * NT) {
        const int tile = (int)(task / 352), cgp = (int)(task % 352), c0 = cgp * 8;
        const int t0 = tile * 64, s0 = t0 & (SQ - 1);
        float wv[3][8], wg[3][8], bv[8], bg[8];
#pragma unroll
        for (int j = 0; j < 3; ++j)
#pragma unroll
            for (int e = 0; e < 8; ++e) { wv[j][e] = cw[j * 5632 + c0 + e]; wg[j][e] = cw[j * 5632 + DFF + c0 + e]; }
#pragma unroll
        for (int e = 0; e < 8; ++e) { bv[e] = cb[c0 + e]; bg[e] = cb[DFF + c0 + e]; }
        float pv[8], pg[8], cv[8], cg_[8], nv[8], ng[8];
        const u32x4 zero4 = (u32x4){0u, 0u, 0u, 0u};
        {
            u32x4 a = zero4, b = zero4;
            if (s0 > 0) { a = *(const u32x4*)(Z + (size_t)(t0 - 1) * 5632 + c0); b = *(const u32x4*)(Z + (size_t)(t0 - 1) * 5632 + DFF + c0); }
            unpack8(a, pv); unpack8(b, pg);
            a = *(const u32x4*)(Z + (size_t)t0 * 5632 + c0); b = *(const u32x4*)(Z + (size_t)t0 * 5632 + DFF + c0);
            unpack8(a, cv); unpack8(b, cg_);
        }
#pragma unroll 8
        for (int r = 0; r < 64; ++r) {
            const int t = t0 + r;
            u32x4 a = zero4, b = zero4;
            if (s0 + r + 1 < SQ) { a = *(const u32x4*)(Z + (size_t)(t + 1) * 5632 + c0); b = *(const u32x4*)(Z + (size_t)(t + 1) * 5632 + DFF + c0); }
            unpack8(a, nv); unpack8(b, ng);
            float o[8];
#pragma unroll
            for (int e = 0; e < 8; ++e) {
                const float v = wv[0][e] * pv[e] + wv[1][e] * cv[e] + wv[2][e] * nv[e] + bv[e];
                const float g = wg[0][e] * pg[e] + wg[1][e] * cg_[e] + wg[2][e] * ng[e] + bg[e];
                o[e] = v * silu(g);
                pv[e] = cv[e]; cv[e] = nv[e]; pg[e] = cg_[e]; cg_[e] = ng[e];
            }
            *(u32x4*)(ACT + (size_t)t * DFF + c0) = (u32x4){pack2(o[0], o[1]), pack2(o[2], o[3]), pack2(o[4], o[5]), pack2(o[6], o[7])};
        }
    }
}

__device__ void mx_rwkv(const Params& P, int l, int item, char* lds) {
    const int tid = tid_(), wid = tid >> 6, lane = tid & 63, fr = lane & 15, fq = lane >> 4;
    const int d = item & 1, h = (item >> 1) & 7, b = item >> 4;
    const bf16_t* prw = (const bf16_t*)(P.ws + OFF_PRW) + (size_t)b * SQ * PRW_LD;
    bf16_t* Yd = (bf16_t*)(P.ws + (d ? OFF_Y1 : OFF_Y0)) + (size_t)b * SQ * 512 + h * 64;
    float* beta = (float*)(P.ws + OFF_BETA) + ((size_t)d * TT + (size_t)b * SQ) * 8 + h;
    float* VA = (float*)lds; float* VWR = VA + 1024; float* VW = VWR + 1024; float* VB = VW + 1024; float* VK = VB + 1024; float* VV = VK + 1024; float* VG = VV + 1024;
    float* SC = VG + 1024;
    bf16_t* RAW = (bf16_t*)(SC + 32);
    bf16_t* AT = RAW + 18 * 320;
    const int s = tid >> 4, jg = tid & 15, j0 = jg * 4;
    float mu[5][4], kkc[4], kac[4], rkc[4];
#pragma unroll
    for (int sg = 0; sg < 5; ++sg) {
        const int base = (sg < 3) ? sg * 512 + h * 64 : 1536 + (sg - 3) * 64;
#pragma unroll
        for (int i = 0; i < 4; ++i) mu[sg][i] = P.in[I_MU][l * 1792 + base + j0 + i];
    }
#pragma unroll
    for (int i = 0; i < 4; ++i) { kkc[i] = P.in[I_KK][l * 512 + h * 64 + j0 + i]; kac[i] = P.in[I_KA][l * 512 + h * 64 + j0 + i]; rkc[i] = P.in[I_RK][l * 512 + h * 64 + j0 + i]; }
    const int mt = wid >> 1, ntb = (wid & 1) * 2;
    bf16x8 bw[2][2]; float bsv[2][4];
    {
        const bf16_t* WT2 = (const bf16_t*)(P.ws + (mt ? WT_A2 : WT_W2)) + (size_t)d * 512 * 64;
        const float* bias = P.in[mt ? I_A0 : I_W0] + (size_t)(l * 2 + d) * 512 + h * 64;
#pragma unroll
        for (int nt = 0; nt < 2; ++nt) {
#pragma unroll
            for (int ks = 0; ks < 2; ++ks) bw[nt][ks] = ldfrag(WT2 + (size_t)(h * 64 + (ntb + nt) * 16 + fr) * 64 + ks * 32 + fq * 8);
#pragma unroll
            for (int jj = 0; jj < 4; ++jj) bsv[nt][jj] = bias[(ntb + nt) * 16 + fq * 4 + jj];
        }
    }
    float S[4][4];
#pragma unroll
    for (int i = 0; i < 4; ++i)
#pragma unroll
        for (int j = 0; j < 4; ++j) S[i][j] = 0.f;
    u32x4 pre[3];
    auto load_raw = [&](int c) {
        const int t0 = d ? SQ - 16 * (c + 1) : 16 * c;
#pragma unroll
        for (int i = 0; i < 3; ++i) {
            const int vi = tid + 256 * i;
            pre[i] = (u32x4){0u, 0u, 0u, 0u};
            if (vi < 720) {
                const int rr = vi / 40, rem = vi % 40, sg = rem >> 3, e = rem & 7, t = t0 - 1 + rr;
                const int col = ((sg < 3) ? sg * 512 + h * 64 : 1536 + (sg - 3) * 64) + e * 8;
                if (t >= 0 && t < SQ) pre[i] = *(const u32x4*)(prw + (size_t)t * PRW_LD + col);
            }
        }
    };
    __syncthreads();
    load_raw(0);
#pragma unroll 1
    for (int c = 0; c < 128; ++c) {
        const int t0 = d ? SQ - 16 * (c + 1) : 16 * c;
#pragma unroll
        for (int i = 0; i < 3; ++i) {
            const int vi = tid + 256 * i;
            if (vi < 720) { const int rr = vi / 40, rem = vi % 40; *(u32x4*)(RAW + rr * 320 + rem * 8) = pre[i]; }
        }
        __syncthreads();
        if (c + 1 < 128) load_raw(c + 1);
        float rs[4], ks_[4], vs[4], kk[4];
        {
            float sh[5][4];
#pragma unroll
            for (int sg = 0; sg < 5; ++sg) {
                float fm[4], f0[4], fp[4];
                unpack4(*(const u32x2*)(RAW + s * 320 + sg * 64 + j0), fm);
                unpack4(*(const u32x2*)(RAW + (s + 1) * 320 + sg * 64 + j0), f0);
                unpack4(*(const u32x2*)(RAW + (s + 2) * 320 + sg * 64 + j0), fp);
#pragma unroll
                for (int i = 0; i < 4; ++i) sh[sg][i] = f0[i] + mu[sg][i] * (0.5f * (fm[i] + fp[i]) - f0[i]);
            }
            float ssq = 0.f, q[4];
#pragma unroll
            for (int i = 0; i < 4; ++i) { rs[i] = sh[0][i]; ks_[i] = sh[1][i]; vs[i] = sh[2][i]; q[i] = ks_[i] * kkc[i]; ssq += q[i] * q[i]; }
            *(u32x2*)(AT + s * 72 + j0) = (u32x2){pack2(tanh_f(sh[3][0]), tanh_f(sh[3][1])), pack2(tanh_f(sh[3][2]), tanh_f(sh[3][3]))};
            *(u32x2*)(AT + 16 * 72 + s * 72 + j0) = (u32x2){pack2(sh[4][0], sh[4][1]), pack2(sh[4][2], sh[4][3])};
            ssq = rowsum16(ssq);
            const float inv = __builtin_amdgcn_rsqf(fmaxf(ssq, 1e-24f));
#pragma unroll
            for (int i = 0; i < 4; ++i) kk[i] = q[i] * inv;
        }
        __syncthreads();
        {
            const bf16_t* At = AT + mt * 16 * 72;
            const bf16x8 a0 = ldfrag(At + fr * 72 + fq * 8), a1 = ldfrag(At + fr * 72 + 32 + fq * 8);
            float* dstv = mt ? VG : VW;
#pragma unroll
            for (int nt = 0; nt < 2; ++nt) {
                f32x4 acc = (f32x4){0.f, 0.f, 0.f, 0.f};
                acc = mfma16(bw[nt][0], a0, acc); acc = mfma16(bw[nt][1], a1, acc);
                f32x4 o;
#pragma unroll
                for (int jj = 0; jj < 4; ++jj) {
                    const float x = acc[jj] + bsv[nt][jj];
                    if (mt == 0) { const float wl = fminf(x, 0.f) - __logf(1.f + __expf(-fabsf(x))) - 0.5f; o[jj] = __expf(-__expf(wl)); }
                    else o[jj] = sigm(x);
                }
                *(f32x4*)(dstv + fr * 64 + (ntb + nt) * 16 + fq * 4) = o;
            }
        }
        __syncthreads();
        {
            const f32x4 w4 = *(const f32x4*)(VW + s * 64 + j0), g4 = *(const f32x4*)(VG + s * 64 + j0);
            f32x4 bb, kt, wr, na, vv;
            float pbr = 0.f, pkr = 0.f, pbe = 0.f;
#pragma unroll
            for (int i = 0; i < 4; ++i) {
                bb[i] = kk[i] * g4[i]; kt[i] = ks_[i] * (1.f + (g4[i] - 1.f) * kac[i]); wr[i] = w4[i] * rs[i]; na[i] = -kk[i]; vv[i] = vs[i];
                pbr += bb[i] * rs[i]; pkr += kt[i] * rs[i]; pbe += rs[i] * kt[i] * rkc[i];
            }
            pbr = rowsum16(pbr); pkr = rowsum16(pkr); pbe = rowsum16(pbe);
            *(f32x4*)(VA + s * 64 + j0) = na; *(f32x4*)(VWR + s * 64 + j0) = wr; *(f32x4*)(VB + s * 64 + j0) = bb; *(f32x4*)(VK + s * 64 + j0) = kt; *(f32x4*)(VV + s * 64 + j0) = vv;
            if (jg == 0) { SC[s * 2] = pbr; SC[s * 2 + 1] = pkr; beta[(size_t)(t0 + s) * 8] = pbe; }
        }
        __syncthreads();
#pragma unroll 1
        for (int st = 0; st < 16; ++st) {
            const int sp = d ? 15 - st : st;
            const f32x4 a4 = *(const f32x4*)(VA + sp * 64 + j0), wr4 = *(const f32x4*)(VWR + sp * 64 + j0), w4 = *(const f32x4*)(VW + sp * 64 + j0);
            const f32x4 b4 = *(const f32x4*)(VB + sp * 64 + j0), k4 = *(const f32x4*)(VK + sp * 64 + j0), v4 = *(const f32x4*)(VV + sp * 64 + s * 4);
            const float br = SC[sp * 2], kr = SC[sp * 2 + 1];
            float psa[4], py[4];
            typedef float f32x2 __attribute__((ext_vector_type(2)));
            const f32x2 a01 = {a4[0], a4[1]}, a23 = {a4[2], a4[3]}, r01 = {wr4[0], wr4[1]}, r23 = {wr4[2], wr4[3]};
#pragma unroll
            for (int i = 0; i < 4; ++i) {
                const f32x2 s01 = {S[i][0], S[i][1]}, s23 = {S[i][2], S[i][3]};
                f32x2 ta = s01 * a01; ta = s23 * a23 + ta;
                f32x2 ty = s01 * r01; ty = s23 * r23 + ty;
                psa[i] = ta.x + ta.y; py[i] = ty.x + ty.y;
            }
#define RS8(CTRL) asm volatile("s_nop 1\n\tv_add_f32_dpp %0, %0, %0 " CTRL " row_mask:0xf bank_mask:0xf\n\tv_add_f32_dpp %1, %1, %1 " CTRL " row_mask:0xf bank_mask:0xf\n\tv_add_f32_dpp %2, %2, %2 " CTRL " row_mask:0xf bank_mask:0xf\n\tv_add_f32_dpp %3, %3, %3 " CTRL " row_mask:0xf bank_mask:0xf\n\tv_add_f32_dpp %4, %4, %4 " CTRL " row_mask:0xf bank_mask:0xf\n\tv_add_f32_dpp %5, %5, %5 " CTRL " row_mask:0xf bank_mask:0xf\n\tv_add_f32_dpp %6, %6, %6 " CTRL " row_mask:0xf bank_mask:0xf\n\tv_add_f32_dpp %7, %7, %7 " CTRL " row_mask:0xf bank_mask:0xf" : "+v"(psa[0]), "+v"(psa[1]), "+v"(psa[2]), "+v"(psa[3]), "+v"(py[0]), "+v"(py[1]), "+v"(py[2]), "+v"(py[3]))
            RS8("row_ror:8"); RS8("row_ror:4"); RS8("row_ror:2"); RS8("row_ror:1");
            asm volatile("s_nop 1" ::: "memory");
            float y[4];
#pragma unroll
            for (int i = 0; i < 4; ++i) {
                y[i] = py[i] + psa[i] * br + v4[i] * kr;
#pragma unroll
                for (int j = 0; j < 4; ++j) S[i][j] = S[i][j] * w4[j] + (psa[i] * b4[j] + v4[i] * k4[j]);
            }
            if (jg == 0) *(u32x2*)(Yd + (size_t)(t0 + sp) * 512 + s * 4) = (u32x2){pack2(y[0], y[1]), pack2(y[2], y[3])};
        }
    }
    __syncthreads();
}

__device__ void mx_mlstm(const Params& P, int l, int item, char* lds) {
    const int tid = tid_(), wid = tid >> 6, lane = tid & 63, fr = lane & 15, fq = lane >> 4;
    const int b = item >> 3, h = (item >> 1) & 3, dsel = item & 1;
    const bf16_t* pr = (const bf16_t*)(P.ws + OFF_PREST) + (size_t)b * SQ * PREST_LD;
    bf16_t* YB = (bf16_t*)(P.ws + (dsel ? OFF_YB : OFF_Y1)) + (size_t)b * SQ * 512 + h * 128;
    bf16_t* Q = (bf16_t*)lds; bf16_t* KP = Q + 64 * 72; bf16_t* KWT = KP + 64 * 72; bf16_t* VT = KWT + 64 * 72; bf16_t* CT = VT + 128 * 72;
    float* NS = (float*)(CT + 128 * 72); float* E = NS + 64; float* MM = E + 64; float* SI = MM + 64; float* WI = SI + 64; float* FL = WI + 64; float* DEC = FL + 64;
    const int i = wid * 16 + fr;
#pragma unroll 1
    for (int d = dsel; d <= dsel; ++d) {
        f32x4 Cacc[8];
#pragma unroll
        for (int dt = 0; dt < 8; ++dt) Cacc[dt] = (f32x4){0.f, 0.f, 0.f, 0.f};
        __syncthreads();
        for (int e = tid; e < 128 * 72 / 2; e += NT) ((unsigned*)CT)[e] = 0u;
        if (tid < 64) NS[tid] = 0.f;
        float m_st = 0.f;
        const float ib = P.in[I_MLIB][(l * 2 + d) * 4 + h], fb = P.in[I_MLFB][(l * 2 + d) * 4 + h];
        __syncthreads();
#pragma unroll 1
        for (int c = 0; c < 32; ++c) {
            const int t0 = d ? SQ - 64 * (c + 1) : 64 * c;
#define TROW(ii) (d ? t0 + 63 - (ii) : t0 + (ii))
            if (wid == 0) {
                const int t = TROW(lane);
                const float fg = bf2f(pr[(size_t)t * PREST_LD + 1544 + d * 4 + h]) + fb, ig = bf2f(pr[(size_t)t * PREST_LD + 1536 + d * 4 + h]) + ib;
                float bc = logsig(fg);
#pragma unroll
                for (int o = 1; o < 64; o <<= 1) { const float x = bperm(bc, lane - o); if (lane >= o) bc += x; }
                const float e = ig - bc; float pm = e;
#pragma unroll
                for (int o = 1; o < 64; o <<= 1) { const float x = bperm(pm, lane - o); if (lane >= o) pm = fmaxf(pm, x); }
                const float gend = rdlane(bc, 63), pmax = rdlane(pm, 63);
                const float mnew = fmaxf(gend + m_st, gend + pmax);
                const float M = fmaxf(m_st, pm);
                E[lane] = e; MM[lane] = M; SI[lane] = __expf(m_st - M); WI[lane] = __expf(gend + e - mnew); FL[lane] = __expf(-(bc + M));
                if (lane == 0) DEC[0] = __expf(gend + m_st - mnew);
                m_st = mnew;
            }
            __syncthreads();
#pragma unroll
            for (int it = 0; it < 2; ++it) {
                const int vi = tid + 256 * it, ii = vi >> 3, e = vi & 7, t = TROW(ii);
                float f[8];
                unpack8(*(const u32x4*)(pr + (size_t)t * PREST_LD + h * 64 + e * 8), f);
                *(u32x4*)(Q + ii * 72 + e * 8) = (u32x4){pack2(f[0] * 0.125f, f[1] * 0.125f), pack2(f[2] * 0.125f, f[3] * 0.125f), pack2(f[4] * 0.125f, f[5] * 0.125f), pack2(f[6] * 0.125f, f[7] * 0.125f)};
                const u32x4 kv = *(const u32x4*)(pr + (size_t)t * PREST_LD + 256 + h * 64 + e * 8);
                *(u32x4*)(KP + ii * 72 + e * 8) = kv;
                unpack8(kv, f);
                const float wi = WI[ii];
#pragma unroll
                for (int x = 0; x < 8; ++x) KWT[(e * 8 + x) * 72 + ii] = f2bf(f[x] * wi);
            }
#pragma unroll
            for (int it = 0; it < 4; ++it) {
                const int vi = tid + 256 * it, ii = vi >> 4, e = vi & 15, t = TROW(ii);
                const u32x4 vv = *(const u32x4*)(pr + (size_t)t * PREST_LD + 512 + h * 128 + e * 8);
                VT[(e * 8 + 0) * 72 + ii] = (bf16_t)(vv.x & 0xffff); VT[(e * 8 + 1) * 72 + ii] = (bf16_t)(vv.x >> 16);
                VT[(e * 8 + 2) * 72 + ii] = (bf16_t)(vv.y & 0xffff); VT[(e * 8 + 3) * 72 + ii] = (bf16_t)(vv.y >> 16);
                VT[(e * 8 + 4) * 72 + ii] = (bf16_t)(vv.z & 0xffff); VT[(e * 8 + 5) * 72 + ii] = (bf16_t)(vv.z >> 16);
                VT[(e * 8 + 6) * 72 + ii] = (bf16_t)(vv.w & 0xffff); VT[(e * 8 + 7) * 72 + ii] = (bf16_t)(vv.w >> 16);
            }
            __syncthreads();
            f32x4 sacc[4];
#pragma unroll
            for (int st = 0; st < 4; ++st) sacc[st] = (f32x4){0.f, 0.f, 0.f, 0.f};
#pragma unroll
            for (int ks = 0; ks < 2; ++ks) {
                const bf16x8 qf = ldfrag(Q + i * 72 + ks * 32 + fq * 8);
#pragma unroll
                for (int st = 0; st < 4; ++st) sacc[st] = mfma16(ldfrag(KP + (st * 16 + fr) * 72 + ks * 32 + fq * 8), qf, sacc[st]);
            }
            const float Mi = MM[i], si = SI[i];
            float rsum = 0.f; unsigned pwp[4][2];
#pragma unroll
            for (int st = 0; st < 4; ++st) {
                float pw[4];
#pragma unroll
                for (int jj = 0; jj < 4; ++jj) { const int sx = st * 16 + fq * 4 + jj; pw[jj] = (sx <= i) ? __expf(E[sx] - Mi) * sacc[st][jj] : 0.f; rsum += pw[jj]; }
                pwp[st][0] = pack2(pw[0], pw[1]); pwp[st][1] = pack2(pw[2], pw[3]);
            }
            rsum = qsum(rsum, lane);
            float qn = 0.f;
            {
                float f[8];
                unpack8(*(const u32x4*)(Q + i * 72 + fq * 16), f);
#pragma unroll
                for (int x = 0; x < 8; ++x) qn += f[x] * NS[fq * 16 + x];
                unpack8(*(const u32x4*)(Q + i * 72 + fq * 16 + 8), f);
#pragma unroll
                for (int x = 0; x < 8; ++x) qn += f[x] * NS[fq * 16 + 8 + x];
            }
            qn = qsum(qn, lane);
            const float den = si * qn + rsum;
            const float rinv = rcpf_(fmaxf(fabsf(den), FL[i]));
            __syncthreads();
#pragma unroll
            for (int st = 0; st < 4; ++st) *(u32x2*)(KP + i * 72 + st * 16 + fq * 4) = (u32x2){pwp[st][0], pwp[st][1]};
            __syncthreads();
            f32x4 oacc[8];
#pragma unroll
            for (int dt = 0; dt < 8; ++dt) oacc[dt] = (f32x4){0.f, 0.f, 0.f, 0.f};
#pragma unroll
            for (int ks = 0; ks < 2; ++ks) {
                const bf16x8 qf = ldfrag(Q + i * 72 + ks * 32 + fq * 8);
#pragma unroll
                for (int dt = 0; dt < 8; ++dt) oacc[dt] = mfma16(ldfrag(CT + (dt * 16 + fr) * 72 + ks * 32 + fq * 8), qf, oacc[dt]);
            }
#pragma unroll
            for (int dt = 0; dt < 8; ++dt) oacc[dt] *= si;
#pragma unroll
            for (int ks = 0; ks < 2; ++ks) {
                const bf16x8 pf = ldfrag(KP + i * 72 + ks * 32 + fq * 8);
#pragma unroll
                for (int dt = 0; dt < 8; ++dt) oacc[dt] = mfma16(ldfrag(VT + (dt * 16 + fr) * 72 + ks * 32 + fq * 8), pf, oacc[dt]);
            }
            {
                const int t = TROW(i);
                bf16_t* yp = YB + (size_t)t * 512 + fq * 4;
                {
#pragma unroll
                    for (int dt = 0; dt < 8; ++dt) { const f32x4 v = oacc[dt] * rinv; *(u32x2*)(yp + dt * 16) = (u32x2){pack2(v[0], v[1]), pack2(v[2], v[3])}; }
                }
            }
            __syncthreads();
            {
                const float dec = DEC[0];
#pragma unroll
                for (int dt = 0; dt < 8; ++dt) Cacc[dt] *= dec;
#pragma unroll
                for (int ks = 0; ks < 2; ++ks) {
                    const bf16x8 kf = ldfrag(KWT + (wid * 16 + fr) * 72 + ks * 32 + fq * 8);
#pragma unroll
                    for (int dt = 0; dt < 8; ++dt) Cacc[dt] = mfma16(kf, ldfrag(VT + (dt * 16 + fr) * 72 + ks * 32 + fq * 8), Cacc[dt]);
                }
#pragma unroll
                for (int dt = 0; dt < 8; ++dt) *(u32x2*)(CT + (dt * 16 + fr) * 72 + wid * 16 + fq * 4) = (u32x2){pack2(Cacc[dt][0], Cacc[dt][1]), pack2(Cacc[dt][2], Cacc[dt][3])};
                if (tid < 64) {
                    float n = dec * NS[tid];
#pragma unroll
                    for (int x = 0; x < 8; ++x) { float f[8]; unpack8(*(const u32x4*)(KWT + tid * 72 + x * 8), f); n += ((f[0] + f[1]) + (f[2] + f[3])) + ((f[4] + f[5]) + (f[6] + f[7])); }
                    NS[tid] = n;
                }
            }
            __syncthreads();
        }
    }
}

__device__ void mx_hgrn(const Params& P, int l, int item, char* lds) {
    const int tid = tid_(), wid = tid >> 6, lane = tid & 63, fr = lane & 15, fq = lane >> 4;
    const int b = item >> 4, h = (item >> 2) & 3, half = (item >> 1) & 1, dsel = item & 1;
    const bf16_t* pr = (const bf16_t*)(P.ws + OFF_PREST) + (size_t)b * SQ * PREST_LD + HG_O;
    bf16_t* YD = (bf16_t*)(P.ws + (dsel ? OFF_YD : OFF_Y0)) + (size_t)b * SQ * 512 + h * 128 + half * 64;
    bf16_t* QT = (bf16_t*)lds; bf16_t* KT = QT + 64 * 136; bf16_t* ATT = KT + 128 * 72; bf16_t* VT = ATT + 64 * 72; bf16_t* ST = VT + 64 * 72;
    float* TOT = (float*)(ST + 64 * 136);
    const int dk = tid & 127, hf = tid >> 7;
    const int i = wid * 16 + fr;
#pragma unroll 1
    for (int d = dsel; d <= dsel; ++d) {
        const float lbv = ((const float*)(P.ws + OFF_LB))[(l * 2 + d) * 512 + h * 128 + dk], oml = 1.f - lbv;
        f32x4 Sacc[2][4];
#pragma unroll
        for (int a = 0; a < 2; ++a)
#pragma unroll
            for (int dt = 0; dt < 4; ++dt) Sacc[a][dt] = (f32x4){0.f, 0.f, 0.f, 0.f};
        __syncthreads();
        for (int e = tid; e < 64 * 136 / 2; e += NT) ((unsigned*)ST)[e] = 0u;
        __syncthreads();
        u32x4 pff[4], pfq[4], pfv[2];
        auto hg_load = [&](int cc) {
            const int t0 = d ? SQ - 64 * (cc + 1) : 64 * cc;
#pragma unroll
            for (int it = 0; it < 4; ++it) {
                const int vi = tid + 256 * it, ii = vi >> 4, e = vi & 15, t = TROW(ii);
                pff[it] = *(const u32x4*)(pr + (size_t)t * PREST_LD + 512 * (1 + d) + h * 128 + e * 8);
                pfq[it] = *(const u32x4*)(pr + (size_t)t * PREST_LD + h * 128 + e * 8);
            }
#pragma unroll
            for (int it = 0; it < 2; ++it) {
                const int vi = tid + 256 * it, ii = vi >> 3, e = vi & 7, t = TROW(ii);
                pfv[it] = *(const u32x4*)(pr + (size_t)t * PREST_LD + 1536 + h * 128 + half * 64 + e * 8);
            }
        };
        hg_load(0);
#pragma unroll 1
        for (int c = 0; c < 32; ++c) {
            const int t0 = d ? SQ - 64 * (c + 1) : 64 * c;
#pragma unroll
            for (int it = 0; it < 4; ++it) {
                const int vi = tid + 256 * it, ii = vi >> 4, e = vi & 15;
                *(u32x4*)(KT + ii * 136 + e * 8) = pff[it];
                *(u32x4*)(QT + ii * 136 + e * 8) = pfq[it];
            }
#pragma unroll
            for (int it = 0; it < 2; ++it) {
                const int vi = tid + 256 * it, ii = vi >> 3, e = vi & 7;
                const u32x4 vv = pfv[it];
                VT[(e * 8 + 0) * 72 + ii] = (bf16_t)(vv.x & 0xffff); VT[(e * 8 + 1) * 72 + ii] = (bf16_t)(vv.x >> 16);
                VT[(e * 8 + 2) * 72 + ii] = (bf16_t)(vv.y & 0xffff); VT[(e * 8 + 3) * 72 + ii] = (bf16_t)(vv.y >> 16);
                VT[(e * 8 + 4) * 72 + ii] = (bf16_t)(vv.z & 0xffff); VT[(e * 8 + 5) * 72 + ii] = (bf16_t)(vv.z >> 16);
                VT[(e * 8 + 6) * 72 + ii] = (bf16_t)(vv.w & 0xffff); VT[(e * 8 + 7) * 72 + ii] = (bf16_t)(vv.w >> 16);
            }
            if (c + 1 < 32) hg_load(c + 1);
            __syncthreads();
            bf16_t* kp = KT + hf * 32 * 136 + dk; bf16_t* qp = QT + hf * 32 * 136 + dk;
            {
                float run = 0.f;
#pragma unroll 8
                for (int r = 0; r < 32; ++r) { const bf16_t fb = f2bf(lbv + oml * sigm(bf2f(kp[r * 136]))); kp[r * 136] = fb; run += __logf(bf2f(fb)); }
                TOT[hf * 128 + dk] = run;
            }
            __syncthreads();
            const float R = TOT[dk], gmR = TOT[128 + dk];
            {
                float g = hf ? R : 0.f;
#pragma unroll 8
                for (int r = 0; r < 32; ++r) {
                    const float fv = bf2f(kp[r * 136]);
                    g += __logf(fv);
                    const float e1 = __expf(fminf(g - R, 80.f));
                    qp[r * 136] = f2bf(silu(bf2f(qp[r * 136])) * e1);
                    kp[r * 136] = f2bf((1.f - fv) * __expf(fminf(R - g, 80.f)));
                }
                const float eR = __expf(R);
                bf16_t* sp = ST + hf * 32 * 136 + dk;
#pragma unroll 8
                for (int r = 0; r < 32; ++r) sp[r * 136] = f2bf(bf2f(sp[r * 136]) * eR);
            }
            __syncthreads();
            f32x4 oacc[4];
            unsigned kw[16];
            {
                f32x4 aacc[4];
#pragma unroll
                for (int st = 0; st < 4; ++st) { aacc[st] = (f32x4){0.f, 0.f, 0.f, 0.f}; oacc[st] = (f32x4){0.f, 0.f, 0.f, 0.f}; }
#pragma unroll
                for (int ks = 0; ks < 4; ++ks) {
                    const bf16x8 qf = ldfrag(QT + i * 136 + ks * 32 + fq * 8);
#pragma unroll
                    for (int st = 0; st < 4; ++st) aacc[st] = mfma16(ldfrag(KT + (st * 16 + fr) * 136 + ks * 32 + fq * 8), qf, aacc[st]);
#pragma unroll
                    for (int dt = 0; dt < 4; ++dt) oacc[dt] = mfma16(ldfrag(ST + (dt * 16 + fr) * 136 + ks * 32 + fq * 8), qf, oacc[dt]);
                }
#pragma unroll
                for (int st = 0; st < 4; ++st) {
                    float a[4];
#pragma unroll
                    for (int jj = 0; jj < 4; ++jj) a[jj] = (st * 16 + fq * 4 + jj <= i) ? aacc[st][jj] : 0.f;
                    *(u32x2*)(ATT + i * 72 + st * 16 + fq * 4) = (u32x2){pack2(a[0], a[1]), pack2(a[2], a[3])};
                }
#pragma unroll
                for (int r = 0; r < 16; ++r) kw[r] = (unsigned)kp[(2 * r) * 136] | ((unsigned)kp[(2 * r + 1) * 136] << 16);
            }
            __syncthreads();
            {
                u32x4* dst = (u32x4*)(KT + dk * 72 + hf * 32);
                dst[0] = (u32x4){kw[0], kw[1], kw[2], kw[3]}; dst[1] = (u32x4){kw[4], kw[5], kw[6], kw[7]};
                dst[2] = (u32x4){kw[8], kw[9], kw[10], kw[11]}; dst[3] = (u32x4){kw[12], kw[13], kw[14], kw[15]};
            }
            __syncthreads();
            {
#pragma unroll
                for (int ks = 0; ks < 2; ++ks) {
                    const bf16x8 af = ldfrag(ATT + i * 72 + ks * 32 + fq * 8);
#pragma unroll
                    for (int dt = 0; dt < 4; ++dt) oacc[dt] = mfma16(ldfrag(VT + (dt * 16 + fr) * 72 + ks * 32 + fq * 8), af, oacc[dt]);
                }
                const int t = TROW(i);
                bf16_t* yp = YD + (size_t)t * 512 + fq * 4;
#pragma unroll
                for (int dt = 0; dt < 4; ++dt) {
                    f32x4 v = oacc[dt];
                    *(u32x2*)(yp + dt * 16) = (u32x2){pack2(v[0], v[1]), pack2(v[2], v[3])};
                }
            }
#pragma unroll
            for (int a = 0; a < 2; ++a) {
                const int ktile = 2 * wid + a;
                f32x4 e1, e2;
#pragma unroll
                for (int jj = 0; jj < 4; ++jj) { const int dkk = ktile * 16 + fq * 4 + jj; e1[jj] = __expf(TOT[dkk]); e2[jj] = __expf(TOT[128 + dkk]); }
#pragma unroll
                for (int dt = 0; dt < 4; ++dt) Sacc[a][dt] *= e1;
#pragma unroll
                for (int ks = 0; ks < 2; ++ks) {
                    const bf16x8 kf = ldfrag(KT + (ktile * 16 + fr) * 72 + ks * 32 + fq * 8);
#pragma unroll
                    for (int dt = 0; dt < 4; ++dt) Sacc[a][dt] = mfma16(kf, ldfrag(VT + (dt * 16 + fr) * 72 + ks * 32 + fq * 8), Sacc[a][dt]);
                }
#pragma unroll
                for (int dt = 0; dt < 4; ++dt) {
                    Sacc[a][dt] *= e2;
                    *(u32x2*)(ST + (dt * 16 + fr) * 136 + ktile * 16 + fq * 4) = (u32x2){pack2(Sacc[a][dt][0], Sacc[a][dt][1]), pack2(Sacc[a][dt][2], Sacc[a][dt][3])};
                }
            }
            __syncthreads();
        }
    }
}

__device__ void mx_lru(const Params& P, int l, int item, char* lds) {
    const int tid = tid_(), wid = tid >> 6, lane = tid & 63, fr = lane & 15, fq = lane >> 4;
    const int b = item >> 3, g = item & 7;
    const bf16_t* pr = (const bf16_t*)(P.ws + OFF_PREST) + (size_t)b * SQ * PREST_LD + LRU_O;
    bf16_t* YC = (bf16_t*)(P.ws + OFF_YC) + (size_t)b * SQ * 512 + g * 64;
    bf16_t* XC = (bf16_t*)lds; float* AA = (float*)(lds + 9216); float* BB = AA + 64 * 65; float* HH = BB + 64 * 65;
    const int ch = tid & 63, tq = tid >> 6;
    float cwv[4];
#pragma unroll
    for (int j = 0; j < 4; ++j) cwv[j] = P.in[I_LCW][(l * 4 + j) * 512 + g * 64 + ch];
    const float cbv = P.in[I_LCB][l * 512 + g * 64 + ch];
    const int i = wid * 16 + fr;
#pragma unroll 1
    for (int d = 0; d < 2; ++d) {
        bf16x8 waf[4][2], wxf[4][2]; f32x4 ba4[4], bx4[4], c8[4];
        {
            const bf16_t* Wa = (const bf16_t*)(P.ws + WT_LRU) + (((size_t)d * 2 + 0) * 8 + g) * 4096;
            const bf16_t* Wx = (const bf16_t*)(P.ws + WT_LRU) + (((size_t)d * 2 + 1) * 8 + g) * 4096;
#pragma unroll
            for (int jt = 0; jt < 4; ++jt) {
#pragma unroll
                for (int ks = 0; ks < 2; ++ks) { waf[jt][ks] = ldfrag(Wa + (jt * 16 + fr) * 64 + ks * 32 + fq * 8); wxf[jt][ks] = ldfrag(Wx + (jt * 16 + fr) * 64 + ks * 32 + fq * 8); }
                const int j = (l * 2 + d) * 512 + g * 64 + jt * 16 + fq * 4;
                ba4[jt] = *(const f32x4*)(P.in[I_LBA] + j); bx4[jt] = *(const f32x4*)(P.in[I_LBX] + j);
                const f32x4 lam = *(const f32x4*)(P.in[I_LLAM] + j);
#pragma unroll
                for (int jj = 0; jj < 4; ++jj) c8[jt][jj] = -8.f * (fmaxf(-lam[jj], 0.f) + log1pf(__expf(-fabsf(lam[jj]))));
            }
        }
        float hst = 0.f;
        bf16_t xr[19];
        auto lru_load = [&](int cc) {
            const int t0 = d ? SQ - 64 * (cc + 1) : 64 * cc;
#pragma unroll
            for (int k = 0; k < 19; ++k) { const int t = t0 + tq * 16 - 1 + k; xr[k] = (t >= 0 && t < SQ) ? pr[(size_t)t * PREST_LD + g * 64 + ch] : (bf16_t)0; }
        };
        lru_load(0);
#pragma unroll 1
        for (int c = 0; c < 32; ++c) {
            const int t0 = d ? SQ - 64 * (c + 1) : 64 * c;
            {
                float xw[19];
#pragma unroll
                for (int k = 0; k < 19; ++k) xw[k] = bf2f(xr[k]);
                if (c + 1 < 32) lru_load(c + 1);
#pragma unroll
                for (int r = 0; r < 16; ++r) XC[(tq * 16 + r) * 72 + ch] = f2bf(cbv + cwv[0] * xw[r] + cwv[1] * xw[r + 1] + cwv[2] * xw[r + 2] + cwv[3] * xw[r + 3]);
            }
            __syncthreads();
            {
                f32x4 ra[4], rx[4];
#pragma unroll
                for (int jt = 0; jt < 4; ++jt) { ra[jt] = (f32x4){0.f, 0.f, 0.f, 0.f}; rx[jt] = (f32x4){0.f, 0.f, 0.f, 0.f}; }
#pragma unroll
                for (int ks = 0; ks < 2; ++ks) {
                    const bf16x8 xf = ldfrag(XC + i * 72 + ks * 32 + fq * 8);
#pragma unroll
                    for (int jt = 0; jt < 4; ++jt) { ra[jt] = mfma16(waf[jt][ks], xf, ra[jt]); rx[jt] = mfma16(wxf[jt][ks], xf, rx[jt]); }
                }
#pragma unroll
                for (int jt = 0; jt < 4; ++jt) {
                    float xc[4]; unpack4(*(const u32x2*)(XC + i * 72 + jt * 16 + fq * 4), xc);
#pragma unroll
                    for (int jj = 0; jj < 4; ++jj) {
                        const float la = c8[jt][jj] * sigm(ra[jt][jj] + ba4[jt][jj]);
                        const float av = __expf(la);
                        const float mult = __builtin_amdgcn_sqrtf(fmaxf(1.f - av * av, 0.f));
                        AA[i * 65 + jt * 16 + fq * 4 + jj] = av;
                        BB[i * 65 + jt * 16 + fq * 4 + jj] = mult * sigm(rx[jt][jj] + bx4[jt][jj]) * xc[jj];
                    }
                }
            }
            __syncthreads();
            if (tid < 64) {
#pragma unroll 1
                for (int r8 = 0; r8 < 8; ++r8) {
                    float av[8], bv[8];
#pragma unroll
                    for (int x = 0; x < 8; ++x) { const int r = d ? 63 - (r8 * 8 + x) : r8 * 8 + x; av[x] = AA[r * 65 + ch]; bv[x] = BB[r * 65 + ch]; }
#pragma unroll
                    for (int x = 0; x < 8; ++x) { const int r = d ? 63 - (r8 * 8 + x) : r8 * 8 + x; hst = av[x] * hst + bv[x]; HH[r * 65 + ch] = hst; }
                }
            }
            __syncthreads();
#pragma unroll
            for (int r = 0; r < 16; ++r) {
                const int ii = tq * 16 + r, t = t0 + ii;
                const float hv = HH[ii * 65 + ch];
                if (d == 0) YC[(size_t)t * 512 + ch] = f2bf(hv);
                else { const float prev = bf2f(YC[(size_t)t * 512 + ch]), gb = bf2f(pr[(size_t)t * PREST_LD + 512 + g * 64 + ch]); YC[(size_t)t * 512 + ch] = f2bf((prev + hv) * gelu_t(gb)); }
            }
        }
        __syncthreads();
    }
}

__device__ void dbg_zero(bf16_t* p, size_t n, int part, int nparts) {
    u32x4* q = (u32x4*)p; const size_t n8 = n / 8, per = (n8 + nparts - 1) / nparts, lo = per * part, hi = (lo + per < n8) ? lo + per : n8;
    for (size_t e = lo + tid_(); e < hi; e += NT) q[e] = (u32x4){0u, 0u, 0u, 0u};
}
__device__ void ph_mixers(const Params& P, int l, char* lds, int which) {
    const int nitems = 384;
    for (int item = bid_(); item < nitems; item += gridDim.x) {
        if (which) { if (item < 256) mx_rwkv(P, l, item, lds); else mx_lru(P, l, item - 256, lds); }
        else if (item < 256) mx_hgrn(P, l, item, lds);
        else mx_mlstm(P, l, item - 256, lds);
        __syncthreads();
    }
}

__device__ void ph_rwpost(const Params& P, int l, char* lds) {
    const int tid = tid_(), wid = tid >> 6, lane = tid & 63, fr = lane & 15, fq = lane >> 4;
    bf16_t* SG = (bf16_t*)lds; float* STAT = (float*)(lds + 64 * 136 * 2);
    const bf16_t* G2T = (const bf16_t*)(P.ws + WT_G2);
    const float* mu = P.in[I_MU] + l * 1792;
    for (int item = bid_(); item < TT / 64; item += gridDim.x) {
        const int tok0 = item * 64, s0 = tok0 & (SQ - 1);
        const bf16_t* prw = (const bf16_t*)(P.ws + OFF_PRW);
        bf16_t* Y0 = (bf16_t*)(P.ws + OFF_Y0); const bf16_t* Y1 = (const bf16_t*)(P.ws + OFF_Y1);
        const float* be0 = (const float*)(P.ws + OFF_BETA); const float* be1 = be0 + (size_t)TT * 8;
        __syncthreads();
        {
            const int r = tid >> 2, part = tid & 3, t = tok0 + r, sp = s0 + r;
#pragma unroll
            for (int v = 0; v < 4; ++v) {
                const int c = part * 32 + v * 8;
                float f0[8], fm[8], fp[8];
                unpack8(*(const u32x4*)(prw + (size_t)t * PRW_LD + 1664 + c), f0);
                if (sp > 0) unpack8(*(const u32x4*)(prw + (size_t)(t - 1) * PRW_LD + 1664 + c), fm); else { for (int x = 0; x < 8; ++x) fm[x] = 0.f; }
                if (sp < SQ - 1) unpack8(*(const u32x4*)(prw + (size_t)(t + 1) * PRW_LD + 1664 + c), fp); else { for (int x = 0; x < 8; ++x) fp[x] = 0.f; }
                float o[8];
#pragma unroll
                for (int x = 0; x < 8; ++x) o[x] = sigm(f0[x] + mu[1664 + c + x] * (0.5f * (fm[x] + fp[x]) - f0[x]));
                *(u32x4*)(SG + r * 136 + c) = (u32x4){pack2(o[0], o[1]), pack2(o[2], o[3]), pack2(o[4], o[5]), pack2(o[6], o[7])};
            }
#pragma unroll
            for (int hh = 0; hh < 2; ++hh) {
                const int head = part * 2 + hh;
                float sm = 0.f, sq = 0.f;
#pragma unroll
                for (int v = 0; v < 8; ++v) {
                    float a[8], bq[8];
                    unpack8(*(const u32x4*)(Y0 + (size_t)t * 512 + head * 64 + v * 8), a); unpack8(*(const u32x4*)(Y1 + (size_t)t * 512 + head * 64 + v * 8), bq);
#pragma unroll
                    for (int x = 0; x < 8; ++x) { const float y = a[x] + bq[x]; sm += y; sq += y * y; }
                }
                const float mean = sm * (1.f / 64.f), var = fmaxf(sq * (1.f / 64.f) - mean * mean, 0.f);
                STAT[(r * 8 + head) * 2] = mean; STAT[(r * 8 + head) * 2 + 1] = rsqrtf(var + 64e-5f);
            }
        }
        __syncthreads();
#pragma unroll 1
        for (int np = 0; np < 4; ++np) {
            const int nt0 = wid * 8 + np * 2;
#pragma unroll 1
            for (int tt = 0; tt < 4; ++tt) {
                f32x4 acc[2];
                acc[0] = (f32x4){0.f, 0.f, 0.f, 0.f}; acc[1] = (f32x4){0.f, 0.f, 0.f, 0.f};
#pragma unroll
                for (int ks = 0; ks < 4; ++ks) {
                    const bf16x8 b0 = ldfrag(G2T + (size_t)(nt0 * 16 + fr) * 128 + ks * 32 + fq * 8), b1 = ldfrag(G2T + (size_t)((nt0 + 1) * 16 + fr) * 128 + ks * 32 + fq * 8);
                    const bf16x8 af = ldfrag(SG + (tt * 16 + fr) * 136 + ks * 32 + fq * 8);
                    acc[0] = mfma16(b0, af, acc[0]); acc[1] = mfma16(b1, af, acc[1]);
                }
#pragma unroll
                for (int q = 0; q < 2; ++q) {
                    const int r = tt * 16 + fr, t = tok0 + r, sp = s0 + r, n = (nt0 + q) * 16 + fq * 4, head = n >> 6;
                    float y0[4], y1[4], v0[4], vm[4], vp[4];
                    unpack4(*(const u32x2*)(Y0 + (size_t)t * 512 + n), y0); unpack4(*(const u32x2*)(Y1 + (size_t)t * 512 + n), y1);
                    unpack4(*(const u32x2*)(prw + (size_t)t * PRW_LD + 1024 + n), v0);
                    if (sp > 0) unpack4(*(const u32x2*)(prw + (size_t)(t - 1) * PRW_LD + 1024 + n), vm); else { vm[0] = vm[1] = vm[2] = vm[3] = 0.f; }
                    if (sp < SQ - 1) unpack4(*(const u32x2*)(prw + (size_t)(t + 1) * PRW_LD + 1024 + n), vp); else { vp[0] = vp[1] = vp[2] = vp[3] = 0.f; }
                    const float mean = STAT[(r * 8 + head) * 2], rstd = STAT[(r * 8 + head) * 2 + 1];
                    const float be = 0.5f * (be0[(size_t)t * 8 + head] + be1[(size_t)t * 8 + head]);
                    const f32x4 lw = *(const f32x4*)(P.in[I_LNW] + l * 512 + n), lb = *(const f32x4*)(P.in[I_LNB] + l * 512 + n), m4 = *(const f32x4*)(mu + 1024 + n);
                    float o[4];
#pragma unroll
                    for (int jj = 0; jj < 4; ++jj) {
                        const float vs = v0[jj] + m4[jj] * (0.5f * (vm[jj] + vp[jj]) - v0[jj]);
                        o[jj] = (((y0[jj] + y1[jj]) - mean) * rstd * lw[jj] + lb[jj] + be * vs) * acc[q][jj];
                    }
                    *(u32x2*)(Y0 + (size_t)t * 512 + n) = (u32x2){pack2(o[0], o[1]), pack2(o[2], o[3])};
                }
            }
        }
    }
    __syncthreads();
}
template <bool ML> __device__ void ph_headpost(const Params& P, int l) {
    const int tid = tid_();
    bf16_t* YO = (bf16_t*)(P.ws + (ML ? OFF_YB : OFF_YD)); const bf16_t* SDF = (const bf16_t*)(P.ws + (ML ? OFF_Y1 : OFF_Y0));
    const bf16_t* pr = (const bf16_t*)(P.ws + OFF_PREST) + (ML ? 1024 : HG_O + 2048);
    const float* ng = P.in[ML ? I_MLN : I_HGN] + l * 512;
    for (int item = bid_(); item < TT / 64; item += gridDim.x) {
        const int t = item * 64 + (tid >> 2), part = tid & 3;
#pragma unroll 2
        for (int hh = 0; hh < 4; ++hh) {
            const int c0 = hh * 128 + part * 32;
            float v[32]; float ss = 0.f;
#pragma unroll
            for (int q = 0; q < 4; ++q) { float f[8], f2[8]; unpack8(*(const u32x4*)(YO + (size_t)t * 512 + c0 + q * 8), f); unpack8(*(const u32x4*)(SDF + (size_t)t * 512 + c0 + q * 8), f2);
#pragma unroll
                for (int x = 0; x < 8; ++x) { const float y = f[x] + f2[x]; v[q * 8 + x] = y; ss += y * y; } }
            ss += dppf<0xB1>(ss); ss += dppf<0x4E>(ss);
            const float rms = rsqrtf(ss * (1.f / 128.f) + 1e-6f);
#pragma unroll
            for (int q = 0; q < 4; ++q) {
                float gq[8]; unpack8(*(const u32x4*)(pr + (size_t)t * PREST_LD + c0 + q * 8), gq);
                float o[8];
#pragma unroll
                for (int x = 0; x < 8; ++x) o[x] = (ML ? sigm(gq[x]) : silu(gq[x])) * v[q * 8 + x] * rms * ng[c0 + q * 8 + x];
                *(u32x4*)(YO + (size_t)t * 512 + c0 + q * 8) = (u32x4){pack2(o[0], o[1]), pack2(o[2], o[3]), pack2(o[4], o[5]), pack2(o[6], o[7])};
            }
        }
    }
}

#define XB_TMO      128
#define XB_XCNT(j)  (256  + 64 * (j))
#define XB_XSUB(j)  (1280 + 64 * (j))
#define XB_XGEN(j)  (2304 + 64 * (j))
#define XB_TOP      3328
#define XB_TOPGEN   3392
#define XCD_BAR_WORDS 3456
#define XB_SPIN_CAP (1u << 18)
#define LAS __attribute__((address_space(3)))

__device__ __forceinline__ unsigned xb_ld(unsigned* p)              { return __hip_atomic_load(p, __ATOMIC_RELAXED, __HIP_MEMORY_SCOPE_AGENT); }
__device__ __forceinline__ unsigned xb_add(unsigned* p, unsigned v) { return __hip_atomic_fetch_add(p, v, __ATOMIC_RELAXED, __HIP_MEMORY_SCOPE_AGENT); }
__device__ __forceinline__ unsigned xb_xcc_id() { return (unsigned)__builtin_amdgcn_s_getreg((3 << 11) | 20) & 0xFu; }
#define XB_SPIN(cond, bar) do { unsigned _sp = 0; while (cond) { __builtin_amdgcn_s_sleep(1); \
    if ((++_sp & 255u) == 0u) { if (xb_ld(&(bar)[XB_TMO])) break; if (_sp > XB_SPIN_CAP) { atomicAdd(&(bar)[XB_TMO], 1u); break; } } } } while (0)

struct XcdBarrier {
    unsigned* bar; unsigned x;
    volatile LAS unsigned* st;
};

__device__ __forceinline__ XcdBarrier xcd_barrier_post(unsigned* bar, volatile LAS unsigned* st) {
    XcdBarrier b; b.bar = bar; b.x = xb_xcc_id(); b.st = st;
    if (threadIdx.x == 0) (void)xb_add(&bar[XB_XCNT(b.x)], 1u);
    return b;
}
__device__ __forceinline__ void xcd_barrier_complete(unsigned* bar, unsigned x, unsigned& nloc, unsigned& nx) {
    const unsigned G = gridDim.x * gridDim.y * gridDim.z;
    unsigned sum, cnt, mine, sp = 0u;
    for (;;) {
        sum = 0u; cnt = 0u; mine = 0u;
#pragma unroll
        for (unsigned j = 0; j < 16; ++j) { const unsigned c = xb_ld(&bar[XB_XCNT(j)]); sum += c; cnt += (c > 0u) ? 1u : 0u; mine = (j == x) ? c : mine; }
        if (sum == G) break;
        __builtin_amdgcn_s_sleep(1);
        if ((++sp & 255u) == 0u) { if (xb_ld(&bar[XB_TMO])) break; if (sp > XB_SPIN_CAP) { atomicAdd(&bar[XB_TMO], 1u); break; } }
    }
    nloc = mine > 0u ? mine : 1u; nx = cnt > 0u ? cnt : 1u;
}

__device__ __forceinline__ void xcd_barrier(const XcdBarrier& b) {
    asm volatile("s_waitcnt vmcnt(0)" ::: "memory");
    __syncthreads();
    if (threadIdx.x == 0) {
        unsigned* bar = b.bar;
        __builtin_amdgcn_s_waitcnt(0);
        unsigned nloc = b.st[0], nx = b.st[1];
        if (nloc == 0u) { xcd_barrier_complete(bar, b.x, nloc, nx); b.st[0] = nloc; b.st[1] = nx; }
        const unsigned old = xb_add(&bar[XB_XSUB(b.x)], 1u);
        const unsigned gen = old / nloc;
        if (old + 1u == (gen + 1u) * nloc) {
            __builtin_amdgcn_fence(__ATOMIC_RELEASE, "agent");
            asm volatile("s_waitcnt vmcnt(0)" ::: "memory");
            const unsigned og = xb_add(&bar[XB_TOP], 1u);
            const unsigned tg = og / nx;
            if (og + 1u == (tg + 1u) * nx) xb_add(&bar[XB_TOPGEN], 1u);
            else XB_SPIN(xb_ld(&bar[XB_TOPGEN]) == tg, bar);
            __builtin_amdgcn_fence(__ATOMIC_ACQUIRE, "agent");
            xb_add(&bar[XB_XGEN(b.x)], 1u);
            asm volatile("s_waitcnt vmcnt(0)" ::: "memory");
        } else {
            XB_SPIN(xb_ld(&bar[XB_XGEN(b.x)]) == gen, bar);
            __builtin_amdgcn_fence(__ATOMIC_ACQUIRE, "agent");
            asm volatile("s_waitcnt vmcnt(0)" ::: "memory");
        }
    }
    __syncthreads();
}


constexpr int N_PHASES = 2 + NL * 13;
__device__ void run_phase(const Params& P, int ph, char* lds) {
    if (ph == 0) { ph_init(P, lds); return; }
    if (ph == N_PHASES - 1) { ph_norm(P, P.in[I_FING], nullptr, 0, 0, nullptr, true); return; }
    const int l = (ph - 1) / 13; int sp = (ph - 1) % 13;
    const float* modl = (const float*)(P.ws + OFF_MOD) + (size_t)l * 16 * 6144;
    if (sp == 2) { ph_mixers(P, l, lds, 0); return; }
    if (sp == 3) { ph_headpost<false>(P, l); ph_headpost<true>(P, l); return; }
    if (sp == 4) { ph_mixers(P, l, lds, 1); return; }
    if (sp > 4) sp -= 2;
    switch (sp) {
        case 0: ph_wt(P, l, lds); ph_norm(P, P.in[I_N1G] + l * DM, modl, 0, 1024, (bf16_t*)(P.ws + OFF_U), false); break;
        case 1: ph_gemm_p(P, lds); break;
        case 3: ph_rwpost(P, l, lds); break;
        case 4: ph_norm(P, P.in[I_N1G] + l * DM, modl, 0, 1024, (bf16_t*)(P.ws + OFF_URE), false); break;
        case 5: ph_gemm_merge(P, lds); break;
        case 6: ph_gemm_out(P, l, lds); break;
        case 7: ph_norm(P, P.in[I_N2G] + l * DM, modl, 3072, 4096, (bf16_t*)(P.ws + OFF_U2), false); break;
        case 8: ph_gemm_up(P, lds); break;
        case 9: ph_convact(P, l); break;
        default: ph_gemm_down(P, l, lds); break;
    }
}

__global__ void __launch_bounds__(NT, 2) mega(Params P, int ph_lo, int ph_hi) {
    extern __shared__ __attribute__((aligned(16))) char smem[];
    cg::grid_group grid = cg::this_grid();
    volatile LAS unsigned* xst = (volatile LAS unsigned*)(smem + LDS_BYTES - 16);
    if (threadIdx.x == 0) { xst[0] = 0u; xst[1] = 0u; }
    __syncthreads();
    XcdBarrier xb = xcd_barrier_post((unsigned*)(P.ws + OFF_BAR), xst);
    for (int ph = ph_lo; ph < ph_hi; ++ph) {
        run_phase(P, ph, smem);
        if (ph + 1 < ph_hi) { if (ph == ph_lo) grid.sync(); else xcd_barrier(xb); }
    }
}

extern "C" void kernel_launch(void* const* d_in, const int* in_sizes, int n_in, void* d_out, int out_size, void* d_ws, size_t ws_size, hipStream_t stream) {
    static int grid_blocks = 0;
    if (grid_blocks == 0) {
        if (n_in != N_INPUTS || ws_size < WS_NEED || out_size != TT * DM) { fprintf(stderr, "kernel_launch: unexpected shapes (n_in %d ws %zu need %zu)\n", n_in, ws_size, (size_t)WS_NEED); grid_blocks = -1; return; }
        int dev = 0, cus = 0, per_cu = 0;
        hipGetDevice(&dev);
        hipDeviceGetAttribute(&cus, hipDeviceAttributeMultiprocessorCount, dev);
        if (hipFuncSetAttribute((const void*)mega, hipFuncAttributeMaxDynamicSharedMemorySize, LDS_BYTES) != hipSuccess) { fprintf(stderr, "kernel_launch: hipFuncSetAttribute failed\n"); grid_blocks = -1; return; }
        hipOccupancyMaxActiveBlocksPerMultiprocessor(&per_cu, (const void*)mega, NT, LDS_BYTES);
        if (per_cu < 1) per_cu = 1;
        if (per_cu > 2) per_cu = 2;
        grid_blocks = cus * per_cu;
    }
    if (grid_blocks < 0) return;
    if (hipMemsetAsync((char*)d_ws + OFF_BAR, 0, BAR_BYTES, stream) != hipSuccess) { fprintf(stderr, "kernel_launch: memset of the barrier words failed\n"); return; }
    Params p{};
    for (int i = 0; i < N_INPUTS; ++i) p.in[i] = (const float*)d_in[i];
    p.out = (float*)d_out; p.ws = (char*)d_ws;
#if MULTI_LAUNCH
    for (int ph = 0; ph < N_PHASES; ++ph) hipLaunchKernelGGL(mega, dim3(grid_blocks), dim3(NT), LDS_BYTES, stream, p, ph, ph + 1);
#else
    int lo = 0, hi = N_PHASES;
    void* args[] = {&p, &lo, &hi};
    hipError_t e = hipLaunchCooperativeKernel((const void*)mega, dim3(grid_blocks), dim3(NT), args, LDS_BYTES, stream);
    if (e != hipSuccess) fprintf(stderr, "cooperative launch failed: %s (grid %d)\n", hipGetErrorString(e), grid_blocks);
#endif
}
```

```cpp
#include <hip/hip_runtime.h>
#include <hip/hip_cooperative_groups.h>
#include <cstdio>
namespace cg = cooperative_groups;

typedef unsigned short bf16_t;
typedef short bf16x8 __attribute__((ext_vector_type(8)));
typedef float f32x4 __attribute__((ext_vector_type(4)));
typedef unsigned u32x4 __attribute__((ext_vector_type(4)));
typedef unsigned u32x2 __attribute__((ext_vector_type(2)));

#ifndef DBG_SKIP
#define DBG_SKIP 0
#endif
#ifndef DBG_NOFFN
#define DBG_NOFFN 0
#endif
#ifndef MULTI_LAUNCH
#define MULTI_LAUNCH 0
#endif

constexpr int NB = 16, SQ = 2048, DM = 1024, TT = NB * SQ, MW = 512, NL = 4;
constexpr int NT = 256;
constexpr int PRW_LD = 1792, PREST_LD = 5248;
constexpr int LRU_O = 1664, HG_O = 2688;
constexpr int GATE_ROW0 = 7040;
constexpr int DFF = 2816;
constexpr int LDS_BYTES = 73728;

constexpr size_t WT_WIN = 0;
constexpr size_t WT_WB = WT_WIN + (size_t)11136 * 1024 * 2;
constexpr size_t WT_WOUT = WT_WB + (size_t)4 * 1024 * 512 * 2;
constexpr size_t WT_WUP = WT_WOUT + (size_t)1024 * 1024 * 2;
constexpr size_t WT_WDN = WT_WUP + (size_t)5632 * 1024 * 2;
constexpr size_t WT_G2 = WT_WDN + (size_t)1024 * 2816 * 2;
constexpr size_t WT_W2 = WT_G2 + (size_t)512 * 128 * 2;
constexpr size_t WT_A2 = WT_W2 + (size_t)2 * 512 * 64 * 2;
constexpr size_t WT_LRU = WT_A2 + (size_t)2 * 512 * 64 * 2;
constexpr size_t WT_END = WT_LRU + (size_t)2 * 2 * 8 * 64 * 64 * 2;
constexpr size_t OFF_PRW = (size_t)48 << 20;
static_assert(WT_END <= OFF_PRW, "wt");
constexpr size_t OFF_PREST = OFF_PRW + (size_t)TT * PRW_LD * 2;
constexpr size_t OFF_Y = OFF_PREST + (size_t)TT * PREST_LD * 2;
constexpr size_t YSZ = (size_t)TT * 512 * 2;
constexpr size_t OFF_YB = OFF_Y, OFF_YC = OFF_Y + YSZ, OFF_YD = OFF_Y + 2 * YSZ, OFF_Y0 = OFF_Y + 3 * YSZ, OFF_Y1 = OFF_Y + 4 * YSZ;
constexpr size_t OFF_SMALL = OFF_Y + 5 * YSZ;
constexpr size_t OFF_MOD = OFF_SMALL;
constexpr size_t OFF_LB = OFF_MOD + (size_t)4 * 16 * 6144 * 4;
constexpr size_t OFF_BETA = OFF_LB + (size_t)4 * 2 * 512 * 4;
constexpr size_t OFF_BAR = OFF_BETA + (size_t)2 * TT * 8 * 4;
constexpr size_t BAR_BYTES = 16384;
constexpr size_t WS_NEED = OFF_BAR + BAR_BYTES;
constexpr size_t OFF_U = OFF_Y;
constexpr size_t OFF_URE = OFF_PREST;
constexpr size_t OFF_MERGED = OFF_PREST + (size_t)TT * 1024 * 2;
constexpr size_t OFF_U2 = OFF_Y;
constexpr size_t OFF_Z = OFF_PRW;
constexpr size_t OFF_ACT = OFF_PRW + (size_t)TT * 5632 * 2;
static_assert(OFF_ACT + (size_t)TT * 2816 * 2 <= OFF_SMALL, "act");

enum { I_X = 0, I_C, I_ADAW, I_ADAB, I_N1G, I_WIN, I_MU, I_W0, I_W2, I_A0, I_A2, I_G2, I_KK, I_KA, I_RK, I_LNW, I_LNB,
       I_MLIB, I_MLFB, I_MLN, I_LCW, I_LCB, I_LWA, I_LBA, I_LWX, I_LBX, I_LLAM, I_HGLB, I_HGN, I_WBR, I_WOUT, I_N2G,
       I_FUP, I_FCW, I_FCB, I_FDN, I_FING, N_INPUTS };

struct Params { const float* in[N_INPUTS]; float* out; char* ws; };

__device__ __forceinline__ int tid_() { int x = threadIdx.x; asm volatile("" : "+v"(x)); return x; }
__device__ __forceinline__ int bid_() { int x = blockIdx.x; asm volatile("" : "+s"(x)); return x; }
__device__ __forceinline__ bf16_t f2bf(float f) { unsigned u = __float_as_uint(f); u += 0x7fffu + ((u >> 16) & 1u); return (bf16_t)(u >> 16); }
__device__ __forceinline__ float bf2f(bf16_t h) { return __uint_as_float(((unsigned)h) << 16); }
__device__ __forceinline__ unsigned pack2(float a, float b) { return (unsigned)f2bf(a) | ((unsigned)f2bf(b) << 16); }
__device__ __forceinline__ float lo2f(unsigned u) { return __uint_as_float(u << 16); }
__device__ __forceinline__ float hi2f(unsigned u) { return __uint_as_float(u & 0xffff0000u); }
__device__ __forceinline__ float rcpf_(float x) { return __builtin_amdgcn_rcpf(x); }
__device__ __forceinline__ float flog_(float x) { return __builtin_amdgcn_logf(x) * 0.69314718056f; }
__device__ __forceinline__ float sigm(float x) { return rcpf_(1.f + __expf(-x)); }
__device__ __forceinline__ float silu(float x) { return x * sigm(x); }
__device__ __forceinline__ float logsig(float x) { return fminf(x, 0.f) - flog_(1.f + __expf(-fabsf(x))); }
__device__ __forceinline__ float tanh_f(float x) { return 1.f - 2.f * rcpf_(1.f + __expf(2.f * x)); }
__device__ __forceinline__ float gelu_t(float x) { return 0.5f * x * (1.f + tanh_f(0.7978845608f * (x + 0.044715f * x * x * x))); }
template <int CTRL> __device__ __forceinline__ float dppf(float x) { return __int_as_float(__builtin_amdgcn_update_dpp(0, __float_as_int(x), CTRL, 0xF, 0xF, false)); }
__device__ __forceinline__ float rowsum16(float x) { x += dppf<0x128>(x); x += dppf<0x124>(x); x += dppf<0x122>(x); x += dppf<0x121>(x); return x; }
__device__ __forceinline__ float rdlane(float x, int l) { return __int_as_float(__builtin_amdgcn_readlane(__float_as_int(x), l)); }
__device__ __forceinline__ float wsum64(float x) { x = rowsum16(x); return (rdlane(x, 0) + rdlane(x, 16)) + (rdlane(x, 32) + rdlane(x, 48)); }
__device__ __forceinline__ float bperm(float x, int srclane) { return __int_as_float(__builtin_amdgcn_ds_bpermute(srclane << 2, __float_as_int(x))); }
__device__ __forceinline__ float qsum(float x, int lane) { x += bperm(x, lane ^ 16); x += bperm(x, lane ^ 32); return x; }
__device__ __forceinline__ void unpack8(u32x4 v, float (&f)[8]) {
    f[0] = lo2f(v.x); f[1] = hi2f(v.x); f[2] = lo2f(v.y); f[3] = hi2f(v.y); f[4] = lo2f(v.z); f[5] = hi2f(v.z); f[6] = lo2f(v.w); f[7] = hi2f(v.w); }
__device__ __forceinline__ void unpack4(u32x2 v, float (&f)[4]) { f[0] = lo2f(v.x); f[1] = hi2f(v.x); f[2] = lo2f(v.y); f[3] = hi2f(v.y); }
__device__ __forceinline__ f32x4 mfma16(bf16x8 a, bf16x8 b, f32x4 c) { return __builtin_amdgcn_mfma_f32_16x16x32_bf16(a, b, c, 0, 0, 0); }
__device__ __forceinline__ bf16x8 ldfrag(const bf16_t* p) { return *reinterpret_cast<const bf16x8*>(p); }

__device__ __forceinline__ void gemm_stage(const bf16_t* __restrict__ A, long lda, const bf16_t* __restrict__ Bt, long ldb, int kt, char* buf, int tid) {
#pragma unroll
    for (int i = 0; i < 4; ++i) {
        const int b = tid * 16 + i * 4096, r = b >> 7, c = ((b & 127) >> 4) ^ (r & 7);
        __builtin_amdgcn_global_load_lds((const unsigned*)(A + (long)r * lda + kt * 64 + c * 8), (__attribute__((address_space(3))) unsigned*)(buf + b), 16, 0, 0);
        __builtin_amdgcn_global_load_lds((const unsigned*)(Bt + (long)r * ldb + kt * 64 + c * 8), (__attribute__((address_space(3))) unsigned*)(buf + 16384 + b), 16, 0, 0);
    }
}
__device__ __forceinline__ void gemm_acc(const bf16_t* __restrict__ A, long lda, const bf16_t* __restrict__ Bt, long ldb, int K, f32x4 (&acc)[4][4], char* lds) {
    const int tid = tid_(), wid = tid >> 6, lane = tid & 63, wr = wid >> 1, wc = wid & 1, fr = lane & 15, fq = lane >> 4;
    const int nk = K >> 6;
    gemm_stage(A, lda, Bt, ldb, 0, lds, tid);
    asm volatile("s_waitcnt vmcnt(0)" ::: "memory");
    __syncthreads();
    for (int kt = 0; kt < nk; ++kt) {
        char* cur = lds + (kt & 1) * 32768;
        if (kt + 1 < nk) gemm_stage(A, lda, Bt, ldb, kt + 1, lds + ((kt + 1) & 1) * 32768, tid);
#pragma unroll
        for (int ks = 0; ks < 2; ++ks) {
            bf16x8 af[4], bfr[4];
#pragma unroll
            for (int m = 0; m < 4; ++m) { const int row = wr * 64 + m * 16 + fr; af[m] = *reinterpret_cast<const bf16x8*>(cur + row * 128 + (((ks * 4 + fq) ^ (row & 7)) << 4)); }
#pragma unroll
            for (int n = 0; n < 4; ++n) { const int row = wc * 64 + n * 16 + fr; bfr[n] = *reinterpret_cast<const bf16x8*>(cur + 16384 + row * 128 + (((ks * 4 + fq) ^ (row & 7)) << 4)); }
            __builtin_amdgcn_s_setprio(1);
#pragma unroll
            for (int m = 0; m < 4; ++m)
#pragma unroll
                for (int n = 0; n < 4; ++n) acc[m][n] = mfma16(bfr[n], af[m], acc[m][n]);
            __builtin_amdgcn_s_setprio(0);
        }
        asm volatile("s_waitcnt vmcnt(0)" ::: "memory");
        __syncthreads();
    }
}
__device__ __forceinline__ void gemm2_stage(const bf16_t* __restrict__ A, long lda, const bf16_t* __restrict__ Bt, long ldb, int kt, char* buf, int tid) {
#pragma unroll
    for (int i = 0; i < 4; ++i) {
        const int b = tid * 16 + i * 4096, r = b >> 6, c = ((b & 63) >> 4) ^ ((r >> 2) & 3);
        __builtin_amdgcn_global_load_lds((const unsigned*)(A + (long)r * lda + kt * 32 + c * 8), (__attribute__((address_space(3))) unsigned*)(buf + b), 16, 0, 0);
    }
#pragma unroll
    for (int i = 0; i < 2; ++i) {
        const int b = tid * 16 + i * 4096, r = b >> 6, c = ((b & 63) >> 4) ^ ((r >> 2) & 3);
        __builtin_amdgcn_global_load_lds((const unsigned*)(Bt + (long)r * ldb + kt * 32 + c * 8), (__attribute__((address_space(3))) unsigned*)(buf + 16384 + b), 16, 0, 0);
    }
}
__device__ __forceinline__ void gemm_acc2(const bf16_t* __restrict__ A, long lda, const bf16_t* __restrict__ Bt, long ldb, int K, f32x4 (&acc)[8][4], char* lds) {
    const int tid = tid_(), wid = tid >> 6, lane = tid & 63, wr = wid >> 1, wc = wid & 1, fr = lane & 15, fq = lane >> 4;
    const int nk = K >> 5;
    gemm2_stage(A, lda, Bt, ldb, 0, lds, tid);
    asm volatile("s_waitcnt vmcnt(0)" ::: "memory");
    __syncthreads();
    for (int kt = 0; kt < nk; ++kt) {
        char* cur = lds + (kt & 1) * 24576;
        if (kt + 1 < nk) gemm2_stage(A, lda, Bt, ldb, kt + 1, lds + ((kt + 1) & 1) * 24576, tid);
        bf16x8 bfr[4];
#pragma unroll
        for (int n = 0; n < 4; ++n) { const int row = wc * 64 + n * 16 + fr; bfr[n] = *reinterpret_cast<const bf16x8*>(cur + 16384 + row * 64 + ((fq ^ ((row >> 2) & 3)) << 4)); }
#pragma unroll
        for (int m = 0; m < 8; ++m) {
            const int row = wr * 128 + m * 16 + fr;
            const bf16x8 af = *reinterpret_cast<const bf16x8*>(cur + row * 64 + ((fq ^ ((row >> 2) & 3)) << 4));
            __builtin_amdgcn_s_setprio(1);
#pragma unroll
            for (int n = 0; n < 4; ++n) acc[m][n] = mfma16(bfr[n], af, acc[m][n]);
            __builtin_amdgcn_s_setprio(0);
        }
        asm volatile("s_waitcnt vmcnt(0)" ::: "memory");
        __syncthreads();
    }
}
__device__ __forceinline__ void zero_acc2(f32x4 (&acc)[8][4]) {
#pragma unroll
    for (int m = 0; m < 8; ++m)
#pragma unroll
        for (int n = 0; n < 4; ++n) acc[m][n] = (f32x4){0.f, 0.f, 0.f, 0.f};
}
__device__ __forceinline__ void zero_acc(f32x4 (&acc)[4][4]) {
#pragma unroll
    for (int m = 0; m < 4; ++m)
#pragma unroll
        for (int n = 0; n < 4; ++n) acc[m][n] = (f32x4){0.f, 0.f, 0.f, 0.f};
}

__device__ void ph_init(const Params& P, char* lds) {
    const int tid = tid_();
    {
        const f32x4* src = (const f32x4*)P.in[I_X]; f32x4* dst = (f32x4*)P.out;
        const long n4 = (long)TT * DM / 4;
        for (long i = (long)bid_() * NT + tid; i < n4; i += (long)gridDim.x * NT) dst[i] = src[i];
    }
    float* mod = (float*)(P.ws + OFF_MOD);
    float* lbo = (float*)(P.ws + OFF_LB);
    for (int item = bid_(); item < 385; item += gridDim.x) {
        if (item < 384) {
            const int l = item / 96, j0 = (item % 96) * 64;
            const int col = tid & 63, kg = tid >> 6;
            float* CS = (float*)lds;
            float* RED = CS + 4096;
            float acc[16];
#pragma unroll
            for (int b = 0; b < 16; ++b) acc[b] = 0.f;
            const float* Wl = P.in[I_ADAW] + (size_t)l * DM * 6144;
            for (int sub = 0; sub < 4; ++sub) {
                __syncthreads();
                for (int e = tid; e < 4096; e += NT) {
                    const int kk = e & 63, b = (e >> 6) & 15, g = e >> 10;
                    CS[e] = silu(P.in[I_C][b * DM + g * 256 + sub * 64 + kk]);
                }
                __syncthreads();
                for (int kk = 0; kk < 64; ++kk) {
                    const float w = Wl[(size_t)(kg * 256 + sub * 64 + kk) * 6144 + j0 + col];
#pragma unroll
                    for (int b = 0; b < 16; ++b) acc[b] += CS[(kg * 16 + b) * 64 + kk] * w;
                }
            }
#pragma unroll
            for (int b = 0; b < 16; ++b) RED[(kg * 64 + col) * 16 + b] = acc[b];
            __syncthreads();
            {
                const int bg = tid >> 6;
#pragma unroll
                for (int bb = 0; bb < 4; ++bb) {
                    const int b = bg * 4 + bb;
                    float s = RED[(0 * 64 + col) * 16 + b] + RED[(1 * 64 + col) * 16 + b] + RED[(2 * 64 + col) * 16 + b] + RED[(3 * 64 + col) * 16 + b];
                    mod[((size_t)l * 16 + b) * 6144 + j0 + col] = s + P.in[I_ADAB][l * 6144 + j0 + col];
                }
            }
            __syncthreads();
        } else {
            for (int e = tid; e < 1024; e += NT) {
                float x[4], mx = -1e30f;
#pragma unroll
                for (int l = 0; l < 4; ++l) { x[l] = P.in[I_HGLB][l * 1024 + e]; mx = fmaxf(mx, x[l]); }
                float s = 0.f;
#pragma unroll
                for (int l = 0; l < 4; ++l) { x[l] = __expf(x[l] - mx); s += x[l]; }
                const float inv = rcpf_(s);
                float cum = 0.f;
                lbo[0 * 1024 + e] = 0.f;
#pragma unroll
                for (int l = 1; l < 4; ++l) { cum += x[l] * inv; lbo[l * 1024 + e] = fminf(fmaxf(cum, 0.f), 1.f); }
            }
        }
    }
}

__device__ __forceinline__ void tr_tile(const float* __restrict__ src, int ld, int N, int k0, int n0, bf16_t* __restrict__ dst, int dld, int drow0, bool winmap, char* lds) {
    float* Tl = (float*)lds;
    const int tid = tid_();
    __syncthreads();
#pragma unroll
    for (int i = 0; i < 4; ++i) {
        const int kk = (tid >> 4) + 16 * i, nn = (tid & 15) * 4;
        f32x4 v = (f32x4){0.f, 0.f, 0.f, 0.f};
        if (n0 + nn < N) v = *(const f32x4*)(src + (size_t)(k0 + kk) * ld + n0 + nn);
        Tl[kk * 65 + nn] = v[0]; Tl[kk * 65 + nn + 1] = v[1]; Tl[kk * 65 + nn + 2] = v[2]; Tl[kk * 65 + nn + 3] = v[3];
    }
    __syncthreads();
    {
        const int nn = tid >> 2, kb = (tid & 3) * 16;
        if (n0 + nn < N) {
            int drow = drow0 + nn;
            if (winmap) { const int n = n0 + nn; drow = n + (n >= 3344 ? 112 : 0); }
            unsigned w[8];
#pragma unroll
            for (int j = 0; j < 8; ++j) w[j] = pack2(Tl[(kb + 2 * j) * 65 + nn], Tl[(kb + 2 * j + 1) * 65 + nn]);
            u32x4* d = (u32x4*)(dst + (size_t)drow * dld + k0 + kb);
            d[0] = (u32x4){w[0], w[1], w[2], w[3]}; d[1] = (u32x4){w[4], w[5], w[6], w[7]};
        }
    }
}
__device__ void ph_wt(const Params& P, int l, char* lds) {
    char* ws = P.ws;
    const int NI = 2768 + 512 + 256 + 1408 + 704 + 16 + 16 + 16 + 16 + 16 + 7;
    for (int item = bid_(); item < NI; item += gridDim.x) {
        int it = item;
        if (it < 2768) { const int kt = it / 173, nt = it % 173;
            tr_tile(P.in[I_WIN] + (size_t)l * 1024 * 11024, 11024, 11024, kt * 64, nt * 64, (bf16_t*)(ws + WT_WIN), 1024, 0, true, lds); continue; }
        it -= 2768;
        if (it < 512) { const int n = it / 128, r = it % 128, kt = r / 16, nt = r % 16;
            tr_tile(P.in[I_WBR] + ((size_t)l * 4 + n) * 512 * 1024, 1024, 1024, kt * 64, nt * 64, (bf16_t*)(ws + WT_WB) + (size_t)n * 1024 * 512, 512, nt * 64, false, lds); continue; }
        it -= 512;
        if (it < 256) { const int kt = it / 16, nt = it % 16;
            tr_tile(P.in[I_WOUT] + (size_t)l * 1024 * 1024, 1024, 1024, kt * 64, nt * 64, (bf16_t*)(ws + WT_WOUT), 1024, nt * 64, false, lds); continue; }
        it -= 256;
        if (it < 1408) { const int kt = it / 88, nt = it % 88;
            tr_tile(P.in[I_FUP] + (size_t)l * 1024 * 5632, 5632, 5632, kt * 64, nt * 64, (bf16_t*)(ws + WT_WUP), 1024, nt * 64, false, lds); continue; }
        it -= 1408;
        if (it < 704) { const int kt = it / 16, nt = it % 16;
            tr_tile(P.in[I_FDN] + (size_t)l * 2816 * 1024, 1024, 1024, kt * 64, nt * 64, (bf16_t*)(ws + WT_WDN), 2816, nt * 64, false, lds); continue; }
        it -= 704;
        if (it < 16) { const int kt = it / 8, nt = it % 8;
            tr_tile(P.in[I_G2] + (size_t)l * 128 * 512, 512, 512, kt * 64, nt * 64, (bf16_t*)(ws + WT_G2), 128, nt * 64, false, lds); continue; }
        it -= 16;
        if (it < 16) { const int d = it / 8, nt = it % 8;
            tr_tile(P.in[I_W2] + ((size_t)l * 2 + d) * 64 * 512, 512, 512, 0, nt * 64, (bf16_t*)(ws + WT_W2) + (size_t)d * 512 * 64, 64, nt * 64, false, lds); continue; }
        it -= 16;
        if (it < 16) { const int d = it / 8, nt = it % 8;
            tr_tile(P.in[I_A2] + ((size_t)l * 2 + d) * 64 * 512, 512, 512, 0, nt * 64, (bf16_t*)(ws + WT_A2) + (size_t)d * 512 * 64, 64, nt * 64, false, lds); continue; }
        it -= 16;
        if (it < 32) { const int mat = it / 16, d = (it % 16) / 8, g = it % 8;
            const float* src = P.in[mat ? I_LWX : I_LWA] + (((size_t)l * 2 + d) * 8 + g) * 64 * 64;
            tr_tile(src, 64, 64, 0, 0, (bf16_t*)(ws + WT_LRU) + (((size_t)d * 2 + mat) * 8 + g) * 64 * 64, 64, 0, false, lds); continue; }
        it -= 32;
        {
            u32x4* d = (u32x4*)((bf16_t*)(ws + WT_WIN) + (size_t)(3344 + it * 16) * 1024);
            for (int e = tid_(); e < 16 * 1024 / 8; e += NT) d[e] = (u32x4){0u, 0u, 0u, 0u};
        }
    }
}

__device__ void ph_norm(const Params& P, const float* __restrict__ g, const float* __restrict__ modl, int sh_off, int sc_off, bf16_t* __restrict__ dst, bool final_) {
    const int tid = tid_(), wid = tid >> 6, lane = tid & 63;
    for (int item = bid_(); item < TT / 16; item += gridDim.x) {
        const int row0 = item * 16 + wid * 4, b = row0 >> 11;
        f32x4 v[4][4];
#pragma unroll
        for (int r = 0; r < 4; ++r)
#pragma unroll
            for (int i = 0; i < 4; ++i) v[r][i] = *(const f32x4*)(P.out + (size_t)(row0 + r) * DM + i * 256 + lane * 4);
        f32x4 gv[4], sc[4], sh[4];
#pragma unroll
        for (int i = 0; i < 4; ++i) {
            const int c = i * 256 + lane * 4;
            gv[i] = *(const f32x4*)(g + c);
            if (!final_) { sc[i] = *(const f32x4*)(modl + (size_t)b * 6144 + sc_off + c); sh[i] = *(const f32x4*)(modl + (size_t)b * 6144 + sh_off + c); }
        }
#pragma unroll
        for (int r = 0; r < 4; ++r) {
            float ss = 0.f;
#pragma unroll
            for (int i = 0; i < 4; ++i) ss += v[r][i][0] * v[r][i][0] + v[r][i][1] * v[r][i][1] + v[r][i][2] * v[r][i][2] + v[r][i][3] * v[r][i][3];
            ss = wsum64(ss);
            const float rs = rsqrtf(ss * (1.f / DM) + 1e-6f);
            float* hr = P.out + (size_t)(row0 + r) * DM;
#pragma unroll
            for (int i = 0; i < 4; ++i) {
                const int c = i * 256 + lane * 4;
                if (final_) {
                    *(f32x4*)(hr + c) = v[r][i] * rs * gv[i];
                } else {
                    const f32x4 o = v[r][i] * rs * gv[i] * (sc[i] + 1.f) + sh[i];
                    *(u32x2*)(dst + (size_t)(row0 + r) * DM + c) = (u32x2){pack2(o[0], o[1]), pack2(o[2], o[3])};
                }
            }
        }
    }
}

__device__ __forceinline__ void store_tile_bf16(const f32x4 (&acc)[4][4], bf16_t* __restrict__ dst, long ld) {
    const int tid = tid_(), wid = tid >> 6, lane = tid & 63, wr = wid >> 1, wc = wid & 1, fr = lane & 15, fq = lane >> 4;
#pragma unroll
    for (int m = 0; m < 4; ++m)
#pragma unroll
        for (int n = 0; n < 4; ++n) {
            const f32x4 v = acc[m][n];
            *(u32x2*)(dst + (long)(wr * 64 + m * 16 + fr) * ld + wc * 64 + n * 16 + fq * 4) = (u32x2){pack2(v[0], v[1]), pack2(v[2], v[3])};
        }
}
__device__ __forceinline__ void resid_tile(const f32x4 (&acc)[4][4], float* __restrict__ h, int row0, int col0, const float* __restrict__ gate) {
    const int tid = tid_(), wid = tid >> 6, lane = tid & 63, wr = wid >> 1, wc = wid & 1, fr = lane & 15, fq = lane >> 4;
    const int b = row0 >> 11;
#pragma unroll
    for (int n = 0; n < 4; ++n) {
        const int col = col0 + wc * 64 + n * 16 + fq * 4;
        const f32x4 gv = *(const f32x4*)(gate + (size_t)b * 6144 + col);
#pragma unroll
        for (int m = 0; m < 4; ++m) {
            float* hp = h + (size_t)(row0 + wr * 64 + m * 16 + fr) * DM + col;
            const f32x4 o = *(const f32x4*)hp + gv * acc[m][n];
            *(f32x4*)hp = o;
        }
    }
}
__device__ __forceinline__ void store_tile2_bf16(const f32x4 (&acc)[8][4], bf16_t* __restrict__ dst, long ld) {
    const int tid = tid_(), wid = tid >> 6, lane = tid & 63, wr = wid >> 1, wc = wid & 1, fr = lane & 15, fq = lane >> 4;
#pragma unroll
    for (int m = 0; m < 8; ++m)
#pragma unroll
        for (int n = 0; n < 4; ++n) {
            const f32x4 v = acc[m][n];
            *(u32x2*)(dst + (long)(wr * 128 + m * 16 + fr) * ld + wc * 64 + n * 16 + fq * 4) = (u32x2){pack2(v[0], v[1]), pack2(v[2], v[3])};
        }
}
__device__ __forceinline__ void resid_tile2(const f32x4 (&acc)[8][4], float* __restrict__ h, int row0, int col0, const float* __restrict__ gate) {
    const int tid = tid_(), wid = tid >> 6, lane = tid & 63, wr = wid >> 1, wc = wid & 1, fr = lane & 15, fq = lane >> 4;
    const int b = row0 >> 11;
#pragma unroll
    for (int n = 0; n < 4; ++n) {
        const int col = col0 + wc * 64 + n * 16 + fq * 4;
        const f32x4 gv = *(const f32x4*)(gate + (size_t)b * 6144 + col);
#pragma unroll
        for (int m = 0; m < 8; ++m) {
            float* hp = h + (size_t)(row0 + wr * 128 + m * 16 + fr) * DM + col;
            const f32x4 o = *(const f32x4*)hp + gv * acc[m][n];
            *(f32x4*)hp = o;
        }
    }
}
__device__ void ph_gemm_p(const Params& P, char* lds) {
    const bf16_t* U = (const bf16_t*)(P.ws + OFF_U); const bf16_t* Wt = (const bf16_t*)(P.ws + WT_WIN);
    bf16_t* prw = (bf16_t*)(P.ws + OFF_PRW); bf16_t* prest = (bf16_t*)(P.ws + OFF_PREST);
    for (int item = bid_(); item < 128 * 55; item += gridDim.x) {
        const int mt = item / 55, nt = item % 55;
        f32x4 acc[8][4]; zero_acc2(acc);
        gemm_acc2(U + (size_t)mt * 256 * DM, DM, Wt + (size_t)nt * 128 * DM, DM, DM, acc, lds);
        if (nt < 14) store_tile2_bf16(acc, prw + (size_t)mt * 256 * PRW_LD + nt * 128, PRW_LD);
        else store_tile2_bf16(acc, prest + (size_t)mt * 256 * PREST_LD + (nt - 14) * 128, PREST_LD);
    }
}
__device__ void ph_gemm_merge(const Params& P, char* lds) {
    const bf16_t* U = (const bf16_t*)(P.ws + OFF_URE); const bf16_t* Wt = (const bf16_t*)(P.ws + WT_WIN); const bf16_t* Wb = (const bf16_t*)(P.ws + WT_WB);
    bf16_t* mg = (bf16_t*)(P.ws + OFF_MERGED);
    for (int item = bid_(); item < 256 * 8; item += gridDim.x) {
        const int mt = item / 8, nt = item % 8;
        unsigned mpk[4][4][2];
#pragma unroll
        for (int m = 0; m < 4; ++m)
#pragma unroll
            for (int q = 0; q < 4; ++q) { mpk[m][q][0] = 0u; mpk[m][q][1] = 0u; }
#pragma unroll 1
        for (int n = 0; n < 4; ++n) {
            unsigned gpk[4][4][2];
            {
                f32x4 acc[4][4]; zero_acc(acc);
                gemm_acc(U + (size_t)mt * 128 * DM, DM, Wt + (size_t)(GATE_ROW0 + n * 1024 + nt * 128) * DM, DM, DM, acc, lds);
#pragma unroll
                for (int m = 0; m < 4; ++m)
#pragma unroll
                    for (int q = 0; q < 4; ++q) { gpk[m][q][0] = pack2(sigm(acc[m][q][0]), sigm(acc[m][q][1])); gpk[m][q][1] = pack2(sigm(acc[m][q][2]), sigm(acc[m][q][3])); }
            }
            const size_t yoff = (n == 0) ? OFF_Y0 : (n == 1 ? OFF_YB : (n == 2 ? OFF_YC : OFF_YD));
            const bf16_t* Y = (const bf16_t*)(P.ws + yoff);
            f32x4 acc[4][4]; zero_acc(acc);
            gemm_acc(Y + (size_t)mt * 128 * 512, 512, Wb + ((size_t)n * 1024 + nt * 128) * 512, 512, 512, acc, lds);
#pragma unroll
            for (int m = 0; m < 4; ++m)
#pragma unroll
                for (int q = 0; q < 4; ++q) {
                    mpk[m][q][0] = pack2(lo2f(mpk[m][q][0]) + lo2f(gpk[m][q][0]) * acc[m][q][0], hi2f(mpk[m][q][0]) + hi2f(gpk[m][q][0]) * acc[m][q][1]);
                    mpk[m][q][1] = pack2(lo2f(mpk[m][q][1]) + lo2f(gpk[m][q][1]) * acc[m][q][2], hi2f(mpk[m][q][1]) + hi2f(gpk[m][q][1]) * acc[m][q][3]);
                }
        }
        {
            const int tid = tid_(), wid = tid >> 6, lane = tid & 63, wr = wid >> 1, wc = wid & 1, fr = lane & 15, fq = lane >> 4;
            bf16_t* dst = mg + (size_t)mt * 128 * DM + nt * 128;
#pragma unroll
            for (int m = 0; m < 4; ++m)
#pragma unroll
                for (int q = 0; q < 4; ++q) *(u32x2*)(dst + (long)(wr * 64 + m * 16 + fr) * DM + wc * 64 + q * 16 + fq * 4) = (u32x2){mpk[m][q][0], mpk[m][q][1]};
        }
    }
}
__device__ void ph_gemm_out(const Params& P, int l, char* lds) {
    const bf16_t* A = (const bf16_t*)(P.ws + OFF_MERGED); const bf16_t* Wt = (const bf16_t*)(P.ws + WT_WOUT);
    const float* gate = (const float*)(P.ws + OFF_MOD) + (size_t)l * 16 * 6144 + 2048;
    for (int item = bid_(); item < 256 * 8; item += gridDim.x) {
        const int mt = item / 8, nt = item % 8;
        f32x4 acc[4][4]; zero_acc(acc);
        gemm_acc(A + (size_t)mt * 128 * DM, DM, Wt + (size_t)nt * 128 * DM, DM, DM, acc, lds);
        resid_tile(acc, P.out, mt * 128, nt * 128, gate);
    }
}
__device__ void ph_gemm_up(const Params& P, char* lds) {
    const bf16_t* A = (const bf16_t*)(P.ws + OFF_U2); const bf16_t* Wt = (const bf16_t*)(P.ws + WT_WUP);
    bf16_t* Z = (bf16_t*)(P.ws + OFF_Z);
    for (int item = bid_(); item < 128 * 44; item += gridDim.x) {
        const int mt = item / 44, nt = item % 44;
        f32x4 acc[8][4]; zero_acc2(acc);
        gemm_acc2(A + (size_t)mt * 256 * DM, DM, Wt + (size_t)nt * 128 * DM, DM, DM, acc, lds);
        store_tile2_bf16(acc, Z + (size_t)mt * 256 * 5632 + nt * 128, 5632);
    }
}
__device__ void ph_gemm_down(const Params& P, int l, char* lds) {
    const bf16_t* A = (const bf16_t*)(P.ws + OFF_ACT); const bf16_t* Wt = (const bf16_t*)(P.ws + WT_WDN);
    const float* gate = (const float*)(P.ws + OFF_MOD) + (size_t)l * 16 * 6144 + 5120;
    for (int item = bid_(); item < 128 * 8; item += gridDim.x) {
        const int mt = item / 8, nt = item % 8;
        f32x4 acc[8][4]; zero_acc2(acc);
        gemm_acc2(A + (size_t)mt * 256 * DFF, DFF, Wt + (size_t)nt * 128 * DFF, DFF, DFF, acc, lds);
        resid_tile2(acc, P.out, mt * 256, nt * 128, gate);
    }
}
__device__ void ph_convact(const Params& P, int l) {
    const bf16_t* Z = (const bf16_t*)(P.ws + OFF_Z); bf16_t* ACT = (bf16_t*)(P.ws + OFF_ACT);
    const float* cw = P.in[I_FCW] + (size_t)l * 3 * 5632; const float* cb = P.in[I_FCB] + (size_t)l * 5632;
    const long ntask = (long)(TT / 64) * 352;
    for (long task = (long)bid_() * NT + tid_(); task < ntask; task += (long)gridDim.x * NT) {
        const int tile = (int)(task / 352), cgp = (int)(task % 352), c0 = cgp * 8;
        const int t0 = tile * 64, s0 = t0 & (SQ - 1);
        float wv[3][8], wg[3][8], bv[8], bg[8];
#pragma unroll
        for (int j = 0; j < 3; ++j)
#pragma unroll
            for (int e = 0; e < 8; ++e) { wv[j][e] = cw[j * 5632 + c0 + e]; wg[j][e] = cw[j * 5632 + DFF + c0 + e]; }
#pragma unroll
        for (int e = 0; e < 8; ++e) { bv[e] = cb[c0 + e]; bg[e] = cb[DFF + c0 + e]; }
        float pv[8], pg[8], cv[8], cg_[8], nv[8], ng[8];
        const u32x4 zero4 = (u32x4){0u, 0u, 0u, 0u};
        {
            u32x4 a = zero4, b = zero4;
            if (s0 > 0) { a = *(const u32x4*)(Z + (size_t)(t0 - 1) * 5632 + c0); b = *(const u32x4*)(Z + (size_t)(t0 - 1) * 5632 + DFF + c0); }
            unpack8(a, pv); unpack8(b, pg);
            a = *(const u32x4*)(Z + (size_t)t0 * 5632 + c0); b = *(const u32x4*)(Z + (size_t)t0 * 5632 + DFF + c0);
            unpack8(a, cv); unpack8(b, cg_);
        }
#pragma unroll 8
        for (int r = 0; r < 64; ++r) {
            const int t = t0 + r;
            u32x4 a = zero4, b = zero4;
            if (s0 + r + 1 < SQ) { a = *(const u32x4*)(Z + (size_t)(t + 1) * 5632 + c0); b = *(const u32x4*)(Z + (size_t)(t + 1) * 5632 + DFF + c0); }
            unpack8(a, nv); unpack8(b, ng);
            float o[8];
#pragma unroll
            for (int e = 0; e < 8; ++e) {
                const float v = wv[0][e] * pv[e] + wv[1][e] * cv[e] + wv[2][e] * nv[e] + bv[e];
                const float g = wg[0][e] * pg[e] + wg[1][e] * cg_[e] + wg[2][e] * ng[e] + bg[e];
                o[e] = v * silu(g);
                pv[e] = cv[e]; cv[e] = nv[e]; pg[e] = cg_[e]; cg_[e] = ng[e];
            }
            *(u32x4*)(ACT + (size_t)t * DFF + c0) = (u32x4){pack2(o[0], o[1]), pack2(o[2], o[3]), pack2(o[4], o[5]), pack2(o[6], o[7])};
        }
    }
}

__device__ void mx_rwkv(const Params& P, int l, int item, char* lds) {
    const int tid = tid_(), wid = tid >> 6, lane = tid & 63, fr = lane & 15, fq = lane >> 4;
    const int d = item & 1, h = (item >> 1) & 7, b = item >> 4;
    const bf16_t* prw = (const bf16_t*)(P.ws + OFF_PRW) + (size_t)b * SQ * PRW_LD;
    bf16_t* Yd = (bf16_t*)(P.ws + (d ? OFF_Y1 : OFF_Y0)) + (size_t)b * SQ * 512 + h * 64;
    float* beta = (float*)(P.ws + OFF_BETA) + ((size_t)d * TT + (size_t)b * SQ) * 8 + h;
    float* VA = (float*)lds; float* VWR = VA + 1024; float* VW = VWR + 1024; float* VB = VW + 1024; float* VK = VB + 1024; float* VV = VK + 1024; float* VG = VV + 1024;
    float* SC = VG + 1024;
    bf16_t* RAW = (bf16_t*)(SC + 32);
    bf16_t* AT = RAW + 18 * 320;
    const int s = tid >> 4, jg = tid & 15, j0 = jg * 4;
    float mu[5][4], kkc[4], kac[4], rkc[4];
#pragma unroll
    for (int sg = 0; sg < 5; ++sg) {
        const int base = (sg < 3) ? sg * 512 + h * 64 : 1536 + (sg - 3) * 64;
#pragma unroll
        for (int i = 0; i < 4; ++i) mu[sg][i] = P.in[I_MU][l * 1792 + base + j0 + i];
    }
#pragma unroll
    for (int i = 0; i < 4; ++i) { kkc[i] = P.in[I_KK][l * 512 + h * 64 + j0 + i]; kac[i] = P.in[I_KA][l * 512 + h * 64 + j0 + i]; rkc[i] = P.in[I_RK][l * 512 + h * 64 + j0 + i]; }
    const int mt = wid >> 1, ntb = (wid & 1) * 2;
    bf16x8 bw[2][2]; float bsv[2][4];
    {
        const bf16_t* WT2 = (const bf16_t*)(P.ws + (mt ? WT_A2 : WT_W2)) + (size_t)d * 512 * 64;
        const float* bias = P.in[mt ? I_A0 : I_W0] + (size_t)(l * 2 + d) * 512 + h * 64;
#pragma unroll
        for (int nt = 0; nt < 2; ++nt) {
#pragma unroll
            for (int ks = 0; ks < 2; ++ks) bw[nt][ks] = ldfrag(WT2 + (size_t)(h * 64 + (ntb + nt) * 16 + fr) * 64 + ks * 32 + fq * 8);
#pragma unroll
            for (int jj = 0; jj < 4; ++jj) bsv[nt][jj] = bias[(ntb + nt) * 16 + fq * 4 + jj];
        }
    }
    float S[4][4];
#pragma unroll
    for (int i = 0; i < 4; ++i)
#pragma unroll
        for (int j = 0; j < 4; ++j) S[i][j] = 0.f;
    u32x4 pre[3];
    auto load_raw = [&](int c) {
        const int t0 = d ? SQ - 16 * (c + 1) : 16 * c;
#pragma unroll
        for (int i = 0; i < 3; ++i) {
            const int vi = tid + 256 * i;
            pre[i] = (u32x4){0u, 0u, 0u, 0u};
            if (vi < 720) {
                const int rr = vi / 40, rem = vi % 40, sg = rem >> 3, e = rem & 7, t = t0 - 1 + rr;
                const int col = ((sg < 3) ? sg * 512 + h * 64 : 1536 + (sg - 3) * 64) + e * 8;
                if (t >= 0 && t < SQ) pre[i] = *(const u32x4*)(prw + (size_t)t * PRW_LD + col);
            }
        }
    };
    __syncthreads();
    load_raw(0);
#pragma unroll 1
    for (int c = 0; c < 128; ++c) {
        const int t0 = d ? SQ - 16 * (c + 1) : 16 * c;
#pragma unroll
        for (int i = 0; i < 3; ++i) {
            const int vi = tid + 256 * i;
            if (vi < 720) { const int rr = vi / 40, rem = vi % 40; *(u32x4*)(RAW + rr * 320 + rem * 8) = pre[i]; }
        }
        __syncthreads();
        if (c + 1 < 128) load_raw(c + 1);
        float rs[4], ks_[4], vs[4], kk[4];
        {
            float sh[5][4];
#pragma unroll
            for (int sg = 0; sg < 5; ++sg) {
                float fm[4], f0[4], fp[4];
                unpack4(*(const u32x2*)(RAW + s * 320 + sg * 64 + j0), fm);
                unpack4(*(const u32x2*)(RAW + (s + 1) * 320 + sg * 64 + j0), f0);
                unpack4(*(const u32x2*)(RAW + (s + 2) * 320 + sg * 64 + j0), fp);
#pragma unroll
                for (int i = 0; i < 4; ++i) sh[sg][i] = f0[i] + mu[sg][i] * (0.5f * (fm[i] + fp[i]) - f0[i]);
            }
            float ssq = 0.f, q[4];
#pragma unroll
            for (int i = 0; i < 4; ++i) { rs[i] = sh[0][i]; ks_[i] = sh[1][i]; vs[i] = sh[2][i]; q[i] = ks_[i] * kkc[i]; ssq += q[i] * q[i]; }
            *(u32x2*)(AT + s * 72 + j0) = (u32x2){pack2(tanh_f(sh[3][0]), tanh_f(sh[3][1])), pack2(tanh_f(sh[3][2]), tanh_f(sh[3][3]))};
            *(u32x2*)(AT + 16 * 72 + s * 72 + j0) = (u32x2){pack2(sh[4][0], sh[4][1]), pack2(sh[4][2], sh[4][3])};
            ssq = rowsum16(ssq);
            const float inv = __builtin_amdgcn_rsqf(fmaxf(ssq, 1e-24f));
#pragma unroll
            for (int i = 0; i < 4; ++i) kk[i] = q[i] * inv;
        }
        __syncthreads();
        {
            const bf16_t* At = AT + mt * 16 * 72;
            const bf16x8 a0 = ldfrag(At + fr * 72 + fq * 8), a1 = ldfrag(At + fr * 72 + 32 + fq * 8);
            float* dstv = mt ? VG : VW;
#pragma unroll
            for (int nt = 0; nt < 2; ++nt) {
                f32x4 acc = (f32x4){0.f, 0.f, 0.f, 0.f};
                acc = mfma16(bw[nt][0], a0, acc); acc = mfma16(bw[nt][1], a1, acc);
                f32x4 o;
#pragma unroll
                for (int jj = 0; jj < 4; ++jj) {
                    const float x = acc[jj] + bsv[nt][jj];
                    if (mt == 0) { const float wl = fminf(x, 0.f) - flog_(1.f + __expf(-fabsf(x))) - 0.5f; o[jj] = __expf(-__expf(wl)); }
                    else o[jj] = sigm(x);
                }
                *(f32x4*)(dstv + fr * 64 + (ntb + nt) * 16 + fq * 4) = o;
            }
        }
        __syncthreads();
        {
            const f32x4 w4 = *(const f32x4*)(VW + s * 64 + j0), g4 = *(const f32x4*)(VG + s * 64 + j0);
            f32x4 bb, kt, wr, na, vv;
            float pbr = 0.f, pkr = 0.f, pbe = 0.f;
#pragma unroll
            for (int i = 0; i < 4; ++i) {
                bb[i] = kk[i] * g4[i]; kt[i] = ks_[i] * (1.f + (g4[i] - 1.f) * kac[i]); wr[i] = w4[i] * rs[i]; na[i] = -kk[i]; vv[i] = vs[i];
                pbr += bb[i] * rs[i]; pkr += kt[i] * rs[i]; pbe += rs[i] * kt[i] * rkc[i];
            }
            pbr = rowsum16(pbr); pkr = rowsum16(pkr); pbe = rowsum16(pbe);
            *(f32x4*)(VA + s * 64 + j0) = na; *(f32x4*)(VWR + s * 64 + j0) = wr; *(f32x4*)(VB + s * 64 + j0) = bb; *(f32x4*)(VK + s * 64 + j0) = kt; *(f32x4*)(VV + s * 64 + j0) = vv;
            if (jg == 0) { SC[s * 2] = pbr; SC[s * 2 + 1] = pkr; beta[(size_t)(t0 + s) * 8] = pbe; }
        }
        __syncthreads();
#pragma unroll 1
        for (int st = 0; st < 16; ++st) {
            const int sp = d ? 15 - st : st;
            const f32x4 a4 = *(const f32x4*)(VA + sp * 64 + j0), wr4 = *(const f32x4*)(VWR + sp * 64 + j0), w4 = *(const f32x4*)(VW + sp * 64 + j0);
            const f32x4 b4 = *(const f32x4*)(VB + sp * 64 + j0), k4 = *(const f32x4*)(VK + sp * 64 + j0), v4 = *(const f32x4*)(VV + sp * 64 + s * 4);
            const float br = SC[sp * 2], kr = SC[sp * 2 + 1];
            float psa[4], py[4];
            typedef float f32x2 __attribute__((ext_vector_type(2)));
            const f32x2 a01 = {a4[0], a4[1]}, a23 = {a4[2], a4[3]}, r01 = {wr4[0], wr4[1]}, r23 = {wr4[2], wr4[3]};
#pragma unroll
            for (int i = 0; i < 4; ++i) {
                const f32x2 s01 = {S[i][0], S[i][1]}, s23 = {S[i][2], S[i][3]};
                f32x2 ta = s01 * a01; ta = s23 * a23 + ta;
                f32x2 ty = s01 * r01; ty = s23 * r23 + ty;
                psa[i] = ta.x + ta.y; py[i] = ty.x + ty.y;
            }
#define RS8(CTRL) asm volatile("s_nop 1\n\tv_add_f32_dpp %0, %0, %0 " CTRL " row_mask:0xf bank_mask:0xf\n\tv_add_f32_dpp %1, %1, %1 " CTRL " row_mask:0xf bank_mask:0xf\n\tv_add_f32_dpp %2, %2, %2 " CTRL " row_mask:0xf bank_mask:0xf\n\tv_add_f32_dpp %3, %3, %3 " CTRL " row_mask:0xf bank_mask:0xf\n\tv_add_f32_dpp %4, %4, %4 " CTRL " row_mask:0xf bank_mask:0xf\n\tv_add_f32_dpp %5, %5, %5 " CTRL " row_mask:0xf bank_mask:0xf\n\tv_add_f32_dpp %6, %6, %6 " CTRL " row_mask:0xf bank_mask:0xf\n\tv_add_f32_dpp %7, %7, %7 " CTRL " row_mask:0xf bank_mask:0xf" : "+v"(psa[0]), "+v"(psa[1]), "+v"(psa[2]), "+v"(psa[3]), "+v"(py[0]), "+v"(py[1]), "+v"(py[2]), "+v"(py[3]))
            RS8("row_ror:8"); RS8("row_ror:4"); RS8("row_ror:2"); RS8("row_ror:1");
            asm volatile("s_nop 1" ::: "memory");
            float y[4];
#pragma unroll
            for (int i = 0; i < 4; ++i) {
                y[i] = py[i] + psa[i] * br + v4[i] * kr;
#pragma unroll
                for (int j = 0; j < 4; ++j) S[i][j] = S[i][j] * w4[j] + (psa[i] * b4[j] + v4[i] * k4[j]);
            }
            if (jg == 0) *(u32x2*)(Yd + (size_t)(t0 + sp) * 512 + s * 4) = (u32x2){pack2(y[0], y[1]), pack2(y[2], y[3])};
        }
    }
    __syncthreads();
}

__device__ void mx_mlstm(const Params& P, int l, int item, char* lds) {
    const int tid = tid_(), wid = tid >> 6, lane = tid & 63, fr = lane & 15, fq = lane >> 4;
    const int b = item >> 3, h = (item >> 1) & 3, dsel = item & 1;
    const bf16_t* pr = (const bf16_t*)(P.ws + OFF_PREST) + (size_t)b * SQ * PREST_LD;
    bf16_t* YB = (bf16_t*)(P.ws + (dsel ? OFF_YB : OFF_Y1)) + (size_t)b * SQ * 512 + h * 128;
    bf16_t* Q = (bf16_t*)lds; bf16_t* KP = Q + 64 * 72; bf16_t* KWT = KP + 64 * 72; bf16_t* VT = KWT + 64 * 72; bf16_t* CT = VT + 128 * 72;
    float* NS = (float*)(CT + 128 * 72); float* E = NS + 64; float* MM = E + 64; float* SI = MM + 64; float* WI = SI + 64; float* FL = WI + 64; float* DEC = FL + 64;
    const int i = wid * 16 + fr;
#pragma unroll 1
    for (int d = dsel; d <= dsel; ++d) {
        f32x4 Cacc[8];
#pragma unroll
        for (int dt = 0; dt < 8; ++dt) Cacc[dt] = (f32x4){0.f, 0.f, 0.f, 0.f};
        __syncthreads();
        for (int e = tid; e < 128 * 72 / 2; e += NT) ((unsigned*)CT)[e] = 0u;
        if (tid < 64) NS[tid] = 0.f;
        float m_st = 0.f;
        const float ib = P.in[I_MLIB][(l * 2 + d) * 4 + h], fb = P.in[I_MLFB][(l * 2 + d) * 4 + h];
        __syncthreads();
#pragma unroll 1
        for (int c = 0; c < 32; ++c) {
            const int t0 = d ? SQ - 64 * (c + 1) : 64 * c;
#define TROW(ii) (d ? t0 + 63 - (ii) : t0 + (ii))
            if (wid == 0) {
                const int t = TROW(lane);
                const float fg = bf2f(pr[(size_t)t * PREST_LD + 1544 + d * 4 + h]) + fb, ig = bf2f(pr[(size_t)t * PREST_LD + 1536 + d * 4 + h]) + ib;
                float bc = logsig(fg);
#pragma unroll
                for (int o = 1; o < 64; o <<= 1) { const float x = bperm(bc, lane - o); if (lane >= o) bc += x; }
                const float e = ig - bc; float pm = e;
#pragma unroll
                for (int o = 1; o < 64; o <<= 1) { const float x = bperm(pm, lane - o); if (lane >= o) pm = fmaxf(pm, x); }
                const float gend = rdlane(bc, 63), pmax = rdlane(pm, 63);
                const float mnew = fmaxf(gend + m_st, gend + pmax);
                const float M = fmaxf(m_st, pm);
                E[lane] = e; MM[lane] = M; SI[lane] = __expf(m_st - M); WI[lane] = __expf(gend + e - mnew); FL[lane] = __expf(-(bc + M));
                if (lane == 0) DEC[0] = __expf(gend + m_st - mnew);
                m_st = mnew;
            }
            __syncthreads();
#pragma unroll
            for (int it = 0; it < 2; ++it) {
                const int vi = tid + 256 * it, ii = vi >> 3, e = vi & 7, t = TROW(ii);
                float f[8];
                unpack8(*(const u32x4*)(pr + (size_t)t * PREST_LD + h * 64 + e * 8), f);
                *(u32x4*)(Q + ii * 72 + e * 8) = (u32x4){pack2(f[0] * 0.125f, f[1] * 0.125f), pack2(f[2] * 0.125f, f[3] * 0.125f), pack2(f[4] * 0.125f, f[5] * 0.125f), pack2(f[6] * 0.125f, f[7] * 0.125f)};
                const u32x4 kv = *(const u32x4*)(pr + (size_t)t * PREST_LD + 256 + h * 64 + e * 8);
                *(u32x4*)(KP + ii * 72 + e * 8) = kv;
                unpack8(kv, f);
                const float wi = WI[ii];
#pragma unroll
                for (int x = 0; x < 8; ++x) KWT[(e * 8 + x) * 72 + ii] = f2bf(f[x] * wi);
            }
#pragma unroll
            for (int it = 0; it < 4; ++it) {
                const int vi = tid + 256 * it, ii = vi >> 4, e = vi & 15, t = TROW(ii);
                const u32x4 vv = *(const u32x4*)(pr + (size_t)t * PREST_LD + 512 + h * 128 + e * 8);
                VT[(e * 8 + 0) * 72 + ii] = (bf16_t)(vv.x & 0xffff); VT[(e * 8 + 1) * 72 + ii] = (bf16_t)(vv.x >> 16);
                VT[(e * 8 + 2) * 72 + ii] = (bf16_t)(vv.y & 0xffff); VT[(e * 8 + 3) * 72 + ii] = (bf16_t)(vv.y >> 16);
                VT[(e * 8 + 4) * 72 + ii] = (bf16_t)(vv.z & 0xffff); VT[(e * 8 + 5) * 72 + ii] = (bf16_t)(vv.z >> 16);
                VT[(e * 8 + 6) * 72 + ii] = (bf16_t)(vv.w & 0xffff); VT[(e * 8 + 7) * 72 + ii] = (bf16_t)(vv.w >> 16);
            }
            __syncthreads();
            f32x4 sacc[4];
#pragma unroll
            for (int st = 0; st < 4; ++st) sacc[st] = (f32x4){0.f, 0.f, 0.f, 0.f};
#pragma unroll
            for (int ks = 0; ks < 2; ++ks) {
                const bf16x8 qf = ldfrag(Q + i * 72 + ks * 32 + fq * 8);
#pragma unroll
                for (int st = 0; st < 4; ++st) sacc[st] = mfma16(ldfrag(KP + (st * 16 + fr) * 72 + ks * 32 + fq * 8), qf, sacc[st]);
            }
            const float Mi = MM[i], si = SI[i];
            float rsum = 0.f; unsigned pwp[4][2];
#pragma unroll
            for (int st = 0; st < 4; ++st) {
                float pw[4];
#pragma unroll
                for (int jj = 0; jj < 4; ++jj) { const int sx = st * 16 + fq * 4 + jj; pw[jj] = (sx <= i) ? __expf(E[sx] - Mi) * sacc[st][jj] : 0.f; rsum += pw[jj]; }
                pwp[st][0] = pack2(pw[0], pw[1]); pwp[st][1] = pack2(pw[2], pw[3]);
            }
            rsum = qsum(rsum, lane);
            float qn = 0.f;
            {
                float f[8];
                unpack8(*(const u32x4*)(Q + i * 72 + fq * 16), f);
#pragma unroll
                for (int x = 0; x < 8; ++x) qn += f[x] * NS[fq * 16 + x];
                unpack8(*(const u32x4*)(Q + i * 72 + fq * 16 + 8), f);
#pragma unroll
                for (int x = 0; x < 8; ++x) qn += f[x] * NS[fq * 16 + 8 + x];
            }
            qn = qsum(qn, lane);
            const float den = si * qn + rsum;
            const float rinv = rcpf_(fmaxf(fabsf(den), FL[i]));
            __syncthreads();
#pragma unroll
            for (int st = 0; st < 4; ++st) *(u32x2*)(KP + i * 72 + st * 16 + fq * 4) = (u32x2){pwp[st][0], pwp[st][1]};
            __syncthreads();
            f32x4 oacc[8];
#pragma unroll
            for (int dt = 0; dt < 8; ++dt) oacc[dt] = (f32x4){0.f, 0.f, 0.f, 0.f};
#pragma unroll
            for (int ks = 0; ks < 2; ++ks) {
                const bf16x8 qf = ldfrag(Q + i * 72 + ks * 32 + fq * 8);
#pragma unroll
                for (int dt = 0; dt < 8; ++dt) oacc[dt] = mfma16(ldfrag(CT + (dt * 16 + fr) * 72 + ks * 32 + fq * 8), qf, oacc[dt]);
            }
#pragma unroll
            for (int dt = 0; dt < 8; ++dt) oacc[dt] *= si;
#pragma unroll
            for (int ks = 0; ks < 2; ++ks) {
                const bf16x8 pf = ldfrag(KP + i * 72 + ks * 32 + fq * 8);
#pragma unroll
                for (int dt = 0; dt < 8; ++dt) oacc[dt] = mfma16(ldfrag(VT + (dt * 16 + fr) * 72 + ks * 32 + fq * 8), pf, oacc[dt]);
            }
            {
                const int t = TROW(i);
                bf16_t* yp = YB + (size_t)t * 512 + fq * 4;
                {
#pragma unroll
                    for (int dt = 0; dt < 8; ++dt) { const f32x4 v = oacc[dt] * rinv; *(u32x2*)(yp + dt * 16) = (u32x2){pack2(v[0], v[1]), pack2(v[2], v[3])}; }
                }
            }
            __syncthreads();
            {
                const float dec = DEC[0];
#pragma unroll
                for (int dt = 0; dt < 8; ++dt) Cacc[dt] *= dec;
#pragma unroll
                for (int ks = 0; ks < 2; ++ks) {
                    const bf16x8 kf = ldfrag(KWT + (wid * 16 + fr) * 72 + ks * 32 + fq * 8);
#pragma unroll
                    for (int dt = 0; dt < 8; ++dt) Cacc[dt] = mfma16(kf, ldfrag(VT + (dt * 16 + fr) * 72 + ks * 32 + fq * 8), Cacc[dt]);
                }
#pragma unroll
                for (int dt = 0; dt < 8; ++dt) *(u32x2*)(CT + (dt * 16 + fr) * 72 + wid * 16 + fq * 4) = (u32x2){pack2(Cacc[dt][0], Cacc[dt][1]), pack2(Cacc[dt][2], Cacc[dt][3])};
                if (tid < 64) {
                    float n = dec * NS[tid];
#pragma unroll
                    for (int x = 0; x < 8; ++x) { float f[8]; unpack8(*(const u32x4*)(KWT + tid * 72 + x * 8), f); n += ((f[0] + f[1]) + (f[2] + f[3])) + ((f[4] + f[5]) + (f[6] + f[7])); }
                    NS[tid] = n;
                }
            }
            __syncthreads();
        }
    }
}

__device__ void mx_hgrn(const Params& P, int l, int item, char* lds) {
    const int tid = tid_(), wid = tid >> 6, lane = tid & 63, fr = lane & 15, fq = lane >> 4;
    const int b = item >> 4, h = (item >> 2) & 3, half = (item >> 1) & 1, dsel = item & 1;
    const bf16_t* pr = (const bf16_t*)(P.ws + OFF_PREST) + (size_t)b * SQ * PREST_LD + HG_O;
    bf16_t* YD = (bf16_t*)(P.ws + (dsel ? OFF_YD : OFF_Y0)) + (size_t)b * SQ * 512 + h * 128 + half * 64;
    bf16_t* QT = (bf16_t*)lds; bf16_t* KT = QT + 64 * 136; bf16_t* ATT = KT + 128 * 72; bf16_t* VT = ATT + 64 * 72; bf16_t* ST = VT + 64 * 72;
    float* TOT = (float*)(ST + 64 * 136);
    const int dk = tid & 127, hf = tid >> 7;
    const int i = wid * 16 + fr;
#pragma unroll 1
    for (int d = dsel; d <= dsel; ++d) {
        const float lbv = ((const float*)(P.ws + OFF_LB))[(l * 2 + d) * 512 + h * 128 + dk], oml = 1.f - lbv;
        f32x4 Sacc[2][4];
#pragma unroll
        for (int a = 0; a < 2; ++a)
#pragma unroll
            for (int dt = 0; dt < 4; ++dt) Sacc[a][dt] = (f32x4){0.f, 0.f, 0.f, 0.f};
        __syncthreads();
        for (int e = tid; e < 64 * 136 / 2; e += NT) ((unsigned*)ST)[e] = 0u;
        __syncthreads();
        u32x4 pff[4], pfq[4], pfv[2];
        auto hg_load = [&](int cc) {
            const int t0 = d ? SQ - 64 * (cc + 1) : 64 * cc;
#pragma unroll
            for (int it = 0; it < 4; ++it) {
                const int vi = tid + 256 * it, ii = vi >> 4, e = vi & 15, t = TROW(ii);
                pff[it] = *(const u32x4*)(pr + (size_t)t * PREST_LD + 512 * (1 + d) + h * 128 + e * 8);
                pfq[it] = *(const u32x4*)(pr + (size_t)t * PREST_LD + h * 128 + e * 8);
            }
#pragma unroll
            for (int it = 0; it < 2; ++it) {
                const int vi = tid + 256 * it, ii = vi >> 3, e = vi & 7, t = TROW(ii);
                pfv[it] = *(const u32x4*)(pr + (size_t)t * PREST_LD + 1536 + h * 128 + half * 64 + e * 8);
            }
        };
        hg_load(0);
#pragma unroll 1
        for (int c = 0; c < 32; ++c) {
            const int t0 = d ? SQ - 64 * (c + 1) : 64 * c;
#pragma unroll
            for (int it = 0; it < 4; ++it) {
                const int vi = tid + 256 * it, ii = vi >> 4, e = vi & 15;
                *(u32x4*)(KT + ii * 136 + e * 8) = pff[it];
                *(u32x4*)(QT + ii * 136 + e * 8) = pfq[it];
            }
#pragma unroll
            for (int it = 0; it < 2; ++it) {
                const int vi = tid + 256 * it, ii = vi >> 3, e = vi & 7;
                const u32x4 vv = pfv[it];
                VT[(e * 8 + 0) * 72 + ii] = (bf16_t)(vv.x & 0xffff); VT[(e * 8 + 1) * 72 + ii] = (bf16_t)(vv.x >> 16);
                VT[(e * 8 + 2) * 72 + ii] = (bf16_t)(vv.y & 0xffff); VT[(e * 8 + 3) * 72 + ii] = (bf16_t)(vv.y >> 16);
                VT[(e * 8 + 4) * 72 + ii] = (bf16_t)(vv.z & 0xffff); VT[(e * 8 + 5) * 72 + ii] = (bf16_t)(vv.z >> 16);
                VT[(e * 8 + 6) * 72 + ii] = (bf16_t)(vv.w & 0xffff); VT[(e * 8 + 7) * 72 + ii] = (bf16_t)(vv.w >> 16);
            }
            if (c + 1 < 32) hg_load(c + 1);
            __syncthreads();
            bf16_t* kp = KT + hf * 32 * 136 + dk; bf16_t* qp = QT + hf * 32 * 136 + dk;
            {
                float run = 0.f;
#pragma unroll 8
                for (int r = 0; r < 32; ++r) { const bf16_t fb = f2bf(lbv + oml * sigm(bf2f(kp[r * 136]))); kp[r * 136] = fb; run += flog_(bf2f(fb)); }
                TOT[hf * 128 + dk] = run;
            }
            __syncthreads();
            const float R = TOT[dk], gmR = TOT[128 + dk];
            {
                float g = hf ? R : 0.f;
#pragma unroll 8
                for (int r = 0; r < 32; ++r) {
                    const float fv = bf2f(kp[r * 136]);
                    g += flog_(fv);
                    const float e1 = __expf(fminf(g - R, 80.f));
                    qp[r * 136] = f2bf(silu(bf2f(qp[r * 136])) * e1);
                    kp[r * 136] = f2bf((1.f - fv) * __expf(fminf(R - g, 80.f)));
                }
                const float eR = __expf(R);
                bf16_t* sp = ST + hf * 32 * 136 + dk;
#pragma unroll 8
                for (int r = 0; r < 32; ++r) sp[r * 136] = f2bf(bf2f(sp[r * 136]) * eR);
            }
            __syncthreads();
            f32x4 oacc[4];
            unsigned kw[16];
            {
                f32x4 aacc[4];
#pragma unroll
                for (int st = 0; st < 4; ++st) { aacc[st] = (f32x4){0.f, 0.f, 0.f, 0.f}; oacc[st] = (f32x4){0.f, 0.f, 0.f, 0.f}; }
#pragma unroll
                for (int ks = 0; ks < 4; ++ks) {
                    const bf16x8 qf = ldfrag(QT + i * 136 + ks * 32 + fq * 8);
#pragma unroll
                    for (int st = 0; st < 4; ++st) aacc[st] = mfma16(ldfrag(KT + (st * 16 + fr) * 136 + ks * 32 + fq * 8), qf, aacc[st]);
#pragma unroll
                    for (int dt = 0; dt < 4; ++dt) oacc[dt] = mfma16(ldfrag(ST + (dt * 16 + fr) * 136 + ks * 32 + fq * 8), qf, oacc[dt]);
                }
#pragma unroll
                for (int st = 0; st < 4; ++st) {
                    float a[4];
#pragma unroll
                    for (int jj = 0; jj < 4; ++jj) a[jj] = (st * 16 + fq * 4 + jj <= i) ? aacc[st][jj] : 0.f;
                    *(u32x2*)(ATT + i * 72 + st * 16 + fq * 4) = (u32x2){pack2(a[0], a[1]), pack2(a[2], a[3])};
                }
#pragma unroll
                for (int r = 0; r < 16; ++r) kw[r] = (unsigned)kp[(2 * r) * 136] | ((unsigned)kp[(2 * r + 1) * 136] << 16);
            }
            __syncthreads();
            {
                u32x4* dst = (u32x4*)(KT + dk * 72 + hf * 32);
                dst[0] = (u32x4){kw[0], kw[1], kw[2], kw[3]}; dst[1] = (u32x4){kw[4], kw[5], kw[6], kw[7]};
                dst[2] = (u32x4){kw[8], kw[9], kw[10], kw[11]}; dst[3] = (u32x4){kw[12], kw[13], kw[14], kw[15]};
            }
            __syncthreads();
            {
#pragma unroll
                for (int ks = 0; ks < 2; ++ks) {
                    const bf16x8 af = ldfrag(ATT + i * 72 + ks * 32 + fq * 8);
#pragma unroll
                    for (int dt = 0; dt < 4; ++dt) oacc[dt] = mfma16(ldfrag(VT + (dt * 16 + fr) * 72 + ks * 32 + fq * 8), af, oacc[dt]);
                }
                const int t = TROW(i);
                bf16_t* yp = YD + (size_t)t * 512 + fq * 4;
#pragma unroll
                for (int dt = 0; dt < 4; ++dt) {
                    f32x4 v = oacc[dt];
                    *(u32x2*)(yp + dt * 16) = (u32x2){pack2(v[0], v[1]), pack2(v[2], v[3])};
                }
            }
#pragma unroll
            for (int a = 0; a < 2; ++a) {
                const int ktile = 2 * wid + a;
                f32x4 e1, e2;
#pragma unroll
                for (int jj = 0; jj < 4; ++jj) { const int dkk = ktile * 16 + fq * 4 + jj; e1[jj] = __expf(TOT[dkk]); e2[jj] = __expf(TOT[128 + dkk]); }
#pragma unroll
                for (int dt = 0; dt < 4; ++dt) Sacc[a][dt] *= e1;
#pragma unroll
                for (int ks = 0; ks < 2; ++ks) {
                    const bf16x8 kf = ldfrag(KT + (ktile * 16 + fr) * 72 + ks * 32 + fq * 8);
#pragma unroll
                    for (int dt = 0; dt < 4; ++dt) Sacc[a][dt] = mfma16(kf, ldfrag(VT + (dt * 16 + fr) * 72 + ks * 32 + fq * 8), Sacc[a][dt]);
                }
#pragma unroll
                for (int dt = 0; dt < 4; ++dt) {
                    Sacc[a][dt] *= e2;
                    *(u32x2*)(ST + (dt * 16 + fr) * 136 + ktile * 16 + fq * 4) = (u32x2){pack2(Sacc[a][dt][0], Sacc[a][dt][1]), pack2(Sacc[a][dt][2], Sacc[a][dt][3])};
                }
            }
            __syncthreads();
        }
    }
}

__device__ void mx_lru(const Params& P, int l, int item, char* lds) {
    const int tid = tid_(), wid = tid >> 6, lane = tid & 63, fr = lane & 15, fq = lane >> 4;
    const int b = item >> 3, g = item & 7;
    const bf16_t* pr = (const bf16_t*)(P.ws + OFF_PREST) + (size_t)b * SQ * PREST_LD + LRU_O;
    bf16_t* YC = (bf16_t*)(P.ws + OFF_YC) + (size_t)b * SQ * 512 + g * 64;
    bf16_t* XC = (bf16_t*)lds; float* AA = (float*)(lds + 9216); float* BB = AA + 64 * 65; float* HH = BB + 64 * 65;
    const int ch = tid & 63, tq = tid >> 6;
    float cwv[4];
#pragma unroll
    for (int j = 0; j < 4; ++j) cwv[j] = P.in[I_LCW][(l * 4 + j) * 512 + g * 64 + ch];
    const float cbv = P.in[I_LCB][l * 512 + g * 64 + ch];
    const int i = wid * 16 + fr;
#pragma unroll 1
    for (int d = 0; d < 2; ++d) {
        bf16x8 waf[4][2], wxf[4][2]; f32x4 ba4[4], bx4[4], c8[4];
        {
            const bf16_t* Wa = (const bf16_t*)(P.ws + WT_LRU) + (((size_t)d * 2 + 0) * 8 + g) * 4096;
            const bf16_t* Wx = (const bf16_t*)(P.ws + WT_LRU) + (((size_t)d * 2 + 1) * 8 + g) * 4096;
#pragma unroll
            for (int jt = 0; jt < 4; ++jt) {
#pragma unroll
                for (int ks = 0; ks < 2; ++ks) { waf[jt][ks] = ldfrag(Wa + (jt * 16 + fr) * 64 + ks * 32 + fq * 8); wxf[jt][ks] = ldfrag(Wx + (jt * 16 + fr) * 64 + ks * 32 + fq * 8); }
                const int j = (l * 2 + d) * 512 + g * 64 + jt * 16 + fq * 4;
                ba4[jt] = *(const f32x4*)(P.in[I_LBA] + j); bx4[jt] = *(const f32x4*)(P.in[I_LBX] + j);
                const f32x4 lam = *(const f32x4*)(P.in[I_LLAM] + j);
#pragma unroll
                for (int jj = 0; jj < 4; ++jj) c8[jt][jj] = -8.f * (fmaxf(-lam[jj], 0.f) + log1pf(__expf(-fabsf(lam[jj]))));
            }
        }
        float hst = 0.f;
        bf16_t xr[19];
        auto lru_load = [&](int cc) {
            const int t0 = d ? SQ - 64 * (cc + 1) : 64 * cc;
#pragma unroll
            for (int k = 0; k < 19; ++k) { const int t = t0 + tq * 16 - 1 + k; xr[k] = (t >= 0 && t < SQ) ? pr[(size_t)t * PREST_LD + g * 64 + ch] : (bf16_t)0; }
        };
        lru_load(0);
#pragma unroll 1
        for (int c = 0; c < 32; ++c) {
            const int t0 = d ? SQ - 64 * (c + 1) : 64 * c;
            {
                float xw[19];
#pragma unroll
                for (int k = 0; k < 19; ++k) xw[k] = bf2f(xr[k]);
                if (c + 1 < 32) lru_load(c + 1);
#pragma unroll
                for (int r = 0; r < 16; ++r) XC[(tq * 16 + r) * 72 + ch] = f2bf(cbv + cwv[0] * xw[r] + cwv[1] * xw[r + 1] + cwv[2] * xw[r + 2] + cwv[3] * xw[r + 3]);
            }
            __syncthreads();
            {
                f32x4 ra[4], rx[4];
#pragma unroll
                for (int jt = 0; jt < 4; ++jt) { ra[jt] = (f32x4){0.f, 0.f, 0.f, 0.f}; rx[jt] = (f32x4){0.f, 0.f, 0.f, 0.f}; }
#pragma unroll
                for (int ks = 0; ks < 2; ++ks) {
                    const bf16x8 xf = ldfrag(XC + i * 72 + ks * 32 + fq * 8);
#pragma unroll
                    for (int jt = 0; jt < 4; ++jt) { ra[jt] = mfma16(waf[jt][ks], xf, ra[jt]); rx[jt] = mfma16(wxf[jt][ks], xf, rx[jt]); }
                }
#pragma unroll
                for (int jt = 0; jt < 4; ++jt) {
                    float xc[4]; unpack4(*(const u32x2*)(XC + i * 72 + jt * 16 + fq * 4), xc);
#pragma unroll
                    for (int jj = 0; jj < 4; ++jj) {
                        const float la = c8[jt][jj] * sigm(ra[jt][jj] + ba4[jt][jj]);
                        const float av = __expf(la);
                        const float mult = __builtin_amdgcn_sqrtf(fmaxf(1.f - av * av, 0.f));
                        AA[i * 65 + jt * 16 + fq * 4 + jj] = av;
                        BB[i * 65 + jt * 16 + fq * 4 + jj] = mult * sigm(rx[jt][jj] + bx4[jt][jj]) * xc[jj];
                    }
                }
            }
            __syncthreads();
            if (tid < 64) {
#pragma unroll 1
                for (int r8 = 0; r8 < 8; ++r8) {
                    float av[8], bv[8];
#pragma unroll
                    for (int x = 0; x < 8; ++x) { const int r = d ? 63 - (r8 * 8 + x) : r8 * 8 + x; av[x] = AA[r * 65 + ch]; bv[x] = BB[r * 65 + ch]; }
#pragma unroll
                    for (int x = 0; x < 8; ++x) { const int r = d ? 63 - (r8 * 8 + x) : r8 * 8 + x; hst = av[x] * hst + bv[x]; HH[r * 65 + ch] = hst; }
                }
            }
            __syncthreads();
#pragma unroll
            for (int r = 0; r < 16; ++r) {
                const int ii = tq * 16 + r, t = t0 + ii;
                const float hv = HH[ii * 65 + ch];
                if (d == 0) YC[(size_t)t * 512 + ch] = f2bf(hv);
                else { const float prev = bf2f(YC[(size_t)t * 512 + ch]), gb = bf2f(pr[(size_t)t * PREST_LD + 512 + g * 64 + ch]); YC[(size_t)t * 512 + ch] = f2bf((prev + hv) * gelu_t(gb)); }
            }
        }
        __syncthreads();
    }
}

__device__ void dbg_zero(bf16_t* p, size_t n, int part, int nparts) {
    u32x4* q = (u32x4*)p; const size_t n8 = n / 8, per = (n8 + nparts - 1) / nparts, lo = per * part, hi = (lo + per < n8) ? lo + per : n8;
    for (size_t e = lo + tid_(); e < hi; e += NT) q[e] = (u32x4){0u, 0u, 0u, 0u};
}
__device__ void ph_mixers(const Params& P, int l, char* lds, int which) {
    const int nitems = 384;
    for (int item = bid_(); item < nitems; item += gridDim.x) {
        if (which) { if (item < 256) mx_rwkv(P, l, item, lds); else mx_lru(P, l, item - 256, lds); }
        else if (item < 256) mx_hgrn(P, l, item, lds);
        else mx_mlstm(P, l, item - 256, lds);
        __syncthreads();
    }
}

__device__ void ph_rwpost(const Params& P, int l, char* lds) {
    const int tid = tid_(), wid = tid >> 6, lane = tid & 63, fr = lane & 15, fq = lane >> 4;
    bf16_t* SG = (bf16_t*)lds; float* STAT = (float*)(lds + 64 * 136 * 2);
    const bf16_t* G2T = (const bf16_t*)(P.ws + WT_G2);
    const float* mu = P.in[I_MU] + l * 1792;
    for (int item = bid_(); item < TT / 64; item += gridDim.x) {
        const int tok0 = item * 64, s0 = tok0 & (SQ - 1);
        const bf16_t* prw = (const bf16_t*)(P.ws + OFF_PRW);
        bf16_t* Y0 = (bf16_t*)(P.ws + OFF_Y0); const bf16_t* Y1 = (const bf16_t*)(P.ws + OFF_Y1);
        const float* be0 = (const float*)(P.ws + OFF_BETA); const float* be1 = be0 + (size_t)TT * 8;
        __syncthreads();
        {
            const int r = tid >> 2, part = tid & 3, t = tok0 + r, sp = s0 + r;
#pragma unroll
            for (int v = 0; v < 4; ++v) {
                const int c = part * 32 + v * 8;
                float f0[8], fm[8], fp[8];
                unpack8(*(const u32x4*)(prw + (size_t)t * PRW_LD + 1664 + c), f0);
                if (sp > 0) unpack8(*(const u32x4*)(prw + (size_t)(t - 1) * PRW_LD + 1664 + c), fm); else { for (int x = 0; x < 8; ++x) fm[x] = 0.f; }
                if (sp < SQ - 1) unpack8(*(const u32x4*)(prw + (size_t)(t + 1) * PRW_LD + 1664 + c), fp); else { for (int x = 0; x < 8; ++x) fp[x] = 0.f; }
                float o[8];
#pragma unroll
                for (int x = 0; x < 8; ++x) o[x] = sigm(f0[x] + mu[1664 + c + x] * (0.5f * (fm[x] + fp[x]) - f0[x]));
                *(u32x4*)(SG + r * 136 + c) = (u32x4){pack2(o[0], o[1]), pack2(o[2], o[3]), pack2(o[4], o[5]), pack2(o[6], o[7])};
            }
#pragma unroll
            for (int hh = 0; hh < 2; ++hh) {
                const int head = part * 2 + hh;
                float sm = 0.f, sq = 0.f;
#pragma unroll
                for (int v = 0; v < 8; ++v) {
                    float a[8], bq[8];
                    unpack8(*(const u32x4*)(Y0 + (size_t)t * 512 + head * 64 + v * 8), a); unpack8(*(const u32x4*)(Y1 + (size_t)t * 512 + head * 64 + v * 8), bq);
#pragma unroll
                    for (int x = 0; x < 8; ++x) { const float y = a[x] + bq[x]; sm += y; sq += y * y; }
                }
                const float mean = sm * (1.f / 64.f), var = fmaxf(sq * (1.f / 64.f) - mean * mean, 0.f);
                STAT[(r * 8 + head) * 2] = mean; STAT[(r * 8 + head) * 2 + 1] = rsqrtf(var + 64e-5f);
            }
        }
        __syncthreads();
#pragma unroll 1
        for (int np = 0; np < 4; ++np) {
            const int nt0 = wid * 8 + np * 2;
#pragma unroll 1
            for (int tt = 0; tt < 4; ++tt) {
                f32x4 acc[2];
                acc[0] = (f32x4){0.f, 0.f, 0.f, 0.f}; acc[1] = (f32x4){0.f, 0.f, 0.f, 0.f};
#pragma unroll
                for (int ks = 0; ks < 4; ++ks) {
                    const bf16x8 b0 = ldfrag(G2T + (size_t)(nt0 * 16 + fr) * 128 + ks * 32 + fq * 8), b1 = ldfrag(G2T + (size_t)((nt0 + 1) * 16 + fr) * 128 + ks * 32 + fq * 8);
                    const bf16x8 af = ldfrag(SG + (tt * 16 + fr) * 136 + ks * 32 + fq * 8);
                    acc[0] = mfma16(b0, af, acc[0]); acc[1] = mfma16(b1, af, acc[1]);
                }
#pragma unroll
                for (int q = 0; q < 2; ++q) {
                    const int r = tt * 16 + fr, t = tok0 + r, sp = s0 + r, n = (nt0 + q) * 16 + fq * 4, head = n >> 6;
                    float y0[4], y1[4], v0[4], vm[4], vp[4];
                    unpack4(*(const u32x2*)(Y0 + (size_t)t * 512 + n), y0); unpack4(*(const u32x2*)(Y1 + (size_t)t * 512 + n), y1);
                    unpack4(*(const u32x2*)(prw + (size_t)t * PRW_LD + 1024 + n), v0);
                    if (sp > 0) unpack4(*(const u32x2*)(prw + (size_t)(t - 1) * PRW_LD + 1024 + n), vm); else { vm[0] = vm[1] = vm[2] = vm[3] = 0.f; }
                    if (sp < SQ - 1) unpack4(*(const u32x2*)(prw + (size_t)(t + 1) * PRW_LD + 1024 + n), vp); else { vp[0] = vp[1] = vp[2] = vp[3] = 0.f; }
                    const float mean = STAT[(r * 8 + head) * 2], rstd = STAT[(r * 8 + head) * 2 + 1];
                    const float be = 0.5f * (be0[(size_t)t * 8 + head] + be1[(size_t)t * 8 + head]);
                    const f32x4 lw = *(const f32x4*)(P.in[I_LNW] + l * 512 + n), lb = *(const f32x4*)(P.in[I_LNB] + l * 512 + n), m4 = *(const f32x4*)(mu + 1024 + n);
                    float o[4];
#pragma unroll
                    for (int jj = 0; jj < 4; ++jj) {
                        const float vs = v0[jj] + m4[jj] * (0.5f * (vm[jj] + vp[jj]) - v0[jj]);
                        o[jj] = (((y0[jj] + y1[jj]) - mean) * rstd * lw[jj] + lb[jj] + be * vs) * acc[q][jj];
                    }
                    *(u32x2*)(Y0 + (size_t)t * 512 + n) = (u32x2){pack2(o[0], o[1]), pack2(o[2], o[3])};
                }
            }
        }
    }
    __syncthreads();
}
template <bool ML> __device__ void ph_headpost(const Params& P, int l) {
    const int tid = tid_();
    bf16_t* YO = (bf16_t*)(P.ws + (ML ? OFF_YB : OFF_YD)); const bf16_t* SDF = (const bf16_t*)(P.ws + (ML ? OFF_Y1 : OFF_Y0));
    const bf16_t* pr = (const bf16_t*)(P.ws + OFF_PREST) + (ML ? 1024 : HG_O + 2048);
    const float* ng = P.in[ML ? I_MLN : I_HGN] + l * 512;
    for (int item = bid_(); item < TT / 64; item += gridDim.x) {
        const int t = item * 64 + (tid >> 2), part = tid & 3;
#pragma unroll 2
        for (int hh = 0; hh < 4; ++hh) {
            const int c0 = hh * 128 + part * 32;
            float v[32]; float ss = 0.f;
#pragma unroll
            for (int q = 0; q < 4; ++q) { float f[8], f2[8]; unpack8(*(const u32x4*)(YO + (size_t)t * 512 + c0 + q * 8), f); unpack8(*(const u32x4*)(SDF + (size_t)t * 512 + c0 + q * 8), f2);
#pragma unroll
                for (int x = 0; x < 8; ++x) { const float y = f[x] + f2[x]; v[q * 8 + x] = y; ss += y * y; } }
            ss += dppf<0xB1>(ss); ss += dppf<0x4E>(ss);
            const float rms = rsqrtf(ss * (1.f / 128.f) + 1e-6f);
#pragma unroll
            for (int q = 0; q < 4; ++q) {
                float gq[8]; unpack8(*(const u32x4*)(pr + (size_t)t * PREST_LD + c0 + q * 8), gq);
                float o[8];
#pragma unroll
                for (int x = 0; x < 8; ++x) o[x] = (ML ? sigm(gq[x]) : silu(gq[x])) * v[q * 8 + x] * rms * ng[c0 + q * 8 + x];
                *(u32x4*)(YO + (size_t)t * 512 + c0 + q * 8) = (u32x4){pack2(o[0], o[1]), pack2(o[2], o[3]), pack2(o[4], o[5]), pack2(o[6], o[7])};
            }
        }
    }
}

#define XB_TMO      128
#define XB_XCNT(j)  (256  + 64 * (j))
#define XB_XSUB(j)  (1280 + 64 * (j))
#define XB_XGEN(j)  (2304 + 64 * (j))
#define XB_TOP      3328
#define XB_TOPGEN   3392
#define XCD_BAR_WORDS 3456
#define XB_SPIN_CAP (1u << 18)
#define LAS __attribute__((address_space(3)))

__device__ __forceinline__ unsigned xb_ld(unsigned* p)              { return __hip_atomic_load(p, __ATOMIC_RELAXED, __HIP_MEMORY_SCOPE_AGENT); }
__device__ __forceinline__ unsigned xb_add(unsigned* p, unsigned v) { return __hip_atomic_fetch_add(p, v, __ATOMIC_RELAXED, __HIP_MEMORY_SCOPE_AGENT); }
__device__ __forceinline__ unsigned xb_xcc_id() { return (unsigned)__builtin_amdgcn_s_getreg((3 << 11) | 20) & 0xFu; }
#define XB_SPIN(cond, bar) do { unsigned _sp = 0; while (cond) { __builtin_amdgcn_s_sleep(1); \
    if ((++_sp & 255u) == 0u) { if (xb_ld(&(bar)[XB_TMO])) break; if (_sp > XB_SPIN_CAP) { atomicAdd(&(bar)[XB_TMO], 1u); break; } } } } while (0)

struct XcdBarrier {
    unsigned* bar; unsigned x;
    volatile LAS unsigned* st;
};

__device__ __forceinline__ XcdBarrier xcd_barrier_post(unsigned* bar, volatile LAS unsigned* st) {
    XcdBarrier b; b.bar = bar; b.x = xb_xcc_id(); b.st = st;
    if (threadIdx.x == 0) (void)xb_add(&bar[XB_XCNT(b.x)], 1u);
    return b;
}
__device__ __forceinline__ void xcd_barrier_complete(unsigned* bar, unsigned x, unsigned& nloc, unsigned& nx) {
    const unsigned G = gridDim.x * gridDim.y * gridDim.z;
    unsigned sum, cnt, mine, sp = 0u;
    for (;;) {
        sum = 0u; cnt = 0u; mine = 0u;
#pragma unroll
        for (unsigned j = 0; j < 16; ++j) { const unsigned c = xb_ld(&bar[XB_XCNT(j)]); sum += c; cnt += (c > 0u) ? 1u : 0u; mine = (j == x) ? c : mine; }
        if (sum == G) break;
        __builtin_amdgcn_s_sleep(1);
        if ((++sp & 255u) == 0u) { if (xb_ld(&bar[XB_TMO])) break; if (sp > XB_SPIN_CAP) { atomicAdd(&bar[XB_TMO], 1u); break; } }
    }
    nloc = mine > 0u ? mine : 1u; nx = cnt > 0u ? cnt : 1u;
}

__device__ __forceinline__ void xcd_barrier(const XcdBarrier& b) {
    asm volatile("s_waitcnt vmcnt(0)" ::: "memory");
    __syncthreads();
    if (threadIdx.x == 0) {
        unsigned* bar = b.bar;
        __builtin_amdgcn_s_waitcnt(0);
        unsigned nloc = b.st[0], nx = b.st[1];
        if (nloc == 0u) { xcd_barrier_complete(bar, b.x, nloc, nx); b.st[0] = nloc; b.st[1] = nx; }
        const unsigned old = xb_add(&bar[XB_XSUB(b.x)], 1u);
        const unsigned gen = old / nloc;
        if (old + 1u == (gen + 1u) * nloc) {
            __builtin_amdgcn_fence(__ATOMIC_RELEASE, "agent");
            asm volatile("s_waitcnt vmcnt(0)" ::: "memory");
            const unsigned og = xb_add(&bar[XB_TOP], 1u);
            const unsigned tg = og / nx;
            if (og + 1u == (tg + 1u) * nx) xb_add(&bar[XB_TOPGEN], 1u);
            else XB_SPIN(xb_ld(&bar[XB_TOPGEN]) == tg, bar);
            __builtin_amdgcn_fence(__ATOMIC_ACQUIRE, "agent");
            xb_add(&bar[XB_XGEN(b.x)], 1u);
            asm volatile("s_waitcnt vmcnt(0)" ::: "memory");
        } else {
            XB_SPIN(xb_ld(&bar[XB_XGEN(b.x)]) == gen, bar);
            __builtin_amdgcn_fence(__ATOMIC_ACQUIRE, "agent");
            asm volatile("s_waitcnt vmcnt(0)" ::: "memory");
        }
    }
    __syncthreads();
}


constexpr int N_PHASES = 2 + NL * 13;
__device__ void run_phase(const Params& P, int ph, char* lds) {
    if (ph == 0) { ph_init(P, lds); return; }
    if (ph == N_PHASES - 1) { ph_norm(P, P.in[I_FING], nullptr, 0, 0, nullptr, true); return; }
    const int l = (ph - 1) / 13; int sp = (ph - 1) % 13;
    const float* modl = (const float*)(P.ws + OFF_MOD) + (size_t)l * 16 * 6144;
    if (sp == 2) { ph_mixers(P, l, lds, 0); return; }
    if (sp == 3) { ph_headpost<false>(P, l); ph_headpost<true>(P, l); return; }
    if (sp == 4) { ph_mixers(P, l, lds, 1); return; }
    if (sp > 4) sp -= 2;
    switch (sp) {
        case 0: ph_wt(P, l, lds); ph_norm(P, P.in[I_N1G] + l * DM, modl, 0, 1024, (bf16_t*)(P.ws + OFF_U), false); break;
        case 1: ph_gemm_p(P, lds); break;
        case 3: ph_rwpost(P, l, lds); break;
        case 4: ph_norm(P, P.in[I_N1G] + l * DM, modl, 0, 1024, (bf16_t*)(P.ws + OFF_URE), false); break;
        case 5: ph_gemm_merge(P, lds); break;
        case 6: ph_gemm_out(P, l, lds); break;
        case 7: ph_norm(P, P.in[I_N2G] + l * DM, modl, 3072, 4096, (bf16_t*)(P.ws + OFF_U2), false); break;
        case 8: ph_gemm_up(P, lds); break;
        case 9: ph_convact(P, l); break;
        default: ph_gemm_down(P, l, lds); break;
    }
}

__global__ void __launch_bounds__(NT, 2) mega(Params P, int ph_lo, int ph_hi) {
    extern __shared__ __attribute__((aligned(16))) char smem[];
    cg::grid_group grid = cg::this_grid();
    volatile LAS unsigned* xst = (volatile LAS unsigned*)(smem + LDS_BYTES - 16);
    if (threadIdx.x == 0) { xst[0] = 0u; xst[1] = 0u; }
    __syncthreads();
    XcdBarrier xb = xcd_barrier_post((unsigned*)(P.ws + OFF_BAR), xst);
    for (int ph = ph_lo; ph < ph_hi; ++ph) {
        run_phase(P, ph, smem);
        if (ph + 1 < ph_hi) { if (ph == ph_lo) grid.sync(); else xcd_barrier(xb); }
    }
}

extern "C" void kernel_launch(void* const* d_in, const int* in_sizes, int n_in, void* d_out, int out_size, void* d_ws, size_t ws_size, hipStream_t stream) {
    static int grid_blocks = 0;
    if (grid_blocks == 0) {
        if (n_in != N_INPUTS || ws_size < WS_NEED || out_size != TT * DM) { fprintf(stderr, "kernel_launch: unexpected shapes (n_in %d ws %zu need %zu)\n", n_in, ws_size, (size_t)WS_NEED); grid_blocks = -1; return; }
        int dev = 0, cus = 0, per_cu = 0;
        hipGetDevice(&dev);
        hipDeviceGetAttribute(&cus, hipDeviceAttributeMultiprocessorCount, dev);
        if (hipFuncSetAttribute((const void*)mega, hipFuncAttributeMaxDynamicSharedMemorySize, LDS_BYTES) != hipSuccess) { fprintf(stderr, "kernel_launch: hipFuncSetAttribute failed\n"); grid_blocks = -1; return; }
        hipOccupancyMaxActiveBlocksPerMultiprocessor(&per_cu, (const void*)mega, NT, LDS_BYTES);
        if (per_cu < 1) per_cu = 1;
        if (per_cu > 2) per_cu = 2;
        grid_blocks = cus * per_cu;
    }
    if (grid_blocks < 0) return;
    if (hipMemsetAsync((char*)d_ws + OFF_BAR, 0, BAR_BYTES, stream) != hipSuccess) { fprintf(stderr, "kernel_launch: memset of the barrier words failed\n"); return; }
    Params p{};
    for (int i = 0; i < N_INPUTS; ++i) p.in[i] = (const float*)d_in[i];
    p.out = (float*)d_out; p.ws = (char*)d_ws;
#if MULTI_LAUNCH
    for (int ph = 0; ph < N_PHASES; ++ph) hipLaunchKernelGGL(mega, dim3(grid_blocks), dim3(NT), LDS_BYTES, stream, p, ph, ph + 1);
#else
    int lo = 0, hi = N_PHASES;
    void* args[] = {&p, &lo, &hi};
    hipError_t e = hipLaunchCooperativeKernel((const void*)mega, dim3(grid_blocks), dim3(NT), args, LDS_BYTES, stream);
    if (e != hipSuccess) fprintf(stderr, "cooperative launch failed: %s (grid %d)\n", hipGetErrorString(e), grid_blocks);
#endif
}
```

```cpp
#include <hip/hip_runtime.h>
#include <hip/hip_cooperative_groups.h>
#include <cstdio>
namespace cg = cooperative_groups;

typedef unsigned short bf16_t;
typedef short bf16x8 __attribute__((ext_vector_type(8)));
typedef float f32x4 __attribute__((ext_vector_type(4)));
typedef unsigned u32x4 __attribute__((ext_vector_type(4)));
typedef unsigned u32x2 __attribute__((ext_vector_type(2)));

#ifndef DBG_SKIP
#define DBG_SKIP 0
#endif
#ifndef DBG_NOFFN
#define DBG_NOFFN 0
#endif
#ifndef MULTI_LAUNCH
#define MULTI_LAUNCH 0
#endif

constexpr int NB = 16, SQ = 2048, DM = 1024, TT = NB * SQ, MW = 512, NL = 4;
constexpr int NT = 256;
constexpr int PRW_LD = 1792, PREST_LD = 5248;
constexpr int LRU_O = 1664, HG_O = 2688;
constexpr int GATE_ROW0 = 7040;
constexpr int DFF = 2816;
constexpr int LDS_BYTES = 73728;

constexpr size_t WT_WIN = 0;
constexpr size_t WT_WB = WT_WIN + (size_t)11136 * 1024 * 2;
constexpr size_t WT_WOUT = WT_WB + (size_t)4 * 1024 * 512 * 2;
constexpr size_t WT_WUP = WT_WOUT + (size_t)1024 * 1024 * 2;
constexpr size_t WT_WDN = WT_WUP + (size_t)5632 * 1024 * 2;
constexpr size_t WT_G2 = WT_WDN + (size_t)1024 * 2816 * 2;
constexpr size_t WT_W2 = WT_G2 + (size_t)512 * 128 * 2;
constexpr size_t WT_A2 = WT_W2 + (size_t)2 * 512 * 64 * 2;
constexpr size_t WT_LRU = WT_A2 + (size_t)2 * 512 * 64 * 2;
constexpr size_t WT_END = WT_LRU + (size_t)2 * 2 * 8 * 64 * 64 * 2;
constexpr size_t OFF_PRW = (size_t)48 << 20;
static_assert(WT_END <= OFF_PRW, "wt");
constexpr size_t OFF_PREST = OFF_PRW + (size_t)TT * PRW_LD * 2;
constexpr size_t OFF_Y = OFF_PREST + (size_t)TT * PREST_LD * 2;
constexpr size_t YSZ = (size_t)TT * 512 * 2;
constexpr size_t OFF_YB = OFF_Y, OFF_YC = OFF_Y + YSZ, OFF_YD = OFF_Y + 2 * YSZ, OFF_Y0 = OFF_Y + 3 * YSZ, OFF_Y1 = OFF_Y + 4 * YSZ;
constexpr size_t OFF_SMALL = OFF_Y + 5 * YSZ;
constexpr size_t OFF_MOD = OFF_SMALL;
constexpr size_t OFF_LB = OFF_MOD + (size_t)4 * 16 * 6144 * 4;
constexpr size_t OFF_BETA = OFF_LB + (size_t)4 * 2 * 512 * 4;
constexpr size_t OFF_BAR = OFF_BETA + (size_t)2 * TT * 8 * 4;
constexpr size_t BAR_BYTES = 16384;
constexpr size_t WS_NEED = OFF_BAR + BAR_BYTES;
constexpr size_t OFF_U = OFF_Y;
constexpr size_t OFF_URE = OFF_PREST;
constexpr size_t OFF_MERGED = OFF_PREST + (size_t)TT * 1024 * 2;
constexpr size_t OFF_U2 = OFF_Y;
constexpr size_t OFF_Z = OFF_PRW;
constexpr size_t OFF_ACT = OFF_PRW + (size_t)TT * 5632 * 2;
static_assert(OFF_ACT + (size_t)TT * 2816 * 2 <= OFF_SMALL, "act");

enum { I_X = 0, I_C, I_ADAW, I_ADAB, I_N1G, I_WIN, I_MU, I_W0, I_W2, I_A0, I_A2, I_G2, I_KK, I_KA, I_RK, I_LNW, I_LNB,
       I_MLIB, I_MLFB, I_MLN, I_LCW, I_LCB, I_LWA, I_LBA, I_LWX, I_LBX, I_LLAM, I_HGLB, I_HGN, I_WBR, I_WOUT, I_N2G,
       I_FUP, I_FCW, I_FCB, I_FDN, I_FING, N_INPUTS };

struct Params { const float* in[N_INPUTS]; float* out; char* ws; };

__device__ __forceinline__ int tid_() { int x = threadIdx.x; asm volatile("" : "+v"(x)); return x; }
__device__ __forceinline__ int bid_() { int x = blockIdx.x; asm volatile("" : "+s"(x)); return x; }
__device__ __forceinline__ bf16_t f2bf(float f) { const __bf16 h = (__bf16)f; return __builtin_bit_cast(unsigned short, h); }
__device__ __forceinline__ float bf2f(bf16_t h) { return __uint_as_float(((unsigned)h) << 16); }
typedef __bf16 bf16x2n __attribute__((ext_vector_type(2)));
typedef float f32x2n __attribute__((ext_vector_type(2)));
__device__ __forceinline__ unsigned pack2(float a, float b) { const f32x2n v = {a, b}; const bf16x2n h = __builtin_convertvector(v, bf16x2n); return __builtin_bit_cast(unsigned, h); }
__device__ __forceinline__ float lo2f(unsigned u) { return __uint_as_float(u << 16); }
__device__ __forceinline__ float hi2f(unsigned u) { return __uint_as_float(u & 0xffff0000u); }
__device__ __forceinline__ float rcpf_(float x) { return __builtin_amdgcn_rcpf(x); }
__device__ __forceinline__ float flog_(float x) { return __builtin_amdgcn_logf(x) * 0.69314718056f; }
__device__ __forceinline__ float sigm(float x) { return rcpf_(1.f + __expf(-x)); }
__device__ __forceinline__ float silu(float x) { return x * sigm(x); }
__device__ __forceinline__ float logsig(float x) { return fminf(x, 0.f) - flog_(1.f + __expf(-fabsf(x))); }
__device__ __forceinline__ float tanh_f(float x) { return 1.f - 2.f * rcpf_(1.f + __expf(2.f * x)); }
__device__ __forceinline__ float gelu_t(float x) { return 0.5f * x * (1.f + tanh_f(0.7978845608f * (x + 0.044715f * x * x * x))); }
template <int CTRL> __device__ __forceinline__ float dppf(float x) { return __int_as_float(__builtin_amdgcn_update_dpp(0, __float_as_int(x), CTRL, 0xF, 0xF, false)); }
__device__ __forceinline__ float rowsum16(float x) { x += dppf<0x128>(x); x += dppf<0x124>(x); x += dppf<0x122>(x); x += dppf<0x121>(x); return x; }
__device__ __forceinline__ float rdlane(float x, int l) { return __int_as_float(__builtin_amdgcn_readlane(__float_as_int(x), l)); }
__device__ __forceinline__ float wsum64(float x) { x = rowsum16(x); return (rdlane(x, 0) + rdlane(x, 16)) + (rdlane(x, 32) + rdlane(x, 48)); }
__device__ __forceinline__ float bperm(float x, int srclane) { return __int_as_float(__builtin_amdgcn_ds_bpermute(srclane << 2, __float_as_int(x))); }
__device__ __forceinline__ float qsum(float x, int lane) { x += bperm(x, lane ^ 16); x += bperm(x, lane ^ 32); return x; }
__device__ __forceinline__ void unpack8(u32x4 v, float (&f)[8]) {
    f[0] = lo2f(v.x); f[1] = hi2f(v.x); f[2] = lo2f(v.y); f[3] = hi2f(v.y); f[4] = lo2f(v.z); f[5] = hi2f(v.z); f[6] = lo2f(v.w); f[7] = hi2f(v.w); }
__device__ __forceinline__ void unpack4(u32x2 v, float (&f)[4]) { f[0] = lo2f(v.x); f[1] = hi2f(v.x); f[2] = lo2f(v.y); f[3] = hi2f(v.y); }
__device__ __forceinline__ f32x4 mfma16(bf16x8 a, bf16x8 b, f32x4 c) { return __builtin_amdgcn_mfma_f32_16x16x32_bf16(a, b, c, 0, 0, 0); }
__device__ __forceinline__ bf16x8 ldfrag(const bf16_t* p) { return *reinterpret_cast<const bf16x8*>(p); }

__device__ __forceinline__ void gemm_stage(const bf16_t* __restrict__ A, long lda, const bf16_t* __restrict__ Bt, long ldb, int kt, char* buf, int tid) {
#pragma unroll
    for (int i = 0; i < 4; ++i) {
        const int b = tid * 16 + i * 4096, r = b >> 7, c = ((b & 127) >> 4) ^ (r & 7);
        __builtin_amdgcn_global_load_lds((const unsigned*)(A + (long)r * lda + kt * 64 + c * 8), (__attribute__((address_space(3))) unsigned*)(buf + b), 16, 0, 0);
        __builtin_amdgcn_global_load_lds((const unsigned*)(Bt + (long)r * ldb + kt * 64 + c * 8), (__attribute__((address_space(3))) unsigned*)(buf + 16384 + b), 16, 0, 0);
    }
}
__device__ __forceinline__ void gemm_acc(const bf16_t* __restrict__ A, long lda, const bf16_t* __restrict__ Bt, long ldb, int K, f32x4 (&acc)[4][4], char* lds) {
    const int tid = tid_(), wid = tid >> 6, lane = tid & 63, wr = wid >> 1, wc = wid & 1, fr = lane & 15, fq = lane >> 4;
    const int nk = K >> 6;
    gemm_stage(A, lda, Bt, ldb, 0, lds, tid);
    asm volatile("s_waitcnt vmcnt(0)" ::: "memory");
    __syncthreads();
    for (int kt = 0; kt < nk; ++kt) {
        char* cur = lds + (kt & 1) * 32768;
        if (kt + 1 < nk) gemm_stage(A, lda, Bt, ldb, kt + 1, lds + ((kt + 1) & 1) * 32768, tid);
#pragma unroll
        for (int ks = 0; ks < 2; ++ks) {
            bf16x8 af[4], bfr[4];
#pragma unroll
            for (int m = 0; m < 4; ++m) { const int row = wr * 64 + m * 16 + fr; af[m] = *reinterpret_cast<const bf16x8*>(cur + row * 128 + (((ks * 4 + fq) ^ (row & 7)) << 4)); }
#pragma unroll
            for (int n = 0; n < 4; ++n) { const int row = wc * 64 + n * 16 + fr; bfr[n] = *reinterpret_cast<const bf16x8*>(cur + 16384 + row * 128 + (((ks * 4 + fq) ^ (row & 7)) << 4)); }
            __builtin_amdgcn_s_setprio(1);
#pragma unroll
            for (int m = 0; m < 4; ++m)
#pragma unroll
                for (int n = 0; n < 4; ++n) acc[m][n] = mfma16(bfr[n], af[m], acc[m][n]);
            __builtin_amdgcn_s_setprio(0);
        }
        asm volatile("s_waitcnt vmcnt(0)" ::: "memory");
        __syncthreads();
    }
}
__device__ __forceinline__ void gemm2_stage(const bf16_t* __restrict__ A, long lda, const bf16_t* __restrict__ Bt, long ldb, int kt, char* buf, int tid) {
#pragma unroll
    for (int i = 0; i < 4; ++i) {
        const int b = tid * 16 + i * 4096, r = b >> 6, c = ((b & 63) >> 4) ^ ((r >> 2) & 3);
        __builtin_amdgcn_global_load_lds((const unsigned*)(A + (long)r * lda + kt * 32 + c * 8), (__attribute__((address_space(3))) unsigned*)(buf + b), 16, 0, 0);
    }
#pragma unroll
    for (int i = 0; i < 2; ++i) {
        const int b = tid * 16 + i * 4096, r = b >> 6, c = ((b & 63) >> 4) ^ ((r >> 2) & 3);
        __builtin_amdgcn_global_load_lds((const unsigned*)(Bt + (long)r * ldb + kt * 32 + c * 8), (__attribute__((address_space(3))) unsigned*)(buf + 16384 + b), 16, 0, 0);
    }
}
__device__ __forceinline__ void gemm_acc2(const bf16_t* __restrict__ A, long lda, const bf16_t* __restrict__ Bt, long ldb, int K, f32x4 (&acc)[8][4], char* lds) {
    const int tid = tid_(), wid = tid >> 6, lane = tid & 63, wr = wid >> 1, wc = wid & 1, fr = lane & 15, fq = lane >> 4;
    const int nk = K >> 5;
    gemm2_stage(A, lda, Bt, ldb, 0, lds, tid);
    asm volatile("s_waitcnt vmcnt(0)" ::: "memory");
    __syncthreads();
    for (int kt = 0; kt < nk; ++kt) {
        char* cur = lds + (kt & 1) * 24576;
        if (kt + 1 < nk) gemm2_stage(A, lda, Bt, ldb, kt + 1, lds + ((kt + 1) & 1) * 24576, tid);
        bf16x8 bfr[4];
#pragma unroll
        for (int n = 0; n < 4; ++n) { const int row = wc * 64 + n * 16 + fr; bfr[n] = *reinterpret_cast<const bf16x8*>(cur + 16384 + row * 64 + ((fq ^ ((row >> 2) & 3)) << 4)); }
#pragma unroll
        for (int m = 0; m < 8; ++m) {
            const int row = wr * 128 + m * 16 + fr;
            const bf16x8 af = *reinterpret_cast<const bf16x8*>(cur + row * 64 + ((fq ^ ((row >> 2) & 3)) << 4));
            __builtin_amdgcn_s_setprio(1);
#pragma unroll
            for (int n = 0; n < 4; ++n) acc[m][n] = mfma16(bfr[n], af, acc[m][n]);
            __builtin_amdgcn_s_setprio(0);
        }
        asm volatile("s_waitcnt vmcnt(0)" ::: "memory");
        __syncthreads();
    }
}
__device__ __forceinline__ void zero_acc2(f32x4 (&acc)[8][4]) {
#pragma unroll
    for (int m = 0; m < 8; ++m)
#pragma unroll
        for (int n = 0; n < 4; ++n) acc[m][n] = (f32x4){0.f, 0.f, 0.f, 0.f};
}
__device__ __forceinline__ void zero_acc(f32x4 (&acc)[4][4]) {
#pragma unroll
    for (int m = 0; m < 4; ++m)
#pragma unroll
        for (int n = 0; n < 4; ++n) acc[m][n] = (f32x4){0.f, 0.f, 0.f, 0.f};
}

__device__ void ph_init(const Params& P, char* lds) {
    const int tid = tid_();
    {
        const f32x4* src = (const f32x4*)P.in[I_X]; f32x4* dst = (f32x4*)P.out;
        const long n4 = (long)TT * DM / 4;
        for (long i = (long)bid_() * NT + tid; i < n4; i += (long)gridDim.x * NT) dst[i] = src[i];
    }
    float* mod = (float*)(P.ws + OFF_MOD);
    float* lbo = (float*)(P.ws + OFF_LB);
    for (int item = bid_(); item < 385; item += gridDim.x) {
        if (item < 384) {
            const int l = item / 96, j0 = (item % 96) * 64;
            const int col = tid & 63, kg = tid >> 6;
            float* CS = (float*)lds;
            float* RED = CS + 4096;
            float acc[16];
#pragma unroll
            for (int b = 0; b < 16; ++b) acc[b] = 0.f;
            const float* Wl = P.in[I_ADAW] + (size_t)l * DM * 6144;
            for (int sub = 0; sub < 4; ++sub) {
                __syncthreads();
                for (int e = tid; e < 4096; e += NT) {
                    const int kk = e & 63, b = (e >> 6) & 15, g = e >> 10;
                    CS[e] = silu(P.in[I_C][b * DM + g * 256 + sub * 64 + kk]);
                }
                __syncthreads();
                for (int kk = 0; kk < 64; ++kk) {
                    const float w = Wl[(size_t)(kg * 256 + sub * 64 + kk) * 6144 + j0 + col];
#pragma unroll
                    for (int b = 0; b < 16; ++b) acc[b] += CS[(kg * 16 + b) * 64 + kk] * w;
                }
            }
#pragma unroll
            for (int b = 0; b < 16; ++b) RED[(kg * 64 + col) * 16 + b] = acc[b];
            __syncthreads();
            {
                const int bg = tid >> 6;
#pragma unroll
                for (int bb = 0; bb < 4; ++bb) {
                    const int b = bg * 4 + bb;
                    float s = RED[(0 * 64 + col) * 16 + b] + RED[(1 * 64 + col) * 16 + b] + RED[(2 * 64 + col) * 16 + b] + RED[(3 * 64 + col) * 16 + b];
                    mod[((size_t)l * 16 + b) * 6144 + j0 + col] = s + P.in[I_ADAB][l * 6144 + j0 + col];
                }
            }
            __syncthreads();
        } else {
            for (int e = tid; e < 1024; e += NT) {
                float x[4], mx = -1e30f;
#pragma unroll
                for (int l = 0; l < 4; ++l) { x[l] = P.in[I_HGLB][l * 1024 + e]; mx = fmaxf(mx, x[l]); }
                float s = 0.f;
#pragma unroll
                for (int l = 0; l < 4; ++l) { x[l] = __expf(x[l] - mx); s += x[l]; }
                const float inv = rcpf_(s);
                float cum = 0.f;
                lbo[0 * 1024 + e] = 0.f;
#pragma unroll
                for (int l = 1; l < 4; ++l) { cum += x[l] * inv; lbo[l * 1024 + e] = fminf(fmaxf(cum, 0.f), 1.f); }
            }
        }
    }
}

__device__ __forceinline__ void tr_tile(const float* __restrict__ src, int ld, int N, int k0, int n0, bf16_t* __restrict__ dst, int dld, int drow0, bool winmap, char* lds) {
    float* Tl = (float*)lds;
    const int tid = tid_();
    __syncthreads();
#pragma unroll
    for (int i = 0; i < 4; ++i) {
        const int kk = (tid >> 4) + 16 * i, nn = (tid & 15) * 4;
        f32x4 v = (f32x4){0.f, 0.f, 0.f, 0.f};
        if (n0 + nn < N) v = *(const f32x4*)(src + (size_t)(k0 + kk) * ld + n0 + nn);
        Tl[kk * 65 + nn] = v[0]; Tl[kk * 65 + nn + 1] = v[1]; Tl[kk * 65 + nn + 2] = v[2]; Tl[kk * 65 + nn + 3] = v[3];
    }
    __syncthreads();
    {
        const int nn = tid >> 2, kb = (tid & 3) * 16;
        if (n0 + nn < N) {
            int drow = drow0 + nn;
            if (winmap) { const int n = n0 + nn; drow = n + (n >= 3344 ? 112 : 0); }
            unsigned w[8];
#pragma unroll
            for (int j = 0; j < 8; ++j) w[j] = pack2(Tl[(kb + 2 * j) * 65 + nn], Tl[(kb + 2 * j + 1) * 65 + nn]);
            u32x4* d = (u32x4*)(dst + (size_t)drow * dld + k0 + kb);
            d[0] = (u32x4){w[0], w[1], w[2], w[3]}; d[1] = (u32x4){w[4], w[5], w[6], w[7]};
        }
    }
}
__device__ void ph_wt(const Params& P, int l, char* lds) {
    char* ws = P.ws;
    const int NI = 2768 + 512 + 256 + 1408 + 704 + 16 + 16 + 16 + 16 + 16 + 7;
    for (int item = bid_(); item < NI; item += gridDim.x) {
        int it = item;
        if (it < 2768) { const int kt = it / 173, nt = it % 173;
            tr_tile(P.in[I_WIN] + (size_t)l * 1024 * 11024, 11024, 11024, kt * 64, nt * 64, (bf16_t*)(ws + WT_WIN), 1024, 0, true, lds); continue; }
        it -= 2768;
        if (it < 512) { const int n = it / 128, r = it % 128, kt = r / 16, nt = r % 16;
            tr_tile(P.in[I_WBR] + ((size_t)l * 4 + n) * 512 * 1024, 1024, 1024, kt * 64, nt * 64, (bf16_t*)(ws + WT_WB) + (size_t)n * 1024 * 512, 512, nt * 64, false, lds); continue; }
        it -= 512;
        if (it < 256) { const int kt = it / 16, nt = it % 16;
            tr_tile(P.in[I_WOUT] + (size_t)l * 1024 * 1024, 1024, 1024, kt * 64, nt * 64, (bf16_t*)(ws + WT_WOUT), 1024, nt * 64, false, lds); continue; }
        it -= 256;
        if (it < 1408) { const int kt = it / 88, nt = it % 88;
            tr_tile(P.in[I_FUP] + (size_t)l * 1024 * 5632, 5632, 5632, kt * 64, nt * 64, (bf16_t*)(ws + WT_WUP), 1024, nt * 64, false, lds); continue; }
        it -= 1408;
        if (it < 704) { const int kt = it / 16, nt = it % 16;
            tr_tile(P.in[I_FDN] + (size_t)l * 2816 * 1024, 1024, 1024, kt * 64, nt * 64, (bf16_t*)(ws + WT_WDN), 2816, nt * 64, false, lds); continue; }
        it -= 704;
        if (it < 16) { const int kt = it / 8, nt = it % 8;
            tr_tile(P.in[I_G2] + (size_t)l * 128 * 512, 512, 512, kt * 64, nt * 64, (bf16_t*)(ws + WT_G2), 128, nt * 64, false, lds); continue; }
        it -= 16;
        if (it < 16) { const int d = it / 8, nt = it % 8;
            tr_tile(P.in[I_W2] + ((size_t)l * 2 + d) * 64 * 512, 512, 512, 0, nt * 64, (bf16_t*)(ws + WT_W2) + (size_t)d * 512 * 64, 64, nt * 64, false, lds); continue; }
        it -= 16;
        if (it < 16) { const int d = it / 8, nt = it % 8;
            tr_tile(P.in[I_A2] + ((size_t)l * 2 + d) * 64 * 512, 512, 512, 0, nt * 64, (bf16_t*)(ws + WT_A2) + (size_t)d * 512 * 64, 64, nt * 64, false, lds); continue; }
        it -= 16;
        if (it < 32) { const int mat = it / 16, d = (it % 16) / 8, g = it % 8;
            const float* src = P.in[mat ? I_LWX : I_LWA] + (((size_t)l * 2 + d) * 8 + g) * 64 * 64;
            tr_tile(src, 64, 64, 0, 0, (bf16_t*)(ws + WT_LRU) + (((size_t)d * 2 + mat) * 8 + g) * 64 * 64, 64, 0, false, lds); continue; }
        it -= 32;
        {
            u32x4* d = (u32x4*)((bf16_t*)(ws + WT_WIN) + (size_t)(3344 + it * 16) * 1024);
            for (int e = tid_(); e < 16 * 1024 / 8; e += NT) d[e] = (u32x4){0u, 0u, 0u, 0u};
        }
    }
}

__device__ void ph_norm(const Params& P, const float* __restrict__ g, const float* __restrict__ modl, int sh_off, int sc_off, bf16_t* __restrict__ dst, bool final_) {
    const int tid = tid_(), wid = tid >> 6, lane = tid & 63;
    for (int item = bid_(); item < TT / 16; item += gridDim.x) {
        const int row0 = item * 16 + wid * 4, b = row0 >> 11;
        f32x4 v[4][4];
#pragma unroll
        for (int r = 0; r < 4; ++r)
#pragma unroll
            for (int i = 0; i < 4; ++i) v[r][i] = *(const f32x4*)(P.out + (size_t)(row0 + r) * DM + i * 256 + lane * 4);
        f32x4 gv[4], sc[4], sh[4];
#pragma unroll
        for (int i = 0; i < 4; ++i) {
            const int c = i * 256 + lane * 4;
            gv[i] = *(const f32x4*)(g + c);
            if (!final_) { sc[i] = *(const f32x4*)(modl + (size_t)b * 6144 + sc_off + c); sh[i] = *(const f32x4*)(modl + (size_t)b * 6144 + sh_off + c); }
        }
#pragma unroll
        for (int r = 0; r < 4; ++r) {
            float ss = 0.f;
#pragma unroll
            for (int i = 0; i < 4; ++i) ss += v[r][i][0] * v[r][i][0] + v[r][i][1] * v[r][i][1] + v[r][i][2] * v[r][i][2] + v[r][i][3] * v[r][i][3];
            ss = wsum64(ss);
            const float rs = rsqrtf(ss * (1.f / DM) + 1e-6f);
            float* hr = P.out + (size_t)(row0 + r) * DM;
#pragma unroll
            for (int i = 0; i < 4; ++i) {
                const int c = i * 256 + lane * 4;
                if (final_) {
                    *(f32x4*)(hr + c) = v[r][i] * rs * gv[i];
                } else {
                    const f32x4 o = v[r][i] * rs * gv[i] * (sc[i] + 1.f) + sh[i];
                    *(u32x2*)(dst + (size_t)(row0 + r) * DM + c) = (u32x2){pack2(o[0], o[1]), pack2(o[2], o[3])};
                }
            }
        }
    }
}

__device__ __forceinline__ void store_tile_bf16(const f32x4 (&acc)[4][4], bf16_t* __restrict__ dst, long ld) {
    const int tid = tid_(), wid = tid >> 6, lane = tid & 63, wr = wid >> 1, wc = wid & 1, fr = lane & 15, fq = lane >> 4;
#pragma unroll
    for (int m = 0; m < 4; ++m)
#pragma unroll
        for (int n = 0; n < 4; ++n) {
            const f32x4 v = acc[m][n];
            *(u32x2*)(dst + (long)(wr * 64 + m * 16 + fr) * ld + wc * 64 + n * 16 + fq * 4) = (u32x2){pack2(v[0], v[1]), pack2(v[2], v[3])};
        }
}
__device__ __forceinline__ void resid_tile(const f32x4 (&acc)[4][4], float* __restrict__ h, int row0, int col0, const float* __restrict__ gate) {
    const int tid = tid_(), wid = tid >> 6, lane = tid & 63, wr = wid >> 1, wc = wid & 1, fr = lane & 15, fq = lane >> 4;
    const int b = row0 >> 11;
#pragma unroll
    for (int n = 0; n < 4; ++n) {
        const int col = col0 + wc * 64 + n * 16 + fq * 4;
        const f32x4 gv = *(const f32x4*)(gate + (size_t)b * 6144 + col);
#pragma unroll
        for (int m = 0; m < 4; ++m) {
            float* hp = h + (size_t)(row0 + wr * 64 + m * 16 + fr) * DM + col;
            const f32x4 o = *(const f32x4*)hp + gv * acc[m][n];
            *(f32x4*)hp = o;
        }
    }
}
__device__ __forceinline__ void store_tile2_bf16(const f32x4 (&acc)[8][4], bf16_t* __restrict__ dst, long ld) {
    const int tid = tid_(), wid = tid >> 6, lane = tid & 63, wr = wid >> 1, wc = wid & 1, fr = lane & 15, fq = lane >> 4;
#pragma unroll
    for (int m = 0; m < 8; ++m)
#pragma unroll
        for (int n = 0; n < 4; ++n) {
            const f32x4 v = acc[m][n];
            *(u32x2*)(dst + (long)(wr * 128 + m * 16 + fr) * ld + wc * 64 + n * 16 + fq * 4) = (u32x2){pack2(v[0], v[1]), pack2(v[2], v[3])};
        }
}
__device__ __forceinline__ void resid_tile2(const f32x4 (&acc)[8][4], float* __restrict__ h, int row0, int col0, const float* __restrict__ gate) {
    const int tid = tid_(), wid = tid >> 6, lane = tid & 63, wr = wid >> 1, wc = wid & 1, fr = lane & 15, fq = lane >> 4;
    const int b = row0 >> 11;
#pragma unroll
    for (int n = 0; n < 4; ++n) {
        const int col = col0 + wc * 64 + n * 16 + fq * 4;
        const f32x4 gv = *(const f32x4*)(gate + (size_t)b * 6144 + col);
#pragma unroll
        for (int m = 0; m < 8; ++m) {
            float* hp = h + (size_t)(row0 + wr * 128 + m * 16 + fr) * DM + col;
            const f32x4 o = *(const f32x4*)hp + gv * acc[m][n];
            *(f32x4*)hp = o;
        }
    }
}
__device__ void ph_gemm_p(const Params& P, char* lds) {
    const bf16_t* U = (const bf16_t*)(P.ws + OFF_U); const bf16_t* Wt = (const bf16_t*)(P.ws + WT_WIN);
    bf16_t* prw = (bf16_t*)(P.ws + OFF_PRW); bf16_t* prest = (bf16_t*)(P.ws + OFF_PREST);
    for (int item = bid_(); item < 128 * 55; item += gridDim.x) {
        const int mt = item / 55, nt = item % 55;
        f32x4 acc[8][4]; zero_acc2(acc);
        gemm_acc2(U + (size_t)mt * 256 * DM, DM, Wt + (size_t)nt * 128 * DM, DM, DM, acc, lds);
        if (nt < 14) store_tile2_bf16(acc, prw + (size_t)mt * 256 * PRW_LD + nt * 128, PRW_LD);
        else store_tile2_bf16(acc, prest + (size_t)mt * 256 * PREST_LD + (nt - 14) * 128, PREST_LD);
    }
}
__device__ void ph_gemm_merge(const Params& P, char* lds) {
    const bf16_t* U = (const bf16_t*)(P.ws + OFF_URE); const bf16_t* Wt = (const bf16_t*)(P.ws + WT_WIN); const bf16_t* Wb = (const bf16_t*)(P.ws + WT_WB);
    bf16_t* mg = (bf16_t*)(P.ws + OFF_MERGED);
    for (int item = bid_(); item < 256 * 8; item += gridDim.x) {
        const int mt = item / 8, nt = item % 8;
        unsigned mpk[4][4][2];
#pragma unroll
        for (int m = 0; m < 4; ++m)
#pragma unroll
            for (int q = 0; q < 4; ++q) { mpk[m][q][0] = 0u; mpk[m][q][1] = 0u; }
#pragma unroll 1
        for (int n = 0; n < 4; ++n) {
            unsigned gpk[4][4][2];
            {
                f32x4 acc[4][4]; zero_acc(acc);
                gemm_acc(U + (size_t)mt * 128 * DM, DM, Wt + (size_t)(GATE_ROW0 + n * 1024 + nt * 128) * DM, DM, DM, acc, lds);
#pragma unroll
                for (int m = 0; m < 4; ++m)
#pragma unroll
                    for (int q = 0; q < 4; ++q) { gpk[m][q][0] = pack2(sigm(acc[m][q][0]), sigm(acc[m][q][1])); gpk[m][q][1] = pack2(sigm(acc[m][q][2]), sigm(acc[m][q][3])); }
            }
            const size_t yoff = (n == 0) ? OFF_Y0 : (n == 1 ? OFF_YB : (n == 2 ? OFF_YC : OFF_YD));
            const bf16_t* Y = (const bf16_t*)(P.ws + yoff);
            f32x4 acc[4][4]; zero_acc(acc);
            gemm_acc(Y + (size_t)mt * 128 * 512, 512, Wb + ((size_t)n * 1024 + nt * 128) * 512, 512, 512, acc, lds);
#pragma unroll
            for (int m = 0; m < 4; ++m)
#pragma unroll
                for (int q = 0; q < 4; ++q) {
                    mpk[m][q][0] = pack2(lo2f(mpk[m][q][0]) + lo2f(gpk[m][q][0]) * acc[m][q][0], hi2f(mpk[m][q][0]) + hi2f(gpk[m][q][0]) * acc[m][q][1]);
                    mpk[m][q][1] = pack2(lo2f(mpk[m][q][1]) + lo2f(gpk[m][q][1]) * acc[m][q][2], hi2f(mpk[m][q][1]) + hi2f(gpk[m][q][1]) * acc[m][q][3]);
                }
        }
        {
            const int tid = tid_(), wid = tid >> 6, lane = tid & 63, wr = wid >> 1, wc = wid & 1, fr = lane & 15, fq = lane >> 4;
            bf16_t* dst = mg + (size_t)mt * 128 * DM + nt * 128;
#pragma unroll
            for (int m = 0; m < 4; ++m)
#pragma unroll
                for (int q = 0; q < 4; ++q) *(u32x2*)(dst + (long)(wr * 64 + m * 16 + fr) * DM + wc * 64 + q * 16 + fq * 4) = (u32x2){mpk[m][q][0], mpk[m][q][1]};
        }
    }
}
__device__ void ph_gemm_out(const Params& P, int l, char* lds) {
    const bf16_t* A = (const bf16_t*)(P.ws + OFF_MERGED); const bf16_t* Wt = (const bf16_t*)(P.ws + WT_WOUT);
    const float* gate = (const float*)(P.ws + OFF_MOD) + (size_t)l * 16 * 6144 + 2048;
    for (int item = bid_(); item < 256 * 8; item += gridDim.x) {
        const int mt = item / 8, nt = item % 8;
        f32x4 acc[4][4]; zero_acc(acc);
        gemm_acc(A + (size_t)mt * 128 * DM, DM, Wt + (size_t)nt * 128 * DM, DM, DM, acc, lds);
        resid_tile(acc, P.out, mt * 128, nt * 128, gate);
    }
}
__device__ void ph_gemm_up(const Params& P, char* lds) {
    const bf16_t* A = (const bf16_t*)(P.ws + OFF_U2); const bf16_t* Wt = (const bf16_t*)(P.ws + WT_WUP);
    bf16_t* Z = (bf16_t*)(P.ws + OFF_Z);
    for (int item = bid_(); item < 128 * 44; item += gridDim.x) {
        const int mt = item / 44, nt = item % 44;
        f32x4 acc[8][4]; zero_acc2(acc);
        gemm_acc2(A + (size_t)mt * 256 * DM, DM, Wt + (size_t)nt * 128 * DM, DM, DM, acc, lds);
        store_tile2_bf16(acc, Z + (size_t)mt * 256 * 5632 + nt * 128, 5632);
    }
}
__device__ void ph_gemm_down(const Params& P, int l, char* lds) {
    const bf16_t* A = (const bf16_t*)(P.ws + OFF_ACT); const bf16_t* Wt = (const bf16_t*)(P.ws + WT_WDN);
    const float* gate = (const float*)(P.ws + OFF_MOD) + (size_t)l * 16 * 6144 + 5120;
    for (int item = bid_(); item < 128 * 8; item += gridDim.x) {
        const int mt = item / 8, nt = item % 8;
        f32x4 acc[8][4]; zero_acc2(acc);
        gemm_acc2(A + (size_t)mt * 256 * DFF, DFF, Wt + (size_t)nt * 128 * DFF, DFF, DFF, acc, lds);
        resid_tile2(acc, P.out, mt * 256, nt * 128, gate);
    }
}
__device__ void ph_convact(const Params& P, int l) {
    const bf16_t* Z = (const bf16_t*)(P.ws + OFF_Z); bf16_t* ACT = (bf16_t*)(P.ws + OFF_ACT);
    const float* cw = P.in[I_FCW] + (size_t)l * 3 * 5632; const float* cb = P.in[I_FCB] + (size_t)l * 5632;
    const long ntask = (long)(TT / 64) * 352;
    for (long task = (long)bid_() * NT + tid_(); task < ntask; task += (long)gridDim.x * NT) {
        const int tile = (int)(task / 352), cgp = (int)(task % 352), c0 = cgp * 8;
        const int t0 = tile * 64, s0 = t0 & (SQ - 1);
        float wv[3][8], wg[3][8], bv[8], bg[8];
#pragma unroll
        for (int j = 0; j < 3; ++j)
#pragma unroll
            for (int e = 0; e < 8; ++e) { wv[j][e] = cw[j * 5632 + c0 + e]; wg[j][e] = cw[j * 5632 + DFF + c0 + e]; }
#pragma unroll
        for (int e = 0; e < 8; ++e) { bv[e] = cb[c0 + e]; bg[e] = cb[DFF + c0 + e]; }
        float pv[8], pg[8], cv[8], cg_[8], nv[8], ng[8];
        const u32x4 zero4 = (u32x4){0u, 0u, 0u, 0u};
        {
            u32x4 a = zero4, b = zero4;
            if (s0 > 0) { a = *(const u32x4*)(Z + (size_t)(t0 - 1) * 5632 + c0); b = *(const u32x4*)(Z + (size_t)(t0 - 1) * 5632 + DFF + c0); }
            unpack8(a, pv); unpack8(b, pg);
            a = *(const u32x4*)(Z + (size_t)t0 * 5632 + c0); b = *(const u32x4*)(Z + (size_t)t0 * 5632 + DFF + c0);
            unpack8(a, cv); unpack8(b, cg_);
        }
#pragma unroll 8
        for (int r = 0; r < 64; ++r) {
            const int t = t0 + r;
            u32x4 a = zero4, b = zero4;
            if (s0 + r + 1 < SQ) { a = *(const u32x4*)(Z + (size_t)(t + 1) * 5632 + c0); b = *(const u32x4*)(Z + (size_t)(t + 1) * 5632 + DFF + c0); }
            unpack8(a, nv); unpack8(b, ng);
            float o[8];
#pragma unroll
            for (int e = 0; e < 8; ++e) {
                const float v = wv[0][e] * pv[e] + wv[1][e] * cv[e] + wv[2][e] * nv[e] + bv[e];
                const float g = wg[0][e] * pg[e] + wg[1][e] * cg_[e] + wg[2][e] * ng[e] + bg[e];
                o[e] = v * silu(g);
                pv[e] = cv[e]; cv[e] = nv[e]; pg[e] = cg_[e]; cg_[e] = ng[e];
            }
            *(u32x4*)(ACT + (size_t)t * DFF + c0) = (u32x4){pack2(o[0], o[1]), pack2(o[2], o[3]), pack2(o[4], o[5]), pack2(o[6], o[7])};
        }
    }
}

__device__ void mx_rwkv(const Params& P, int l, int item, char* lds) {
    const int tid = tid_(), wid = tid >> 6, lane = tid & 63, fr = lane & 15, fq = lane >> 4;
    const int d = item & 1, h = (item >> 1) & 7, b = item >> 4;
    const bf16_t* prw = (const bf16_t*)(P.ws + OFF_PRW) + (size_t)b * SQ * PRW_LD;
    bf16_t* Yd = (bf16_t*)(P.ws + (d ? OFF_Y1 : OFF_Y0)) + (size_t)b * SQ * 512 + h * 64;
    float* beta = (float*)(P.ws + OFF_BETA) + ((size_t)d * TT + (size_t)b * SQ) * 8 + h;
    float* VA = (float*)lds; float* VWR = VA + 1024; float* VW = VWR + 1024; float* VB = VW + 1024; float* VK = VB + 1024; float* VV = VK + 1024; float* VG = VV + 1024;
    float* SC = VG + 1024;
    bf16_t* RAW = (bf16_t*)(SC + 32);
    bf16_t* AT = RAW + 18 * 320;
    const int s = tid >> 4, jg = tid & 15, j0 = jg * 4;
    float mu[5][4], kkc[4], kac[4], rkc[4];
#pragma unroll
    for (int sg = 0; sg < 5; ++sg) {
        const int base = (sg < 3) ? sg * 512 + h * 64 : 1536 + (sg - 3) * 64;
#pragma unroll
        for (int i = 0; i < 4; ++i) mu[sg][i] = P.in[I_MU][l * 1792 + base + j0 + i];
    }
#pragma unroll
    for (int i = 0; i < 4; ++i) { kkc[i] = P.in[I_KK][l * 512 + h * 64 + j0 + i]; kac[i] = P.in[I_KA][l * 512 + h * 64 + j0 + i]; rkc[i] = P.in[I_RK][l * 512 + h * 64 + j0 + i]; }
    const int mt = wid >> 1, ntb = (wid & 1) * 2;
    bf16x8 bw[2][2]; float bsv[2][4];
    {
        const bf16_t* WT2 = (const bf16_t*)(P.ws + (mt ? WT_A2 : WT_W2)) + (size_t)d * 512 * 64;
        const float* bias = P.in[mt ? I_A0 : I_W0] + (size_t)(l * 2 + d) * 512 + h * 64;
#pragma unroll
        for (int nt = 0; nt < 2; ++nt) {
#pragma unroll
            for (int ks = 0; ks < 2; ++ks) bw[nt][ks] = ldfrag(WT2 + (size_t)(h * 64 + (ntb + nt) * 16 + fr) * 64 + ks * 32 + fq * 8);
#pragma unroll
            for (int jj = 0; jj < 4; ++jj) bsv[nt][jj] = bias[(ntb + nt) * 16 + fq * 4 + jj];
        }
    }
    float S[4][4];
#pragma unroll
    for (int i = 0; i < 4; ++i)
#pragma unroll
        for (int j = 0; j < 4; ++j) S[i][j] = 0.f;
    u32x4 pre[3];
    auto load_raw = [&](int c) {
        const int t0 = d ? SQ - 16 * (c + 1) : 16 * c;
#pragma unroll
        for (int i = 0; i < 3; ++i) {
            const int vi = tid + 256 * i;
            pre[i] = (u32x4){0u, 0u, 0u, 0u};
            if (vi < 720) {
                const int rr = vi / 40, rem = vi % 40, sg = rem >> 3, e = rem & 7, t = t0 - 1 + rr;
                const int col = ((sg < 3) ? sg * 512 + h * 64 : 1536 + (sg - 3) * 64) + e * 8;
                if (t >= 0 && t < SQ) pre[i] = *(const u32x4*)(prw + (size_t)t * PRW_LD + col);
            }
        }
    };
    __syncthreads();
    load_raw(0);
#pragma unroll 1
    for (int c = 0; c < 128; ++c) {
        const int t0 = d ? SQ - 16 * (c + 1) : 16 * c;
#pragma unroll
        for (int i = 0; i < 3; ++i) {
            const int vi = tid + 256 * i;
            if (vi < 720) { const int rr = vi / 40, rem = vi % 40; *(u32x4*)(RAW + rr * 320 + rem * 8) = pre[i]; }
        }
        __syncthreads();
        if (c + 1 < 128) load_raw(c + 1);
        float rs[4], ks_[4], vs[4], kk[4];
        {
            float sh[5][4];
#pragma unroll
            for (int sg = 0; sg < 5; ++sg) {
                float fm[4], f0[4], fp[4];
                unpack4(*(const u32x2*)(RAW + s * 320 + sg * 64 + j0), fm);
                unpack4(*(const u32x2*)(RAW + (s + 1) * 320 + sg * 64 + j0), f0);
                unpack4(*(const u32x2*)(RAW + (s + 2) * 320 + sg * 64 + j0), fp);
#pragma unroll
                for (int i = 0; i < 4; ++i) sh[sg][i] = f0[i] + mu[sg][i] * (0.5f * (fm[i] + fp[i]) - f0[i]);
            }
            float ssq = 0.f, q[4];
#pragma unroll
            for (int i = 0; i < 4; ++i) { rs[i] = sh[0][i]; ks_[i] = sh[1][i]; vs[i] = sh[2][i]; q[i] = ks_[i] * kkc[i]; ssq += q[i] * q[i]; }
            *(u32x2*)(AT + s * 72 + j0) = (u32x2){pack2(tanh_f(sh[3][0]), tanh_f(sh[3][1])), pack2(tanh_f(sh[3][2]), tanh_f(sh[3][3]))};
            *(u32x2*)(AT + 16 * 72 + s * 72 + j0) = (u32x2){pack2(sh[4][0], sh[4][1]), pack2(sh[4][2], sh[4][3])};
            ssq = rowsum16(ssq);
            const float inv = __builtin_amdgcn_rsqf(fmaxf(ssq, 1e-24f));
#pragma unroll
            for (int i = 0; i < 4; ++i) kk[i] = q[i] * inv;
        }
        __syncthreads();
        {
            const bf16_t* At = AT + mt * 16 * 72;
            const bf16x8 a0 = ldfrag(At + fr * 72 + fq * 8), a1 = ldfrag(At + fr * 72 + 32 + fq * 8);
            float* dstv = mt ? VG : VW;
#pragma unroll
            for (int nt = 0; nt < 2; ++nt) {
                f32x4 acc = (f32x4){0.f, 0.f, 0.f, 0.f};
                acc = mfma16(bw[nt][0], a0, acc); acc = mfma16(bw[nt][1], a1, acc);
                f32x4 o;
#pragma unroll
                for (int jj = 0; jj < 4; ++jj) {
                    const float x = acc[jj] + bsv[nt][jj];
                    if (mt == 0) { const float wl = fminf(x, 0.f) - flog_(1.f + __expf(-fabsf(x))) - 0.5f; o[jj] = __expf(-__expf(wl)); }
                    else o[jj] = sigm(x);
                }
                *(f32x4*)(dstv + fr * 64 + (ntb + nt) * 16 + fq * 4) = o;
            }
        }
        __syncthreads();
        {
            const f32x4 w4 = *(const f32x4*)(VW + s * 64 + j0), g4 = *(const f32x4*)(VG + s * 64 + j0);
            f32x4 bb, kt, wr, na, vv;
            float pbr = 0.f, pkr = 0.f, pbe = 0.f;
#pragma unroll
            for (int i = 0; i < 4; ++i) {
                bb[i] = kk[i] * g4[i]; kt[i] = ks_[i] * (1.f + (g4[i] - 1.f) * kac[i]); wr[i] = w4[i] * rs[i]; na[i] = -kk[i]; vv[i] = vs[i];
                pbr += bb[i] * rs[i]; pkr += kt[i] * rs[i]; pbe += rs[i] * kt[i] * rkc[i];
            }
            pbr = rowsum16(pbr); pkr = rowsum16(pkr); pbe = rowsum16(pbe);
            *(f32x4*)(VA + s * 64 + j0) = na; *(f32x4*)(VWR + s * 64 + j0) = wr; *(f32x4*)(VB + s * 64 + j0) = bb; *(f32x4*)(VK + s * 64 + j0) = kt; *(f32x4*)(VV + s * 64 + j0) = vv;
            if (jg == 0) { SC[s * 2] = pbr; SC[s * 2 + 1] = pkr; beta[(size_t)(t0 + s) * 8] = pbe; }
        }
        __syncthreads();
#pragma unroll 1
        for (int st = 0; st < 16; ++st) {
            const int sp = d ? 15 - st : st;
            const f32x4 a4 = *(const f32x4*)(VA + sp * 64 + j0), wr4 = *(const f32x4*)(VWR + sp * 64 + j0), w4 = *(const f32x4*)(VW + sp * 64 + j0);
            const f32x4 b4 = *(const f32x4*)(VB + sp * 64 + j0), k4 = *(const f32x4*)(VK + sp * 64 + j0), v4 = *(const f32x4*)(VV + sp * 64 + s * 4);
            const float br = SC[sp * 2], kr = SC[sp * 2 + 1];
            float psa[4], py[4];
            typedef float f32x2 __attribute__((ext_vector_type(2)));
            const f32x2 a01 = {a4[0], a4[1]}, a23 = {a4[2], a4[3]}, r01 = {wr4[0], wr4[1]}, r23 = {wr4[2], wr4[3]};
#pragma unroll
            for (int i = 0; i < 4; ++i) {
                const f32x2 s01 = {S[i][0], S[i][1]}, s23 = {S[i][2], S[i][3]};
                f32x2 ta = s01 * a01; ta = s23 * a23 + ta;
                f32x2 ty = s01 * r01; ty = s23 * r23 + ty;
                psa[i] = ta.x + ta.y; py[i] = ty.x + ty.y;
            }
#define RS8(CTRL) asm volatile("s_nop 1\n\tv_add_f32_dpp %0, %0, %0 " CTRL " row_mask:0xf bank_mask:0xf\n\tv_add_f32_dpp %1, %1, %1 " CTRL " row_mask:0xf bank_mask:0xf\n\tv_add_f32_dpp %2, %2, %2 " CTRL " row_mask:0xf bank_mask:0xf\n\tv_add_f32_dpp %3, %3, %3 " CTRL " row_mask:0xf bank_mask:0xf\n\tv_add_f32_dpp %4, %4, %4 " CTRL " row_mask:0xf bank_mask:0xf\n\tv_add_f32_dpp %5, %5, %5 " CTRL " row_mask:0xf bank_mask:0xf\n\tv_add_f32_dpp %6, %6, %6 " CTRL " row_mask:0xf bank_mask:0xf\n\tv_add_f32_dpp %7, %7, %7 " CTRL " row_mask:0xf bank_mask:0xf" : "+v"(psa[0]), "+v"(psa[1]), "+v"(psa[2]), "+v"(psa[3]), "+v"(py[0]), "+v"(py[1]), "+v"(py[2]), "+v"(py[3]))
            RS8("row_ror:8"); RS8("row_ror:4"); RS8("row_ror:2"); RS8("row_ror:1");
            asm volatile("s_nop 1" ::: "memory");
            float y[4];
#pragma unroll
            for (int i = 0; i < 4; ++i) {
                y[i] = py[i] + psa[i] * br + v4[i] * kr;
#pragma unroll
                for (int j = 0; j < 4; ++j) S[i][j] = S[i][j] * w4[j] + (psa[i] * b4[j] + v4[i] * k4[j]);
            }
            if (jg == 0) *(u32x2*)(Yd + (size_t)(t0 + sp) * 512 + s * 4) = (u32x2){pack2(y[0], y[1]), pack2(y[2], y[3])};
        }
    }
    __syncthreads();
}

__device__ void mx_mlstm(const Params& P, int l, int item, char* lds) {
    const int tid = tid_(), wid = tid >> 6, lane = tid & 63, fr = lane & 15, fq = lane >> 4;
    const int b = item >> 3, h = (item >> 1) & 3, dsel = item & 1;
    const bf16_t* pr = (const bf16_t*)(P.ws + OFF_PREST) + (size_t)b * SQ * PREST_LD;
    bf16_t* YB = (bf16_t*)(P.ws + (dsel ? OFF_YB : OFF_Y1)) + (size_t)b * SQ * 512 + h * 128;
    bf16_t* Q = (bf16_t*)lds; bf16_t* KP = Q + 64 * 72; bf16_t* KWT = KP + 64 * 72; bf16_t* VT = KWT + 64 * 72; bf16_t* CT = VT + 128 * 72;
    float* NS = (float*)(CT + 128 * 72); float* E = NS + 64; float* MM = E + 64; float* SI = MM + 64; float* WI = SI + 64; float* FL = WI + 64; float* DEC = FL + 64;
    const int i = wid * 16 + fr;
#pragma unroll 1
    for (int d = dsel; d <= dsel; ++d) {
        f32x4 Cacc[8];
#pragma unroll
        for (int dt = 0; dt < 8; ++dt) Cacc[dt] = (f32x4){0.f, 0.f, 0.f, 0.f};
        __syncthreads();
        for (int e = tid; e < 128 * 72 / 2; e += NT) ((unsigned*)CT)[e] = 0u;
        if (tid < 64) NS[tid] = 0.f;
        float m_st = 0.f;
        const float ib = P.in[I_MLIB][(l * 2 + d) * 4 + h], fb = P.in[I_MLFB][(l * 2 + d) * 4 + h];
        __syncthreads();
#pragma unroll 1
        for (int c = 0; c < 32; ++c) {
            const int t0 = d ? SQ - 64 * (c + 1) : 64 * c;
#define TROW(ii) (d ? t0 + 63 - (ii) : t0 + (ii))
            if (wid == 0) {
                const int t = TROW(lane);
                const float fg = bf2f(pr[(size_t)t * PREST_LD + 1544 + d * 4 + h]) + fb, ig = bf2f(pr[(size_t)t * PREST_LD + 1536 + d * 4 + h]) + ib;
                float bc = logsig(fg);
#pragma unroll
                for (int o = 1; o < 64; o <<= 1) { const float x = bperm(bc, lane - o); if (lane >= o) bc += x; }
                const float e = ig - bc; float pm = e;
#pragma unroll
                for (int o = 1; o < 64; o <<= 1) { const float x = bperm(pm, lane - o); if (lane >= o) pm = fmaxf(pm, x); }
                const float gend = rdlane(bc, 63), pmax = rdlane(pm, 63);
                const float mnew = fmaxf(gend + m_st, gend + pmax);
                const float M = fmaxf(m_st, pm);
                E[lane] = e; MM[lane] = M; SI[lane] = __expf(m_st - M); WI[lane] = __expf(gend + e - mnew); FL[lane] = __expf(-(bc + M));
                if (lane == 0) DEC[0] = __expf(gend + m_st - mnew);
                m_st = mnew;
            }
            __syncthreads();
#pragma unroll
            for (int it = 0; it < 2; ++it) {
                const int vi = tid + 256 * it, ii = vi >> 3, e = vi & 7, t = TROW(ii);
                float f[8];
                unpack8(*(const u32x4*)(pr + (size_t)t * PREST_LD + h * 64 + e * 8), f);
                *(u32x4*)(Q + ii * 72 + e * 8) = (u32x4){pack2(f[0] * 0.125f, f[1] * 0.125f), pack2(f[2] * 0.125f, f[3] * 0.125f), pack2(f[4] * 0.125f, f[5] * 0.125f), pack2(f[6] * 0.125f, f[7] * 0.125f)};
                const u32x4 kv = *(const u32x4*)(pr + (size_t)t * PREST_LD + 256 + h * 64 + e * 8);
                *(u32x4*)(KP + ii * 72 + e * 8) = kv;
                unpack8(kv, f);
                const float wi = WI[ii];
#pragma unroll
                for (int x = 0; x < 8; ++x) KWT[(e * 8 + x) * 72 + ii] = f2bf(f[x] * wi);
            }
#pragma unroll
            for (int it = 0; it < 4; ++it) {
                const int vi = tid + 256 * it, ii = vi >> 4, e = vi & 15, t = TROW(ii);
                const u32x4 vv = *(const u32x4*)(pr + (size_t)t * PREST_LD + 512 + h * 128 + e * 8);
                VT[(e * 8 + 0) * 72 + ii] = (bf16_t)(vv.x & 0xffff); VT[(e * 8 + 1) * 72 + ii] = (bf16_t)(vv.x >> 16);
                VT[(e * 8 + 2) * 72 + ii] = (bf16_t)(vv.y & 0xffff); VT[(e * 8 + 3) * 72 + ii] = (bf16_t)(vv.y >> 16);
                VT[(e * 8 + 4) * 72 + ii] = (bf16_t)(vv.z & 0xffff); VT[(e * 8 + 5) * 72 + ii] = (bf16_t)(vv.z >> 16);
                VT[(e * 8 + 6) * 72 + ii] = (bf16_t)(vv.w & 0xffff); VT[(e * 8 + 7) * 72 + ii] = (bf16_t)(vv.w >> 16);
            }
            __syncthreads();
            f32x4 sacc[4];
#pragma unroll
            for (int st = 0; st < 4; ++st) sacc[st] = (f32x4){0.f, 0.f, 0.f, 0.f};
#pragma unroll
            for (int ks = 0; ks < 2; ++ks) {
                const bf16x8 qf = ldfrag(Q + i * 72 + ks * 32 + fq * 8);
#pragma unroll
                for (int st = 0; st < 4; ++st) sacc[st] = mfma16(ldfrag(KP + (st * 16 + fr) * 72 + ks * 32 + fq * 8), qf, sacc[st]);
            }
            const float Mi = MM[i], si = SI[i];
            float rsum = 0.f; unsigned pwp[4][2];
#pragma unroll
            for (int st = 0; st < 4; ++st) {
                float pw[4];
#pragma unroll
                for (int jj = 0; jj < 4; ++jj) { const int sx = st * 16 + fq * 4 + jj; pw[jj] = (sx <= i) ? __expf(E[sx] - Mi) * sacc[st][jj] : 0.f; rsum += pw[jj]; }
                pwp[st][0] = pack2(pw[0], pw[1]); pwp[st][1] = pack2(pw[2], pw[3]);
            }
            rsum = qsum(rsum, lane);
            float qn = 0.f;
            {
                float f[8];
                unpack8(*(const u32x4*)(Q + i * 72 + fq * 16), f);
#pragma unroll
                for (int x = 0; x < 8; ++x) qn += f[x] * NS[fq * 16 + x];
                unpack8(*(const u32x4*)(Q + i * 72 + fq * 16 + 8), f);
#pragma unroll
                for (int x = 0; x < 8; ++x) qn += f[x] * NS[fq * 16 + 8 + x];
            }
            qn = qsum(qn, lane);
            const float den = si * qn + rsum;
            const float rinv = rcpf_(fmaxf(fabsf(den), FL[i]));
            __syncthreads();
#pragma unroll
            for (int st = 0; st < 4; ++st) *(u32x2*)(KP + i * 72 + st * 16 + fq * 4) = (u32x2){pwp[st][0], pwp[st][1]};
            __syncthreads();
            f32x4 oacc[8];
#pragma unroll
            for (int dt = 0; dt < 8; ++dt) oacc[dt] = (f32x4){0.f, 0.f, 0.f, 0.f};
#pragma unroll
            for (int ks = 0; ks < 2; ++ks) {
                const bf16x8 qf = ldfrag(Q + i * 72 + ks * 32 + fq * 8);
#pragma unroll
                for (int dt = 0; dt < 8; ++dt) oacc[dt] = mfma16(ldfrag(CT + (dt * 16 + fr) * 72 + ks * 32 + fq * 8), qf, oacc[dt]);
            }
#pragma unroll
            for (int dt = 0; dt < 8; ++dt) oacc[dt] *= si;
#pragma unroll
            for (int ks = 0; ks < 2; ++ks) {
                const bf16x8 pf = ldfrag(KP + i * 72 + ks * 32 + fq * 8);
#pragma unroll
                for (int dt = 0; dt < 8; ++dt) oacc[dt] = mfma16(ldfrag(VT + (dt * 16 + fr) * 72 + ks * 32 + fq * 8), pf, oacc[dt]);
            }
            {
                const int t = TROW(i);
                bf16_t* yp = YB + (size_t)t * 512 + fq * 4;
                {
#pragma unroll
                    for (int dt = 0; dt < 8; ++dt) { const f32x4 v = oacc[dt] * rinv; *(u32x2*)(yp + dt * 16) = (u32x2){pack2(v[0], v[1]), pack2(v[2], v[3])}; }
                }
            }
            __syncthreads();
            {
                const float dec = DEC[0];
#pragma unroll
                for (int dt = 0; dt < 8; ++dt) Cacc[dt] *= dec;
#pragma unroll
                for (int ks = 0; ks < 2; ++ks) {
                    const bf16x8 kf = ldfrag(KWT + (wid * 16 + fr) * 72 + ks * 32 + fq * 8);
#pragma unroll
                    for (int dt = 0; dt < 8; ++dt) Cacc[dt] = mfma16(kf, ldfrag(VT + (dt * 16 + fr) * 72 + ks * 32 + fq * 8), Cacc[dt]);
                }
#pragma unroll
                for (int dt = 0; dt < 8; ++dt) *(u32x2*)(CT + (dt * 16 + fr) * 72 + wid * 16 + fq * 4) = (u32x2){pack2(Cacc[dt][0], Cacc[dt][1]), pack2(Cacc[dt][2], Cacc[dt][3])};
                if (tid < 64) {
                    float n = dec * NS[tid];
#pragma unroll
                    for (int x = 0; x < 8; ++x) { float f[8]; unpack8(*(const u32x4*)(KWT + tid * 72 + x * 8), f); n += ((f[0] + f[1]) + (f[2] + f[3])) + ((f[4] + f[5]) + (f[6] + f[7])); }
                    NS[tid] = n;
                }
            }
            __syncthreads();
        }
    }
}

__device__ void mx_hgrn(const Params& P, int l, int item, char* lds) {
    const int tid = tid_(), wid = tid >> 6, lane = tid & 63, fr = lane & 15, fq = lane >> 4;
    const int b = item >> 4, h = (item >> 2) & 3, half = (item >> 1) & 1, dsel = item & 1;
    const bf16_t* pr = (const bf16_t*)(P.ws + OFF_PREST) + (size_t)b * SQ * PREST_LD + HG_O;
    bf16_t* YD = (bf16_t*)(P.ws + (dsel ? OFF_YD : OFF_Y0)) + (size_t)b * SQ * 512 + h * 128 + half * 64;
    bf16_t* QT = (bf16_t*)lds; bf16_t* KT = QT + 64 * 136; bf16_t* ATT = KT + 128 * 72; bf16_t* VT = ATT + 64 * 72; bf16_t* ST = VT + 64 * 72;
    float* TOT = (float*)(ST + 64 * 136);
    const int dk = tid & 127, hf = tid >> 7;
    const int i = wid * 16 + fr;
#pragma unroll 1
    for (int d = dsel; d <= dsel; ++d) {
        const float lbv = ((const float*)(P.ws + OFF_LB))[(l * 2 + d) * 512 + h * 128 + dk], oml = 1.f - lbv;
        f32x4 Sacc[2][4];
#pragma unroll
        for (int a = 0; a < 2; ++a)
#pragma unroll
            for (int dt = 0; dt < 4; ++dt) Sacc[a][dt] = (f32x4){0.f, 0.f, 0.f, 0.f};
        __syncthreads();
        for (int e = tid; e < 64 * 136 / 2; e += NT) ((unsigned*)ST)[e] = 0u;
        __syncthreads();
        u32x4 pff[4], pfq[4], pfv[2];
        auto hg_load = [&](int cc) {
            const int t0 = d ? SQ - 64 * (cc + 1) : 64 * cc;
#pragma unroll
            for (int it = 0; it < 4; ++it) {
                const int vi = tid + 256 * it, ii = vi >> 4, e = vi & 15, t = TROW(ii);
                pff[it] = *(const u32x4*)(pr + (size_t)t * PREST_LD + 512 * (1 + d) + h * 128 + e * 8);
                pfq[it] = *(const u32x4*)(pr + (size_t)t * PREST_LD + h * 128 + e * 8);
            }
#pragma unroll
            for (int it = 0; it < 2; ++it) {
                const int vi = tid + 256 * it, ii = vi >> 3, e = vi & 7, t = TROW(ii);
                pfv[it] = *(const u32x4*)(pr + (size_t)t * PREST_LD + 1536 + h * 128 + half * 64 + e * 8);
            }
        };
        hg_load(0);
#pragma unroll 1
        for (int c = 0; c < 32; ++c) {
            const int t0 = d ? SQ - 64 * (c + 1) : 64 * c;
#pragma unroll
            for (int it = 0; it < 4; ++it) {
                const int vi = tid + 256 * it, ii = vi >> 4, e = vi & 15;
                *(u32x4*)(KT + ii * 136 + e * 8) = pff[it];
                *(u32x4*)(QT + ii * 136 + e * 8) = pfq[it];
            }
#pragma unroll
            for (int it = 0; it < 2; ++it) {
                const int vi = tid + 256 * it, ii = vi >> 3, e = vi & 7;
                const u32x4 vv = pfv[it];
                VT[(e * 8 + 0) * 72 + ii] = (bf16_t)(vv.x & 0xffff); VT[(e * 8 + 1) * 72 + ii] = (bf16_t)(vv.x >> 16);
                VT[(e * 8 + 2) * 72 + ii] = (bf16_t)(vv.y & 0xffff); VT[(e * 8 + 3) * 72 + ii] = (bf16_t)(vv.y >> 16);
                VT[(e * 8 + 4) * 72 + ii] = (bf16_t)(vv.z & 0xffff); VT[(e * 8 + 5) * 72 + ii] = (bf16_t)(vv.z >> 16);
                VT[(e * 8 + 6) * 72 + ii] = (bf16_t)(vv.w & 0xffff); VT[(e * 8 + 7) * 72 + ii] = (bf16_t)(vv.w >> 16);
            }
            if (c + 1 < 32) hg_load(c + 1);
            __syncthreads();
            bf16_t* kp = KT + hf * 32 * 136 + dk; bf16_t* qp = QT + hf * 32 * 136 + dk;
            {
                float run = 0.f;
#pragma unroll 8
                for (int r = 0; r < 32; ++r) { const bf16_t fb = f2bf(lbv + oml * sigm(bf2f(kp[r * 136]))); kp[r * 136] = fb; run += flog_(bf2f(fb)); }
                TOT[hf * 128 + dk] = run;
            }
            __syncthreads();
            const float R = TOT[dk], gmR = TOT[128 + dk];
            {
                float g = hf ? R : 0.f;
#pragma unroll 8
                for (int r = 0; r < 32; ++r) {
                    const float fv = bf2f(kp[r * 136]);
                    g += flog_(fv);
                    const float e1 = __expf(fminf(g - R, 80.f));
                    qp[r * 136] = f2bf(silu(bf2f(qp[r * 136])) * e1);
                    kp[r * 136] = f2bf((1.f - fv) * __expf(fminf(R - g, 80.f)));
                }
                const float eR = __expf(R);
                bf16_t* sp = ST + hf * 32 * 136 + dk;
#pragma unroll 8
                for (int r = 0; r < 32; ++r) sp[r * 136] = f2bf(bf2f(sp[r * 136]) * eR);
            }
            __syncthreads();
            f32x4 oacc[4];
            unsigned kw[16];
            {
                f32x4 aacc[4];
#pragma unroll
                for (int st = 0; st < 4; ++st) { aacc[st] = (f32x4){0.f, 0.f, 0.f, 0.f}; oacc[st] = (f32x4){0.f, 0.f, 0.f, 0.f}; }
#pragma unroll
                for (int ks = 0; ks < 4; ++ks) {
                    const bf16x8 qf = ldfrag(QT + i * 136 + ks * 32 + fq * 8);
#pragma unroll
                    for (int st = 0; st < 4; ++st) aacc[st] = mfma16(ldfrag(KT + (st * 16 + fr) * 136 + ks * 32 + fq * 8), qf, aacc[st]);
#pragma unroll
                    for (int dt = 0; dt < 4; ++dt) oacc[dt] = mfma16(ldfrag(ST + (dt * 16 + fr) * 136 + ks * 32 + fq * 8), qf, oacc[dt]);
                }
#pragma unroll
                for (int st = 0; st < 4; ++st) {
                    float a[4];
#pragma unroll
                    for (int jj = 0; jj < 4; ++jj) a[jj] = (st * 16 + fq * 4 + jj <= i) ? aacc[st][jj] : 0.f;
                    *(u32x2*)(ATT + i * 72 + st * 16 + fq * 4) = (u32x2){pack2(a[0], a[1]), pack2(a[2], a[3])};
                }
#pragma unroll
                for (int r = 0; r < 16; ++r) kw[r] = (unsigned)kp[(2 * r) * 136] | ((unsigned)kp[(2 * r + 1) * 136] << 16);
            }
            __syncthreads();
            {
                u32x4* dst = (u32x4*)(KT + dk * 72 + hf * 32);
                dst[0] = (u32x4){kw[0], kw[1], kw[2], kw[3]}; dst[1] = (u32x4){kw[4], kw[5], kw[6], kw[7]};
                dst[2] = (u32x4){kw[8], kw[9], kw[10], kw[11]}; dst[3] = (u32x4){kw[12], kw[13], kw[14], kw[15]};
            }
            __syncthreads();
            {
#pragma unroll
                for (int ks = 0; ks < 2; ++ks) {
                    const bf16x8 af = ldfrag(ATT + i * 72 + ks * 32 + fq * 8);
#pragma unroll
                    for (int dt = 0; dt < 4; ++dt) oacc[dt] = mfma16(ldfrag(VT + (dt * 16 + fr) * 72 + ks * 32 + fq * 8), af, oacc[dt]);
                }
                const int t = TROW(i);
                bf16_t* yp = YD + (size_t)t * 512 + fq * 4;
#pragma unroll
                for (int dt = 0; dt < 4; ++dt) {
                    f32x4 v = oacc[dt];
                    *(u32x2*)(yp + dt * 16) = (u32x2){pack2(v[0], v[1]), pack2(v[2], v[3])};
                }
            }
#pragma unroll
            for (int a = 0; a < 2; ++a) {
                const int ktile = 2 * wid + a;
                f32x4 e1, e2;
#pragma unroll
                for (int jj = 0; jj < 4; ++jj) { const int dkk = ktile * 16 + fq * 4 + jj; e1[jj] = __expf(TOT[dkk]); e2[jj] = __expf(TOT[128 + dkk]); }
#pragma unroll
                for (int dt = 0; dt < 4; ++dt) Sacc[a][dt] *= e1;
#pragma unroll
                for (int ks = 0; ks < 2; ++ks) {
                    const bf16x8 kf = ldfrag(KT + (ktile * 16 + fr) * 72 + ks * 32 + fq * 8);
#pragma unroll
                    for (int dt = 0; dt < 4; ++dt) Sacc[a][dt] = mfma16(kf, ldfrag(VT + (dt * 16 + fr) * 72 + ks * 32 + fq * 8), Sacc[a][dt]);
                }
#pragma unroll
                for (int dt = 0; dt < 4; ++dt) {
                    Sacc[a][dt] *= e2;
                    *(u32x2*)(ST + (dt * 16 + fr) * 136 + ktile * 16 + fq * 4) = (u32x2){pack2(Sacc[a][dt][0], Sacc[a][dt][1]), pack2(Sacc[a][dt][2], Sacc[a][dt][3])};
                }
            }
            __syncthreads();
        }
    }
}

__device__ void mx_lru(const Params& P, int l, int item, char* lds) {
    const int tid = tid_(), wid = tid >> 6, lane = tid & 63, fr = lane & 15, fq = lane >> 4;
    const int b = item >> 3, g = item & 7;
    const bf16_t* pr = (const bf16_t*)(P.ws + OFF_PREST) + (size_t)b * SQ * PREST_LD + LRU_O;
    bf16_t* YC = (bf16_t*)(P.ws + OFF_YC) + (size_t)b * SQ * 512 + g * 64;
    bf16_t* XC = (bf16_t*)lds; float* AA = (float*)(lds + 9216); float* BB = AA + 64 * 65; float* HH = BB + 64 * 65;
    const int ch = tid & 63, tq = tid >> 6;
    float cwv[4];
#pragma unroll
    for (int j = 0; j < 4; ++j) cwv[j] = P.in[I_LCW][(l * 4 + j) * 512 + g * 64 + ch];
    const float cbv = P.in[I_LCB][l * 512 + g * 64 + ch];
    const int i = wid * 16 + fr;
#pragma unroll 1
    for (int d = 0; d < 2; ++d) {
        bf16x8 waf[4][2], wxf[4][2]; f32x4 ba4[4], bx4[4], c8[4];
        {
            const bf16_t* Wa = (const bf16_t*)(P.ws + WT_LRU) + (((size_t)d * 2 + 0) * 8 + g) * 4096;
            const bf16_t* Wx = (const bf16_t*)(P.ws + WT_LRU) + (((size_t)d * 2 + 1) * 8 + g) * 4096;
#pragma unroll
            for (int jt = 0; jt < 4; ++jt) {
#pragma unroll
                for (int ks = 0; ks < 2; ++ks) { waf[jt][ks] = ldfrag(Wa + (jt * 16 + fr) * 64 + ks * 32 + fq * 8); wxf[jt][ks] = ldfrag(Wx + (jt * 16 + fr) * 64 + ks * 32 + fq * 8); }
                const int j = (l * 2 + d) * 512 + g * 64 + jt * 16 + fq * 4;
                ba4[jt] = *(const f32x4*)(P.in[I_LBA] + j); bx4[jt] = *(const f32x4*)(P.in[I_LBX] + j);
                const f32x4 lam = *(const f32x4*)(P.in[I_LLAM] + j);
#pragma unroll
                for (int jj = 0; jj < 4; ++jj) c8[jt][jj] = -8.f * (fmaxf(-lam[jj], 0.f) + log1pf(__expf(-fabsf(lam[jj]))));
            }
        }
        float hst = 0.f;
        bf16_t xr[19];
        auto lru_load = [&](int cc) {
            const int t0 = d ? SQ - 64 * (cc + 1) : 64 * cc;
#pragma unroll
            for (int k = 0; k < 19; ++k) { const int t = t0 + tq * 16 - 1 + k; xr[k] = (t >= 0 && t < SQ) ? pr[(size_t)t * PREST_LD + g * 64 + ch] : (bf16_t)0; }
        };
        lru_load(0);
#pragma unroll 1
        for (int c = 0; c < 32; ++c) {
            const int t0 = d ? SQ - 64 * (c + 1) : 64 * c;
            {
                float xw[19];
#pragma unroll
                for (int k = 0; k < 19; ++k) xw[k] = bf2f(xr[k]);
                if (c + 1 < 32) lru_load(c + 1);
#pragma unroll
                for (int r = 0; r < 16; ++r) XC[(tq * 16 + r) * 72 + ch] = f2bf(cbv + cwv[0] * xw[r] + cwv[1] * xw[r + 1] + cwv[2] * xw[r + 2] + cwv[3] * xw[r + 3]);
            }
            __syncthreads();
            {
                f32x4 ra[4], rx[4];
#pragma unroll
                for (int jt = 0; jt < 4; ++jt) { ra[jt] = (f32x4){0.f, 0.f, 0.f, 0.f}; rx[jt] = (f32x4){0.f, 0.f, 0.f, 0.f}; }
#pragma unroll
                for (int ks = 0; ks < 2; ++ks) {
                    const bf16x8 xf = ldfrag(XC + i * 72 + ks * 32 + fq * 8);
#pragma unroll
                    for (int jt = 0; jt < 4; ++jt) { ra[jt] = mfma16(waf[jt][ks], xf, ra[jt]); rx[jt] = mfma16(wxf[jt][ks], xf, rx[jt]); }
                }
#pragma unroll
                for (int jt = 0; jt < 4; ++jt) {
                    float xc[4]; unpack4(*(const u32x2*)(XC + i * 72 + jt * 16 + fq * 4), xc);
#pragma unroll
                    for (int jj = 0; jj < 4; ++jj) {
                        const float la = c8[jt][jj] * sigm(ra[jt][jj] + ba4[jt][jj]);
                        const float av = __expf(la);
                        const float mult = __builtin_amdgcn_sqrtf(fmaxf(1.f - av * av, 0.f));
                        AA[i * 65 + jt * 16 + fq * 4 + jj] = av;
                        BB[i * 65 + jt * 16 + fq * 4 + jj] = mult * sigm(rx[jt][jj] + bx4[jt][jj]) * xc[jj];
                    }
                }
            }
            __syncthreads();
            if (tid < 64) {
#pragma unroll 1
                for (int r8 = 0; r8 < 8; ++r8) {
                    float av[8], bv[8];
#pragma unroll
                    for (int x = 0; x < 8; ++x) { const int r = d ? 63 - (r8 * 8 + x) : r8 * 8 + x; av[x] = AA[r * 65 + ch]; bv[x] = BB[r * 65 + ch]; }
#pragma unroll
                    for (int x = 0; x < 8; ++x) { const int r = d ? 63 - (r8 * 8 + x) : r8 * 8 + x; hst = av[x] * hst + bv[x]; HH[r * 65 + ch] = hst; }
                }
            }
            __syncthreads();
#pragma unroll
            for (int r = 0; r < 16; ++r) {
                const int ii = tq * 16 + r, t = t0 + ii;
                const float hv = HH[ii * 65 + ch];
                if (d == 0) YC[(size_t)t * 512 + ch] = f2bf(hv);
                else { const float prev = bf2f(YC[(size_t)t * 512 + ch]), gb = bf2f(pr[(size_t)t * PREST_LD + 512 + g * 64 + ch]); YC[(size_t)t * 512 + ch] = f2bf((prev + hv) * gelu_t(gb)); }
            }
        }
        __syncthreads();
    }
}

__device__ void dbg_zero(bf16_t* p, size_t n, int part, int nparts) {
    u32x4* q = (u32x4*)p; const size_t n8 = n / 8, per = (n8 + nparts - 1) / nparts, lo = per * part, hi = (lo + per < n8) ? lo + per : n8;
    for (size_t e = lo + tid_(); e < hi; e += NT) q[e] = (u32x4){0u, 0u, 0u, 0u};
}
__device__ void ph_mixers(const Params& P, int l, char* lds, int which) {
    const int nitems = 384;
    for (int item = bid_(); item < nitems; item += gridDim.x) {
        if (which) { if (item < 256) mx_rwkv(P, l, item, lds); else mx_lru(P, l, item - 256, lds); }
        else if (item < 256) mx_hgrn(P, l, item, lds);
        else mx_mlstm(P, l, item - 256, lds);
        __syncthreads();
    }
}

__device__ void ph_rwpost(const Params& P, int l, char* lds) {
    const int tid = tid_(), wid = tid >> 6, lane = tid & 63, fr = lane & 15, fq = lane >> 4;
    bf16_t* SG = (bf16_t*)lds; float* STAT = (float*)(lds + 64 * 136 * 2);
    const bf16_t* G2T = (const bf16_t*)(P.ws + WT_G2);
    const float* mu = P.in[I_MU] + l * 1792;
    for (int item = bid_(); item < TT / 64; item += gridDim.x) {
        const int tok0 = item * 64, s0 = tok0 & (SQ - 1);
        const bf16_t* prw = (const bf16_t*)(P.ws + OFF_PRW);
        bf16_t* Y0 = (bf16_t*)(P.ws + OFF_Y0); const bf16_t* Y1 = (const bf16_t*)(P.ws + OFF_Y1);
        const float* be0 = (const float*)(P.ws + OFF_BETA); const float* be1 = be0 + (size_t)TT * 8;
        __syncthreads();
        {
            const int r = tid >> 2, part = tid & 3, t = tok0 + r, sp = s0 + r;
#pragma unroll
            for (int v = 0; v < 4; ++v) {
                const int c = part * 32 + v * 8;
                float f0[8], fm[8], fp[8];
                unpack8(*(const u32x4*)(prw + (size_t)t * PRW_LD + 1664 + c), f0);
                if (sp > 0) unpack8(*(const u32x4*)(prw + (size_t)(t - 1) * PRW_LD + 1664 + c), fm); else { for (int x = 0; x < 8; ++x) fm[x] = 0.f; }
                if (sp < SQ - 1) unpack8(*(const u32x4*)(prw + (size_t)(t + 1) * PRW_LD + 1664 + c), fp); else { for (int x = 0; x < 8; ++x) fp[x] = 0.f; }
                float o[8];
#pragma unroll
                for (int x = 0; x < 8; ++x) o[x] = sigm(f0[x] + mu[1664 + c + x] * (0.5f * (fm[x] + fp[x]) - f0[x]));
                *(u32x4*)(SG + r * 136 + c) = (u32x4){pack2(o[0], o[1]), pack2(o[2], o[3]), pack2(o[4], o[5]), pack2(o[6], o[7])};
            }
#pragma unroll
            for (int hh = 0; hh < 2; ++hh) {
                const int head = part * 2 + hh;
                float sm = 0.f, sq = 0.f;
#pragma unroll
                for (int v = 0; v < 8; ++v) {
                    float a[8], bq[8];
                    unpack8(*(const u32x4*)(Y0 + (size_t)t * 512 + head * 64 + v * 8), a); unpack8(*(const u32x4*)(Y1 + (size_t)t * 512 + head * 64 + v * 8), bq);
#pragma unroll
                    for (int x = 0; x < 8; ++x) { const float y = a[x] + bq[x]; sm += y; sq += y * y; }
                }
                const float mean = sm * (1.f / 64.f), var = fmaxf(sq * (1.f / 64.f) - mean * mean, 0.f);
                STAT[(r * 8 + head) * 2] = mean; STAT[(r * 8 + head) * 2 + 1] = rsqrtf(var + 64e-5f);
            }
        }
        __syncthreads();
#pragma unroll 1
        for (int np = 0; np < 4; ++np) {
            const int nt0 = wid * 8 + np * 2;
#pragma unroll 1
            for (int tt = 0; tt < 4; ++tt) {
                f32x4 acc[2];
                acc[0] = (f32x4){0.f, 0.f, 0.f, 0.f}; acc[1] = (f32x4){0.f, 0.f, 0.f, 0.f};
#pragma unroll
                for (int ks = 0; ks < 4; ++ks) {
                    const bf16x8 b0 = ldfrag(G2T + (size_t)(nt0 * 16 + fr) * 128 + ks * 32 + fq * 8), b1 = ldfrag(G2T + (size_t)((nt0 + 1) * 16 + fr) * 128 + ks * 32 + fq * 8);
                    const bf16x8 af = ldfrag(SG + (tt * 16 + fr) * 136 + ks * 32 + fq * 8);
                    acc[0] = mfma16(b0, af, acc[0]); acc[1] = mfma16(b1, af, acc[1]);
                }
#pragma unroll
                for (int q = 0; q < 2; ++q) {
                    const int r = tt * 16 + fr, t = tok0 + r, sp = s0 + r, n = (nt0 + q) * 16 + fq * 4, head = n >> 6;
                    float y0[4], y1[4], v0[4], vm[4], vp[4];
                    unpack4(*(const u32x2*)(Y0 + (size_t)t * 512 + n), y0); unpack4(*(const u32x2*)(Y1 + (size_t)t * 512 + n), y1);
                    unpack4(*(const u32x2*)(prw + (size_t)t * PRW_LD + 1024 + n), v0);
                    if (sp > 0) unpack4(*(const u32x2*)(prw + (size_t)(t - 1) * PRW_LD + 1024 + n), vm); else { vm[0] = vm[1] = vm[2] = vm[3] = 0.f; }
                    if (sp < SQ - 1) unpack4(*(const u32x2*)(prw + (size_t)(t + 1) * PRW_LD + 1024 + n), vp); else { vp[0] = vp[1] = vp[2] = vp[3] = 0.f; }
                    const float mean = STAT[(r * 8 + head) * 2], rstd = STAT[(r * 8 + head) * 2 + 1];
                    const float be = 0.5f * (be0[(size_t)t * 8 + head] + be1[(size_t)t * 8 + head]);
                    const f32x4 lw = *(const f32x4*)(P.in[I_LNW] + l * 512 + n), lb = *(const f32x4*)(P.in[I_LNB] + l * 512 + n), m4 = *(const f32x4*)(mu + 1024 + n);
                    float o[4];
#pragma unroll
                    for (int jj = 0; jj < 4; ++jj) {
                        const float vs = v0[jj] + m4[jj] * (0.5f * (vm[jj] + vp[jj]) - v0[jj]);
                        o[jj] = (((y0[jj] + y1[jj]) - mean) * rstd * lw[jj] + lb[jj] + be * vs) * acc[q][jj];
                    }
                    *(u32x2*)(Y0 + (size_t)t * 512 + n) = (u32x2){pack2(o[0], o[1]), pack2(o[2], o[3])};
                }
            }
        }
    }
    __syncthreads();
}
template <bool ML> __device__ void ph_headpost(const Params& P, int l) {
    const int tid = tid_();
    bf16_t* YO = (bf16_t*)(P.ws + (ML ? OFF_YB : OFF_YD)); const bf16_t* SDF = (const bf16_t*)(P.ws + (ML ? OFF_Y1 : OFF_Y0));
    const bf16_t* pr = (const bf16_t*)(P.ws + OFF_PREST) + (ML ? 1024 : HG_O + 2048);
    const float* ng = P.in[ML ? I_MLN : I_HGN] + l * 512;
    for (int item = bid_(); item < TT / 64; item += gridDim.x) {
        const int t = item * 64 + (tid >> 2), part = tid & 3;
#pragma unroll 2
        for (int hh = 0; hh < 4; ++hh) {
            const int c0 = hh * 128 + part * 32;
            float v[32]; float ss = 0.f;
#pragma unroll
            for (int q = 0; q < 4; ++q) { float f[8], f2[8]; unpack8(*(const u32x4*)(YO + (size_t)t * 512 + c0 + q * 8), f); unpack8(*(const u32x4*)(SDF + (size_t)t * 512 + c0 + q * 8), f2);
#pragma unroll
                for (int x = 0; x < 8; ++x) { const float y = f[x] + f2[x]; v[q * 8 + x] = y; ss += y * y; } }
            ss += dppf<0xB1>(ss); ss += dppf<0x4E>(ss);
            const float rms = rsqrtf(ss * (1.f / 128.f) + 1e-6f);
#pragma unroll
            for (int q = 0; q < 4; ++q) {
                float gq[8]; unpack8(*(const u32x4*)(pr + (size_t)t * PREST_LD + c0 + q * 8), gq);
                float o[8];
#pragma unroll
                for (int x = 0; x < 8; ++x) o[x] = (ML ? sigm(gq[x]) : silu(gq[x])) * v[q * 8 + x] * rms * ng[c0 + q * 8 + x];
                *(u32x4*)(YO + (size_t)t * 512 + c0 + q * 8) = (u32x4){pack2(o[0], o[1]), pack2(o[2], o[3]), pack2(o[4], o[5]), pack2(o[6], o[7])};
            }
        }
    }
}

#define XB_TMO      128
#define XB_XCNT(j)  (256  + 64 * (j))
#define XB_XSUB(j)  (1280 + 64 * (j))
#define XB_XGEN(j)  (2304 + 64 * (j))
#define XB_TOP      3328
#define XB_TOPGEN   3392
#define XCD_BAR_WORDS 3456
#define XB_SPIN_CAP (1u << 18)
#define LAS __attribute__((address_space(3)))

__device__ __forceinline__ unsigned xb_ld(unsigned* p)              { return __hip_atomic_load(p, __ATOMIC_RELAXED, __HIP_MEMORY_SCOPE_AGENT); }
__device__ __forceinline__ unsigned xb_add(unsigned* p, unsigned v) { return __hip_atomic_fetch_add(p, v, __ATOMIC_RELAXED, __HIP_MEMORY_SCOPE_AGENT); }
__device__ __forceinline__ unsigned xb_xcc_id() { return (unsigned)__builtin_amdgcn_s_getreg((3 << 11) | 20) & 0xFu; }
#define XB_SPIN(cond, bar) do { unsigned _sp = 0; while (cond) { __builtin_amdgcn_s_sleep(1); \
    if ((++_sp & 255u) == 0u) { if (xb_ld(&(bar)[XB_TMO])) break; if (_sp > XB_SPIN_CAP) { atomicAdd(&(bar)[XB_TMO], 1u); break; } } } } while (0)

struct XcdBarrier {
    unsigned* bar; unsigned x;
    volatile LAS unsigned* st;
};

__device__ __forceinline__ XcdBarrier xcd_barrier_post(unsigned* bar, volatile LAS unsigned* st) {
    XcdBarrier b; b.bar = bar; b.x = xb_xcc_id(); b.st = st;
    if (threadIdx.x == 0) (void)xb_add(&bar[XB_XCNT(b.x)], 1u);
    return b;
}
__device__ __forceinline__ void xcd_barrier_complete(unsigned* bar, unsigned x, unsigned& nloc, unsigned& nx) {
    const unsigned G = gridDim.x * gridDim.y * gridDim.z;
    unsigned sum, cnt, mine, sp = 0u;
    for (;;) {
        sum = 0u; cnt = 0u; mine = 0u;
#pragma unroll
        for (unsigned j = 0; j < 16; ++j) { const unsigned c = xb_ld(&bar[XB_XCNT(j)]); sum += c; cnt += (c > 0u) ? 1u : 0u; mine = (j == x) ? c : mine; }
        if (sum == G) break;
        __builtin_amdgcn_s_sleep(1);
        if ((++sp & 255u) == 0u) { if (xb_ld(&bar[XB_TMO])) break; if (sp > XB_SPIN_CAP) { atomicAdd(&bar[XB_TMO], 1u); break; } }
    }
    nloc = mine > 0u ? mine : 1u; nx = cnt > 0u ? cnt : 1u;
}

__device__ __forceinline__ void xcd_barrier(const XcdBarrier& b) {
    asm volatile("s_waitcnt vmcnt(0)" ::: "memory");
    __syncthreads();
    if (threadIdx.x == 0) {
        unsigned* bar = b.bar;
        __builtin_amdgcn_s_waitcnt(0);
        unsigned nloc = b.st[0], nx = b.st[1];
        if (nloc == 0u) { xcd_barrier_complete(bar, b.x, nloc, nx); b.st[0] = nloc; b.st[1] = nx; }
        const unsigned old = xb_add(&bar[XB_XSUB(b.x)], 1u);
        const unsigned gen = old / nloc;
        if (old + 1u == (gen + 1u) * nloc) {
            __builtin_amdgcn_fence(__ATOMIC_RELEASE, "agent");
            asm volatile("s_waitcnt vmcnt(0)" ::: "memory");
            const unsigned og = xb_add(&bar[XB_TOP], 1u);
            const unsigned tg = og / nx;
            if (og + 1u == (tg + 1u) * nx) xb_add(&bar[XB_TOPGEN], 1u);
            else XB_SPIN(xb_ld(&bar[XB_TOPGEN]) == tg, bar);
            __builtin_amdgcn_fence(__ATOMIC_ACQUIRE, "agent");
            xb_add(&bar[XB_XGEN(b.x)], 1u);
            asm volatile("s_waitcnt vmcnt(0)" ::: "memory");
        } else {
            XB_SPIN(xb_ld(&bar[XB_XGEN(b.x)]) == gen, bar);
            __builtin_amdgcn_fence(__ATOMIC_ACQUIRE, "agent");
            asm volatile("s_waitcnt vmcnt(0)" ::: "memory");
        }
    }
    __syncthreads();
}


constexpr int N_PHASES = 2 + NL * 13;
__device__ void run_phase(const Params& P, int ph, char* lds) {
    if (ph == 0) { ph_init(P, lds); return; }
    if (ph == N_PHASES - 1) { ph_norm(P, P.in[I_FING], nullptr, 0, 0, nullptr, true); return; }
    const int l = (ph - 1) / 13; int sp = (ph - 1) % 13;
    const float* modl = (const float*)(P.ws + OFF_MOD) + (size_t)l * 16 * 6144;
    if (sp == 2) { ph_mixers(P, l, lds, 0); return; }
    if (sp == 3) { ph_headpost<false>(P, l); ph_headpost<true>(P, l); return; }
    if (sp == 4) { ph_mixers(P, l, lds, 1); return; }
    if (sp > 4) sp -= 2;
    switch (sp) {
        case 0: ph_wt(P, l, lds); ph_norm(P, P.in[I_N1G] + l * DM, modl, 0, 1024, (bf16_t*)(P.ws + OFF_U), false); break;
        case 1: ph_gemm_p(P, lds); break;
        case 3: ph_rwpost(P, l, lds); break;
        case 4: ph_norm(P, P.in[I_N1G] + l * DM, modl, 0, 1024, (bf16_t*)(P.ws + OFF_URE), false); break;
        case 5: ph_gemm_merge(P, lds); break;
        case 6: ph_gemm_out(P, l, lds); break;
        case 7: ph_norm(P, P.in[I_N2G] + l * DM, modl, 3072, 4096, (bf16_t*)(P.ws + OFF_U2), false); break;
        case 8: ph_gemm_up(P, lds); break;
        case 9: ph_convact(P, l); break;
        default: ph_gemm_down(P, l, lds); break;
    }
}

__global__ void __launch_bounds__(NT, 2) mega(Params P, int ph_lo, int ph_hi) {
    extern __shared__ __attribute__((aligned(16))) char smem[];
    cg::grid_group grid = cg::this_grid();
    volatile LAS unsigned* xst = (volatile LAS unsigned*)(smem + LDS_BYTES - 16);
    if (threadIdx.x == 0) { xst[0] = 0u; xst[1] = 0u; }
    __syncthreads();
    XcdBarrier xb = xcd_barrier_post((unsigned*)(P.ws + OFF_BAR), xst);
    for (int ph = ph_lo; ph < ph_hi; ++ph) {
        run_phase(P, ph, smem);
        if (ph + 1 < ph_hi) { if (ph == ph_lo) grid.sync(); else xcd_barrier(xb); }
    }
}

extern "C" void kernel_launch(void* const* d_in, const int* in_sizes, int n_in, void* d_out, int out_size, void* d_ws, size_t ws_size, hipStream_t stream) {
    static int grid_blocks = 0;
    if (grid_blocks == 0) {
        if (n_in != N_INPUTS || ws_size < WS_NEED || out_size != TT * DM) { fprintf(stderr, "kernel_launch: unexpected shapes (n_in %d ws %zu need %zu)\n", n_in, ws_size, (size_t)WS_NEED); grid_blocks = -1; return; }
        int dev = 0, cus = 0, per_cu = 0;
        hipGetDevice(&dev);
        hipDeviceGetAttribute(&cus, hipDeviceAttributeMultiprocessorCount, dev);
        if (hipFuncSetAttribute((const void*)mega, hipFuncAttributeMaxDynamicSharedMemorySize, LDS_BYTES) != hipSuccess) { fprintf(stderr, "kernel_launch: hipFuncSetAttribute failed\n"); grid_blocks = -1; return; }
        hipOccupancyMaxActiveBlocksPerMultiprocessor(&per_cu, (const void*)mega, NT, LDS_BYTES);
        if (per_cu < 1) per_cu = 1;
        if (per_cu > 2) per_cu = 2;
        grid_blocks = cus * per_cu;
    }
    if (grid_blocks < 0) return;
    if (hipMemsetAsync((char*)d_ws + OFF_BAR, 0, BAR_BYTES, stream) != hipSuccess) { fprintf(stderr, "kernel_launch: memset of the barrier words failed\n"); return; }
    Params p{};
    for (int i = 0; i < N_INPUTS; ++i) p.in[i] = (const float*)d_in[i];
    p.out = (float*)d_out; p.ws = (char*)d_ws;
#if MULTI_LAUNCH
    for (int ph = 0; ph < N_PHASES; ++ph) hipLaunchKernelGGL(mega, dim3(grid_blocks), dim3(NT), LDS_BYTES, stream, p, ph, ph + 1);
#else
    int lo = 0, hi = N_PHASES;
    void* args[] = {&p, &lo, &hi};
    hipError_t e = hipLaunchCooperativeKernel((const void*)mega, dim3(grid_blocks), dim3(NT), args, LDS_BYTES, stream);
    if (e != hipSuccess) fprintf(stderr, "cooperative launch failed: %s (grid %d)\n", hipGetErrorString(e), grid_blocks);
#endif
}
```

```cpp
#include <hip/hip_runtime.h>
#include <hip/hip_cooperative_groups.h>
#include <cstdio>
namespace cg = cooperative_groups;

typedef unsigned short bf16_t;
typedef short bf16x8 __attribute__((ext_vector_type(8)));
typedef float f32x4 __attribute__((ext_vector_type(4)));
typedef unsigned u32x4 __attribute__((ext_vector_type(4)));
typedef unsigned u32x2 __attribute__((ext_vector_type(2)));

#ifndef DBG_SKIP
#define DBG_SKIP 0
#endif
#ifndef DBG_NOFFN
#define DBG_NOFFN 0
#endif
#ifndef MULTI_LAUNCH
#define MULTI_LAUNCH 0
#endif

constexpr int NB = 16, SQ = 2048, DM = 1024, TT = NB * SQ, MW = 512, NL = 4;
constexpr int NT = 256;
constexpr int PRW_LD = 1792, PREST_LD = 5248;
constexpr int LRU_O = 1664, HG_O = 2688;
constexpr int GATE_ROW0 = 7040;
constexpr int DFF = 2816;
constexpr int LDS_BYTES = 73728;

constexpr size_t WT_WIN = 0;
constexpr size_t WT_WB = WT_WIN + (size_t)11136 * 1024 * 2;
constexpr size_t WT_WOUT = WT_WB + (size_t)4 * 1024 * 512 * 2;
constexpr size_t WT_WUP = WT_WOUT + (size_t)1024 * 1024 * 2;
constexpr size_t WT_WDN = WT_WUP + (size_t)5632 * 1024 * 2;
constexpr size_t WT_G2 = WT_WDN + (size_t)1024 * 2816 * 2;
constexpr size_t WT_W2 = WT_G2 + (size_t)512 * 128 * 2;
constexpr size_t WT_A2 = WT_W2 + (size_t)2 * 512 * 64 * 2;
constexpr size_t WT_LRU = WT_A2 + (size_t)2 * 512 * 64 * 2;
constexpr size_t WT_END = WT_LRU + (size_t)2 * 2 * 8 * 64 * 64 * 2;
constexpr size_t OFF_PRW = (size_t)48 << 20;
static_assert(WT_END <= OFF_PRW, "wt");
constexpr size_t OFF_PREST = OFF_PRW + (size_t)TT * PRW_LD * 2;
constexpr size_t OFF_Y = OFF_PREST + (size_t)TT * PREST_LD * 2;
constexpr size_t YSZ = (size_t)TT * 512 * 2;
constexpr size_t OFF_YB = OFF_Y, OFF_YC = OFF_Y + YSZ, OFF_YD = OFF_Y + 2 * YSZ, OFF_Y0 = OFF_Y + 3 * YSZ, OFF_Y1 = OFF_Y + 4 * YSZ;
constexpr size_t OFF_SMALL = OFF_Y + 5 * YSZ;
constexpr size_t OFF_MOD = OFF_SMALL;
constexpr size_t OFF_LB = OFF_MOD + (size_t)4 * 16 * 6144 * 4;
constexpr size_t OFF_BETA = OFF_LB + (size_t)4 * 2 * 512 * 4;
constexpr size_t OFF_BAR = OFF_BETA + (size_t)2 * TT * 8 * 4;
constexpr size_t BAR_BYTES = 16384;
constexpr size_t WS_NEED = OFF_BAR + BAR_BYTES;
constexpr size_t OFF_U = OFF_Y;
constexpr size_t OFF_URE = OFF_PREST;
constexpr size_t OFF_MERGED = OFF_PREST + (size_t)TT * 1024 * 2;
constexpr size_t OFF_U2 = OFF_Y;
constexpr size_t OFF_Z = OFF_PRW;
constexpr size_t OFF_ACT = OFF_PRW + (size_t)TT * 5632 * 2;
static_assert(OFF_ACT + (size_t)TT * 2816 * 2 <= OFF_SMALL, "act");

enum { I_X = 0, I_C, I_ADAW, I_ADAB, I_N1G, I_WIN, I_MU, I_W0, I_W2, I_A0, I_A2, I_G2, I_KK, I_KA, I_RK, I_LNW, I_LNB,
       I_MLIB, I_MLFB, I_MLN, I_LCW, I_LCB, I_LWA, I_LBA, I_LWX, I_LBX, I_LLAM, I_HGLB, I_HGN, I_WBR, I_WOUT, I_N2G,
       I_FUP, I_FCW, I_FCB, I_FDN, I_FING, N_INPUTS };

struct Params { const float* in[N_INPUTS]; float* out; char* ws; };

__device__ __forceinline__ int tid_() { int x = threadIdx.x; asm volatile("" : "+v"(x)); return x; }
__device__ __forceinline__ int bid_() { int x = blockIdx.x; asm volatile("" : "+s"(x)); return x; }
__device__ __forceinline__ bf16_t f2bf(float f) { const __bf16 h = (__bf16)f; return __builtin_bit_cast(unsigned short, h); }
__device__ __forceinline__ float bf2f(bf16_t h) { return __uint_as_float(((unsigned)h) << 16); }
typedef __bf16 bf16x2n __attribute__((ext_vector_type(2)));
typedef float f32x2n __attribute__((ext_vector_type(2)));
__device__ __forceinline__ unsigned pack2(float a, float b) { const f32x2n v = {a, b}; const bf16x2n h = __builtin_convertvector(v, bf16x2n); return __builtin_bit_cast(unsigned, h); }
__device__ __forceinline__ float lo2f(unsigned u) { return __uint_as_float(u << 16); }
__device__ __forceinline__ float hi2f(unsigned u) { return __uint_as_float(u & 0xffff0000u); }
__device__ __forceinline__ float rcpf_(float x) { return __builtin_amdgcn_rcpf(x); }
__device__ __forceinline__ float flog_(float x) { return __builtin_amdgcn_logf(x) * 0.69314718056f; }
__device__ __forceinline__ float sigm(float x) { return rcpf_(1.f + __expf(-x)); }
__device__ __forceinline__ float silu(float x) { return x * sigm(x); }
__device__ __forceinline__ float logsig(float x) { return fminf(x, 0.f) - flog_(1.f + __expf(-fabsf(x))); }
__device__ __forceinline__ float tanh_f(float x) { return 1.f - 2.f * rcpf_(1.f + __expf(2.f * x)); }
__device__ __forceinline__ float gelu_t(float x) { return 0.5f * x * (1.f + tanh_f(0.7978845608f * (x + 0.044715f * x * x * x))); }
template <int CTRL> __device__ __forceinline__ float dppf(float x) { return __int_as_float(__builtin_amdgcn_update_dpp(0, __float_as_int(x), CTRL, 0xF, 0xF, false)); }
__device__ __forceinline__ float rowsum16(float x) { x += dppf<0x128>(x); x += dppf<0x124>(x); x += dppf<0x122>(x); x += dppf<0x121>(x); return x; }
__device__ __forceinline__ float rdlane(float x, int l) { return __int_as_float(__builtin_amdgcn_readlane(__float_as_int(x), l)); }
__device__ __forceinline__ float wsum64(float x) { x = rowsum16(x); return (rdlane(x, 0) + rdlane(x, 16)) + (rdlane(x, 32) + rdlane(x, 48)); }
__device__ __forceinline__ float bperm(float x, int srclane) { return __int_as_float(__builtin_amdgcn_ds_bpermute(srclane << 2, __float_as_int(x))); }
__device__ __forceinline__ float qsum(float x, int lane) { x += bperm(x, lane ^ 16); x += bperm(x, lane ^ 32); return x; }
__device__ __forceinline__ void unpack8(u32x4 v, float (&f)[8]) {
    f[0] = lo2f(v.x); f[1] = hi2f(v.x); f[2] = lo2f(v.y); f[3] = hi2f(v.y); f[4] = lo2f(v.z); f[5] = hi2f(v.z); f[6] = lo2f(v.w); f[7] = hi2f(v.w); }
__device__ __forceinline__ void unpack4(u32x2 v, float (&f)[4]) { f[0] = lo2f(v.x); f[1] = hi2f(v.x); f[2] = lo2f(v.y); f[3] = hi2f(v.y); }
__device__ __forceinline__ f32x4 mfma16(bf16x8 a, bf16x8 b, f32x4 c) { return __builtin_amdgcn_mfma_f32_16x16x32_bf16(a, b, c, 0, 0, 0); }
__device__ __forceinline__ bf16x8 ldfrag(const bf16_t* p) { return *reinterpret_cast<const bf16x8*>(p); }

__device__ __forceinline__ void gemm_stage(const bf16_t* __restrict__ A, long lda, const bf16_t* __restrict__ Bt, long ldb, int kt, char* buf, int tid) {
#pragma unroll
    for (int i = 0; i < 4; ++i) {
        const int b = tid * 16 + i * 4096, r = b >> 7, c = ((b & 127) >> 4) ^ (r & 7);
        __builtin_amdgcn_global_load_lds((const unsigned*)(A + (long)r * lda + kt * 64 + c * 8), (__attribute__((address_space(3))) unsigned*)(buf + b), 16, 0, 0);
        __builtin_amdgcn_global_load_lds((const unsigned*)(Bt + (long)r * ldb + kt * 64 + c * 8), (__attribute__((address_space(3))) unsigned*)(buf + 16384 + b), 16, 0, 0);
    }
}
__device__ __forceinline__ void gemm_acc(const bf16_t* __restrict__ A, long lda, const bf16_t* __restrict__ Bt, long ldb, int K, f32x4 (&acc)[4][4], char* lds) {
    const int tid = tid_(), wid = tid >> 6, lane = tid & 63, wr = wid >> 1, wc = wid & 1, fr = lane & 15, fq = lane >> 4;
    const int nk = K >> 6;
    gemm_stage(A, lda, Bt, ldb, 0, lds, tid);
    asm volatile("s_waitcnt vmcnt(0)" ::: "memory");
    __syncthreads();
    for (int kt = 0; kt < nk; ++kt) {
        char* cur = lds + (kt & 1) * 32768;
        if (kt + 1 < nk) gemm_stage(A, lda, Bt, ldb, kt + 1, lds + ((kt + 1) & 1) * 32768, tid);
#pragma unroll
        for (int ks = 0; ks < 2; ++ks) {
            bf16x8 af[4], bfr[4];
#pragma unroll
            for (int m = 0; m < 4; ++m) { const int row = wr * 64 + m * 16 + fr; af[m] = *reinterpret_cast<const bf16x8*>(cur + row * 128 + (((ks * 4 + fq) ^ (row & 7)) << 4)); }
#pragma unroll
            for (int n = 0; n < 4; ++n) { const int row = wc * 64 + n * 16 + fr; bfr[n] = *reinterpret_cast<const bf16x8*>(cur + 16384 + row * 128 + (((ks * 4 + fq) ^ (row & 7)) << 4)); }
            __builtin_amdgcn_s_setprio(1);
#pragma unroll
            for (int m = 0; m < 4; ++m)
#pragma unroll
                for (int n = 0; n < 4; ++n) acc[m][n] = mfma16(bfr[n], af[m], acc[m][n]);
            __builtin_amdgcn_s_setprio(0);
        }
        asm volatile("s_waitcnt vmcnt(0)" ::: "memory");
        __syncthreads();
    }
}
__device__ __forceinline__ void gemm2_stage(const bf16_t* __restrict__ A, long lda, const bf16_t* __restrict__ Bt, long ldb, int kt, char* buf, int tid) {
#pragma unroll
    for (int i = 0; i < 4; ++i) {
        const int b = tid * 16 + i * 4096, r = b >> 6, c = ((b & 63) >> 4) ^ ((r >> 2) & 3);
        __builtin_amdgcn_global_load_lds((const unsigned*)(A + (long)r * lda + kt * 32 + c * 8), (__attribute__((address_space(3))) unsigned*)(buf + b), 16, 0, 0);
    }
#pragma unroll
    for (int i = 0; i < 2; ++i) {
        const int b = tid * 16 + i * 4096, r = b >> 6, c = ((b & 63) >> 4) ^ ((r >> 2) & 3);
        __builtin_amdgcn_global_load_lds((const unsigned*)(Bt + (long)r * ldb + kt * 32 + c * 8), (__attribute__((address_space(3))) unsigned*)(buf + 16384 + b), 16, 0, 0);
    }
}
__device__ __forceinline__ void gemm_acc2(const bf16_t* __restrict__ A, long lda, const bf16_t* __restrict__ Bt, long ldb, int K, f32x4 (&acc)[8][4], char* lds) {
    const int tid = tid_(), wid = tid >> 6, lane = tid & 63, wr = wid >> 1, wc = wid & 1, fr = lane & 15, fq = lane >> 4;
    const int nk = K >> 5;
    gemm2_stage(A, lda, Bt, ldb, 0, lds, tid);
    asm volatile("s_waitcnt vmcnt(0)" ::: "memory");
    __syncthreads();
    for (int kt = 0; kt < nk; ++kt) {
        char* cur = lds + (kt & 1) * 24576;
        if (kt + 1 < nk) gemm2_stage(A, lda, Bt, ldb, kt + 1, lds + ((kt + 1) & 1) * 24576, tid);
        bf16x8 bfr[4];
#pragma unroll
        for (int n = 0; n < 4; ++n) { const int row = wc * 64 + n * 16 + fr; bfr[n] = *reinterpret_cast<const bf16x8*>(cur + 16384 + row * 64 + ((fq ^ ((row >> 2) & 3)) << 4)); }
#pragma unroll
        for (int m = 0; m < 8; ++m) {
            const int row = wr * 128 + m * 16 + fr;
            const bf16x8 af = *reinterpret_cast<const bf16x8*>(cur + row * 64 + ((fq ^ ((row >> 2) & 3)) << 4));
            __builtin_amdgcn_s_setprio(1);
#pragma unroll
            for (int n = 0; n < 4; ++n) acc[m][n] = mfma16(bfr[n], af, acc[m][n]);
            __builtin_amdgcn_s_setprio(0);
        }
        asm volatile("s_waitcnt vmcnt(0)" ::: "memory");
        __syncthreads();
    }
}
__device__ __forceinline__ void zero_acc2(f32x4 (&acc)[8][4]) {
#pragma unroll
    for (int m = 0; m < 8; ++m)
#pragma unroll
        for (int n = 0; n < 4; ++n) acc[m][n] = (f32x4){0.f, 0.f, 0.f, 0.f};
}
__device__ __forceinline__ void zero_acc(f32x4 (&acc)[4][4]) {
#pragma unroll
    for (int m = 0; m < 4; ++m)
#pragma unroll
        for (int n = 0; n < 4; ++n) acc[m][n] = (f32x4){0.f, 0.f, 0.f, 0.f};
}

__device__ void ph_init(const Params& P, char* lds) {
    const int tid = tid_();
    {
        const f32x4* src = (const f32x4*)P.in[I_X]; f32x4* dst = (f32x4*)P.out;
        const long n4 = (long)TT * DM / 4;
        for (long i = (long)bid_() * NT + tid; i < n4; i += (long)gridDim.x * NT) dst[i] = src[i];
    }
    float* mod = (float*)(P.ws + OFF_MOD);
    float* lbo = (float*)(P.ws + OFF_LB);
    for (int item = bid_(); item < 385; item += gridDim.x) {
        if (item < 384) {
            const int l = item / 96, j0 = (item % 96) * 64;
            const int col = tid & 63, kg = tid >> 6;
            float* CS = (float*)lds;
            float* RED = CS + 4096;
            float acc[16];
#pragma unroll
            for (int b = 0; b < 16; ++b) acc[b] = 0.f;
            const float* Wl = P.in[I_ADAW] + (size_t)l * DM * 6144;
            for (int sub = 0; sub < 4; ++sub) {
                __syncthreads();
                for (int e = tid; e < 4096; e += NT) {
                    const int kk = e & 63, b = (e >> 6) & 15, g = e >> 10;
                    CS[e] = silu(P.in[I_C][b * DM + g * 256 + sub * 64 + kk]);
                }
                __syncthreads();
                for (int kk = 0; kk < 64; ++kk) {
                    const float w = Wl[(size_t)(kg * 256 + sub * 64 + kk) * 6144 + j0 + col];
#pragma unroll
                    for (int b = 0; b < 16; ++b) acc[b] += CS[(kg * 16 + b) * 64 + kk] * w;
                }
            }
#pragma unroll
            for (int b = 0; b < 16; ++b) RED[(kg * 64 + col) * 16 + b] = acc[b];
            __syncthreads();
            {
                const int bg = tid >> 6;
#pragma unroll
                for (int bb = 0; bb < 4; ++bb) {
                    const int b = bg * 4 + bb;
                    float s = RED[(0 * 64 + col) * 16 + b] + RED[(1 * 64 + col) * 16 + b] + RED[(2 * 64 + col) * 16 + b] + RED[(3 * 64 + col) * 16 + b];
                    mod[((size_t)l * 16 + b) * 6144 + j0 + col] = s + P.in[I_ADAB][l * 6144 + j0 + col];
                }
            }
            __syncthreads();
        } else {
            for (int e = tid; e < 1024; e += NT) {
                float x[4], mx = -1e30f;
#pragma unroll
                for (int l = 0; l < 4; ++l) { x[l] = P.in[I_HGLB][l * 1024 + e]; mx = fmaxf(mx, x[l]); }
                float s = 0.f;
#pragma unroll
                for (int l = 0; l < 4; ++l) { x[l] = __expf(x[l] - mx); s += x[l]; }
                const float inv = rcpf_(s);
                float cum = 0.f;
                lbo[0 * 1024 + e] = 0.f;
#pragma unroll
                for (int l = 1; l < 4; ++l) { cum += x[l] * inv; lbo[l * 1024 + e] = fminf(fmaxf(cum, 0.f), 1.f); }
            }
        }
    }
}

__device__ __forceinline__ void tr_tile(const float* __restrict__ src, int ld, int N, int k0, int n0, bf16_t* __restrict__ dst, int dld, int drow0, bool winmap, char* lds) {
    float* Tl = (float*)lds;
    const int tid = tid_();
    __syncthreads();
#pragma unroll
    for (int i = 0; i < 4; ++i) {
        const int kk = (tid >> 4) + 16 * i, nn = (tid & 15) * 4;
        f32x4 v = (f32x4){0.f, 0.f, 0.f, 0.f};
        if (n0 + nn < N) v = *(const f32x4*)(src + (size_t)(k0 + kk) * ld + n0 + nn);
        Tl[kk * 65 + nn] = v[0]; Tl[kk * 65 + nn + 1] = v[1]; Tl[kk * 65 + nn + 2] = v[2]; Tl[kk * 65 + nn + 3] = v[3];
    }
    __syncthreads();
    {
        const int nn = tid >> 2, kb = (tid & 3) * 16;
        if (n0 + nn < N) {
            int drow = drow0 + nn;
            if (winmap) { const int n = n0 + nn; drow = n + (n >= 3344 ? 112 : 0); }
            unsigned w[8];
#pragma unroll
            for (int j = 0; j < 8; ++j) w[j] = pack2(Tl[(kb + 2 * j) * 65 + nn], Tl[(kb + 2 * j + 1) * 65 + nn]);
            u32x4* d = (u32x4*)(dst + (size_t)drow * dld + k0 + kb);
            d[0] = (u32x4){w[0], w[1], w[2], w[3]}; d[1] = (u32x4){w[4], w[5], w[6], w[7]};
        }
    }
}
__device__ void ph_wt(const Params& P, int l, char* lds) {
    char* ws = P.ws;
    const int NI = 2768 + 512 + 256 + 1408 + 704 + 16 + 16 + 16 + 16 + 16 + 7;
    for (int item = bid_(); item < NI; item += gridDim.x) {
        int it = item;
        if (it < 2768) { const int kt = it / 173, nt = it % 173;
            tr_tile(P.in[I_WIN] + (size_t)l * 1024 * 11024, 11024, 11024, kt * 64, nt * 64, (bf16_t*)(ws + WT_WIN), 1024, 0, true, lds); continue; }
        it -= 2768;
        if (it < 512) { const int n = it / 128, r = it % 128, kt = r / 16, nt = r % 16;
            tr_tile(P.in[I_WBR] + ((size_t)l * 4 + n) * 512 * 1024, 1024, 1024, kt * 64, nt * 64, (bf16_t*)(ws + WT_WB) + (size_t)n * 1024 * 512, 512, nt * 64, false, lds); continue; }
        it -= 512;
        if (it < 256) { const int kt = it / 16, nt = it % 16;
            tr_tile(P.in[I_WOUT] + (size_t)l * 1024 * 1024, 1024, 1024, kt * 64, nt * 64, (bf16_t*)(ws + WT_WOUT), 1024, nt * 64, false, lds); continue; }
        it -= 256;
        if (it < 1408) { const int kt = it / 88, nt = it % 88;
            tr_tile(P.in[I_FUP] + (size_t)l * 1024 * 5632, 5632, 5632, kt * 64, nt * 64, (bf16_t*)(ws + WT_WUP), 1024, nt * 64, false, lds); continue; }
        it -= 1408;
        if (it < 704) { const int kt = it / 16, nt = it % 16;
            tr_tile(P.in[I_FDN] + (size_t)l * 2816 * 1024, 1024, 1024, kt * 64, nt * 64, (bf16_t*)(ws + WT_WDN), 2816, nt * 64, false, lds); continue; }
        it -= 704;
        if (it < 16) { const int kt = it / 8, nt = it % 8;
            tr_tile(P.in[I_G2] + (size_t)l * 128 * 512, 512, 512, kt * 64, nt * 64, (bf16_t*)(ws + WT_G2), 128, nt * 64, false, lds); continue; }
        it -= 16;
        if (it < 16) { const int d = it / 8, nt = it % 8;
            tr_tile(P.in[I_W2] + ((size_t)l * 2 + d) * 64 * 512, 512, 512, 0, nt * 64, (bf16_t*)(ws + WT_W2) + (size_t)d * 512 * 64, 64, nt * 64, false, lds); continue; }
        it -= 16;
        if (it < 16) { const int d = it / 8, nt = it % 8;
            tr_tile(P.in[I_A2] + ((size_t)l * 2 + d) * 64 * 512, 512, 512, 0, nt * 64, (bf16_t*)(ws + WT_A2) + (size_t)d * 512 * 64, 64, nt * 64, false, lds); continue; }
        it -= 16;
        if (it < 32) { const int mat = it / 16, d = (it % 16) / 8, g = it % 8;
            const float* src = P.in[mat ? I_LWX : I_LWA] + (((size_t)l * 2 + d) * 8 + g) * 64 * 64;
            tr_tile(src, 64, 64, 0, 0, (bf16_t*)(ws + WT_LRU) + (((size_t)d * 2 + mat) * 8 + g) * 64 * 64, 64, 0, false, lds); continue; }
        it -= 32;
        {
            u32x4* d = (u32x4*)((bf16_t*)(ws + WT_WIN) + (size_t)(3344 + it * 16) * 1024);
            for (int e = tid_(); e < 16 * 1024 / 8; e += NT) d[e] = (u32x4){0u, 0u, 0u, 0u};
        }
    }
}

__device__ void ph_norm(const Params& P, const float* __restrict__ g, const float* __restrict__ modl, int sh_off, int sc_off, bf16_t* __restrict__ dst, bool final_) {
    const int tid = tid_(), wid = tid >> 6, lane = tid & 63;
    for (int item = bid_(); item < TT / 16; item += gridDim.x) {
        const int row0 = item * 16 + wid * 4, b = row0 >> 11;
        f32x4 v[4][4];
#pragma unroll
        for (int r = 0; r < 4; ++r)
#pragma unroll
            for (int i = 0; i < 4; ++i) v[r][i] = *(const f32x4*)(P.out + (size_t)(row0 + r) * DM + i * 256 + lane * 4);
        f32x4 gv[4], sc[4], sh[4];
#pragma unroll
        for (int i = 0; i < 4; ++i) {
            const int c = i * 256 + lane * 4;
            gv[i] = *(const f32x4*)(g + c);
            if (!final_) { sc[i] = *(const f32x4*)(modl + (size_t)b * 6144 + sc_off + c); sh[i] = *(const f32x4*)(modl + (size_t)b * 6144 + sh_off + c); }
        }
#pragma unroll
        for (int r = 0; r < 4; ++r) {
            float ss = 0.f;
#pragma unroll
            for (int i = 0; i < 4; ++i) ss += v[r][i][0] * v[r][i][0] + v[r][i][1] * v[r][i][1] + v[r][i][2] * v[r][i][2] + v[r][i][3] * v[r][i][3];
            ss = wsum64(ss);
            const float rs = rsqrtf(ss * (1.f / DM) + 1e-6f);
            float* hr = P.out + (size_t)(row0 + r) * DM;
#pragma unroll
            for (int i = 0; i < 4; ++i) {
                const int c = i * 256 + lane * 4;
                if (final_) {
                    *(f32x4*)(hr + c) = v[r][i] * rs * gv[i];
                } else {
                    const f32x4 o = v[r][i] * rs * gv[i] * (sc[i] + 1.f) + sh[i];
                    *(u32x2*)(dst + (size_t)(row0 + r) * DM + c) = (u32x2){pack2(o[0], o[1]), pack2(o[2], o[3])};
                }
            }
        }
    }
}

__device__ __forceinline__ void store_tile_bf16(const f32x4 (&acc)[4][4], bf16_t* __restrict__ dst, long ld) {
    const int tid = tid_(), wid = tid >> 6, lane = tid & 63, wr = wid >> 1, wc = wid & 1, fr = lane & 15, fq = lane >> 4;
#pragma unroll
    for (int m = 0; m < 4; ++m)
#pragma unroll
        for (int n = 0; n < 4; ++n) {
            const f32x4 v = acc[m][n];
            *(u32x2*)(dst + (long)(wr * 64 + m * 16 + fr) * ld + wc * 64 + n * 16 + fq * 4) = (u32x2){pack2(v[0], v[1]), pack2(v[2], v[3])};
        }
}
__device__ __forceinline__ void resid_tile(const f32x4 (&acc)[4][4], float* __restrict__ h, int row0, int col0, const float* __restrict__ gate) {
    const int tid = tid_(), wid = tid >> 6, lane = tid & 63, wr = wid >> 1, wc = wid & 1, fr = lane & 15, fq = lane >> 4;
    const int b = row0 >> 11;
#pragma unroll
    for (int n = 0; n < 4; ++n) {
        const int col = col0 + wc * 64 + n * 16 + fq * 4;
        const f32x4 gv = *(const f32x4*)(gate + (size_t)b * 6144 + col);
#pragma unroll
        for (int m = 0; m < 4; ++m) {
            float* hp = h + (size_t)(row0 + wr * 64 + m * 16 + fr) * DM + col;
            const f32x4 o = *(const f32x4*)hp + gv * acc[m][n];
            *(f32x4*)hp = o;
        }
    }
}
__device__ __forceinline__ void store_tile2_bf16(const f32x4 (&acc)[8][4], bf16_t* __restrict__ dst, long ld) {
    const int tid = tid_(), wid = tid >> 6, lane = tid & 63, wr = wid >> 1, wc = wid & 1, fr = lane & 15, fq = lane >> 4;
#pragma unroll
    for (int m = 0; m < 8; ++m)
#pragma unroll
        for (int n = 0; n < 4; ++n) {
            const f32x4 v = acc[m][n];
            *(u32x2*)(dst + (long)(wr * 128 + m * 16 + fr) * ld + wc * 64 + n * 16 + fq * 4) = (u32x2){pack2(v[0], v[1]), pack2(v[2], v[3])};
        }
}
__device__ __forceinline__ void resid_tile2(const f32x4 (&acc)[8][4], float* __restrict__ h, int row0, int col0, const float* __restrict__ gate) {
    const int tid = tid_(), wid = tid >> 6, lane = tid & 63, wr = wid >> 1, wc = wid & 1, fr = lane & 15, fq = lane >> 4;
    const int b = row0 >> 11;
#pragma unroll
    for (int n = 0; n < 4; ++n) {
        const int col = col0 + wc * 64 + n * 16 + fq * 4;
        const f32x4 gv = *(const f32x4*)(gate + (size_t)b * 6144 + col);
#pragma unroll
        for (int m = 0; m < 8; ++m) {
            float* hp = h + (size_t)(row0 + wr * 128 + m * 16 + fr) * DM + col;
            const f32x4 o = *(const f32x4*)hp + gv * acc[m][n];
            *(f32x4*)hp = o;
        }
    }
}
__device__ void ph_gemm_p(const Params& P, char* lds) {
    const bf16_t* U = (const bf16_t*)(P.ws + OFF_U); const bf16_t* Wt = (const bf16_t*)(P.ws + WT_WIN);
    bf16_t* prw = (bf16_t*)(P.ws + OFF_PRW); bf16_t* prest = (bf16_t*)(P.ws + OFF_PREST);
    for (int item = bid_(); item < 128 * 55; item += gridDim.x) {
        const int mt = item / 55, nt = item % 55;
        f32x4 acc[8][4]; zero_acc2(acc);
        gemm_acc2(U + (size_t)mt * 256 * DM, DM, Wt + (size_t)nt * 128 * DM, DM, DM, acc, lds);
        if (nt < 14) store_tile2_bf16(acc, prw + (size_t)mt * 256 * PRW_LD + nt * 128, PRW_LD);
        else store_tile2_bf16(acc, prest + (size_t)mt * 256 * PREST_LD + (nt - 14) * 128, PREST_LD);
    }
}
__device__ void ph_gemm_merge(const Params& P, char* lds) {
    const bf16_t* U = (const bf16_t*)(P.ws + OFF_URE); const bf16_t* Wt = (const bf16_t*)(P.ws + WT_WIN); const bf16_t* Wb = (const bf16_t*)(P.ws + WT_WB);
    bf16_t* mg = (bf16_t*)(P.ws + OFF_MERGED);
    for (int item = bid_(); item < 256 * 8; item += gridDim.x) {
        const int mt = item / 8, nt = item % 8;
        unsigned mpk[4][4][2];
#pragma unroll
        for (int m = 0; m < 4; ++m)
#pragma unroll
            for (int q = 0; q < 4; ++q) { mpk[m][q][0] = 0u; mpk[m][q][1] = 0u; }
#pragma unroll 1
        for (int n = 0; n < 4; ++n) {
            unsigned gpk[4][4][2];
            {
                f32x4 acc[4][4]; zero_acc(acc);
                gemm_acc(U + (size_t)mt * 128 * DM, DM, Wt + (size_t)(GATE_ROW0 + n * 1024 + nt * 128) * DM, DM, DM, acc, lds);
#pragma unroll
                for (int m = 0; m < 4; ++m)
#pragma unroll
                    for (int q = 0; q < 4; ++q) { gpk[m][q][0] = pack2(sigm(acc[m][q][0]), sigm(acc[m][q][1])); gpk[m][q][1] = pack2(sigm(acc[m][q][2]), sigm(acc[m][q][3])); }
            }
            const size_t yoff = (n == 0) ? OFF_Y0 : (n == 1 ? OFF_YB : (n == 2 ? OFF_YC : OFF_YD));
            const bf16_t* Y = (const bf16_t*)(P.ws + yoff);
            f32x4 acc[4][4]; zero_acc(acc);
            gemm_acc(Y + (size_t)mt * 128 * 512, 512, Wb + ((size_t)n * 1024 + nt * 128) * 512, 512, 512, acc, lds);
#pragma unroll
            for (int m = 0; m < 4; ++m)
#pragma unroll
                for (int q = 0; q < 4; ++q) {
                    mpk[m][q][0] = pack2(lo2f(mpk[m][q][0]) + lo2f(gpk[m][q][0]) * acc[m][q][0], hi2f(mpk[m][q][0]) + hi2f(gpk[m][q][0]) * acc[m][q][1]);
                    mpk[m][q][1] = pack2(lo2f(mpk[m][q][1]) + lo2f(gpk[m][q][1]) * acc[m][q][2], hi2f(mpk[m][q][1]) + hi2f(gpk[m][q][1]) * acc[m][q][3]);
                }
        }
        {
            const int tid = tid_(), wid = tid >> 6, lane = tid & 63, wr = wid >> 1, wc = wid & 1, fr = lane & 15, fq = lane >> 4;
            bf16_t* dst = mg + (size_t)mt * 128 * DM + nt * 128;
#pragma unroll
            for (int m = 0; m < 4; ++m)
#pragma unroll
                for (int q = 0; q < 4; ++q) *(u32x2*)(dst + (long)(wr * 64 + m * 16 + fr) * DM + wc * 64 + q * 16 + fq * 4) = (u32x2){mpk[m][q][0], mpk[m][q][1]};
        }
    }
}
__device__ void ph_gemm_out(const Params& P, int l, char* lds) {
    const bf16_t* A = (const bf16_t*)(P.ws + OFF_MERGED); const bf16_t* Wt = (const bf16_t*)(P.ws + WT_WOUT);
    const float* gate = (const float*)(P.ws + OFF_MOD) + (size_t)l * 16 * 6144 + 2048;
    for (int item = bid_(); item < 256 * 8; item += gridDim.x) {
        const int mt = item / 8, nt = item % 8;
        f32x4 acc[4][4]; zero_acc(acc);
        gemm_acc(A + (size_t)mt * 128 * DM, DM, Wt + (size_t)nt * 128 * DM, DM, DM, acc, lds);
        resid_tile(acc, P.out, mt * 128, nt * 128, gate);
    }
}
__device__ void ph_gemm_up(const Params& P, char* lds) {
    const bf16_t* A = (const bf16_t*)(P.ws + OFF_U2); const bf16_t* Wt = (const bf16_t*)(P.ws + WT_WUP);
    bf16_t* Z = (bf16_t*)(P.ws + OFF_Z);
    for (int item = bid_(); item < 128 * 44; item += gridDim.x) {
        const int mt = item / 44, nt = item % 44;
        f32x4 acc[8][4]; zero_acc2(acc);
        gemm_acc2(A + (size_t)mt * 256 * DM, DM, Wt + (size_t)nt * 128 * DM, DM, DM, acc, lds);
        store_tile2_bf16(acc, Z + (size_t)mt * 256 * 5632 + nt * 128, 5632);
    }
}
__device__ void ph_gemm_down(const Params& P, int l, char* lds) {
    const bf16_t* A = (const bf16_t*)(P.ws + OFF_ACT); const bf16_t* Wt = (const bf16_t*)(P.ws + WT_WDN);
    const float* gate = (const float*)(P.ws + OFF_MOD) + (size_t)l * 16 * 6144 + 5120;
    for (int item = bid_(); item < 128 * 8; item += gridDim.x) {
        const int mt = item / 8, nt = item % 8;
        f32x4 acc[8][4]; zero_acc2(acc);
        gemm_acc2(A + (size_t)mt * 256 * DFF, DFF, Wt + (size_t)nt * 128 * DFF, DFF, DFF, acc, lds);
        resid_tile2(acc, P.out, mt * 256, nt * 128, gate);
    }
}
__device__ void ph_convact(const Params& P, int l) {
    const bf16_t* Z = (const bf16_t*)(P.ws + OFF_Z); bf16_t* ACT = (bf16_t*)(P.ws + OFF_ACT);
    const float* cw = P.in[I_FCW] + (size_t)l * 3 * 5632; const float* cb = P.in[I_FCB] + (size_t)l * 5632;
    const long ntask = (long)(TT / 64) * 352;
    for (long task = (long)bid_() * NT + tid_(); task < ntask; task += (long)gridDim.x * NT) {
        const int tile = (int)(task / 352), cgp = (int)(task % 352), c0 = cgp * 8;
        const int t0 = tile * 64, s0 = t0 & (SQ - 1);
        float wv[3][8], wg[3][8], bv[8], bg[8];
#pragma unroll
        for (int j = 0; j < 3; ++j)
#pragma unroll
            for (int e = 0; e < 8; ++e) { wv[j][e] = cw[j * 5632 + c0 + e]; wg[j][e] = cw[j * 5632 + DFF + c0 + e]; }
#pragma unroll
        for (int e = 0; e < 8; ++e) { bv[e] = cb[c0 + e]; bg[e] = cb[DFF + c0 + e]; }
        float pv[8], pg[8], cv[8], cg_[8], nv[8], ng[8];
        const u32x4 zero4 = (u32x4){0u, 0u, 0u, 0u};
        {
            u32x4 a = zero4, b = zero4;
            if (s0 > 0) { a = *(const u32x4*)(Z + (size_t)(t0 - 1) * 5632 + c0); b = *(const u32x4*)(Z + (size_t)(t0 - 1) * 5632 + DFF + c0); }
            unpack8(a, pv); unpack8(b, pg);
            a = *(const u32x4*)(Z + (size_t)t0 * 5632 + c0); b = *(const u32x4*)(Z + (size_t)t0 * 5632 + DFF + c0);
            unpack8(a, cv); unpack8(b, cg_);
        }
#pragma unroll 8
        for (int r = 0; r < 64; ++r) {
            const int t = t0 + r;
            u32x4 a = zero4, b = zero4;
            if (s0 + r + 1 < SQ) { a = *(const u32x4*)(Z + (size_t)(t + 1) * 5632 + c0); b = *(const u32x4*)(Z + (size_t)(t + 1) * 5632 + DFF + c0); }
            unpack8(a, nv); unpack8(b, ng);
            float o[8];
#pragma unroll
            for (int e = 0; e < 8; ++e) {
                const float v = wv[0][e] * pv[e] + wv[1][e] * cv[e] + wv[2][e] * nv[e] + bv[e];
                const float g = wg[0][e] * pg[e] + wg[1][e] * cg_[e] + wg[2][e] * ng[e] + bg[e];
                o[e] = v * silu(g);
                pv[e] = cv[e]; cv[e] = nv[e]; pg[e] = cg_[e]; cg_[e] = ng[e];
            }
            *(u32x4*)(ACT + (size_t)t * DFF + c0) = (u32x4){pack2(o[0], o[1]), pack2(o[2], o[3]), pack2(o[4], o[5]), pack2(o[6], o[7])};
        }
    }
}

__device__ void mx_rwkv(const Params& P, int l, int item, char* lds) {
    const int tid = tid_(), wid = tid >> 6, lane = tid & 63, fr = lane & 15, fq = lane >> 4;
    const int d = item & 1, h = (item >> 1) & 7, b = item >> 4;
    const bf16_t* prw = (const bf16_t*)(P.ws + OFF_PRW) + (size_t)b * SQ * PRW_LD;
    bf16_t* Yd = (bf16_t*)(P.ws + (d ? OFF_Y1 : OFF_Y0)) + (size_t)b * SQ * 512 + h * 64;
    float* beta = (float*)(P.ws + OFF_BETA) + ((size_t)d * TT + (size_t)b * SQ) * 8 + h;
    float* VA = (float*)lds; float* VWR = VA + 1024; float* VW = VWR + 1024; float* VB = VW + 1024; float* VK = VB + 1024; float* VV = VK + 1024; float* VG = VV + 1024;
    float* SC = VG + 1024;
    bf16_t* RAW = (bf16_t*)(SC + 32);
    bf16_t* AT = RAW + 18 * 320;
    const int s = tid >> 4, jg = tid & 15, j0 = jg * 4;
    float mu[5][4], kkc[4], kac[4], rkc[4];
#pragma unroll
    for (int sg = 0; sg < 5; ++sg) {
        const int base = (sg < 3) ? sg * 512 + h * 64 : 1536 + (sg - 3) * 64;
#pragma unroll
        for (int i = 0; i < 4; ++i) mu[sg][i] = P.in[I_MU][l * 1792 + base + j0 + i];
    }
#pragma unroll
    for (int i = 0; i < 4; ++i) { kkc[i] = P.in[I_KK][l * 512 + h * 64 + j0 + i]; kac[i] = P.in[I_KA][l * 512 + h * 64 + j0 + i]; rkc[i] = P.in[I_RK][l * 512 + h * 64 + j0 + i]; }
    const int mt = wid >> 1, ntb = (wid & 1) * 2;
    bf16x8 bw[2][2]; float bsv[2][4];
    {
        const bf16_t* WT2 = (const bf16_t*)(P.ws + (mt ? WT_A2 : WT_W2)) + (size_t)d * 512 * 64;
        const float* bias = P.in[mt ? I_A0 : I_W0] + (size_t)(l * 2 + d) * 512 + h * 64;
#pragma unroll
        for (int nt = 0; nt < 2; ++nt) {
#pragma unroll
            for (int ks = 0; ks < 2; ++ks) bw[nt][ks] = ldfrag(WT2 + (size_t)(h * 64 + (ntb + nt) * 16 + fr) * 64 + ks * 32 + fq * 8);
#pragma unroll
            for (int jj = 0; jj < 4; ++jj) bsv[nt][jj] = bias[(ntb + nt) * 16 + fq * 4 + jj];
        }
    }
    float S[4][4];
#pragma unroll
    for (int i = 0; i < 4; ++i)
#pragma unroll
        for (int j = 0; j < 4; ++j) S[i][j] = 0.f;
    u32x4 pre[3];
    auto load_raw = [&](int c) {
        const int t0 = d ? SQ - 16 * (c + 1) : 16 * c;
#pragma unroll
        for (int i = 0; i < 3; ++i) {
            const int vi = tid + 256 * i;
            pre[i] = (u32x4){0u, 0u, 0u, 0u};
            if (vi < 720) {
                const int rr = vi / 40, rem = vi % 40, sg = rem >> 3, e = rem & 7, t = t0 - 1 + rr;
                const int col = ((sg < 3) ? sg * 512 + h * 64 : 1536 + (sg - 3) * 64) + e * 8;
                if (t >= 0 && t < SQ) pre[i] = *(const u32x4*)(prw + (size_t)t * PRW_LD + col);
            }
        }
    };
    __syncthreads();
    load_raw(0);
#pragma unroll 1
    for (int c = 0; c < 128; ++c) {
        const int t0 = d ? SQ - 16 * (c + 1) : 16 * c;
#pragma unroll
        for (int i = 0; i < 3; ++i) {
            const int vi = tid + 256 * i;
            if (vi < 720) { const int rr = vi / 40, rem = vi % 40; *(u32x4*)(RAW + rr * 320 + rem * 8) = pre[i]; }
        }
        __syncthreads();
        if (c + 1 < 128) load_raw(c + 1);
        float rs[4], ks_[4], vs[4], kk[4];
        {
            float sh[5][4];
#pragma unroll
            for (int sg = 0; sg < 5; ++sg) {
                float fm[4], f0[4], fp[4];
                unpack4(*(const u32x2*)(RAW + s * 320 + sg * 64 + j0), fm);
                unpack4(*(const u32x2*)(RAW + (s + 1) * 320 + sg * 64 + j0), f0);
                unpack4(*(const u32x2*)(RAW + (s + 2) * 320 + sg * 64 + j0), fp);
#pragma unroll
                for (int i = 0; i < 4; ++i) sh[sg][i] = f0[i] + mu[sg][i] * (0.5f * (fm[i] + fp[i]) - f0[i]);
            }
            float ssq = 0.f, q[4];
#pragma unroll
            for (int i = 0; i < 4; ++i) { rs[i] = sh[0][i]; ks_[i] = sh[1][i]; vs[i] = sh[2][i]; q[i] = ks_[i] * kkc[i]; ssq += q[i] * q[i]; }
            *(u32x2*)(AT + s * 72 + j0) = (u32x2){pack2(tanh_f(sh[3][0]), tanh_f(sh[3][1])), pack2(tanh_f(sh[3][2]), tanh_f(sh[3][3]))};
            *(u32x2*)(AT + 16 * 72 + s * 72 + j0) = (u32x2){pack2(sh[4][0], sh[4][1]), pack2(sh[4][2], sh[4][3])};
            ssq = rowsum16(ssq);
            const float inv = __builtin_amdgcn_rsqf(fmaxf(ssq, 1e-24f));
#pragma unroll
            for (int i = 0; i < 4; ++i) kk[i] = q[i] * inv;
        }
        __syncthreads();
        {
            const bf16_t* At = AT + mt * 16 * 72;
            const bf16x8 a0 = ldfrag(At + fr * 72 + fq * 8), a1 = ldfrag(At + fr * 72 + 32 + fq * 8);
            float* dstv = mt ? VG : VW;
#pragma unroll
            for (int nt = 0; nt < 2; ++nt) {
                f32x4 acc = (f32x4){0.f, 0.f, 0.f, 0.f};
                acc = mfma16(bw[nt][0], a0, acc); acc = mfma16(bw[nt][1], a1, acc);
                f32x4 o;
#pragma unroll
                for (int jj = 0; jj < 4; ++jj) {
                    const float x = acc[jj] + bsv[nt][jj];
                    if (mt == 0) { const float wl = fminf(x, 0.f) - flog_(1.f + __expf(-fabsf(x))) - 0.5f; o[jj] = __expf(-__expf(wl)); }
                    else o[jj] = sigm(x);
                }
                *(f32x4*)(dstv + fr * 64 + (ntb + nt) * 16 + fq * 4) = o;
            }
        }
        __syncthreads();
        {
            const f32x4 w4 = *(const f32x4*)(VW + s * 64 + j0), g4 = *(const f32x4*)(VG + s * 64 + j0);
            f32x4 bb, kt, wr, na, vv;
            float pbr = 0.f, pkr = 0.f, pbe = 0.f;
#pragma unroll
            for (int i = 0; i < 4; ++i) {
                bb[i] = kk[i] * g4[i]; kt[i] = ks_[i] * (1.f + (g4[i] - 1.f) * kac[i]); wr[i] = w4[i] * rs[i]; na[i] = -kk[i]; vv[i] = vs[i];
                pbr += bb[i] * rs[i]; pkr += kt[i] * rs[i]; pbe += rs[i] * kt[i] * rkc[i];
            }
            pbr = rowsum16(pbr); pkr = rowsum16(pkr); pbe = rowsum16(pbe);
            *(f32x4*)(VA + s * 64 + j0) = na; *(f32x4*)(VWR + s * 64 + j0) = wr; *(f32x4*)(VB + s * 64 + j0) = bb; *(f32x4*)(VK + s * 64 + j0) = kt; *(f32x4*)(VV + s * 64 + j0) = vv;
            if (jg == 0) { SC[s * 2] = pbr; SC[s * 2 + 1] = pkr; beta[(size_t)(t0 + s) * 8] = pbe; }
        }
        __syncthreads();
#pragma unroll 1
        for (int st = 0; st < 16; ++st) {
            const int sp = d ? 15 - st : st;
            const f32x4 a4 = *(const f32x4*)(VA + sp * 64 + j0), wr4 = *(const f32x4*)(VWR + sp * 64 + j0), w4 = *(const f32x4*)(VW + sp * 64 + j0);
            const f32x4 b4 = *(const f32x4*)(VB + sp * 64 + j0), k4 = *(const f32x4*)(VK + sp * 64 + j0), v4 = *(const f32x4*)(VV + sp * 64 + s * 4);
            const float br = SC[sp * 2], kr = SC[sp * 2 + 1];
            float psa[4], py[4];
            typedef float f32x2 __attribute__((ext_vector_type(2)));
            const f32x2 a01 = {a4[0], a4[1]}, a23 = {a4[2], a4[3]}, r01 = {wr4[0], wr4[1]}, r23 = {wr4[2], wr4[3]};
#pragma unroll
            for (int i = 0; i < 4; ++i) {
                const f32x2 s01 = {S[i][0], S[i][1]}, s23 = {S[i][2], S[i][3]};
                f32x2 ta = s01 * a01; ta = s23 * a23 + ta;
                f32x2 ty = s01 * r01; ty = s23 * r23 + ty;
                psa[i] = ta.x + ta.y; py[i] = ty.x + ty.y;
            }
#define RS8(CTRL) asm volatile("s_nop 1\n\tv_add_f32_dpp %0, %0, %0 " CTRL " row_mask:0xf bank_mask:0xf\n\tv_add_f32_dpp %1, %1, %1 " CTRL " row_mask:0xf bank_mask:0xf\n\tv_add_f32_dpp %2, %2, %2 " CTRL " row_mask:0xf bank_mask:0xf\n\tv_add_f32_dpp %3, %3, %3 " CTRL " row_mask:0xf bank_mask:0xf\n\tv_add_f32_dpp %4, %4, %4 " CTRL " row_mask:0xf bank_mask:0xf\n\tv_add_f32_dpp %5, %5, %5 " CTRL " row_mask:0xf bank_mask:0xf\n\tv_add_f32_dpp %6, %6, %6 " CTRL " row_mask:0xf bank_mask:0xf\n\tv_add_f32_dpp %7, %7, %7 " CTRL " row_mask:0xf bank_mask:0xf" : "+v"(psa[0]), "+v"(psa[1]), "+v"(psa[2]), "+v"(psa[3]), "+v"(py[0]), "+v"(py[1]), "+v"(py[2]), "+v"(py[3]))
            RS8("row_ror:8"); RS8("row_ror:4"); RS8("row_ror:2"); RS8("row_ror:1");
            asm volatile("s_nop 1" ::: "memory");
            float y[4];
#pragma unroll
            for (int i = 0; i < 4; ++i) {
                y[i] = py[i] + psa[i] * br + v4[i] * kr;
#pragma unroll
                for (int j = 0; j < 4; ++j) S[i][j] = S[i][j] * w4[j] + (psa[i] * b4[j] + v4[i] * k4[j]);
            }
            if (jg == 0) *(u32x2*)(Yd + (size_t)(t0 + sp) * 512 + s * 4) = (u32x2){pack2(y[0], y[1]), pack2(y[2], y[3])};
        }
    }
    __syncthreads();
}

__device__ void mx_mlstm(const Params& P, int l, int item, char* lds) {
    const int tid = tid_(), wid = tid >> 6, lane = tid & 63, fr = lane & 15, fq = lane >> 4;
    const int b = item >> 3, h = (item >> 1) & 3, dsel = item & 1;
    const bf16_t* pr = (const bf16_t*)(P.ws + OFF_PREST) + (size_t)b * SQ * PREST_LD;
    bf16_t* YB = (bf16_t*)(P.ws + (dsel ? OFF_YB : OFF_Y1)) + (size_t)b * SQ * 512 + h * 128;
    bf16_t* Q = (bf16_t*)lds; bf16_t* KP = Q + 64 * 72; bf16_t* KWT = KP + 64 * 72; bf16_t* VT = KWT + 64 * 72; bf16_t* CT = VT + 128 * 72;
    float* NS = (float*)(CT + 128 * 72); float* E = NS + 64; float* MM = E + 64; float* SI = MM + 64; float* WI = SI + 64; float* FL = WI + 64; float* DEC = FL + 64;
    const int i = wid * 16 + fr;
#pragma unroll 1
    for (int d = dsel; d <= dsel; ++d) {
        f32x4 Cacc[8];
#pragma unroll
        for (int dt = 0; dt < 8; ++dt) Cacc[dt] = (f32x4){0.f, 0.f, 0.f, 0.f};
        __syncthreads();
        for (int e = tid; e < 128 * 72 / 2; e += NT) ((unsigned*)CT)[e] = 0u;
        if (tid < 64) NS[tid] = 0.f;
        float m_st = 0.f;
        const float ib = P.in[I_MLIB][(l * 2 + d) * 4 + h], fb = P.in[I_MLFB][(l * 2 + d) * 4 + h];
        __syncthreads();
#pragma unroll 1
        for (int c = 0; c < 32; ++c) {
            const int t0 = d ? SQ - 64 * (c + 1) : 64 * c;
#define TROW(ii) (d ? t0 + 63 - (ii) : t0 + (ii))
            if (wid == 0) {
                const int t = TROW(lane);
                const float fg = bf2f(pr[(size_t)t * PREST_LD + 1544 + d * 4 + h]) + fb, ig = bf2f(pr[(size_t)t * PREST_LD + 1536 + d * 4 + h]) + ib;
                float bc = logsig(fg);
#pragma unroll
                for (int o = 1; o < 64; o <<= 1) { const float x = bperm(bc, lane - o); if (lane >= o) bc += x; }
                const float e = ig - bc; float pm = e;
#pragma unroll
                for (int o = 1; o < 64; o <<= 1) { const float x = bperm(pm, lane - o); if (lane >= o) pm = fmaxf(pm, x); }
                const float gend = rdlane(bc, 63), pmax = rdlane(pm, 63);
                const float mnew = fmaxf(gend + m_st, gend + pmax);
                const float M = fmaxf(m_st, pm);
                E[lane] = e; MM[lane] = M; SI[lane] = __expf(m_st - M); WI[lane] = __expf(gend + e - mnew); FL[lane] = __expf(-(bc + M));
                if (lane == 0) DEC[0] = __expf(gend + m_st - mnew);
                m_st = mnew;
            }
            __syncthreads();
#pragma unroll
            for (int it = 0; it < 2; ++it) {
                const int vi = tid + 256 * it, ii = vi >> 3, e = vi & 7, t = TROW(ii);
                float f[8];
                unpack8(*(const u32x4*)(pr + (size_t)t * PREST_LD + h * 64 + e * 8), f);
                *(u32x4*)(Q + ii * 72 + e * 8) = (u32x4){pack2(f[0] * 0.125f, f[1] * 0.125f), pack2(f[2] * 0.125f, f[3] * 0.125f), pack2(f[4] * 0.125f, f[5] * 0.125f), pack2(f[6] * 0.125f, f[7] * 0.125f)};
                const u32x4 kv = *(const u32x4*)(pr + (size_t)t * PREST_LD + 256 + h * 64 + e * 8);
                *(u32x4*)(KP + ii * 72 + e * 8) = kv;
                unpack8(kv, f);
                const float wi = WI[ii];
#pragma unroll
                for (int x = 0; x < 8; ++x) KWT[(e * 8 + x) * 72 + ii] = f2bf(f[x] * wi);
            }
#pragma unroll
            for (int it = 0; it < 4; ++it) {
                const int vi = tid + 256 * it, ii = vi >> 4, e = vi & 15, t = TROW(ii);
                const u32x4 vv = *(const u32x4*)(pr + (size_t)t * PREST_LD + 512 + h * 128 + e * 8);
                VT[(e * 8 + 0) * 72 + ii] = (bf16_t)(vv.x & 0xffff); VT[(e * 8 + 1) * 72 + ii] = (bf16_t)(vv.x >> 16);
                VT[(e * 8 + 2) * 72 + ii] = (bf16_t)(vv.y & 0xffff); VT[(e * 8 + 3) * 72 + ii] = (bf16_t)(vv.y >> 16);
                VT[(e * 8 + 4) * 72 + ii] = (bf16_t)(vv.z & 0xffff); VT[(e * 8 + 5) * 72 + ii] = (bf16_t)(vv.z >> 16);
                VT[(e * 8 + 6) * 72 + ii] = (bf16_t)(vv.w & 0xffff); VT[(e * 8 + 7) * 72 + ii] = (bf16_t)(vv.w >> 16);
            }
            __syncthreads();
            f32x4 sacc[4];
#pragma unroll
            for (int st = 0; st < 4; ++st) sacc[st] = (f32x4){0.f, 0.f, 0.f, 0.f};
#pragma unroll
            for (int ks = 0; ks < 2; ++ks) {
                const bf16x8 qf = ldfrag(Q + i * 72 + ks * 32 + fq * 8);
#pragma unroll
                for (int st = 0; st < 4; ++st) sacc[st] = mfma16(ldfrag(KP + (st * 16 + fr) * 72 + ks * 32 + fq * 8), qf, sacc[st]);
            }
            const float Mi = MM[i], si = SI[i];
            float rsum = 0.f; unsigned pwp[4][2];
#pragma unroll
            for (int st = 0; st < 4; ++st) {
                float pw[4];
#pragma unroll
                for (int jj = 0; jj < 4; ++jj) { const int sx = st * 16 + fq * 4 + jj; pw[jj] = (sx <= i) ? __expf(E[sx] - Mi) * sacc[st][jj] : 0.f; rsum += pw[jj]; }
                pwp[st][0] = pack2(pw[0], pw[1]); pwp[st][1] = pack2(pw[2], pw[3]);
            }
            rsum = qsum(rsum, lane);
            float qn = 0.f;
            {
                float f[8];
                unpack8(*(const u32x4*)(Q + i * 72 + fq * 16), f);
#pragma unroll
                for (int x = 0; x < 8; ++x) qn += f[x] * NS[fq * 16 + x];
                unpack8(*(const u32x4*)(Q + i * 72 + fq * 16 + 8), f);
#pragma unroll
                for (int x = 0; x < 8; ++x) qn += f[x] * NS[fq * 16 + 8 + x];
            }
            qn = qsum(qn, lane);
            const float den = si * qn + rsum;
            const float rinv = rcpf_(fmaxf(fabsf(den), FL[i]));
            __syncthreads();
#pragma unroll
            for (int st = 0; st < 4; ++st) *(u32x2*)(KP + i * 72 + st * 16 + fq * 4) = (u32x2){pwp[st][0], pwp[st][1]};
            __syncthreads();
            f32x4 oacc[8];
#pragma unroll
            for (int dt = 0; dt < 8; ++dt) oacc[dt] = (f32x4){0.f, 0.f, 0.f, 0.f};
#pragma unroll
            for (int ks = 0; ks < 2; ++ks) {
                const bf16x8 qf = ldfrag(Q + i * 72 + ks * 32 + fq * 8);
#pragma unroll
                for (int dt = 0; dt < 8; ++dt) oacc[dt] = mfma16(ldfrag(CT + (dt * 16 + fr) * 72 + ks * 32 + fq * 8), qf, oacc[dt]);
            }
#pragma unroll
            for (int dt = 0; dt < 8; ++dt) oacc[dt] *= si;
#pragma unroll
            for (int ks = 0; ks < 2; ++ks) {
                const bf16x8 pf = ldfrag(KP + i * 72 + ks * 32 + fq * 8);
#pragma unroll
                for (int dt = 0; dt < 8; ++dt) oacc[dt] = mfma16(ldfrag(VT + (dt * 16 + fr) * 72 + ks * 32 + fq * 8), pf, oacc[dt]);
            }
            {
                const int t = TROW(i);
                bf16_t* yp = YB + (size_t)t * 512 + fq * 4;
                {
#pragma unroll
                    for (int dt = 0; dt < 8; ++dt) { const f32x4 v = oacc[dt] * rinv; *(u32x2*)(yp + dt * 16) = (u32x2){pack2(v[0], v[1]), pack2(v[2], v[3])}; }
                }
            }
            __syncthreads();
            {
                const float dec = DEC[0];
#pragma unroll
                for (int dt = 0; dt < 8; ++dt) Cacc[dt] *= dec;
#pragma unroll
                for (int ks = 0; ks < 2; ++ks) {
                    const bf16x8 kf = ldfrag(KWT + (wid * 16 + fr) * 72 + ks * 32 + fq * 8);
#pragma unroll
                    for (int dt = 0; dt < 8; ++dt) Cacc[dt] = mfma16(kf, ldfrag(VT + (dt * 16 + fr) * 72 + ks * 32 + fq * 8), Cacc[dt]);
                }
#pragma unroll
                for (int dt = 0; dt < 8; ++dt) *(u32x2*)(CT + (dt * 16 + fr) * 72 + wid * 16 + fq * 4) = (u32x2){pack2(Cacc[dt][0], Cacc[dt][1]), pack2(Cacc[dt][2], Cacc[dt][3])};
                if (tid < 64) {
                    float n = dec * NS[tid];
#pragma unroll
                    for (int x = 0; x < 8; ++x) { float f[8]; unpack8(*(const u32x4*)(KWT + tid * 72 + x * 8), f); n += ((f[0] + f[1]) + (f[2] + f[3])) + ((f[4] + f[5]) + (f[6] + f[7])); }
                    NS[tid] = n;
                }
            }
            __syncthreads();
        }
    }
}

__device__ void mx_hgrn(const Params& P, int l, int item, char* lds) {
    const int tid = tid_(), wid = tid >> 6, lane = tid & 63, fr = lane & 15, fq = lane >> 4;
    const int b = item >> 4, h = (item >> 2) & 3, half = (item >> 1) & 1, dsel = item & 1;
    const bf16_t* pr = (const bf16_t*)(P.ws + OFF_PREST) + (size_t)b * SQ * PREST_LD + HG_O;
    bf16_t* YD = (bf16_t*)(P.ws + (dsel ? OFF_YD : OFF_Y0)) + (size_t)b * SQ * 512 + h * 128 + half * 64;
    bf16_t* QT = (bf16_t*)lds; bf16_t* KT = QT + 64 * 136; bf16_t* ATT = KT + 128 * 72; bf16_t* VT = ATT + 64 * 72; bf16_t* ST = VT + 64 * 72;
    float* TOT = (float*)(ST + 64 * 136);
    const int dk = tid & 127, hf = tid >> 7;
    const int i = wid * 16 + fr;
#pragma unroll 1
    for (int d = dsel; d <= dsel; ++d) {
        const float lbv = ((const float*)(P.ws + OFF_LB))[(l * 2 + d) * 512 + h * 128 + dk], oml = 1.f - lbv;
        f32x4 Sacc[2][4];
#pragma unroll
        for (int a = 0; a < 2; ++a)
#pragma unroll
            for (int dt = 0; dt < 4; ++dt) Sacc[a][dt] = (f32x4){0.f, 0.f, 0.f, 0.f};
        __syncthreads();
        for (int e = tid; e < 64 * 136 / 2; e += NT) ((unsigned*)ST)[e] = 0u;
        __syncthreads();
        u32x4 pff[4], pfq[4], pfv[2];
        auto hg_load = [&](int cc) {
            const int t0 = d ? SQ - 64 * (cc + 1) : 64 * cc;
#pragma unroll
            for (int it = 0; it < 4; ++it) {
                const int vi = tid + 256 * it, ii = vi >> 4, e = vi & 15, t = TROW(ii);
                pff[it] = *(const u32x4*)(pr + (size_t)t * PREST_LD + 512 * (1 + d) + h * 128 + e * 8);
                pfq[it] = *(const u32x4*)(pr + (size_t)t * PREST_LD + h * 128 + e * 8);
            }
#pragma unroll
            for (int it = 0; it < 2; ++it) {
                const int vi = tid + 256 * it, ii = vi >> 3, e = vi & 7, t = TROW(ii);
                pfv[it] = *(const u32x4*)(pr + (size_t)t * PREST_LD + 1536 + h * 128 + half * 64 + e * 8);
            }
        };
        hg_load(0);
#pragma unroll 1
        for (int c = 0; c < 32; ++c) {
            const int t0 = d ? SQ - 64 * (c + 1) : 64 * c;
#pragma unroll
            for (int it = 0; it < 4; ++it) {
                const int vi = tid + 256 * it, ii = vi >> 4, e = vi & 15;
                *(u32x4*)(KT + ii * 136 + e * 8) = pff[it];
                *(u32x4*)(QT + ii * 136 + e * 8) = pfq[it];
            }
#pragma unroll
            for (int it = 0; it < 2; ++it) {
                const int vi = tid + 256 * it, ii = vi >> 3, e = vi & 7;
                const u32x4 vv = pfv[it];
                VT[(e * 8 + 0) * 72 + ii] = (bf16_t)(vv.x & 0xffff); VT[(e * 8 + 1) * 72 + ii] = (bf16_t)(vv.x >> 16);
                VT[(e * 8 + 2) * 72 + ii] = (bf16_t)(vv.y & 0xffff); VT[(e * 8 + 3) * 72 + ii] = (bf16_t)(vv.y >> 16);
                VT[(e * 8 + 4) * 72 + ii] = (bf16_t)(vv.z & 0xffff); VT[(e * 8 + 5) * 72 + ii] = (bf16_t)(vv.z >> 16);
                VT[(e * 8 + 6) * 72 + ii] = (bf16_t)(vv.w & 0xffff); VT[(e * 8 + 7) * 72 + ii] = (bf16_t)(vv.w >> 16);
            }
            if (c + 1 < 32) hg_load(c + 1);
            __syncthreads();
            bf16_t* kp = KT + hf * 32 * 136 + dk; bf16_t* qp = QT + hf * 32 * 136 + dk;
            {
                float run = 0.f;
#pragma unroll 8
                for (int r = 0; r < 32; ++r) { const bf16_t fb = f2bf(lbv + oml * sigm(bf2f(kp[r * 136]))); kp[r * 136] = fb; run += flog_(bf2f(fb)); }
                TOT[hf * 128 + dk] = run;
            }
            __syncthreads();
            const float R = TOT[dk], gmR = TOT[128 + dk];
            {
                float g = hf ? R : 0.f;
#pragma unroll 8
                for (int r = 0; r < 32; ++r) {
                    const float fv = bf2f(kp[r * 136]);
                    g += flog_(fv);
                    const float e1 = __expf(fminf(g - R, 80.f));
                    qp[r * 136] = f2bf(silu(bf2f(qp[r * 136])) * e1);
                    kp[r * 136] = f2bf((1.f - fv) * __expf(fminf(R - g, 80.f)));
                }
                const float eR = __expf(R);
                bf16_t* sp = ST + hf * 32 * 136 + dk;
#pragma unroll 8
                for (int r = 0; r < 32; ++r) sp[r * 136] = f2bf(bf2f(sp[r * 136]) * eR);
            }
            __syncthreads();
            f32x4 oacc[4];
            unsigned kw[16];
            {
                f32x4 aacc[4];
#pragma unroll
                for (int st = 0; st < 4; ++st) { aacc[st] = (f32x4){0.f, 0.f, 0.f, 0.f}; oacc[st] = (f32x4){0.f, 0.f, 0.f, 0.f}; }
#pragma unroll
                for (int ks = 0; ks < 4; ++ks) {
                    const bf16x8 qf = ldfrag(QT + i * 136 + ks * 32 + fq * 8);
#pragma unroll
                    for (int st = 0; st < 4; ++st) aacc[st] = mfma16(ldfrag(KT + (st * 16 + fr) * 136 + ks * 32 + fq * 8), qf, aacc[st]);
#pragma unroll
                    for (int dt = 0; dt < 4; ++dt) oacc[dt] = mfma16(ldfrag(ST + (dt * 16 + fr) * 136 + ks * 32 + fq * 8), qf, oacc[dt]);
                }
#pragma unroll
                for (int st = 0; st < 4; ++st) {
                    float a[4];
#pragma unroll
                    for (int jj = 0; jj < 4; ++jj) a[jj] = (st * 16 + fq * 4 + jj <= i) ? aacc[st][jj] : 0.f;
                    *(u32x2*)(ATT + i * 72 + st * 16 + fq * 4) = (u32x2){pack2(a[0], a[1]), pack2(a[2], a[3])};
                }
#pragma unroll
                for (int r = 0; r < 16; ++r) kw[r] = (unsigned)kp[(2 * r) * 136] | ((unsigned)kp[(2 * r + 1) * 136] << 16);
            }
            __syncthreads();
            {
                u32x4* dst = (u32x4*)(KT + dk * 72 + hf * 32);
                dst[0] = (u32x4){kw[0], kw[1], kw[2], kw[3]}; dst[1] = (u32x4){kw[4], kw[5], kw[6], kw[7]};
                dst[2] = (u32x4){kw[8], kw[9], kw[10], kw[11]}; dst[3] = (u32x4){kw[12], kw[13], kw[14], kw[15]};
            }
            __syncthreads();
            {
#pragma unroll
                for (int ks = 0; ks < 2; ++ks) {
                    const bf16x8 af = ldfrag(ATT + i * 72 + ks * 32 + fq * 8);
#pragma unroll
                    for (int dt = 0; dt < 4; ++dt) oacc[dt] = mfma16(ldfrag(VT + (dt * 16 + fr) * 72 + ks * 32 + fq * 8), af, oacc[dt]);
                }
                const int t = TROW(i);
                bf16_t* yp = YD + (size_t)t * 512 + fq * 4;
#pragma unroll
                for (int dt = 0; dt < 4; ++dt) {
                    f32x4 v = oacc[dt];
                    *(u32x2*)(yp + dt * 16) = (u32x2){pack2(v[0], v[1]), pack2(v[2], v[3])};
                }
            }
#pragma unroll
            for (int a = 0; a < 2; ++a) {
                const int ktile = 2 * wid + a;
                f32x4 e1, e2;
#pragma unroll
                for (int jj = 0; jj < 4; ++jj) { const int dkk = ktile * 16 + fq * 4 + jj; e1[jj] = __expf(TOT[dkk]); e2[jj] = __expf(TOT[128 + dkk]); }
#pragma unroll
                for (int dt = 0; dt < 4; ++dt) Sacc[a][dt] *= e1;
#pragma unroll
                for (int ks = 0; ks < 2; ++ks) {
                    const bf16x8 kf = ldfrag(KT + (ktile * 16 + fr) * 72 + ks * 32 + fq * 8);
#pragma unroll
                    for (int dt = 0; dt < 4; ++dt) Sacc[a][dt] = mfma16(kf, ldfrag(VT + (dt * 16 + fr) * 72 + ks * 32 + fq * 8), Sacc[a][dt]);
                }
#pragma unroll
                for (int dt = 0; dt < 4; ++dt) {
                    Sacc[a][dt] *= e2;
                    *(u32x2*)(ST + (dt * 16 + fr) * 136 + ktile * 16 + fq * 4) = (u32x2){pack2(Sacc[a][dt][0], Sacc[a][dt][1]), pack2(Sacc[a][dt][2], Sacc[a][dt][3])};
                }
            }
            __syncthreads();
        }
    }
}

__device__ void mx_lru(const Params& P, int l, int item, char* lds) {
    const int tid = tid_(), wid = tid >> 6, lane = tid & 63, fr = lane & 15, fq = lane >> 4;
    const int b = item >> 3, g = item & 7;
    const bf16_t* pr = (const bf16_t*)(P.ws + OFF_PREST) + (size_t)b * SQ * PREST_LD + LRU_O;
    bf16_t* YC = (bf16_t*)(P.ws + OFF_YC) + (size_t)b * SQ * 512 + g * 64;
    bf16_t* XC = (bf16_t*)lds; float* AA = (float*)(lds + 9216); float* BB = AA + 64 * 65; float* HH = BB + 64 * 65;
    const int ch = tid & 63, tq = tid >> 6;
    float cwv[4];
#pragma unroll
    for (int j = 0; j < 4; ++j) cwv[j] = P.in[I_LCW][(l * 4 + j) * 512 + g * 64 + ch];
    const float cbv = P.in[I_LCB][l * 512 + g * 64 + ch];
    const int i = wid * 16 + fr;
#pragma unroll 1
    for (int d = 0; d < 2; ++d) {
        bf16x8 waf[4][2], wxf[4][2]; f32x4 ba4[4], bx4[4], c8[4];
        {
            const bf16_t* Wa = (const bf16_t*)(P.ws + WT_LRU) + (((size_t)d * 2 + 0) * 8 + g) * 4096;
            const bf16_t* Wx = (const bf16_t*)(P.ws + WT_LRU) + (((size_t)d * 2 + 1) * 8 + g) * 4096;
#pragma unroll
            for (int jt = 0; jt < 4; ++jt) {
#pragma unroll
                for (int ks = 0; ks < 2; ++ks) { waf[jt][ks] = ldfrag(Wa + (jt * 16 + fr) * 64 + ks * 32 + fq * 8); wxf[jt][ks] = ldfrag(Wx + (jt * 16 + fr) * 64 + ks * 32 + fq * 8); }
                const int j = (l * 2 + d) * 512 + g * 64 + jt * 16 + fq * 4;
                ba4[jt] = *(const f32x4*)(P.in[I_LBA] + j); bx4[jt] = *(const f32x4*)(P.in[I_LBX] + j);
                const f32x4 lam = *(const f32x4*)(P.in[I_LLAM] + j);
#pragma unroll
                for (int jj = 0; jj < 4; ++jj) c8[jt][jj] = -8.f * (fmaxf(-lam[jj], 0.f) + flog_(1.f + __expf(-fabsf(lam[jj]))));
            }
        }
        float hst = 0.f;
        bf16_t xr[19];
        auto lru_load = [&](int cc) {
            const int t0 = d ? SQ - 64 * (cc + 1) : 64 * cc;
#pragma unroll
            for (int k = 0; k < 19; ++k) { const int t = t0 + tq * 16 - 1 + k; xr[k] = (t >= 0 && t < SQ) ? pr[(size_t)t * PREST_LD + g * 64 + ch] : (bf16_t)0; }
        };
        lru_load(0);
#pragma unroll 1
        for (int c = 0; c < 32; ++c) {
            const int t0 = d ? SQ - 64 * (c + 1) : 64 * c;
            {
                float xw[19];
#pragma unroll
                for (int k = 0; k < 19; ++k) xw[k] = bf2f(xr[k]);
                if (c + 1 < 32) lru_load(c + 1);
#pragma unroll
                for (int r = 0; r < 16; ++r) XC[(tq * 16 + r) * 72 + ch] = f2bf(cbv + cwv[0] * xw[r] + cwv[1] * xw[r + 1] + cwv[2] * xw[r + 2] + cwv[3] * xw[r + 3]);
            }
            __syncthreads();
            {
                f32x4 ra[4], rx[4];
#pragma unroll
                for (int jt = 0; jt < 4; ++jt) { ra[jt] = (f32x4){0.f, 0.f, 0.f, 0.f}; rx[jt] = (f32x4){0.f, 0.f, 0.f, 0.f}; }
#pragma unroll
                for (int ks = 0; ks < 2; ++ks) {
                    const bf16x8 xf = ldfrag(XC + i * 72 + ks * 32 + fq * 8);
#pragma unroll
                    for (int jt = 0; jt < 4; ++jt) { ra[jt] = mfma16(waf[jt][ks], xf, ra[jt]); rx[jt] = mfma16(wxf[jt][ks], xf, rx[jt]); }
                }
#pragma unroll
                for (int jt = 0; jt < 4; ++jt) {
                    float xc[4]; unpack4(*(const u32x2*)(XC + i * 72 + jt * 16 + fq * 4), xc);
#pragma unroll
                    for (int jj = 0; jj < 4; ++jj) {
                        const float la = c8[jt][jj] * sigm(ra[jt][jj] + ba4[jt][jj]);
                        const float av = __expf(la);
                        const float mult = __builtin_amdgcn_sqrtf(fmaxf(1.f - av * av, 0.f));
                        AA[i * 65 + jt * 16 + fq * 4 + jj] = av;
                        BB[i * 65 + jt * 16 + fq * 4 + jj] = mult * sigm(rx[jt][jj] + bx4[jt][jj]) * xc[jj];
                    }
                }
            }
            __syncthreads();
            if (tid < 64) {
#pragma unroll 1
                for (int r8 = 0; r8 < 8; ++r8) {
                    float av[8], bv[8];
#pragma unroll
                    for (int x = 0; x < 8; ++x) { const int r = d ? 63 - (r8 * 8 + x) : r8 * 8 + x; av[x] = AA[r * 65 + ch]; bv[x] = BB[r * 65 + ch]; }
#pragma unroll
                    for (int x = 0; x < 8; ++x) { const int r = d ? 63 - (r8 * 8 + x) : r8 * 8 + x; hst = av[x] * hst + bv[x]; HH[r * 65 + ch] = hst; }
                }
            }
            __syncthreads();
#pragma unroll
            for (int r = 0; r < 16; ++r) {
                const int ii = tq * 16 + r, t = t0 + ii;
                const float hv = HH[ii * 65 + ch];
                if (d == 0) YC[(size_t)t * 512 + ch] = f2bf(hv);
                else { const float prev = bf2f(YC[(size_t)t * 512 + ch]), gb = bf2f(pr[(size_t)t * PREST_LD + 512 + g * 64 + ch]); YC[(size_t)t * 512 + ch] = f2bf((prev + hv) * gelu_t(gb)); }
            }
        }
        __syncthreads();
    }
}

__device__ void dbg_zero(bf16_t* p, size_t n, int part, int nparts) {
    u32x4* q = (u32x4*)p; const size_t n8 = n / 8, per = (n8 + nparts - 1) / nparts, lo = per * part, hi = (lo + per < n8) ? lo + per : n8;
    for (size_t e = lo + tid_(); e < hi; e += NT) q[e] = (u32x4){0u, 0u, 0u, 0u};
}
__device__ void ph_mixers(const Params& P, int l, char* lds, int which) {
    const int nitems = 384;
    for (int item = bid_(); item < nitems; item += gridDim.x) {
        if (which) { if (item < 256) mx_rwkv(P, l, item, lds); else mx_lru(P, l, item - 256, lds); }
        else if (item < 256) mx_hgrn(P, l, item, lds);
        else mx_mlstm(P, l, item - 256, lds);
        __syncthreads();
    }
}

__device__ void ph_rwpost(const Params& P, int l, char* lds) {
    const int tid = tid_(), wid = tid >> 6, lane = tid & 63, fr = lane & 15, fq = lane >> 4;
    bf16_t* SG = (bf16_t*)lds; float* STAT = (float*)(lds + 64 * 136 * 2);
    const bf16_t* G2T = (const bf16_t*)(P.ws + WT_G2);
    const float* mu = P.in[I_MU] + l * 1792;
    for (int item = bid_(); item < TT / 64; item += gridDim.x) {
        const int tok0 = item * 64, s0 = tok0 & (SQ - 1);
        const bf16_t* prw = (const bf16_t*)(P.ws + OFF_PRW);
        bf16_t* Y0 = (bf16_t*)(P.ws + OFF_Y0); const bf16_t* Y1 = (const bf16_t*)(P.ws + OFF_Y1);
        const float* be0 = (const float*)(P.ws + OFF_BETA); const float* be1 = be0 + (size_t)TT * 8;
        __syncthreads();
        {
            const int r = tid >> 2, part = tid & 3, t = tok0 + r, sp = s0 + r;
#pragma unroll
            for (int v = 0; v < 4; ++v) {
                const int c = part * 32 + v * 8;
                float f0[8], fm[8], fp[8];
                unpack8(*(const u32x4*)(prw + (size_t)t * PRW_LD + 1664 + c), f0);
                if (sp > 0) unpack8(*(const u32x4*)(prw + (size_t)(t - 1) * PRW_LD + 1664 + c), fm); else { for (int x = 0; x < 8; ++x) fm[x] = 0.f; }
                if (sp < SQ - 1) unpack8(*(const u32x4*)(prw + (size_t)(t + 1) * PRW_LD + 1664 + c), fp); else { for (int x = 0; x < 8; ++x) fp[x] = 0.f; }
                float o[8];
#pragma unroll
                for (int x = 0; x < 8; ++x) o[x] = sigm(f0[x] + mu[1664 + c + x] * (0.5f * (fm[x] + fp[x]) - f0[x]));
                *(u32x4*)(SG + r * 136 + c) = (u32x4){pack2(o[0], o[1]), pack2(o[2], o[3]), pack2(o[4], o[5]), pack2(o[6], o[7])};
            }
#pragma unroll
            for (int hh = 0; hh < 2; ++hh) {
                const int head = part * 2 + hh;
                float sm = 0.f, sq = 0.f;
#pragma unroll
                for (int v = 0; v < 8; ++v) {
                    float a[8], bq[8];
                    unpack8(*(const u32x4*)(Y0 + (size_t)t * 512 + head * 64 + v * 8), a); unpack8(*(const u32x4*)(Y1 + (size_t)t * 512 + head * 64 + v * 8), bq);
#pragma unroll
                    for (int x = 0; x < 8; ++x) { const float y = a[x] + bq[x]; sm += y; sq += y * y; }
                }
                const float mean = sm * (1.f / 64.f), var = fmaxf(sq * (1.f / 64.f) - mean * mean, 0.f);
                STAT[(r * 8 + head) * 2] = mean; STAT[(r * 8 + head) * 2 + 1] = rsqrtf(var + 64e-5f);
            }
        }
        __syncthreads();
#pragma unroll 1
        for (int np = 0; np < 4; ++np) {
            const int nt0 = wid * 8 + np * 2;
#pragma unroll 1
            for (int tt = 0; tt < 4; ++tt) {
                f32x4 acc[2];
                acc[0] = (f32x4){0.f, 0.f, 0.f, 0.f}; acc[1] = (f32x4){0.f, 0.f, 0.f, 0.f};
#pragma unroll
                for (int ks = 0; ks < 4; ++ks) {
                    const bf16x8 b0 = ldfrag(G2T + (size_t)(nt0 * 16 + fr) * 128 + ks * 32 + fq * 8), b1 = ldfrag(G2T + (size_t)((nt0 + 1) * 16 + fr) * 128 + ks * 32 + fq * 8);
                    const bf16x8 af = ldfrag(SG + (tt * 16 + fr) * 136 + ks * 32 + fq * 8);
                    acc[0] = mfma16(b0, af, acc[0]); acc[1] = mfma16(b1, af, acc[1]);
                }
#pragma unroll
                for (int q = 0; q < 2; ++q) {
                    const int r = tt * 16 + fr, t = tok0 + r, sp = s0 + r, n = (nt0 + q) * 16 + fq * 4, head = n >> 6;
                    float y0[4], y1[4], v0[4], vm[4], vp[4];
                    unpack4(*(const u32x2*)(Y0 + (size_t)t * 512 + n), y0); unpack4(*(const u32x2*)(Y1 + (size_t)t * 512 + n), y1);
                    unpack4(*(const u32x2*)(prw + (size_t)t * PRW_LD + 1024 + n), v0);
                    if (sp > 0) unpack4(*(const u32x2*)(prw + (size_t)(t - 1) * PRW_LD + 1024 + n), vm); else { vm[0] = vm[1] = vm[2] = vm[3] = 0.f; }
                    if (sp < SQ - 1) unpack4(*(const u32x2*)(prw + (size_t)(t + 1) * PRW_LD + 1024 + n), vp); else { vp[0] = vp[1] = vp[2] = vp[3] = 0.f; }
                    const float mean = STAT[(r * 8 + head) * 2], rstd = STAT[(r * 8 + head) * 2 + 1];
                    const float be = 0.5f * (be0[(size_t)t * 8 + head] + be1[(size_t)t * 8 + head]);
                    const f32x4 lw = *(const f32x4*)(P.in[I_LNW] + l * 512 + n), lb = *(const f32x4*)(P.in[I_LNB] + l * 512 + n), m4 = *(const f32x4*)(mu + 1024 + n);
                    float o[4];
#pragma unroll
                    for (int jj = 0; jj < 4; ++jj) {
                        const float vs = v0[jj] + m4[jj] * (0.5f * (vm[jj] + vp[jj]) - v0[jj]);
                        o[jj] = (((y0[jj] + y1[jj]) - mean) * rstd * lw[jj] + lb[jj] + be * vs) * acc[q][jj];
                    }
                    *(u32x2*)(Y0 + (size_t)t * 512 + n) = (u32x2){pack2(o[0], o[1]), pack2(o[2], o[3])};
                }
            }
        }
    }
    __syncthreads();
}
template <bool ML> __device__ void ph_headpost(const Params& P, int l) {
    const int tid = tid_();
    bf16_t* YO = (bf16_t*)(P.ws + (ML ? OFF_YB : OFF_YD)); const bf16_t* SDF = (const bf16_t*)(P.ws + (ML ? OFF_Y1 : OFF_Y0));
    const bf16_t* pr = (const bf16_t*)(P.ws + OFF_PREST) + (ML ? 1024 : HG_O + 2048);
    const float* ng = P.in[ML ? I_MLN : I_HGN] + l * 512;
    for (int item = bid_(); item < TT / 64; item += gridDim.x) {
        const int t = item * 64 + (tid >> 2), part = tid & 3;
#pragma unroll 2
        for (int hh = 0; hh < 4; ++hh) {
            const int c0 = hh * 128 + part * 32;
            float v[32]; float ss = 0.f;
#pragma unroll
            for (int q = 0; q < 4; ++q) { float f[8], f2[8]; unpack8(*(const u32x4*)(YO + (size_t)t * 512 + c0 + q * 8), f); unpack8(*(const u32x4*)(SDF + (size_t)t * 512 + c0 + q * 8), f2);
#pragma unroll
                for (int x = 0; x < 8; ++x) { const float y = f[x] + f2[x]; v[q * 8 + x] = y; ss += y * y; } }
            ss += dppf<0xB1>(ss); ss += dppf<0x4E>(ss);
            const float rms = rsqrtf(ss * (1.f / 128.f) + 1e-6f);
#pragma unroll
            for (int q = 0; q < 4; ++q) {
                float gq[8]; unpack8(*(const u32x4*)(pr + (size_t)t * PREST_LD + c0 + q * 8), gq);
                float o[8];
#pragma unroll
                for (int x = 0; x < 8; ++x) o[x] = (ML ? sigm(gq[x]) : silu(gq[x])) * v[q * 8 + x] * rms * ng[c0 + q * 8 + x];
                *(u32x4*)(YO + (size_t)t * 512 + c0 + q * 8) = (u32x4){pack2(o[0], o[1]), pack2(o[2], o[3]), pack2(o[4], o[5]), pack2(o[6], o[7])};
            }
        }
    }
}

#define XB_TMO      128
#define XB_XCNT(j)  (256  + 64 * (j))
#define XB_XSUB(j)  (1280 + 64 * (j))
#define XB_XGEN(j)  (2304 + 64 * (j))
#define XB_TOP      3328
#define XB_TOPGEN   3392
#define XCD_BAR_WORDS 3456
#define XB_SPIN_CAP (1u << 18)
#define LAS __attribute__((address_space(3)))

__device__ __forceinline__ unsigned xb_ld(unsigned* p)              { return __hip_atomic_load(p, __ATOMIC_RELAXED, __HIP_MEMORY_SCOPE_AGENT); }
__device__ __forceinline__ unsigned xb_add(unsigned* p, unsigned v) { return __hip_atomic_fetch_add(p, v, __ATOMIC_RELAXED, __HIP_MEMORY_SCOPE_AGENT); }
__device__ __forceinline__ unsigned xb_xcc_id() { return (unsigned)__builtin_amdgcn_s_getreg((3 << 11) | 20) & 0xFu; }
#define XB_SPIN(cond, bar) do { unsigned _sp = 0; while (cond) { __builtin_amdgcn_s_sleep(1); \
    if ((++_sp & 255u) == 0u) { if (xb_ld(&(bar)[XB_TMO])) break; if (_sp > XB_SPIN_CAP) { atomicAdd(&(bar)[XB_TMO], 1u); break; } } } } while (0)

struct XcdBarrier {
    unsigned* bar; unsigned x;
    volatile LAS unsigned* st;
};

__device__ __forceinline__ XcdBarrier xcd_barrier_post(unsigned* bar, volatile LAS unsigned* st) {
    XcdBarrier b; b.bar = bar; b.x = xb_xcc_id(); b.st = st;
    if (threadIdx.x == 0) (void)xb_add(&bar[XB_XCNT(b.x)], 1u);
    return b;
}
__device__ __forceinline__ void xcd_barrier_complete(unsigned* bar, unsigned x, unsigned& nloc, unsigned& nx) {
    const unsigned G = gridDim.x * gridDim.y * gridDim.z;
    unsigned sum, cnt, mine, sp = 0u;
    for (;;) {
        sum = 0u; cnt = 0u; mine = 0u;
#pragma unroll
        for (unsigned j = 0; j < 16; ++j) { const unsigned c = xb_ld(&bar[XB_XCNT(j)]); sum += c; cnt += (c > 0u) ? 1u : 0u; mine = (j == x) ? c : mine; }
        if (sum == G) break;
        __builtin_amdgcn_s_sleep(1);
        if ((++sp & 255u) == 0u) { if (xb_ld(&bar[XB_TMO])) break; if (sp > XB_SPIN_CAP) { atomicAdd(&bar[XB_TMO], 1u); break; } }
    }
    nloc = mine > 0u ? mine : 1u; nx = cnt > 0u ? cnt : 1u;
}

__device__ __forceinline__ void xcd_barrier(const XcdBarrier& b) {
    asm volatile("s_waitcnt vmcnt(0)" ::: "memory");
    __syncthreads();
    if (threadIdx.x == 0) {
        unsigned* bar = b.bar;
        __builtin_amdgcn_s_waitcnt(0);
        unsigned nloc = b.st[0], nx = b.st[1];
        if (nloc == 0u) { xcd_barrier_complete(bar, b.x, nloc, nx); b.st[0] = nloc; b.st[1] = nx; }
        const unsigned old = xb_add(&bar[XB_XSUB(b.x)], 1u);
        const unsigned gen = old / nloc;
        if (old + 1u == (gen + 1u) * nloc) {
            __builtin_amdgcn_fence(__ATOMIC_RELEASE, "agent");
            asm volatile("s_waitcnt vmcnt(0)" ::: "memory");
            const unsigned og = xb_add(&bar[XB_TOP], 1u);
            const unsigned tg = og / nx;
            if (og + 1u == (tg + 1u) * nx) xb_add(&bar[XB_TOPGEN], 1u);
            else XB_SPIN(xb_ld(&bar[XB_TOPGEN]) == tg, bar);
            __builtin_amdgcn_fence(__ATOMIC_ACQUIRE, "agent");
            xb_add(&bar[XB_XGEN(b.x)], 1u);
            asm volatile("s_waitcnt vmcnt(0)" ::: "memory");
        } else {
            XB_SPIN(xb_ld(&bar[XB_XGEN(b.x)]) == gen, bar);
            __builtin_amdgcn_fence(__ATOMIC_ACQUIRE, "agent");
            asm volatile("s_waitcnt vmcnt(0)" ::: "memory");
        }
    }
    __syncthreads();
}


constexpr int N_PHASES = 2 + NL * 13;
__device__ void run_phase(const Params& P, int ph, char* lds) {
    if (ph == 0) { ph_init(P, lds); return; }
    if (ph == N_PHASES - 1) { ph_norm(P, P.in[I_FING], nullptr, 0, 0, nullptr, true); return; }
    const int l = (ph - 1) / 13; int sp = (ph - 1) % 13;
    const float* modl = (const float*)(P.ws + OFF_MOD) + (size_t)l * 16 * 6144;
    if (sp == 2) { ph_mixers(P, l, lds, 0); return; }
    if (sp == 3) { ph_headpost<false>(P, l); ph_headpost<true>(P, l); return; }
    if (sp == 4) { ph_mixers(P, l, lds, 1); return; }
    if (sp > 4) sp -= 2;
    switch (sp) {
        case 0: ph_wt(P, l, lds); ph_norm(P, P.in[I_N1G] + l * DM, modl, 0, 1024, (bf16_t*)(P.ws + OFF_U), false); break;
        case 1: ph_gemm_p(P, lds); break;
        case 3: ph_rwpost(P, l, lds); break;
        case 4: ph_norm(P, P.in[I_N1G] + l * DM, modl, 0, 1024, (bf16_t*)(P.ws + OFF_URE), false); break;
        case 5: ph_gemm_merge(P, lds); break;
        case 6: ph_gemm_out(P, l, lds); break;
        case 7: ph_norm(P, P.in[I_N2G] + l * DM, modl, 3072, 4096, (bf16_t*)(P.ws + OFF_U2), false); break;
        case 8: ph_gemm_up(P, lds); break;
        case 9: ph_convact(P, l); break;
        default: ph_gemm_down(P, l, lds); break;
    }
}

__global__ void __launch_bounds__(NT, 2) mega(Params P, int ph_lo, int ph_hi) {
    extern __shared__ __attribute__((aligned(16))) char smem[];
    cg::grid_group grid = cg::this_grid();
    volatile LAS unsigned* xst = (volatile LAS unsigned*)(smem + LDS_BYTES - 16);
    if (threadIdx.x == 0) { xst[0] = 0u; xst[1] = 0u; }
    __syncthreads();
    XcdBarrier xb = xcd_barrier_post((unsigned*)(P.ws + OFF_BAR), xst);
    for (int ph = ph_lo; ph < ph_hi; ++ph) {
        run_phase(P, ph, smem);
        if (ph + 1 < ph_hi) { if (ph == ph_lo) grid.sync(); else xcd_barrier(xb); }
    }
}

extern "C" void kernel_launch(void* const* d_in, const int* in_sizes, int n_in, void* d_out, int out_size, void* d_ws, size_t ws_size, hipStream_t stream) {
    static int grid_blocks = 0;
    if (grid_blocks == 0) {
        if (n_in != N_INPUTS || ws_size < WS_NEED || out_size != TT * DM) { fprintf(stderr, "kernel_launch: unexpected shapes (n_in %d ws %zu need %zu)\n", n_in, ws_size, (size_t)WS_NEED); grid_blocks = -1; return; }
        int dev = 0, cus = 0, per_cu = 0;
        hipGetDevice(&dev);
        hipDeviceGetAttribute(&cus, hipDeviceAttributeMultiprocessorCount, dev);
        if (hipFuncSetAttribute((const void*)mega, hipFuncAttributeMaxDynamicSharedMemorySize, LDS_BYTES) != hipSuccess) { fprintf(stderr, "kernel_launch: hipFuncSetAttribute failed\n"); grid_blocks = -1; return; }
        hipOccupancyMaxActiveBlocksPerMultiprocessor(&per_cu, (const void*)mega, NT, LDS_BYTES);
        if (per_cu < 1) per_cu = 1;
        if (per_cu > 2) per_cu = 2;
        grid_blocks = cus * per_cu;
    }
    if (grid_blocks < 0) return;
    if (hipMemsetAsync((char*)d_ws + OFF_BAR, 0, BAR_BYTES, stream) != hipSuccess) { fprintf(stderr, "kernel_launch: memset of the barrier words failed\n"); return; }
    Params p{};
    for (int i = 0; i < N_INPUTS; ++i) p.in[i] = (const float*)d_in[i];
    p.out = (float*)d_out; p.ws = (char*)d_ws;
#if MULTI_LAUNCH
    for (int ph = 0; ph < N_PHASES; ++ph) hipLaunchKernelGGL(mega, dim3(grid_blocks), dim3(NT), LDS_BYTES, stream, p, ph, ph + 1);
#else
    int lo = 0, hi = N_PHASES;
    void* args[] = {&p, &lo, &hi};
    hipError_t e = hipLaunchCooperativeKernel((const void*)mega, dim3(grid_blocks), dim3(NT), args, LDS_BYTES, stream);
    if (e != hipSuccess) fprintf(stderr, "cooperative launch failed: %s (grid %d)\n", hipGetErrorString(e), grid_blocks);
#endif
}
```

```cpp
#include <hip/hip_runtime.h>
#include <hip/hip_cooperative_groups.h>
#include <cstdio>
namespace cg = cooperative_groups;

typedef unsigned short bf16_t;
typedef short bf16x8 __attribute__((ext_vector_type(8)));
typedef float f32x4 __attribute__((ext_vector_type(4)));
typedef unsigned u32x4 __attribute__((ext_vector_type(4)));
typedef unsigned u32x2 __attribute__((ext_vector_type(2)));

#ifndef DBG_SKIP
#define DBG_SKIP 0
#endif
#ifndef DBG_NOFFN
#define DBG_NOFFN 0
#endif
#ifndef MULTI_LAUNCH
#define MULTI_LAUNCH 0
#endif

constexpr int NB = 16, SQ = 2048, DM = 1024, TT = NB * SQ, MW = 512, NL = 4;
constexpr int NT = 256;
constexpr int PRW_LD = 1792, PREST_LD = 5248;
constexpr int LRU_O = 1664, HG_O = 2688;
constexpr int GATE_ROW0 = 7040;
constexpr int DFF = 2816;
constexpr int LDS_BYTES = 73728;

constexpr size_t WT_WIN = 0;
constexpr size_t WT_WB = WT_WIN + (size_t)11136 * 1024 * 2;
constexpr size_t WT_WOUT = WT_WB + (size_t)4 * 1024 * 512 * 2;
constexpr size_t WT_WUP = WT_WOUT + (size_t)1024 * 1024 * 2;
constexpr size_t WT_WDN = WT_WUP + (size_t)5632 * 1024 * 2;
constexpr size_t WT_G2 = WT_WDN + (size_t)1024 * 2816 * 2;
constexpr size_t WT_W2 = WT_G2 + (size_t)512 * 128 * 2;
constexpr size_t WT_A2 = WT_W2 + (size_t)2 * 512 * 64 * 2;
constexpr size_t WT_LRU = WT_A2 + (size_t)2 * 512 * 64 * 2;
constexpr size_t WT_END = WT_LRU + (size_t)2 * 2 * 8 * 64 * 64 * 2;
constexpr size_t OFF_PRW = (size_t)48 << 20;
static_assert(WT_END <= OFF_PRW, "wt");
constexpr size_t OFF_PREST = OFF_PRW + (size_t)TT * PRW_LD * 2;
constexpr size_t OFF_Y = OFF_PREST + (size_t)TT * PREST_LD * 2;
constexpr size_t YSZ = (size_t)TT * 512 * 2;
constexpr size_t OFF_YB = OFF_Y, OFF_YC = OFF_Y + YSZ, OFF_YD = OFF_Y + 2 * YSZ, OFF_Y0 = OFF_Y + 3 * YSZ, OFF_Y1 = OFF_Y + 4 * YSZ;
constexpr size_t OFF_SMALL = OFF_Y + 5 * YSZ;
constexpr size_t OFF_MOD = OFF_SMALL;
constexpr size_t OFF_LB = OFF_MOD + (size_t)4 * 16 * 6144 * 4;
constexpr size_t OFF_BETA = OFF_LB + (size_t)4 * 2 * 512 * 4;
constexpr size_t OFF_BAR = OFF_BETA + (size_t)2 * TT * 8 * 4;
constexpr size_t BAR_BYTES = 16384;
constexpr size_t WS_NEED = OFF_BAR + BAR_BYTES;
constexpr size_t OFF_U = OFF_Y;
constexpr size_t OFF_URE = OFF_PREST;
constexpr size_t OFF_MERGED = OFF_PREST + (size_t)TT * 1024 * 2;
constexpr size_t OFF_U2 = OFF_Y;
constexpr size_t OFF_Z = OFF_PRW;
constexpr size_t OFF_ACT = OFF_PRW + (size_t)TT * 5632 * 2;
static_assert(OFF_ACT + (size_t)TT * 2816 * 2 <= OFF_SMALL, "act");

enum { I_X = 0, I_C, I_ADAW, I_ADAB, I_N1G, I_WIN, I_MU, I_W0, I_W2, I_A0, I_A2, I_G2, I_KK, I_KA, I_RK, I_LNW, I_LNB,
       I_MLIB, I_MLFB, I_MLN, I_LCW, I_LCB, I_LWA, I_LBA, I_LWX, I_LBX, I_LLAM, I_HGLB, I_HGN, I_WBR, I_WOUT, I_N2G,
       I_FUP, I_FCW, I_FCB, I_FDN, I_FING, N_INPUTS };

struct Params { const float* in[N_INPUTS]; float* out; char* ws; };

__device__ __forceinline__ int tid_() { int x = threadIdx.x; asm volatile("" : "+v"(x)); return x; }
__device__ __forceinline__ int bid_() { int x = blockIdx.x; asm volatile("" : "+s"(x)); return x; }
__device__ __forceinline__ bf16_t f2bf(float f) { const __bf16 h = (__bf16)f; return __builtin_bit_cast(unsigned short, h); }
__device__ __forceinline__ float bf2f(bf16_t h) { return __uint_as_float(((unsigned)h) << 16); }
typedef __bf16 bf16x2n __attribute__((ext_vector_type(2)));
typedef float f32x2n __attribute__((ext_vector_type(2)));
__device__ __forceinline__ unsigned pack2(float a, float b) { const f32x2n v = {a, b}; const bf16x2n h = __builtin_convertvector(v, bf16x2n); return __builtin_bit_cast(unsigned, h); }
__device__ __forceinline__ float lo2f(unsigned u) { return __uint_as_float(u << 16); }
__device__ __forceinline__ float hi2f(unsigned u) { return __uint_as_float(u & 0xffff0000u); }
__device__ __forceinline__ float rcpf_(float x) { return __builtin_amdgcn_rcpf(x); }
__device__ __forceinline__ float flog_(float x) { return __builtin_amdgcn_logf(x) * 0.69314718056f; }
__device__ __forceinline__ float sigm(float x) { return rcpf_(1.f + __expf(-x)); }
__device__ __forceinline__ float silu(float x) { return x * sigm(x); }
__device__ __forceinline__ float logsig(float x) { return fminf(x, 0.f) - flog_(1.f + __expf(-fabsf(x))); }
__device__ __forceinline__ float tanh_f(float x) { return 1.f - 2.f * rcpf_(1.f + __expf(2.f * x)); }
__device__ __forceinline__ float gelu_t(float x) { return 0.5f * x * (1.f + tanh_f(0.7978845608f * (x + 0.044715f * x * x * x))); }
template <int CTRL> __device__ __forceinline__ float dppf(float x) { return __int_as_float(__builtin_amdgcn_update_dpp(0, __float_as_int(x), CTRL, 0xF, 0xF, false)); }
__device__ __forceinline__ float rowsum16(float x) { x += dppf<0x128>(x); x += dppf<0x124>(x); x += dppf<0x122>(x); x += dppf<0x121>(x); return x; }
__device__ __forceinline__ float rdlane(float x, int l) { return __int_as_float(__builtin_amdgcn_readlane(__float_as_int(x), l)); }
__device__ __forceinline__ float wsum64(float x) { x = rowsum16(x); return (rdlane(x, 0) + rdlane(x, 16)) + (rdlane(x, 32) + rdlane(x, 48)); }
__device__ __forceinline__ float bperm(float x, int srclane) { return __int_as_float(__builtin_amdgcn_ds_bpermute(srclane << 2, __float_as_int(x))); }
__device__ __forceinline__ float qsum(float x, int lane) { x += bperm(x, lane ^ 16); x += bperm(x, lane ^ 32); return x; }
__device__ __forceinline__ void unpack8(u32x4 v, float (&f)[8]) {
    f[0] = lo2f(v.x); f[1] = hi2f(v.x); f[2] = lo2f(v.y); f[3] = hi2f(v.y); f[4] = lo2f(v.z); f[5] = hi2f(v.z); f[6] = lo2f(v.w); f[7] = hi2f(v.w); }
__device__ __forceinline__ void unpack4(u32x2 v, float (&f)[4]) { f[0] = lo2f(v.x); f[1] = hi2f(v.x); f[2] = lo2f(v.y); f[3] = hi2f(v.y); }
__device__ __forceinline__ f32x4 mfma16(bf16x8 a, bf16x8 b, f32x4 c) { return __builtin_amdgcn_mfma_f32_16x16x32_bf16(a, b, c, 0, 0, 0); }
__device__ __forceinline__ bf16x8 ldfrag(const bf16_t* p) { return *reinterpret_cast<const bf16x8*>(p); }

__device__ __forceinline__ void gemm_stage(const bf16_t* __restrict__ A, long lda, const bf16_t* __restrict__ Bt, long ldb, int kt, char* buf, int tid) {
#pragma unroll
    for (int i = 0; i < 4; ++i) {
        const int b = tid * 16 + i * 4096, r = b >> 7, c = ((b & 127) >> 4) ^ (r & 7);
        __builtin_amdgcn_global_load_lds((const unsigned*)(A + (long)r * lda + kt * 64 + c * 8), (__attribute__((address_space(3))) unsigned*)(buf + b), 16, 0, 0);
        __builtin_amdgcn_global_load_lds((const unsigned*)(Bt + (long)r * ldb + kt * 64 + c * 8), (__attribute__((address_space(3))) unsigned*)(buf + 16384 + b), 16, 0, 0);
    }
}
__device__ __forceinline__ void gemm_acc(const bf16_t* __restrict__ A, long lda, const bf16_t* __restrict__ Bt, long ldb, int K, f32x4 (&acc)[4][4], char* lds) {
    const int tid = tid_(), wid = tid >> 6, lane = tid & 63, wr = wid >> 1, wc = wid & 1, fr = lane & 15, fq = lane >> 4;
    const int nk = K >> 6;
    gemm_stage(A, lda, Bt, ldb, 0, lds, tid);
    asm volatile("s_waitcnt vmcnt(0)" ::: "memory");
    __syncthreads();
    for (int kt = 0; kt < nk; ++kt) {
        char* cur = lds + (kt & 1) * 32768;
        if (kt + 1 < nk) gemm_stage(A, lda, Bt, ldb, kt + 1, lds + ((kt + 1) & 1) * 32768, tid);
#pragma unroll
        for (int ks = 0; ks < 2; ++ks) {
            bf16x8 af[4], bfr[4];
#pragma unroll
            for (int m = 0; m < 4; ++m) { const int row = wr * 64 + m * 16 + fr; af[m] = *reinterpret_cast<const bf16x8*>(cur + row * 128 + (((ks * 4 + fq) ^ (row & 7)) << 4)); }
#pragma unroll
            for (int n = 0; n < 4; ++n) { const int row = wc * 64 + n * 16 + fr; bfr[n] = *reinterpret_cast<const bf16x8*>(cur + 16384 + row * 128 + (((ks * 4 + fq) ^ (row & 7)) << 4)); }
            __builtin_amdgcn_s_setprio(1);
#pragma unroll
            for (int m = 0; m < 4; ++m)
#pragma unroll
                for (int n = 0; n < 4; ++n) acc[m][n] = mfma16(bfr[n], af[m], acc[m][n]);
            __builtin_amdgcn_s_setprio(0);
        }
        asm volatile("s_waitcnt vmcnt(0)" ::: "memory");
        __syncthreads();
    }
}
__device__ __forceinline__ void gemm2_stage(const bf16_t* __restrict__ A, long lda, const bf16_t* __restrict__ Bt, long ldb, int kt, char* buf, int tid) {
#pragma unroll
    for (int i = 0; i < 4; ++i) {
        const int b = tid * 16 + i * 4096, r = b >> 6, c = ((b & 63) >> 4) ^ ((r >> 2) & 3);
        __builtin_amdgcn_global_load_lds((const unsigned*)(A + (long)r * lda + kt * 32 + c * 8), (__attribute__((address_space(3))) unsigned*)(buf + b), 16, 0, 0);
    }
#pragma unroll
    for (int i = 0; i < 2; ++i) {
        const int b = tid * 16 + i * 4096, r = b >> 6, c = ((b & 63) >> 4) ^ ((r >> 2) & 3);
        __builtin_amdgcn_global_load_lds((const unsigned*)(Bt + (long)r * ldb + kt * 32 + c * 8), (__attribute__((address_space(3))) unsigned*)(buf + 16384 + b), 16, 0, 0);
    }
}
__device__ __forceinline__ void gemm_acc2(const bf16_t* __restrict__ A, long lda, const bf16_t* __restrict__ Bt, long ldb, int K, f32x4 (&acc)[8][4], char* lds) {
    const int tid = tid_(), wid = tid >> 6, lane = tid & 63, wr = wid >> 1, wc = wid & 1, fr = lane & 15, fq = lane >> 4;
    const int nk = K >> 5;
    gemm2_stage(A, lda, Bt, ldb, 0, lds, tid);
    asm volatile("s_waitcnt vmcnt(0)" ::: "memory");
    __syncthreads();
    for (int kt = 0; kt < nk; ++kt) {
        char* cur = lds + (kt & 1) * 24576;
        if (kt + 1 < nk) gemm2_stage(A, lda, Bt, ldb, kt + 1, lds + ((kt + 1) & 1) * 24576, tid);
        bf16x8 bfr[4];
#pragma unroll
        for (int n = 0; n < 4; ++n) { const int row = wc * 64 + n * 16 + fr; bfr[n] = *reinterpret_cast<const bf16x8*>(cur + 16384 + row * 64 + ((fq ^ ((row >> 2) & 3)) << 4)); }
        bf16x8 af[8];
#pragma unroll
        for (int m = 0; m < 8; ++m) { const int row = wr * 128 + m * 16 + fr; af[m] = *reinterpret_cast<const bf16x8*>(cur + row * 64 + ((fq ^ ((row >> 2) & 3)) << 4)); }
        __builtin_amdgcn_s_setprio(1);
#pragma unroll
        for (int m = 0; m < 8; ++m)
#pragma unroll
            for (int n = 0; n < 4; ++n) acc[m][n] = mfma16(bfr[n], af[m], acc[m][n]);
        __builtin_amdgcn_s_setprio(0);
        asm volatile("s_waitcnt vmcnt(0)" ::: "memory");
        __syncthreads();
    }
}
__device__ __forceinline__ void zero_acc2(f32x4 (&acc)[8][4]) {
#pragma unroll
    for (int m = 0; m < 8; ++m)
#pragma unroll
        for (int n = 0; n < 4; ++n) acc[m][n] = (f32x4){0.f, 0.f, 0.f, 0.f};
}
__device__ __forceinline__ void zero_acc(f32x4 (&acc)[4][4]) {
#pragma unroll
    for (int m = 0; m < 4; ++m)
#pragma unroll
        for (int n = 0; n < 4; ++n) acc[m][n] = (f32x4){0.f, 0.f, 0.f, 0.f};
}

__device__ void ph_init(const Params& P, char* lds) {
    const int tid = tid_();
    {
        const f32x4* src = (const f32x4*)P.in[I_X]; f32x4* dst = (f32x4*)P.out;
        const long n4 = (long)TT * DM / 4;
        for (long i = (long)bid_() * NT + tid; i < n4; i += (long)gridDim.x * NT) dst[i] = src[i];
    }
    float* mod = (float*)(P.ws + OFF_MOD);
    float* lbo = (float*)(P.ws + OFF_LB);
    for (int item = bid_(); item < 385; item += gridDim.x) {
        if (item < 384) {
            const int l = item / 96, j0 = (item % 96) * 64;
            const int col = tid & 63, kg = tid >> 6;
            float* CS = (float*)lds;
            float* RED = CS + 4096;
            float acc[16];
#pragma unroll
            for (int b = 0; b < 16; ++b) acc[b] = 0.f;
            const float* Wl = P.in[I_ADAW] + (size_t)l * DM * 6144;
            for (int sub = 0; sub < 4; ++sub) {
                __syncthreads();
                for (int e = tid; e < 4096; e += NT) {
                    const int kk = e & 63, b = (e >> 6) & 15, g = e >> 10;
                    CS[e] = silu(P.in[I_C][b * DM + g * 256 + sub * 64 + kk]);
                }
                __syncthreads();
                for (int kk = 0; kk < 64; ++kk) {
                    const float w = Wl[(size_t)(kg * 256 + sub * 64 + kk) * 6144 + j0 + col];
#pragma unroll
                    for (int b = 0; b < 16; ++b) acc[b] += CS[(kg * 16 + b) * 64 + kk] * w;
                }
            }
#pragma unroll
            for (int b = 0; b < 16; ++b) RED[(kg * 64 + col) * 16 + b] = acc[b];
            __syncthreads();
            {
                const int bg = tid >> 6;
#pragma unroll
                for (int bb = 0; bb < 4; ++bb) {
                    const int b = bg * 4 + bb;
                    float s = RED[(0 * 64 + col) * 16 + b] + RED[(1 * 64 + col) * 16 + b] + RED[(2 * 64 + col) * 16 + b] + RED[(3 * 64 + col) * 16 + b];
                    mod[((size_t)l * 16 + b) * 6144 + j0 + col] = s + P.in[I_ADAB][l * 6144 + j0 + col];
                }
            }
            __syncthreads();
        } else {
            for (int e = tid; e < 1024; e += NT) {
                float x[4], mx = -1e30f;
#pragma unroll
                for (int l = 0; l < 4; ++l) { x[l] = P.in[I_HGLB][l * 1024 + e]; mx = fmaxf(mx, x[l]); }
                float s = 0.f;
#pragma unroll
                for (int l = 0; l < 4; ++l) { x[l] = __expf(x[l] - mx); s += x[l]; }
                const float inv = rcpf_(s);
                float cum = 0.f;
                lbo[0 * 1024 + e] = 0.f;
#pragma unroll
                for (int l = 1; l < 4; ++l) { cum += x[l] * inv; lbo[l * 1024 + e] = fminf(fmaxf(cum, 0.f), 1.f); }
            }
        }
    }
}

__device__ __forceinline__ void tr_tile(const float* __restrict__ src, int ld, int N, int k0, int n0, bf16_t* __restrict__ dst, int dld, int drow0, bool winmap, char* lds) {
    float* Tl = (float*)lds;
    const int tid = tid_();
    __syncthreads();
#pragma unroll
    for (int i = 0; i < 4; ++i) {
        const int kk = (tid >> 4) + 16 * i, nn = (tid & 15) * 4;
        f32x4 v = (f32x4){0.f, 0.f, 0.f, 0.f};
        if (n0 + nn < N) v = *(const f32x4*)(src + (size_t)(k0 + kk) * ld + n0 + nn);
        Tl[kk * 65 + nn] = v[0]; Tl[kk * 65 + nn + 1] = v[1]; Tl[kk * 65 + nn + 2] = v[2]; Tl[kk * 65 + nn + 3] = v[3];
    }
    __syncthreads();
    {
        const int nn = tid >> 2, kb = (tid & 3) * 16;
        if (n0 + nn < N) {
            int drow = drow0 + nn;
            if (winmap) { const int n = n0 + nn; drow = n + (n >= 3344 ? 112 : 0); }
            unsigned w[8];
#pragma unroll
            for (int j = 0; j < 8; ++j) w[j] = pack2(Tl[(kb + 2 * j) * 65 + nn], Tl[(kb + 2 * j + 1) * 65 + nn]);
            u32x4* d = (u32x4*)(dst + (size_t)drow * dld + k0 + kb);
            d[0] = (u32x4){w[0], w[1], w[2], w[3]}; d[1] = (u32x4){w[4], w[5], w[6], w[7]};
        }
    }
}
__device__ void ph_wt(const Params& P, int l, char* lds) {
    char* ws = P.ws;
    const int NI = 2768 + 512 + 256 + 1408 + 704 + 16 + 16 + 16 + 16 + 16 + 7;
    for (int item = bid_(); item < NI; item += gridDim.x) {
        int it = item;
        if (it < 2768) { const int kt = it / 173, nt = it % 173;
            tr_tile(P.in[I_WIN] + (size_t)l * 1024 * 11024, 11024, 11024, kt * 64, nt * 64, (bf16_t*)(ws + WT_WIN), 1024, 0, true, lds); continue; }
        it -= 2768;
        if (it < 512) { const int n = it / 128, r = it % 128, kt = r / 16, nt = r % 16;
            tr_tile(P.in[I_WBR] + ((size_t)l * 4 + n) * 512 * 1024, 1024, 1024, kt * 64, nt * 64, (bf16_t*)(ws + WT_WB) + (size_t)n * 1024 * 512, 512, nt * 64, false, lds); continue; }
        it -= 512;
        if (it < 256) { const int kt = it / 16, nt = it % 16;
            tr_tile(P.in[I_WOUT] + (size_t)l * 1024 * 1024, 1024, 1024, kt * 64, nt * 64, (bf16_t*)(ws + WT_WOUT), 1024, nt * 64, false, lds); continue; }
        it -= 256;
        if (it < 1408) { const int kt = it / 88, nt = it % 88;
            tr_tile(P.in[I_FUP] + (size_t)l * 1024 * 5632, 5632, 5632, kt * 64, nt * 64, (bf16_t*)(ws + WT_WUP), 1024, nt * 64, false, lds); continue; }
        it -= 1408;
        if (it < 704) { const int kt = it / 16, nt = it % 16;
            tr_tile(P.in[I_FDN] + (size_t)l * 2816 * 1024, 1024, 1024, kt * 64, nt * 64, (bf16_t*)(ws + WT_WDN), 2816, nt * 64, false, lds); continue; }
        it -= 704;
        if (it < 16) { const int kt = it / 8, nt = it % 8;
            tr_tile(P.in[I_G2] + (size_t)l * 128 * 512, 512, 512, kt * 64, nt * 64, (bf16_t*)(ws + WT_G2), 128, nt * 64, false, lds); continue; }
        it -= 16;
        if (it < 16) { const int d = it / 8, nt = it % 8;
            tr_tile(P.in[I_W2] + ((size_t)l * 2 + d) * 64 * 512, 512, 512, 0, nt * 64, (bf16_t*)(ws + WT_W2) + (size_t)d * 512 * 64, 64, nt * 64, false, lds); continue; }
        it -= 16;
        if (it < 16) { const int d = it / 8, nt = it % 8;
            tr_tile(P.in[I_A2] + ((size_t)l * 2 + d) * 64 * 512, 512, 512, 0, nt * 64, (bf16_t*)(ws + WT_A2) + (size_t)d * 512 * 64, 64, nt * 64, false, lds); continue; }
        it -= 16;
        if (it < 32) { const int mat = it / 16, d = (it % 16) / 8, g = it % 8;
            const float* src = P.in[mat ? I_LWX : I_LWA] + (((size_t)l * 2 + d) * 8 + g) * 64 * 64;
            tr_tile(src, 64, 64, 0, 0, (bf16_t*)(ws + WT_LRU) + (((size_t)d * 2 + mat) * 8 + g) * 64 * 64, 64, 0, false, lds); continue; }
        it -= 32;
        {
            u32x4* d = (u32x4*)((bf16_t*)(ws + WT_WIN) + (size_t)(3344 + it * 16) * 1024);
            for (int e = tid_(); e < 16 * 1024 / 8; e += NT) d[e] = (u32x4){0u, 0u, 0u, 0u};
        }
    }
}

__device__ void ph_norm(const Params& P, const float* __restrict__ g, const float* __restrict__ modl, int sh_off, int sc_off, bf16_t* __restrict__ dst, bool final_) {
    const int tid = tid_(), wid = tid >> 6, lane = tid & 63;
    for (int item = bid_(); item < TT / 16; item += gridDim.x) {
        const int row0 = item * 16 + wid * 4, b = row0 >> 11;
        f32x4 v[4][4];
#pragma unroll
        for (int r = 0; r < 4; ++r)
#pragma unroll
            for (int i = 0; i < 4; ++i) v[r][i] = *(const f32x4*)(P.out + (size_t)(row0 + r) * DM + i * 256 + lane * 4);
        f32x4 gv[4], sc[4], sh[4];
#pragma unroll
        for (int i = 0; i < 4; ++i) {
            const int c = i * 256 + lane * 4;
            gv[i] = *(const f32x4*)(g + c);
            if (!final_) { sc[i] = *(const f32x4*)(modl + (size_t)b * 6144 + sc_off + c); sh[i] = *(const f32x4*)(modl + (size_t)b * 6144 + sh_off + c); }
        }
#pragma unroll
        for (int r = 0; r < 4; ++r) {
            float ss = 0.f;
#pragma unroll
            for (int i = 0; i < 4; ++i) ss += v[r][i][0] * v[r][i][0] + v[r][i][1] * v[r][i][1] + v[r][i][2] * v[r][i][2] + v[r][i][3] * v[r][i][3];
            ss = wsum64(ss);
            const float rs = rsqrtf(ss * (1.f / DM) + 1e-6f);
            float* hr = P.out + (size_t)(row0 + r) * DM;
#pragma unroll
            for (int i = 0; i < 4; ++i) {
                const int c = i * 256 + lane * 4;
                if (final_) {
                    *(f32x4*)(hr + c) = v[r][i] * rs * gv[i];
                } else {
                    const f32x4 o = v[r][i] * rs * gv[i] * (sc[i] + 1.f) + sh[i];
                    *(u32x2*)(dst + (size_t)(row0 + r) * DM + c) = (u32x2){pack2(o[0], o[1]), pack2(o[2], o[3])};
                }
            }
        }
    }
}

__device__ __forceinline__ void store_tile_bf16(const f32x4 (&acc)[4][4], bf16_t* __restrict__ dst, long ld) {
    const int tid = tid_(), wid = tid >> 6, lane = tid & 63, wr = wid >> 1, wc = wid & 1, fr = lane & 15, fq = lane >> 4;
#pragma unroll
    for (int m = 0; m < 4; ++m)
#pragma unroll
        for (int n = 0; n < 4; ++n) {
            const f32x4 v = acc[m][n];
            *(u32x2*)(dst + (long)(wr * 64 + m * 16 + fr) * ld + wc * 64 + n * 16 + fq * 4) = (u32x2){pack2(v[0], v[1]), pack2(v[2], v[3])};
        }
}
__device__ __forceinline__ void resid_tile(const f32x4 (&acc)[4][4], float* __restrict__ h, int row0, int col0, const float* __restrict__ gate) {
    const int tid = tid_(), wid = tid >> 6, lane = tid & 63, wr = wid >> 1, wc = wid & 1, fr = lane & 15, fq = lane >> 4;
    const int b = row0 >> 11;
#pragma unroll
    for (int n = 0; n < 4; ++n) {
        const int col = col0 + wc * 64 + n * 16 + fq * 4;
        const f32x4 gv = *(const f32x4*)(gate + (size_t)b * 6144 + col);
#pragma unroll
        for (int m = 0; m < 4; ++m) {
            float* hp = h + (size_t)(row0 + wr * 64 + m * 16 + fr) * DM + col;
            const f32x4 o = *(const f32x4*)hp + gv * acc[m][n];
            *(f32x4*)hp = o;
        }
    }
}
__device__ __forceinline__ void store_tile2_bf16(const f32x4 (&acc)[8][4], bf16_t* __restrict__ dst, long ld) {
    const int tid = tid_(), wid = tid >> 6, lane = tid & 63, wr = wid >> 1, wc = wid & 1, fr = lane & 15, fq = lane >> 4;
#pragma unroll
    for (int m = 0; m < 8; ++m)
#pragma unroll
        for (int n = 0; n < 4; ++n) {
            const f32x4 v = acc[m][n];
            *(u32x2*)(dst + (long)(wr * 128 + m * 16 + fr) * ld + wc * 64 + n * 16 + fq * 4) = (u32x2){pack2(v[0], v[1]), pack2(v[2], v[3])};
        }
}
__device__ __forceinline__ void resid_tile2(const f32x4 (&acc)[8][4], float* __restrict__ h, int row0, int col0, const float* __restrict__ gate) {
    const int tid = tid_(), wid = tid >> 6, lane = tid & 63, wr = wid >> 1, wc = wid & 1, fr = lane & 15, fq = lane >> 4;
    const int b = row0 >> 11;
#pragma unroll
    for (int n = 0; n < 4; ++n) {
        const int col = col0 + wc * 64 + n * 16 + fq * 4;
        const f32x4 gv = *(const f32x4*)(gate + (size_t)b * 6144 + col);
#pragma unroll
        for (int m = 0; m < 8; ++m) {
            float* hp = h + (size_t)(row0 + wr * 128 + m * 16 + fr) * DM + col;
            const f32x4 o = *(const f32x4*)hp + gv * acc[m][n];
            *(f32x4*)hp = o;
        }
    }
}
__device__ void ph_gemm_p(const Params& P, char* lds) {
    const bf16_t* U = (const bf16_t*)(P.ws + OFF_U); const bf16_t* Wt = (const bf16_t*)(P.ws + WT_WIN);
    bf16_t* prw = (bf16_t*)(P.ws + OFF_PRW); bf16_t* prest = (bf16_t*)(P.ws + OFF_PREST);
    for (int item = bid_(); item < 128 * 55; item += gridDim.x) {
        const int mt = item / 55, nt = item % 55;
        f32x4 acc[8][4]; zero_acc2(acc);
        gemm_acc2(U + (size_t)mt * 256 * DM, DM, Wt + (size_t)nt * 128 * DM, DM, DM, acc, lds);
        if (nt < 14) store_tile2_bf16(acc, prw + (size_t)mt * 256 * PRW_LD + nt * 128, PRW_LD);
        else store_tile2_bf16(acc, prest + (size_t)mt * 256 * PREST_LD + (nt - 14) * 128, PREST_LD);
    }
}
__device__ void ph_gemm_merge(const Params& P, char* lds) {
    const bf16_t* U = (const bf16_t*)(P.ws + OFF_URE); const bf16_t* Wt = (const bf16_t*)(P.ws + WT_WIN); const bf16_t* Wb = (const bf16_t*)(P.ws + WT_WB);
    bf16_t* mg = (bf16_t*)(P.ws + OFF_MERGED);
    for (int item = bid_(); item < 256 * 8; item += gridDim.x) {
        const int mt = item / 8, nt = item % 8;
        unsigned mpk[4][4][2];
#pragma unroll
        for (int m = 0; m < 4; ++m)
#pragma unroll
            for (int q = 0; q < 4; ++q) { mpk[m][q][0] = 0u; mpk[m][q][1] = 0u; }
#pragma unroll 1
        for (int n = 0; n < 4; ++n) {
            unsigned gpk[4][4][2];
            {
                f32x4 acc[4][4]; zero_acc(acc);
                gemm_acc(U + (size_t)mt * 128 * DM, DM, Wt + (size_t)(GATE_ROW0 + n * 1024 + nt * 128) * DM, DM, DM, acc, lds);
#pragma unroll
                for (int m = 0; m < 4; ++m)
#pragma unroll
                    for (int q = 0; q < 4; ++q) { gpk[m][q][0] = pack2(sigm(acc[m][q][0]), sigm(acc[m][q][1])); gpk[m][q][1] = pack2(sigm(acc[m][q][2]), sigm(acc[m][q][3])); }
            }
            const size_t yoff = (n == 0) ? OFF_Y0 : (n == 1 ? OFF_YB : (n == 2 ? OFF_YC : OFF_YD));
            const bf16_t* Y = (const bf16_t*)(P.ws + yoff);
            f32x4 acc[4][4]; zero_acc(acc);
            gemm_acc(Y + (size_t)mt * 128 * 512, 512, Wb + ((size_t)n * 1024 + nt * 128) * 512, 512, 512, acc, lds);
#pragma unroll
            for (int m = 0; m < 4; ++m)
#pragma unroll
                for (int q = 0; q < 4; ++q) {
                    mpk[m][q][0] = pack2(lo2f(mpk[m][q][0]) + lo2f(gpk[m][q][0]) * acc[m][q][0], hi2f(mpk[m][q][0]) + hi2f(gpk[m][q][0]) * acc[m][q][1]);
                    mpk[m][q][1] = pack2(lo2f(mpk[m][q][1]) + lo2f(gpk[m][q][1]) * acc[m][q][2], hi2f(mpk[m][q][1]) + hi2f(gpk[m][q][1]) * acc[m][q][3]);
                }
        }
        {
            const int tid = tid_(), wid = tid >> 6, lane = tid & 63, wr = wid >> 1, wc = wid & 1, fr = lane & 15, fq = lane >> 4;
            bf16_t* dst = mg + (size_t)mt * 128 * DM + nt * 128;
#pragma unroll
            for (int m = 0; m < 4; ++m)
#pragma unroll
                for (int q = 0; q < 4; ++q) *(u32x2*)(dst + (long)(wr * 64 + m * 16 + fr) * DM + wc * 64 + q * 16 + fq * 4) = (u32x2){mpk[m][q][0], mpk[m][q][1]};
        }
    }
}
__device__ void ph_gemm_out(const Params& P, int l, char* lds) {
    const bf16_t* A = (const bf16_t*)(P.ws + OFF_MERGED); const bf16_t* Wt = (const bf16_t*)(P.ws + WT_WOUT);
    const float* gate = (const float*)(P.ws + OFF_MOD) + (size_t)l * 16 * 6144 + 2048;
    for (int item = bid_(); item < 256 * 8; item += gridDim.x) {
        const int mt = item / 8, nt = item % 8;
        f32x4 acc[4][4]; zero_acc(acc);
        gemm_acc(A + (size_t)mt * 128 * DM, DM, Wt + (size_t)nt * 128 * DM, DM, DM, acc, lds);
        resid_tile(acc, P.out, mt * 128, nt * 128, gate);
    }
}
__device__ void ph_gemm_up(const Params& P, char* lds) {
    const bf16_t* A = (const bf16_t*)(P.ws + OFF_U2); const bf16_t* Wt = (const bf16_t*)(P.ws + WT_WUP);
    bf16_t* Z = (bf16_t*)(P.ws + OFF_Z);
    for (int item = bid_(); item < 128 * 44; item += gridDim.x) {
        const int mt = item / 44, nt = item % 44;
        f32x4 acc[8][4]; zero_acc2(acc);
        gemm_acc2(A + (size_t)mt * 256 * DM, DM, Wt + (size_t)nt * 128 * DM, DM, DM, acc, lds);
        store_tile2_bf16(acc, Z + (size_t)mt * 256 * 5632 + nt * 128, 5632);
    }
}
__device__ void ph_gemm_down(const Params& P, int l, char* lds) {
    const bf16_t* A = (const bf16_t*)(P.ws + OFF_ACT); const bf16_t* Wt = (const bf16_t*)(P.ws + WT_WDN);
    const float* gate = (const float*)(P.ws + OFF_MOD) + (size_t)l * 16 * 6144 + 5120;
    for (int item = bid_(); item < 128 * 8; item += gridDim.x) {
        const int mt = item / 8, nt = item % 8;
        f32x4 acc[8][4]; zero_acc2(acc);
        gemm_acc2(A + (size_t)mt * 256 * DFF, DFF, Wt + (size_t)nt * 128 * DFF, DFF, DFF, acc, lds);
        resid_tile2(acc, P.out, mt * 256, nt * 128, gate);
    }
}
__device__ void ph_convact(const Params& P, int l) {
    const bf16_t* Z = (const bf16_t*)(P.ws + OFF_Z); bf16_t* ACT = (bf16_t*)(P.ws + OFF_ACT);
    const float* cw = P.in[I_FCW] + (size_t)l * 3 * 5632; const float* cb = P.in[I_FCB] + (size_t)l * 5632;
    const long ntask = (long)(TT / 64) * 352;
    for (long task = (long)bid_() * NT + tid_(); task < ntask; task += (long)gridDim.x * NT) {
        const int tile = (int)(task / 352), cgp = (int)(task % 352), c0 = cgp * 8;
        const int t0 = tile * 64, s0 = t0 & (SQ - 1);
        float wv[3][8], wg[3][8], bv[8], bg[8];
#pragma unroll
        for (int j = 0; j < 3; ++j)
#pragma unroll
            for (int e = 0; e < 8; ++e) { wv[j][e] = cw[j * 5632 + c0 + e]; wg[j][e] = cw[j * 5632 + DFF + c0 + e]; }
#pragma unroll
        for (int e = 0; e < 8; ++e) { bv[e] = cb[c0 + e]; bg[e] = cb[DFF + c0 + e]; }
        float pv[8], pg[8], cv[8], cg_[8], nv[8], ng[8];
        const u32x4 zero4 = (u32x4){0u, 0u, 0u, 0u};
        {
            u32x4 a = zero4, b = zero4;
            if (s0 > 0) { a = *(const u32x4*)(Z + (size_t)(t0 - 1) * 5632 + c0); b = *(const u32x4*)(Z + (size_t)(t0 - 1) * 5632 + DFF + c0); }
            unpack8(a, pv); unpack8(b, pg);
            a = *(const u32x4*)(Z + (size_t)t0 * 5632 + c0); b = *(const u32x4*)(Z + (size_t)t0 * 5632 + DFF + c0);
            unpack8(a, cv); unpack8(b, cg_);
        }
#pragma unroll 8
        for (int r = 0; r < 64; ++r) {
            const int t = t0 + r;
            u32x4 a = zero4, b = zero4;
            if (s0 + r + 1 < SQ) { a = *(const u32x4*)(Z + (size_t)(t + 1) * 5632 + c0); b = *(const u32x4*)(Z + (size_t)(t + 1) * 5632 + DFF + c0); }
            unpack8(a, nv); unpack8(b, ng);
            float o[8];
#pragma unroll
            for (int e = 0; e < 8; ++e) {
                const float v = wv[0][e] * pv[e] + wv[1][e] * cv[e] + wv[2][e] * nv[e] + bv[e];
                const float g = wg[0][e] * pg[e] + wg[1][e] * cg_[e] + wg[2][e] * ng[e] + bg[e];
                o[e] = v * silu(g);
                pv[e] = cv[e]; cv[e] = nv[e]; pg[e] = cg_[e]; cg_[e] = ng[e];
            }
            *(u32x4*)(ACT + (size_t)t * DFF + c0) = (u32x4){pack2(o[0], o[1]), pack2(o[2], o[3]), pack2(o[4], o[5]), pack2(o[6], o[7])};
        }
    }
}

__device__ void mx_rwkv(const Params& P, int l, int item, char* lds) {
    const int tid = tid_(), wid = tid >> 6, lane = tid & 63, fr = lane & 15, fq = lane >> 4;
    const int d = item & 1, h = (item >> 1) & 7, b = item >> 4;
    const bf16_t* prw = (const bf16_t*)(P.ws + OFF_PRW) + (size_t)b * SQ * PRW_LD;
    bf16_t* Yd = (bf16_t*)(P.ws + (d ? OFF_Y1 : OFF_Y0)) + (size_t)b * SQ * 512 + h * 64;
    float* beta = (float*)(P.ws + OFF_BETA) + ((size_t)d * TT + (size_t)b * SQ) * 8 + h;
    float* VA = (float*)lds; float* VWR = VA + 1024; float* VW = VWR + 1024; float* VB = VW + 1024; float* VK = VB + 1024; float* VV = VK + 1024; float* VG = VV + 1024;
    float* SC = VG + 1024;
    bf16_t* RAW = (bf16_t*)(SC + 32);
    bf16_t* AT = RAW + 18 * 320;
    const int s = tid >> 4, jg = tid & 15, j0 = jg * 4;
    float mu[5][4], kkc[4], kac[4], rkc[4];
#pragma unroll
    for (int sg = 0; sg < 5; ++sg) {
        const int base = (sg < 3) ? sg * 512 + h * 64 : 1536 + (sg - 3) * 64;
#pragma unroll
        for (int i = 0; i < 4; ++i) mu[sg][i] = P.in[I_MU][l * 1792 + base + j0 + i];
    }
#pragma unroll
    for (int i = 0; i < 4; ++i) { kkc[i] = P.in[I_KK][l * 512 + h * 64 + j0 + i]; kac[i] = P.in[I_KA][l * 512 + h * 64 + j0 + i]; rkc[i] = P.in[I_RK][l * 512 + h * 64 + j0 + i]; }
    const int mt = wid >> 1, ntb = (wid & 1) * 2;
    bf16x8 bw[2][2]; float bsv[2][4];
    {
        const bf16_t* WT2 = (const bf16_t*)(P.ws + (mt ? WT_A2 : WT_W2)) + (size_t)d * 512 * 64;
        const float* bias = P.in[mt ? I_A0 : I_W0] + (size_t)(l * 2 + d) * 512 + h * 64;
#pragma unroll
        for (int nt = 0; nt < 2; ++nt) {
#pragma unroll
            for (int ks = 0; ks < 2; ++ks) bw[nt][ks] = ldfrag(WT2 + (size_t)(h * 64 + (ntb + nt) * 16 + fr) * 64 + ks * 32 + fq * 8);
#pragma unroll
            for (int jj = 0; jj < 4; ++jj) bsv[nt][jj] = bias[(ntb + nt) * 16 + fq * 4 + jj];
        }
    }
    float S[4][4];
#pragma unroll
    for (int i = 0; i < 4; ++i)
#pragma unroll
        for (int j = 0; j < 4; ++j) S[i][j] = 0.f;
    u32x4 pre[3];
    auto load_raw = [&](int c) {
        const int t0 = d ? SQ - 16 * (c + 1) : 16 * c;
#pragma unroll
        for (int i = 0; i < 3; ++i) {
            const int vi = tid + 256 * i;
            pre[i] = (u32x4){0u, 0u, 0u, 0u};
            if (vi < 720) {
                const int rr = vi / 40, rem = vi % 40, sg = rem >> 3, e = rem & 7, t = t0 - 1 + rr;
                const int col = ((sg < 3) ? sg * 512 + h * 64 : 1536 + (sg - 3) * 64) + e * 8;
                if (t >= 0 && t < SQ) pre[i] = *(const u32x4*)(prw + (size_t)t * PRW_LD + col);
            }
        }
    };
    __syncthreads();
    load_raw(0);
#pragma unroll 1
    for (int c = 0; c < 128; ++c) {
        const int t0 = d ? SQ - 16 * (c + 1) : 16 * c;
#pragma unroll
        for (int i = 0; i < 3; ++i) {
            const int vi = tid + 256 * i;
            if (vi < 720) { const int rr = vi / 40, rem = vi % 40; *(u32x4*)(RAW + rr * 320 + rem * 8) = pre[i]; }
        }
        __syncthreads();
        if (c + 1 < 128) load_raw(c + 1);
        float rs[4], ks_[4], vs[4], kk[4];
        {
            float sh[5][4];
#pragma unroll
            for (int sg = 0; sg < 5; ++sg) {
                float fm[4], f0[4], fp[4];
                unpack4(*(const u32x2*)(RAW + s * 320 + sg * 64 + j0), fm);
                unpack4(*(const u32x2*)(RAW + (s + 1) * 320 + sg * 64 + j0), f0);
                unpack4(*(const u32x2*)(RAW + (s + 2) * 320 + sg * 64 + j0), fp);
#pragma unroll
                for (int i = 0; i < 4; ++i) sh[sg][i] = f0[i] + mu[sg][i] * (0.5f * (fm[i] + fp[i]) - f0[i]);
            }
            float ssq = 0.f, q[4];
#pragma unroll
            for (int i = 0; i < 4; ++i) { rs[i] = sh[0][i]; ks_[i] = sh[1][i]; vs[i] = sh[2][i]; q[i] = ks_[i] * kkc[i]; ssq += q[i] * q[i]; }
            *(u32x2*)(AT + s * 72 + j0) = (u32x2){pack2(tanh_f(sh[3][0]), tanh_f(sh[3][1])), pack2(tanh_f(sh[3][2]), tanh_f(sh[3][3]))};
            *(u32x2*)(AT + 16 * 72 + s * 72 + j0) = (u32x2){pack2(sh[4][0], sh[4][1]), pack2(sh[4][2], sh[4][3])};
            ssq = rowsum16(ssq);
            const float inv = __builtin_amdgcn_rsqf(fmaxf(ssq, 1e-24f));
#pragma unroll
            for (int i = 0; i < 4; ++i) kk[i] = q[i] * inv;
        }
        __syncthreads();
        {
            const bf16_t* At = AT + mt * 16 * 72;
            const bf16x8 a0 = ldfrag(At + fr * 72 + fq * 8), a1 = ldfrag(At + fr * 72 + 32 + fq * 8);
            float* dstv = mt ? VG : VW;
#pragma unroll
            for (int nt = 0; nt < 2; ++nt) {
                f32x4 acc = (f32x4){0.f, 0.f, 0.f, 0.f};
                acc = mfma16(bw[nt][0], a0, acc); acc = mfma16(bw[nt][1], a1, acc);
                f32x4 o;
#pragma unroll
                for (int jj = 0; jj < 4; ++jj) {
                    const float x = acc[jj] + bsv[nt][jj];
                    if (mt == 0) { const float wl = fminf(x, 0.f) - flog_(1.f + __expf(-fabsf(x))) - 0.5f; o[jj] = __expf(-__expf(wl)); }
                    else o[jj] = sigm(x);
                }
                *(f32x4*)(dstv + fr * 64 + (ntb + nt) * 16 + fq * 4) = o;
            }
        }
        __syncthreads();
        {
            const f32x4 w4 = *(const f32x4*)(VW + s * 64 + j0), g4 = *(const f32x4*)(VG + s * 64 + j0);
            f32x4 bb, kt, wr, na, vv;
            float pbr = 0.f, pkr = 0.f, pbe = 0.f;
#pragma unroll
            for (int i = 0; i < 4; ++i) {
                bb[i] = kk[i] * g4[i]; kt[i] = ks_[i] * (1.f + (g4[i] - 1.f) * kac[i]); wr[i] = w4[i] * rs[i]; na[i] = -kk[i]; vv[i] = vs[i];
                pbr += bb[i] * rs[i]; pkr += kt[i] * rs[i]; pbe += rs[i] * kt[i] * rkc[i];
            }
            pbr = rowsum16(pbr); pkr = rowsum16(pkr); pbe = rowsum16(pbe);
            *(f32x4*)(VA + s * 64 + j0) = na; *(f32x4*)(VWR + s * 64 + j0) = wr; *(f32x4*)(VB + s * 64 + j0) = bb; *(f32x4*)(VK + s * 64 + j0) = kt; *(f32x4*)(VV + s * 64 + j0) = vv;
            if (jg == 0) { SC[s * 2] = pbr; SC[s * 2 + 1] = pkr; beta[(size_t)(t0 + s) * 8] = pbe; }
        }
        __syncthreads();
#pragma unroll 1
        for (int st = 0; st < 16; ++st) {
            const int sp = d ? 15 - st : st;
            const f32x4 a4 = *(const f32x4*)(VA + sp * 64 + j0), wr4 = *(const f32x4*)(VWR + sp * 64 + j0), w4 = *(const f32x4*)(VW + sp * 64 + j0);
            const f32x4 b4 = *(const f32x4*)(VB + sp * 64 + j0), k4 = *(const f32x4*)(VK + sp * 64 + j0), v4 = *(const f32x4*)(VV + sp * 64 + s * 4);
            const float br = SC[sp * 2], kr = SC[sp * 2 + 1];
            float psa[4], py[4];
            typedef float f32x2 __attribute__((ext_vector_type(2)));
            const f32x2 a01 = {a4[0], a4[1]}, a23 = {a4[2], a4[3]}, r01 = {wr4[0], wr4[1]}, r23 = {wr4[2], wr4[3]};
#pragma unroll
            for (int i = 0; i < 4; ++i) {
                const f32x2 s01 = {S[i][0], S[i][1]}, s23 = {S[i][2], S[i][3]};
                f32x2 ta = s01 * a01; ta = s23 * a23 + ta;
                f32x2 ty = s01 * r01; ty = s23 * r23 + ty;
                psa[i] = ta.x + ta.y; py[i] = ty.x + ty.y;
            }
#define RS8(CTRL) asm volatile("s_nop 1\n\tv_add_f32_dpp %0, %0, %0 " CTRL " row_mask:0xf bank_mask:0xf\n\tv_add_f32_dpp %1, %1, %1 " CTRL " row_mask:0xf bank_mask:0xf\n\tv_add_f32_dpp %2, %2, %2 " CTRL " row_mask:0xf bank_mask:0xf\n\tv_add_f32_dpp %3, %3, %3 " CTRL " row_mask:0xf bank_mask:0xf\n\tv_add_f32_dpp %4, %4, %4 " CTRL " row_mask:0xf bank_mask:0xf\n\tv_add_f32_dpp %5, %5, %5 " CTRL " row_mask:0xf bank_mask:0xf\n\tv_add_f32_dpp %6, %6, %6 " CTRL " row_mask:0xf bank_mask:0xf\n\tv_add_f32_dpp %7, %7, %7 " CTRL " row_mask:0xf bank_mask:0xf" : "+v"(psa[0]), "+v"(psa[1]), "+v"(psa[2]), "+v"(psa[3]), "+v"(py[0]), "+v"(py[1]), "+v"(py[2]), "+v"(py[3]))
            RS8("row_ror:8"); RS8("row_ror:4"); RS8("row_ror:2"); RS8("row_ror:1");
            asm volatile("s_nop 1" ::: "memory");
            float y[4];
#pragma unroll
            for (int i = 0; i < 4; ++i) {
                y[i] = py[i] + psa[i] * br + v4[i] * kr;
#pragma unroll
                for (int j = 0; j < 4; ++j) S[i][j] = S[i][j] * w4[j] + (psa[i] * b4[j] + v4[i] * k4[j]);
            }
            if (jg == 0) *(u32x2*)(Yd + (size_t)(t0 + sp) * 512 + s * 4) = (u32x2){pack2(y[0], y[1]), pack2(y[2], y[3])};
        }
    }
    __syncthreads();
}

__device__ void mx_mlstm(const Params& P, int l, int item, char* lds) {
    const int tid = tid_(), wid = tid >> 6, lane = tid & 63, fr = lane & 15, fq = lane >> 4;
    const int b = item >> 3, h = (item >> 1) & 3, dsel = item & 1;
    const bf16_t* pr = (const bf16_t*)(P.ws + OFF_PREST) + (size_t)b * SQ * PREST_LD;
    bf16_t* YB = (bf16_t*)(P.ws + (dsel ? OFF_YB : OFF_Y1)) + (size_t)b * SQ * 512 + h * 128;
    bf16_t* Q = (bf16_t*)lds; bf16_t* KP = Q + 64 * 72; bf16_t* KWT = KP + 64 * 72; bf16_t* VT = KWT + 64 * 72; bf16_t* CT = VT + 128 * 72;
    float* NS = (float*)(CT + 128 * 72); float* E = NS + 64; float* MM = E + 64; float* SI = MM + 64; float* WI = SI + 64; float* FL = WI + 64; float* DEC = FL + 64;
    const int i = wid * 16 + fr;
#pragma unroll 1
    for (int d = dsel; d <= dsel; ++d) {
        f32x4 Cacc[8];
#pragma unroll
        for (int dt = 0; dt < 8; ++dt) Cacc[dt] = (f32x4){0.f, 0.f, 0.f, 0.f};
        __syncthreads();
        for (int e = tid; e < 128 * 72 / 2; e += NT) ((unsigned*)CT)[e] = 0u;
        if (tid < 64) NS[tid] = 0.f;
        float m_st = 0.f;
        const float ib = P.in[I_MLIB][(l * 2 + d) * 4 + h], fb = P.in[I_MLFB][(l * 2 + d) * 4 + h];
        __syncthreads();
#pragma unroll 1
        for (int c = 0; c < 32; ++c) {
            const int t0 = d ? SQ - 64 * (c + 1) : 64 * c;
#define TROW(ii) (d ? t0 + 63 - (ii) : t0 + (ii))
            if (wid == 0) {
                const int t = TROW(lane);
                const float fg = bf2f(pr[(size_t)t * PREST_LD + 1544 + d * 4 + h]) + fb, ig = bf2f(pr[(size_t)t * PREST_LD + 1536 + d * 4 + h]) + ib;
                float bc = logsig(fg);
#pragma unroll
                for (int o = 1; o < 64; o <<= 1) { const float x = bperm(bc, lane - o); if (lane >= o) bc += x; }
                const float e = ig - bc; float pm = e;
#pragma unroll
                for (int o = 1; o < 64; o <<= 1) { const float x = bperm(pm, lane - o); if (lane >= o) pm = fmaxf(pm, x); }
                const float gend = rdlane(bc, 63), pmax = rdlane(pm, 63);
                const float mnew = fmaxf(gend + m_st, gend + pmax);
                const float M = fmaxf(m_st, pm);
                E[lane] = e; MM[lane] = M; SI[lane] = __expf(m_st - M); WI[lane] = __expf(gend + e - mnew); FL[lane] = __expf(-(bc + M));
                if (lane == 0) DEC[0] = __expf(gend + m_st - mnew);
                m_st = mnew;
            }
            __syncthreads();
#pragma unroll
            for (int it = 0; it < 2; ++it) {
                const int vi = tid + 256 * it, ii = vi >> 3, e = vi & 7, t = TROW(ii);
                float f[8];
                unpack8(*(const u32x4*)(pr + (size_t)t * PREST_LD + h * 64 + e * 8), f);
                *(u32x4*)(Q + ii * 72 + e * 8) = (u32x4){pack2(f[0] * 0.125f, f[1] * 0.125f), pack2(f[2] * 0.125f, f[3] * 0.125f), pack2(f[4] * 0.125f, f[5] * 0.125f), pack2(f[6] * 0.125f, f[7] * 0.125f)};
                const u32x4 kv = *(const u32x4*)(pr + (size_t)t * PREST_LD + 256 + h * 64 + e * 8);
                *(u32x4*)(KP + ii * 72 + e * 8) = kv;
                unpack8(kv, f);
                const float wi = WI[ii];
#pragma unroll
                for (int x = 0; x < 8; ++x) KWT[(e * 8 + x) * 72 + ii] = f2bf(f[x] * wi);
            }
#pragma unroll
            for (int it = 0; it < 4; ++it) {
                const int vi = tid + 256 * it, ii = vi >> 4, e = vi & 15, t = TROW(ii);
                const u32x4 vv = *(const u32x4*)(pr + (size_t)t * PREST_LD + 512 + h * 128 + e * 8);
                VT[(e * 8 + 0) * 72 + ii] = (bf16_t)(vv.x & 0xffff); VT[(e * 8 + 1) * 72 + ii] = (bf16_t)(vv.x >> 16);
                VT[(e * 8 + 2) * 72 + ii] = (bf16_t)(vv.y & 0xffff); VT[(e * 8 + 3) * 72 + ii] = (bf16_t)(vv.y >> 16);
                VT[(e * 8 + 4) * 72 + ii] = (bf16_t)(vv.z & 0xffff); VT[(e * 8 + 5) * 72 + ii] = (bf16_t)(vv.z >> 16);
                VT[(e * 8 + 6) * 72 + ii] = (bf16_t)(vv.w & 0xffff); VT[(e * 8 + 7) * 72 + ii] = (bf16_t)(vv.w >> 16);
            }
            __syncthreads();
            f32x4 sacc[4];
#pragma unroll
            for (int st = 0; st < 4; ++st) sacc[st] = (f32x4){0.f, 0.f, 0.f, 0.f};
#pragma unroll
            for (int ks = 0; ks < 2; ++ks) {
                const bf16x8 qf = ldfrag(Q + i * 72 + ks * 32 + fq * 8);
#pragma unroll
                for (int st = 0; st < 4; ++st) sacc[st] = mfma16(ldfrag(KP + (st * 16 + fr) * 72 + ks * 32 + fq * 8), qf, sacc[st]);
            }
            const float Mi = MM[i], si = SI[i];
            float rsum = 0.f; unsigned pwp[4][2];
#pragma unroll
            for (int st = 0; st < 4; ++st) {
                float pw[4];
#pragma unroll
                for (int jj = 0; jj < 4; ++jj) { const int sx = st * 16 + fq * 4 + jj; pw[jj] = (sx <= i) ? __expf(E[sx] - Mi) * sacc[st][jj] : 0.f; rsum += pw[jj]; }
                pwp[st][0] = pack2(pw[0], pw[1]); pwp[st][1] = pack2(pw[2], pw[3]);
            }
            rsum = qsum(rsum, lane);
            float qn = 0.f;
            {
                float f[8];
                unpack8(*(const u32x4*)(Q + i * 72 + fq * 16), f);
#pragma unroll
                for (int x = 0; x < 8; ++x) qn += f[x] * NS[fq * 16 + x];
                unpack8(*(const u32x4*)(Q + i * 72 + fq * 16 + 8), f);
#pragma unroll
                for (int x = 0; x < 8; ++x) qn += f[x] * NS[fq * 16 + 8 + x];
            }
            qn = qsum(qn, lane);
            const float den = si * qn + rsum;
            const float rinv = rcpf_(fmaxf(fabsf(den), FL[i]));
            __syncthreads();
#pragma unroll
            for (int st = 0; st < 4; ++st) *(u32x2*)(KP + i * 72 + st * 16 + fq * 4) = (u32x2){pwp[st][0], pwp[st][1]};
            __syncthreads();
            f32x4 oacc[8];
#pragma unroll
            for (int dt = 0; dt < 8; ++dt) oacc[dt] = (f32x4){0.f, 0.f, 0.f, 0.f};
#pragma unroll
            for (int ks = 0; ks < 2; ++ks) {
                const bf16x8 qf = ldfrag(Q + i * 72 + ks * 32 + fq * 8);
#pragma unroll
                for (int dt = 0; dt < 8; ++dt) oacc[dt] = mfma16(ldfrag(CT + (dt * 16 + fr) * 72 + ks * 32 + fq * 8), qf, oacc[dt]);
            }
#pragma unroll
            for (int dt = 0; dt < 8; ++dt) oacc[dt] *= si;
#pragma unroll
            for (int ks = 0; ks < 2; ++ks) {
                const bf16x8 pf = ldfrag(KP + i * 72 + ks * 32 + fq * 8);
#pragma unroll
                for (int dt = 0; dt < 8; ++dt) oacc[dt] = mfma16(ldfrag(VT + (dt * 16 + fr) * 72 + ks * 32 + fq * 8), pf, oacc[dt]);
            }
            {
                const int t = TROW(i);
                bf16_t* yp = YB + (size_t)t * 512 + fq * 4;
                {
#pragma unroll
                    for (int dt = 0; dt < 8; ++dt) { const f32x4 v = oacc[dt] * rinv; *(u32x2*)(yp + dt * 16) = (u32x2){pack2(v[0], v[1]), pack2(v[2], v[3])}; }
                }
            }
            __syncthreads();
            {
                const float dec = DEC[0];
#pragma unroll
                for (int dt = 0; dt < 8; ++dt) Cacc[dt] *= dec;
#pragma unroll
                for (int ks = 0; ks < 2; ++ks) {
                    const bf16x8 kf = ldfrag(KWT + (wid * 16 + fr) * 72 + ks * 32 + fq * 8);
#pragma unroll
                    for (int dt = 0; dt < 8; ++dt) Cacc[dt] = mfma16(kf, ldfrag(VT + (dt * 16 + fr) * 72 + ks * 32 + fq * 8), Cacc[dt]);
                }
#pragma unroll
                for (int dt = 0; dt < 8; ++dt) *(u32x2*)(CT + (dt * 16 + fr) * 72 + wid * 16 + fq * 4) = (u32x2){pack2(Cacc[dt][0], Cacc[dt][1]), pack2(Cacc[dt][2], Cacc[dt][3])};
                if (tid < 64) {
                    float n = dec * NS[tid];
#pragma unroll
                    for (int x = 0; x < 8; ++x) { float f[8]; unpack8(*(const u32x4*)(KWT + tid * 72 + x * 8), f); n += ((f[0] + f[1]) + (f[2] + f[3])) + ((f[4] + f[5]) + (f[6] + f[7])); }
                    NS[tid] = n;
                }
            }
            __syncthreads();
        }
    }
}

__device__ void mx_hgrn(const Params& P, int l, int item, char* lds) {
    const int tid = tid_(), wid = tid >> 6, lane = tid & 63, fr = lane & 15, fq = lane >> 4;
    const int b = item >> 4, h = (item >> 2) & 3, half = (item >> 1) & 1, dsel = item & 1;
    const bf16_t* pr = (const bf16_t*)(P.ws + OFF_PREST) + (size_t)b * SQ * PREST_LD + HG_O;
    bf16_t* YD = (bf16_t*)(P.ws + (dsel ? OFF_YD : OFF_Y0)) + (size_t)b * SQ * 512 + h * 128 + half * 64;
    bf16_t* QT = (bf16_t*)lds; bf16_t* KT = QT + 64 * 136; bf16_t* ATT = KT + 128 * 72; bf16_t* VT = ATT + 64 * 72; bf16_t* ST = VT + 64 * 72;
    float* TOT = (float*)(ST + 64 * 136);
    const int dk = tid & 127, hf = tid >> 7;
    const int i = wid * 16 + fr;
#pragma unroll 1
    for (int d = dsel; d <= dsel; ++d) {
        const float lbv = ((const float*)(P.ws + OFF_LB))[(l * 2 + d) * 512 + h * 128 + dk], oml = 1.f - lbv;
        f32x4 Sacc[2][4];
#pragma unroll
        for (int a = 0; a < 2; ++a)
#pragma unroll
            for (int dt = 0; dt < 4; ++dt) Sacc[a][dt] = (f32x4){0.f, 0.f, 0.f, 0.f};
        __syncthreads();
        for (int e = tid; e < 64 * 136 / 2; e += NT) ((unsigned*)ST)[e] = 0u;
        __syncthreads();
        u32x4 pff[4], pfq[4], pfv[2];
        auto hg_load = [&](int cc) {
            const int t0 = d ? SQ - 64 * (cc + 1) : 64 * cc;
#pragma unroll
            for (int it = 0; it < 4; ++it) {
                const int vi = tid + 256 * it, ii = vi >> 4, e = vi & 15, t = TROW(ii);
                pff[it] = *(const u32x4*)(pr + (size_t)t * PREST_LD + 512 * (1 + d) + h * 128 + e * 8);
                pfq[it] = *(const u32x4*)(pr + (size_t)t * PREST_LD + h * 128 + e * 8);
            }
#pragma unroll
            for (int it = 0; it < 2; ++it) {
                const int vi = tid + 256 * it, ii = vi >> 3, e = vi & 7, t = TROW(ii);
                pfv[it] = *(const u32x4*)(pr + (size_t)t * PREST_LD + 1536 + h * 128 + half * 64 + e * 8);
            }
        };
        hg_load(0);
#pragma unroll 1
        for (int c = 0; c < 32; ++c) {
            const int t0 = d ? SQ - 64 * (c + 1) : 64 * c;
#pragma unroll
            for (int it = 0; it < 4; ++it) {
                const int vi = tid + 256 * it, ii = vi >> 4, e = vi & 15;
                *(u32x4*)(KT + ii * 136 + e * 8) = pff[it];
                *(u32x4*)(QT + ii * 136 + e * 8) = pfq[it];
            }
#pragma unroll
            for (int it = 0; it < 2; ++it) {
                const int vi = tid + 256 * it, ii = vi >> 3, e = vi & 7;
                const u32x4 vv = pfv[it];
                VT[(e * 8 + 0) * 72 + ii] = (bf16_t)(vv.x & 0xffff); VT[(e * 8 + 1) * 72 + ii] = (bf16_t)(vv.x >> 16);
                VT[(e * 8 + 2) * 72 + ii] = (bf16_t)(vv.y & 0xffff); VT[(e * 8 + 3) * 72 + ii] = (bf16_t)(vv.y >> 16);
                VT[(e * 8 + 4) * 72 + ii] = (bf16_t)(vv.z & 0xffff); VT[(e * 8 + 5) * 72 + ii] = (bf16_t)(vv.z >> 16);
                VT[(e * 8 + 6) * 72 + ii] = (bf16_t)(vv.w & 0xffff); VT[(e * 8 + 7) * 72 + ii] = (bf16_t)(vv.w >> 16);
            }
            if (c + 1 < 32) hg_load(c + 1);
            __syncthreads();
            bf16_t* kp = KT + hf * 32 * 136 + dk; bf16_t* qp = QT + hf * 32 * 136 + dk;
            {
                float run = 0.f;
#pragma unroll 8
                for (int r = 0; r < 32; ++r) { const bf16_t fb = f2bf(lbv + oml * sigm(bf2f(kp[r * 136]))); kp[r * 136] = fb; run += flog_(bf2f(fb)); }
                TOT[hf * 128 + dk] = run;
            }
            __syncthreads();
            const float R = TOT[dk], gmR = TOT[128 + dk];
            {
                float g = hf ? R : 0.f;
#pragma unroll 8
                for (int r = 0; r < 32; ++r) {
                    const float fv = bf2f(kp[r * 136]);
                    g += flog_(fv);
                    const float e1 = __expf(fminf(g - R, 80.f));
                    qp[r * 136] = f2bf(silu(bf2f(qp[r * 136])) * e1);
                    kp[r * 136] = f2bf((1.f - fv) * __expf(fminf(R - g, 80.f)));
                }
                const float eR = __expf(R);
                bf16_t* sp = ST + hf * 32 * 136 + dk;
#pragma unroll 8
                for (int r = 0; r < 32; ++r) sp[r * 136] = f2bf(bf2f(sp[r * 136]) * eR);
            }
            __syncthreads();
            f32x4 oacc[4];
            unsigned kw[16];
            {
                f32x4 aacc[4];
#pragma unroll
                for (int st = 0; st < 4; ++st) { aacc[st] = (f32x4){0.f, 0.f, 0.f, 0.f}; oacc[st] = (f32x4){0.f, 0.f, 0.f, 0.f}; }
#pragma unroll
                for (int ks = 0; ks < 4; ++ks) {
                    const bf16x8 qf = ldfrag(QT + i * 136 + ks * 32 + fq * 8);
#pragma unroll
                    for (int st = 0; st < 4; ++st) aacc[st] = mfma16(ldfrag(KT + (st * 16 + fr) * 136 + ks * 32 + fq * 8), qf, aacc[st]);
#pragma unroll
                    for (int dt = 0; dt < 4; ++dt) oacc[dt] = mfma16(ldfrag(ST + (dt * 16 + fr) * 136 + ks * 32 + fq * 8), qf, oacc[dt]);
                }
#pragma unroll
                for (int st = 0; st < 4; ++st) {
                    float a[4];
#pragma unroll
                    for (int jj = 0; jj < 4; ++jj) a[jj] = (st * 16 + fq * 4 + jj <= i) ? aacc[st][jj] : 0.f;
                    *(u32x2*)(ATT + i * 72 + st * 16 + fq * 4) = (u32x2){pack2(a[0], a[1]), pack2(a[2], a[3])};
                }
#pragma unroll
                for (int r = 0; r < 16; ++r) kw[r] = (unsigned)kp[(2 * r) * 136] | ((unsigned)kp[(2 * r + 1) * 136] << 16);
            }
            __syncthreads();
            {
                u32x4* dst = (u32x4*)(KT + dk * 72 + hf * 32);
                dst[0] = (u32x4){kw[0], kw[1], kw[2], kw[3]}; dst[1] = (u32x4){kw[4], kw[5], kw[6], kw[7]};
                dst[2] = (u32x4){kw[8], kw[9], kw[10], kw[11]}; dst[3] = (u32x4){kw[12], kw[13], kw[14], kw[15]};
            }
            __syncthreads();
            {
#pragma unroll
                for (int ks = 0; ks < 2; ++ks) {
                    const bf16x8 af = ldfrag(ATT + i * 72 + ks * 32 + fq * 8);
#pragma unroll
                    for (int dt = 0; dt < 4; ++dt) oacc[dt] = mfma16(ldfrag(VT + (dt * 16 + fr) * 72 + ks * 32 + fq * 8), af, oacc[dt]);
                }
                const int t = TROW(i);
                bf16_t* yp = YD + (size_t)t * 512 + fq * 4;
#pragma unroll
                for (int dt = 0; dt < 4; ++dt) {
                    f32x4 v = oacc[dt];
                    *(u32x2*)(yp + dt * 16) = (u32x2){pack2(v[0], v[1]), pack2(v[2], v[3])};
                }
            }
#pragma unroll
            for (int a = 0; a < 2; ++a) {
                const int ktile = 2 * wid + a;
                f32x4 e1, e2;
#pragma unroll
                for (int jj = 0; jj < 4; ++jj) { const int dkk = ktile * 16 + fq * 4 + jj; e1[jj] = __expf(TOT[dkk]); e2[jj] = __expf(TOT[128 + dkk]); }
#pragma unroll
                for (int dt = 0; dt < 4; ++dt) Sacc[a][dt] *= e1;
#pragma unroll
                for (int ks = 0; ks < 2; ++ks) {
                    const bf16x8 kf = ldfrag(KT + (ktile * 16 + fr) * 72 + ks * 32 + fq * 8);
#pragma unroll
                    for (int dt = 0; dt < 4; ++dt) Sacc[a][dt] = mfma16(kf, ldfrag(VT + (dt * 16 + fr) * 72 + ks * 32 + fq * 8), Sacc[a][dt]);
                }
#pragma unroll
                for (int dt = 0; dt < 4; ++dt) {
                    Sacc[a][dt] *= e2;
                    *(u32x2*)(ST + (dt * 16 + fr) * 136 + ktile * 16 + fq * 4) = (u32x2){pack2(Sacc[a][dt][0], Sacc[a][dt][1]), pack2(Sacc[a][dt][2], Sacc[a][dt][3])};
                }
            }
            __syncthreads();
        }
    }
}

__device__ void mx_lru(const Params& P, int l, int item, char* lds) {
    const int tid = tid_(), wid = tid >> 6, lane = tid & 63, fr = lane & 15, fq = lane >> 4;
    const int b = item >> 3, g = item & 7;
    const bf16_t* pr = (const bf16_t*)(P.ws + OFF_PREST) + (size_t)b * SQ * PREST_LD + LRU_O;
    bf16_t* YC = (bf16_t*)(P.ws + OFF_YC) + (size_t)b * SQ * 512 + g * 64;
    bf16_t* XC = (bf16_t*)lds; float* AA = (float*)(lds + 9216); float* BB = AA + 64 * 65; float* HH = BB + 64 * 65;
    const int ch = tid & 63, tq = tid >> 6;
    float cwv[4];
#pragma unroll
    for (int j = 0; j < 4; ++j) cwv[j] = P.in[I_LCW][(l * 4 + j) * 512 + g * 64 + ch];
    const float cbv = P.in[I_LCB][l * 512 + g * 64 + ch];
    const int i = wid * 16 + fr;
#pragma unroll 1
    for (int d = 0; d < 2; ++d) {
        bf16x8 waf[4][2], wxf[4][2]; f32x4 ba4[4], bx4[4], c8[4];
        {
            const bf16_t* Wa = (const bf16_t*)(P.ws + WT_LRU) + (((size_t)d * 2 + 0) * 8 + g) * 4096;
            const bf16_t* Wx = (const bf16_t*)(P.ws + WT_LRU) + (((size_t)d * 2 + 1) * 8 + g) * 4096;
#pragma unroll
            for (int jt = 0; jt < 4; ++jt) {
#pragma unroll
                for (int ks = 0; ks < 2; ++ks) { waf[jt][ks] = ldfrag(Wa + (jt * 16 + fr) * 64 + ks * 32 + fq * 8); wxf[jt][ks] = ldfrag(Wx + (jt * 16 + fr) * 64 + ks * 32 + fq * 8); }
                const int j = (l * 2 + d) * 512 + g * 64 + jt * 16 + fq * 4;
                ba4[jt] = *(const f32x4*)(P.in[I_LBA] + j); bx4[jt] = *(const f32x4*)(P.in[I_LBX] + j);
                const f32x4 lam = *(const f32x4*)(P.in[I_LLAM] + j);
#pragma unroll
                for (int jj = 0; jj < 4; ++jj) c8[jt][jj] = -8.f * (fmaxf(-lam[jj], 0.f) + flog_(1.f + __expf(-fabsf(lam[jj]))));
            }
        }
        float hst = 0.f;
        bf16_t xr[19];
        auto lru_load = [&](int cc) {
            const int t0 = d ? SQ - 64 * (cc + 1) : 64 * cc;
#pragma unroll
            for (int k = 0; k < 19; ++k) { const int t = t0 + tq * 16 - 1 + k; xr[k] = (t >= 0 && t < SQ) ? pr[(size_t)t * PREST_LD + g * 64 + ch] : (bf16_t)0; }
        };
        lru_load(0);
#pragma unroll 1
        for (int c = 0; c < 32; ++c) {
            const int t0 = d ? SQ - 64 * (c + 1) : 64 * c;
            {
                float xw[19];
#pragma unroll
                for (int k = 0; k < 19; ++k) xw[k] = bf2f(xr[k]);
                if (c + 1 < 32) lru_load(c + 1);
#pragma unroll
                for (int r = 0; r < 16; ++r) XC[(tq * 16 + r) * 72 + ch] = f2bf(cbv + cwv[0] * xw[r] + cwv[1] * xw[r + 1] + cwv[2] * xw[r + 2] + cwv[3] * xw[r + 3]);
            }
            __syncthreads();
            {
                f32x4 ra[4], rx[4];
#pragma unroll
                for (int jt = 0; jt < 4; ++jt) { ra[jt] = (f32x4){0.f, 0.f, 0.f, 0.f}; rx[jt] = (f32x4){0.f, 0.f, 0.f, 0.f}; }
#pragma unroll
                for (int ks = 0; ks < 2; ++ks) {
                    const bf16x8 xf = ldfrag(XC + i * 72 + ks * 32 + fq * 8);
#pragma unroll
                    for (int jt = 0; jt < 4; ++jt) { ra[jt] = mfma16(waf[jt][ks], xf, ra[jt]); rx[jt] = mfma16(wxf[jt][ks], xf, rx[jt]); }
                }
#pragma unroll
                for (int jt = 0; jt < 4; ++jt) {
                    float xc[4]; unpack4(*(const u32x2*)(XC + i * 72 + jt * 16 + fq * 4), xc);
#pragma unroll
                    for (int jj = 0; jj < 4; ++jj) {
                        const float la = c8[jt][jj] * sigm(ra[jt][jj] + ba4[jt][jj]);
                        const float av = __expf(la);
                        const float mult = __builtin_amdgcn_sqrtf(fmaxf(1.f - av * av, 0.f));
                        AA[i * 65 + jt * 16 + fq * 4 + jj] = av;
                        BB[i * 65 + jt * 16 + fq * 4 + jj] = mult * sigm(rx[jt][jj] + bx4[jt][jj]) * xc[jj];
                    }
                }
            }
            __syncthreads();
            if (tid < 64) {
#pragma unroll 1
                for (int r8 = 0; r8 < 8; ++r8) {
                    float av[8], bv[8];
#pragma unroll
                    for (int x = 0; x < 8; ++x) { const int r = d ? 63 - (r8 * 8 + x) : r8 * 8 + x; av[x] = AA[r * 65 + ch]; bv[x] = BB[r * 65 + ch]; }
#pragma unroll
                    for (int x = 0; x < 8; ++x) { const int r = d ? 63 - (r8 * 8 + x) : r8 * 8 + x; hst = av[x] * hst + bv[x]; HH[r * 65 + ch] = hst; }
                }
            }
            __syncthreads();
#pragma unroll
            for (int r = 0; r < 16; ++r) {
                const int ii = tq * 16 + r, t = t0 + ii;
                const float hv = HH[ii * 65 + ch];
                if (d == 0) YC[(size_t)t * 512 + ch] = f2bf(hv);
                else { const float prev = bf2f(YC[(size_t)t * 512 + ch]), gb = bf2f(pr[(size_t)t * PREST_LD + 512 + g * 64 + ch]); YC[(size_t)t * 512 + ch] = f2bf((prev + hv) * gelu_t(gb)); }
            }
        }
        __syncthreads();
    }
}

__device__ void dbg_zero(bf16_t* p, size_t n, int part, int nparts) {
    u32x4* q = (u32x4*)p; const size_t n8 = n / 8, per = (n8 + nparts - 1) / nparts, lo = per * part, hi = (lo + per < n8) ? lo + per : n8;
    for (size_t e = lo + tid_(); e < hi; e += NT) q[e] = (u32x4){0u, 0u, 0u, 0u};
}
__device__ void ph_mixers(const Params& P, int l, char* lds, int which) {
    const int nitems = 384;
    for (int item = bid_(); item < nitems; item += gridDim.x) {
        if (which) { if (item < 256) mx_rwkv(P, l, item, lds); else mx_lru(P, l, item - 256, lds); }
        else if (item < 256) mx_hgrn(P, l, item, lds);
        else mx_mlstm(P, l, item - 256, lds);
        __syncthreads();
    }
}

__device__ void ph_rwpost(const Params& P, int l, char* lds) {
    const int tid = tid_(), wid = tid >> 6, lane = tid & 63, fr = lane & 15, fq = lane >> 4;
    bf16_t* SG = (bf16_t*)lds; float* STAT = (float*)(lds + 64 * 136 * 2);
    const bf16_t* G2T = (const bf16_t*)(P.ws + WT_G2);
    const float* mu = P.in[I_MU] + l * 1792;
    for (int item = bid_(); item < TT / 64; item += gridDim.x) {
        const int tok0 = item * 64, s0 = tok0 & (SQ - 1);
        const bf16_t* prw = (const bf16_t*)(P.ws + OFF_PRW);
        bf16_t* Y0 = (bf16_t*)(P.ws + OFF_Y0); const bf16_t* Y1 = (const bf16_t*)(P.ws + OFF_Y1);
        const float* be0 = (const float*)(P.ws + OFF_BETA); const float* be1 = be0 + (size_t)TT * 8;
        __syncthreads();
        {
            const int r = tid >> 2, part = tid & 3, t = tok0 + r, sp = s0 + r;
#pragma unroll
            for (int v = 0; v < 4; ++v) {
                const int c = part * 32 + v * 8;
                float f0[8], fm[8], fp[8];
                unpack8(*(const u32x4*)(prw + (size_t)t * PRW_LD + 1664 + c), f0);
                if (sp > 0) unpack8(*(const u32x4*)(prw + (size_t)(t - 1) * PRW_LD + 1664 + c), fm); else { for (int x = 0; x < 8; ++x) fm[x] = 0.f; }
                if (sp < SQ - 1) unpack8(*(const u32x4*)(prw + (size_t)(t + 1) * PRW_LD + 1664 + c), fp); else { for (int x = 0; x < 8; ++x) fp[x] = 0.f; }
                float o[8];
#pragma unroll
                for (int x = 0; x < 8; ++x) o[x] = sigm(f0[x] + mu[1664 + c + x] * (0.5f * (fm[x] + fp[x]) - f0[x]));
                *(u32x4*)(SG + r * 136 + c) = (u32x4){pack2(o[0], o[1]), pack2(o[2], o[3]), pack2(o[4], o[5]), pack2(o[6], o[7])};
            }
#pragma unroll
            for (int hh = 0; hh < 2; ++hh) {
                const int head = part * 2 + hh;
                float sm = 0.f, sq = 0.f;
#pragma unroll
                for (int v = 0; v < 8; ++v) {
                    float a[8], bq[8];
                    unpack8(*(const u32x4*)(Y0 + (size_t)t * 512 + head * 64 + v * 8), a); unpack8(*(const u32x4*)(Y1 + (size_t)t * 512 + head * 64 + v * 8), bq);
#pragma unroll
                    for (int x = 0; x < 8; ++x) { const float y = a[x] + bq[x]; sm += y; sq += y * y; }
                }
                const float mean = sm * (1.f / 64.f), var = fmaxf(sq * (1.f / 64.f) - mean * mean, 0.f);
                STAT[(r * 8 + head) * 2] = mean; STAT[(r * 8 + head) * 2 + 1] = rsqrtf(var + 64e-5f);
            }
        }
        __syncthreads();
#pragma unroll 1
        for (int np = 0; np < 4; ++np) {
            const int nt0 = wid * 8 + np * 2;
#pragma unroll 1
            for (int tt = 0; tt < 4; ++tt) {
                f32x4 acc[2];
                acc[0] = (f32x4){0.f, 0.f, 0.f, 0.f}; acc[1] = (f32x4){0.f, 0.f, 0.f, 0.f};
#pragma unroll
                for (int ks = 0; ks < 4; ++ks) {
                    const bf16x8 b0 = ldfrag(G2T + (size_t)(nt0 * 16 + fr) * 128 + ks * 32 + fq * 8), b1 = ldfrag(G2T + (size_t)((nt0 + 1) * 16 + fr) * 128 + ks * 32 + fq * 8);
                    const bf16x8 af = ldfrag(SG + (tt * 16 + fr) * 136 + ks * 32 + fq * 8);
                    acc[0] = mfma16(b0, af, acc[0]); acc[1] = mfma16(b1, af, acc[1]);
                }
#pragma unroll
                for (int q = 0; q < 2; ++q) {
                    const int r = tt * 16 + fr, t = tok0 + r, sp = s0 + r, n = (nt0 + q) * 16 + fq * 4, head = n >> 6;
                    float y0[4], y1[4], v0[4], vm[4], vp[4];
                    unpack4(*(const u32x2*)(Y0 + (size_t)t * 512 + n), y0); unpack4(*(const u32x2*)(Y1 + (size_t)t * 512 + n), y1);
                    unpack4(*(const u32x2*)(prw + (size_t)t * PRW_LD + 1024 + n), v0);
                    if (sp > 0) unpack4(*(const u32x2*)(prw + (size_t)(t - 1) * PRW_LD + 1024 + n), vm); else { vm[0] = vm[1] = vm[2] = vm[3] = 0.f; }
                    if (sp < SQ - 1) unpack4(*(const u32x2*)(prw + (size_t)(t + 1) * PRW_LD + 1024 + n), vp); else { vp[0] = vp[1] = vp[2] = vp[3] = 0.f; }
                    const float mean = STAT[(r * 8 + head) * 2], rstd = STAT[(r * 8 + head) * 2 + 1];
                    const float be = 0.5f * (be0[(size_t)t * 8 + head] + be1[(size_t)t * 8 + head]);
                    const f32x4 lw = *(const f32x4*)(P.in[I_LNW] + l * 512 + n), lb = *(const f32x4*)(P.in[I_LNB] + l * 512 + n), m4 = *(const f32x4*)(mu + 1024 + n);
                    float o[4];
#pragma unroll
                    for (int jj = 0; jj < 4; ++jj) {
                        const float vs = v0[jj] + m4[jj] * (0.5f * (vm[jj] + vp[jj]) - v0[jj]);
                        o[jj] = (((y0[jj] + y1[jj]) - mean) * rstd * lw[jj] + lb[jj] + be * vs) * acc[q][jj];
                    }
                    *(u32x2*)(Y0 + (size_t)t * 512 + n) = (u32x2){pack2(o[0], o[1]), pack2(o[2], o[3])};
                }
            }
        }
    }
    __syncthreads();
}
template <bool ML> __device__ void ph_headpost(const Params& P, int l) {
    const int tid = tid_();
    bf16_t* YO = (bf16_t*)(P.ws + (ML ? OFF_YB : OFF_YD)); const bf16_t* SDF = (const bf16_t*)(P.ws + (ML ? OFF_Y1 : OFF_Y0));
    const bf16_t* pr = (const bf16_t*)(P.ws + OFF_PREST) + (ML ? 1024 : HG_O + 2048);
    const float* ng = P.in[ML ? I_MLN : I_HGN] + l * 512;
    for (int item = bid_(); item < TT / 64; item += gridDim.x) {
        const int t = item * 64 + (tid >> 2), part = tid & 3;
#pragma unroll 2
        for (int hh = 0; hh < 4; ++hh) {
            const int c0 = hh * 128 + part * 32;
            float v[32]; float ss = 0.f;
#pragma unroll
            for (int q = 0; q < 4; ++q) { float f[8], f2[8]; unpack8(*(const u32x4*)(YO + (size_t)t * 512 + c0 + q * 8), f); unpack8(*(const u32x4*)(SDF + (size_t)t * 512 + c0 + q * 8), f2);
#pragma unroll
                for (int x = 0; x < 8; ++x) { const float y = f[x] + f2[x]; v[q * 8 + x] = y; ss += y * y; } }
            ss += dppf<0xB1>(ss); ss += dppf<0x4E>(ss);
            const float rms = rsqrtf(ss * (1.f / 128.f) + 1e-6f);
#pragma unroll
            for (int q = 0; q < 4; ++q) {
                float gq[8]; unpack8(*(const u32x4*)(pr + (size_t)t * PREST_LD + c0 + q * 8), gq);
                float o[8];
#pragma unroll
                for (int x = 0; x < 8; ++x) o[x] = (ML ? sigm(gq[x]) : silu(gq[x])) * v[q * 8 + x] * rms * ng[c0 + q * 8 + x];
                *(u32x4*)(YO + (size_t)t * 512 + c0 + q * 8) = (u32x4){pack2(o[0], o[1]), pack2(o[2], o[3]), pack2(o[4], o[5]), pack2(o[6], o[7])};
            }
        }
    }
}

#define XB_TMO      128
#define XB_XCNT(j)  (256  + 64 * (j))
#define XB_XSUB(j)  (1280 + 64 * (j))
#define XB_XGEN(j)  (2304 + 64 * (j))
#define XB_TOP      3328
#define XB_TOPGEN   3392
#define XCD_BAR_WORDS 3456
#define XB_SPIN_CAP (1u << 18)
#define LAS __attribute__((address_space(3)))

__device__ __forceinline__ unsigned xb_ld(unsigned* p)              { return __hip_atomic_load(p, __ATOMIC_RELAXED, __HIP_MEMORY_SCOPE_AGENT); }
__device__ __forceinline__ unsigned xb_add(unsigned* p, unsigned v) { return __hip_atomic_fetch_add(p, v, __ATOMIC_RELAXED, __HIP_MEMORY_SCOPE_AGENT); }
__device__ __forceinline__ unsigned xb_xcc_id() { return (unsigned)__builtin_amdgcn_s_getreg((3 << 11) | 20) & 0xFu; }
#define XB_SPIN(cond, bar) do { unsigned _sp = 0; while (cond) { __builtin_amdgcn_s_sleep(1); \
    if ((++_sp & 255u) == 0u) { if (xb_ld(&(bar)[XB_TMO])) break; if (_sp > XB_SPIN_CAP) { atomicAdd(&(bar)[XB_TMO], 1u); break; } } } } while (0)

struct XcdBarrier {
    unsigned* bar; unsigned x;
    volatile LAS unsigned* st;
};

__device__ __forceinline__ XcdBarrier xcd_barrier_post(unsigned* bar, volatile LAS unsigned* st) {
    XcdBarrier b; b.bar = bar; b.x = xb_xcc_id(); b.st = st;
    if (threadIdx.x == 0) (void)xb_add(&bar[XB_XCNT(b.x)], 1u);
    return b;
}
__device__ __forceinline__ void xcd_barrier_complete(unsigned* bar, unsigned x, unsigned& nloc, unsigned& nx) {
    const unsigned G = gridDim.x * gridDim.y * gridDim.z;
    unsigned sum, cnt, mine, sp = 0u;
    for (;;) {
        sum = 0u; cnt = 0u; mine = 0u;
#pragma unroll
        for (unsigned j = 0; j < 16; ++j) { const unsigned c = xb_ld(&bar[XB_XCNT(j)]); sum += c; cnt += (c > 0u) ? 1u : 0u; mine = (j == x) ? c : mine; }
        if (sum == G) break;
        __builtin_amdgcn_s_sleep(1);
        if ((++sp & 255u) == 0u) { if (xb_ld(&bar[XB_TMO])) break; if (sp > XB_SPIN_CAP) { atomicAdd(&bar[XB_TMO], 1u); break; } }
    }
    nloc = mine > 0u ? mine : 1u; nx = cnt > 0u ? cnt : 1u;
}

__device__ __forceinline__ void xcd_barrier(const XcdBarrier& b) {
    asm volatile("s_waitcnt vmcnt(0)" ::: "memory");
    __syncthreads();
    if (threadIdx.x == 0) {
        unsigned* bar = b.bar;
        __builtin_amdgcn_s_waitcnt(0);
        unsigned nloc = b.st[0], nx = b.st[1];
        if (nloc == 0u) { xcd_barrier_complete(bar, b.x, nloc, nx); b.st[0] = nloc; b.st[1] = nx; }
        const unsigned old = xb_add(&bar[XB_XSUB(b.x)], 1u);
        const unsigned gen = old / nloc;
        if (old + 1u == (gen + 1u) * nloc) {
            __builtin_amdgcn_fence(__ATOMIC_RELEASE, "agent");
            asm volatile("s_waitcnt vmcnt(0)" ::: "memory");
            const unsigned og = xb_add(&bar[XB_TOP], 1u);
            const unsigned tg = og / nx;
            if (og + 1u == (tg + 1u) * nx) xb_add(&bar[XB_TOPGEN], 1u);
            else XB_SPIN(xb_ld(&bar[XB_TOPGEN]) == tg, bar);
            __builtin_amdgcn_fence(__ATOMIC_ACQUIRE, "agent");
            xb_add(&bar[XB_XGEN(b.x)], 1u);
            asm volatile("s_waitcnt vmcnt(0)" ::: "memory");
        } else {
            XB_SPIN(xb_ld(&bar[XB_XGEN(b.x)]) == gen, bar);
            __builtin_amdgcn_fence(__ATOMIC_ACQUIRE, "agent");
            asm volatile("s_waitcnt vmcnt(0)" ::: "memory");
        }
    }
    __syncthreads();
}


constexpr int N_PHASES = 2 + NL * 13;
__device__ void run_phase(const Params& P, int ph, char* lds) {
    if (ph == 0) { ph_init(P, lds); return; }
    if (ph == N_PHASES - 1) { ph_norm(P, P.in[I_FING], nullptr, 0, 0, nullptr, true); return; }
    const int l = (ph - 1) / 13; int sp = (ph - 1) % 13;
    const float* modl = (const float*)(P.ws + OFF_MOD) + (size_t)l * 16 * 6144;
    if (sp == 2) { ph_mixers(P, l, lds, 0); return; }
    if (sp == 3) { ph_headpost<false>(P, l); ph_headpost<true>(P, l); return; }
    if (sp == 4) { ph_mixers(P, l, lds, 1); return; }
    if (sp > 4) sp -= 2;
    switch (sp) {
        case 0: ph_wt(P, l, lds); ph_norm(P, P.in[I_N1G] + l * DM, modl, 0, 1024, (bf16_t*)(P.ws + OFF_U), false); break;
        case 1: ph_gemm_p(P, lds); break;
        case 3: ph_rwpost(P, l, lds); break;
        case 4: ph_norm(P, P.in[I_N1G] + l * DM, modl, 0, 1024, (bf16_t*)(P.ws + OFF_URE), false); break;
        case 5: ph_gemm_merge(P, lds); break;
        case 6: ph_gemm_out(P, l, lds); break;
        case 7: ph_norm(P, P.in[I_N2G] + l * DM, modl, 3072, 4096, (bf16_t*)(P.ws + OFF_U2), false); break;
        case 8: ph_gemm_up(P, lds); break;
        case 9: ph_convact(P, l); break;
        default: ph_gemm_down(P, l, lds); break;
    }
}

__global__ void __launch_bounds__(NT, 2) mega(Params P, int ph_lo, int ph_hi) {
    extern __shared__ __attribute__((aligned(16))) char smem[];
    cg::grid_group grid = cg::this_grid();
    volatile LAS unsigned* xst = (volatile LAS unsigned*)(smem + LDS_BYTES - 16);
    if (threadIdx.x == 0) { xst[0] = 0u; xst[1] = 0u; }
    __syncthreads();
    XcdBarrier xb = xcd_barrier_post((unsigned*)(P.ws + OFF_BAR), xst);
    for (int ph = ph_lo; ph < ph_hi; ++ph) {
        run_phase(P, ph, smem);
        if (ph + 1 < ph_hi) { if (ph == ph_lo) grid.sync(); else xcd_barrier(xb); }
    }
}

extern "C" void kernel_launch(void* const* d_in, const int* in_sizes, int n_in, void* d_out, int out_size, void* d_ws, size_t ws_size, hipStream_t stream) {
    static int grid_blocks = 0;
    if (grid_blocks == 0) {
        if (n_in != N_INPUTS || ws_size < WS_NEED || out_size != TT * DM) { fprintf(stderr, "kernel_launch: unexpected shapes (n_in %d ws %zu need %zu)\n", n_in, ws_size, (size_t)WS_NEED); grid_blocks = -1; return; }
        int dev = 0, cus = 0, per_cu = 0;
        hipGetDevice(&dev);
        hipDeviceGetAttribute(&cus, hipDeviceAttributeMultiprocessorCount, dev);
        if (hipFuncSetAttribute((const void*)mega, hipFuncAttributeMaxDynamicSharedMemorySize, LDS_BYTES) != hipSuccess) { fprintf(stderr, "kernel_launch: hipFuncSetAttribute failed\n"); grid_blocks = -1; return; }
        hipOccupancyMaxActiveBlocksPerMultiprocessor(&per_cu, (const void*)mega, NT, LDS_BYTES);
        if (per_cu < 1) per_cu = 1;
        if (per_cu > 2) per_cu = 2;
        grid_blocks = cus * per_cu;
    }
    if (grid_blocks < 0) return;
    if (hipMemsetAsync((char*)d_ws + OFF_BAR, 0, BAR_BYTES, stream) != hipSuccess) { fprintf(stderr, "kernel_launch: memset of the barrier words failed\n"); return; }
    Params p{};
    for (int i = 0; i < N_INPUTS; ++i) p.in[i] = (const float*)d_in[i];
    p.out = (float*)d_out; p.ws = (char*)d_ws;
#if MULTI_LAUNCH
    for (int ph = 0; ph < N_PHASES; ++ph) hipLaunchKernelGGL(mega, dim3(grid_blocks), dim3(NT), LDS_BYTES, stream, p, ph, ph + 1);
#else
    int lo = 0, hi = N_PHASES;
    void* args[] = {&p, &lo, &hi};
    hipError_t e = hipLaunchCooperativeKernel((const void*)mega, dim3(grid_blocks), dim3(NT), args, LDS_BYTES, stream);
    if (e != hipSuccess) fprintf(stderr, "cooperative launch failed: %s (grid %d)\n", hipGetErrorString(e), grid_blocks);
#endif
}
```

```cpp
#include <hip/hip_runtime.h>
#include <hip/hip_cooperative_groups.h>
#include <cstdio>
namespace cg = cooperative_groups;

typedef unsigned short bf16_t;
typedef short bf16x8 __attribute__((ext_vector_type(8)));
typedef float f32x4 __attribute__((ext_vector_type(4)));
typedef unsigned u32x4 __attribute__((ext_vector_type(4)));
typedef unsigned u32x2 __attribute__((ext_vector_type(2)));

#ifndef DBG_SKIP
#define DBG_SKIP 0
#endif
#ifndef DBG_NOFFN
#define DBG_NOFFN 0
#endif
#ifndef MULTI_LAUNCH
#define MULTI_LAUNCH 0
#endif

constexpr int NB = 16, SQ = 2048, DM = 1024, TT = NB * SQ, MW = 512, NL = 4;
constexpr int NT = 256;
constexpr int PRW_LD = 1792, PREST_LD = 5248;
constexpr int LRU_O = 1664, HG_O = 2688;
constexpr int GATE_ROW0 = 7040;
constexpr int DFF = 2816;
constexpr int LDS_BYTES = 73728;

constexpr size_t WT_WIN = 0;
constexpr size_t WT_WB = WT_WIN + (size_t)11136 * 1024 * 2;
constexpr size_t WT_WOUT = WT_WB + (size_t)4 * 1024 * 512 * 2;
constexpr size_t WT_WUP = WT_WOUT + (size_t)1024 * 1024 * 2;
constexpr size_t WT_WDN = WT_WUP + (size_t)5632 * 1024 * 2;
constexpr size_t WT_G2 = WT_WDN + (size_t)1024 * 2816 * 2;
constexpr size_t WT_W2 = WT_G2 + (size_t)512 * 128 * 2;
constexpr size_t WT_A2 = WT_W2 + (size_t)2 * 512 * 64 * 2;
constexpr size_t WT_LRU = WT_A2 + (size_t)2 * 512 * 64 * 2;
constexpr size_t WT_END = WT_LRU + (size_t)2 * 2 * 8 * 64 * 64 * 2;
constexpr size_t OFF_PRW = (size_t)48 << 20;
static_assert(WT_END <= OFF_PRW, "wt");
constexpr size_t OFF_PREST = OFF_PRW + (size_t)TT * PRW_LD * 2;
constexpr size_t OFF_Y = OFF_PREST + (size_t)TT * PREST_LD * 2;
constexpr size_t YSZ = (size_t)TT * 512 * 2;
constexpr size_t OFF_YB = OFF_Y, OFF_YC = OFF_Y + YSZ, OFF_YD = OFF_Y + 2 * YSZ, OFF_Y0 = OFF_Y + 3 * YSZ, OFF_Y1 = OFF_Y + 4 * YSZ;
constexpr size_t OFF_SMALL = OFF_Y + 5 * YSZ;
constexpr size_t OFF_MOD = OFF_SMALL;
constexpr size_t OFF_LB = OFF_MOD + (size_t)4 * 16 * 6144 * 4;
constexpr size_t OFF_BETA = OFF_LB + (size_t)4 * 2 * 512 * 4;
constexpr size_t OFF_BAR = OFF_BETA + (size_t)2 * TT * 8 * 4;
constexpr size_t BAR_BYTES = 16384;
constexpr size_t WS_NEED = OFF_BAR + BAR_BYTES;
constexpr size_t OFF_U = OFF_Y;
constexpr size_t OFF_URE = OFF_PREST;
constexpr size_t OFF_MERGED = OFF_PREST + (size_t)TT * 1024 * 2;
constexpr size_t OFF_U2 = OFF_Y;
constexpr size_t OFF_Z = OFF_PRW;
constexpr size_t OFF_ACT = OFF_PRW + (size_t)TT * 5632 * 2;
static_assert(OFF_ACT + (size_t)TT * 2816 * 2 <= OFF_SMALL, "act");

enum { I_X = 0, I_C, I_ADAW, I_ADAB, I_N1G, I_WIN, I_MU, I_W0, I_W2, I_A0, I_A2, I_G2, I_KK, I_KA, I_RK, I_LNW, I_LNB,
       I_MLIB, I_MLFB, I_MLN, I_LCW, I_LCB, I_LWA, I_LBA, I_LWX, I_LBX, I_LLAM, I_HGLB, I_HGN, I_WBR, I_WOUT, I_N2G,
       I_FUP, I_FCW, I_FCB, I_FDN, I_FING, N_INPUTS };

struct Params { const float* in[N_INPUTS]; float* out; char* ws; };

__device__ __forceinline__ int tid_() { int x = threadIdx.x; asm volatile("" : "+v"(x)); return x; }
__device__ __forceinline__ int bid_() { int x = blockIdx.x; asm volatile("" : "+s"(x)); return x; }
__device__ __forceinline__ bf16_t f2bf(float f) { const __bf16 h = (__bf16)f; return __builtin_bit_cast(unsigned short, h); }
__device__ __forceinline__ float bf2f(bf16_t h) { return __uint_as_float(((unsigned)h) << 16); }
typedef __bf16 bf16x2n __attribute__((ext_vector_type(2)));
typedef float f32x2n __attribute__((ext_vector_type(2)));
__device__ __forceinline__ unsigned pack2(float a, float b) { const f32x2n v = {a, b}; const bf16x2n h = __builtin_convertvector(v, bf16x2n); return __builtin_bit_cast(unsigned, h); }
__device__ __forceinline__ float lo2f(unsigned u) { return __uint_as_float(u << 16); }
__device__ __forceinline__ float hi2f(unsigned u) { return __uint_as_float(u & 0xffff0000u); }
__device__ __forceinline__ float rcpf_(float x) { return __builtin_amdgcn_rcpf(x); }
__device__ __forceinline__ float flog_(float x) { return __builtin_amdgcn_logf(x) * 0.69314718056f; }
__device__ __forceinline__ float sigm(float x) { return rcpf_(1.f + __expf(-x)); }
__device__ __forceinline__ float silu(float x) { return x * sigm(x); }
__device__ __forceinline__ float logsig(float x) { return fminf(x, 0.f) - flog_(1.f + __expf(-fabsf(x))); }
__device__ __forceinline__ float tanh_f(float x) { return 1.f - 2.f * rcpf_(1.f + __expf(2.f * x)); }
__device__ __forceinline__ float gelu_t(float x) { return 0.5f * x * (1.f + tanh_f(0.7978845608f * (x + 0.044715f * x * x * x))); }
template <int CTRL> __device__ __forceinline__ float dppf(float x) { return __int_as_float(__builtin_amdgcn_update_dpp(0, __float_as_int(x), CTRL, 0xF, 0xF, false)); }
__device__ __forceinline__ float rowsum16(float x) { x += dppf<0x128>(x); x += dppf<0x124>(x); x += dppf<0x122>(x); x += dppf<0x121>(x); return x; }
__device__ __forceinline__ float rdlane(float x, int l) { return __int_as_float(__builtin_amdgcn_readlane(__float_as_int(x), l)); }
__device__ __forceinline__ float wsum64(float x) { x = rowsum16(x); return (rdlane(x, 0) + rdlane(x, 16)) + (rdlane(x, 32) + rdlane(x, 48)); }
__device__ __forceinline__ float bperm(float x, int srclane) { return __int_as_float(__builtin_amdgcn_ds_bpermute(srclane << 2, __float_as_int(x))); }
__device__ __forceinline__ float qsum(float x, int lane) { x += bperm(x, lane ^ 16); x += bperm(x, lane ^ 32); return x; }
__device__ __forceinline__ void unpack8(u32x4 v, float (&f)[8]) {
    f[0] = lo2f(v.x); f[1] = hi2f(v.x); f[2] = lo2f(v.y); f[3] = hi2f(v.y); f[4] = lo2f(v.z); f[5] = hi2f(v.z); f[6] = lo2f(v.w); f[7] = hi2f(v.w); }
__device__ __forceinline__ void unpack4(u32x2 v, float (&f)[4]) { f[0] = lo2f(v.x); f[1] = hi2f(v.x); f[2] = lo2f(v.y); f[3] = hi2f(v.y); }
__device__ __forceinline__ f32x4 mfma16(bf16x8 a, bf16x8 b, f32x4 c) { return __builtin_amdgcn_mfma_f32_16x16x32_bf16(a, b, c, 0, 0, 0); }
__device__ __forceinline__ bf16x8 ldfrag(const bf16_t* p) { return *reinterpret_cast<const bf16x8*>(p); }

__device__ __forceinline__ void gemm_stage(const bf16_t* __restrict__ A, long lda, const bf16_t* __restrict__ Bt, long ldb, int kt, char* buf, int tid) {
#pragma unroll
    for (int i = 0; i < 4; ++i) {
        const int b = tid * 16 + i * 4096, r = b >> 7, c = ((b & 127) >> 4) ^ (r & 7);
        __builtin_amdgcn_global_load_lds((const unsigned*)(A + (long)r * lda + kt * 64 + c * 8), (__attribute__((address_space(3))) unsigned*)(buf + b), 16, 0, 0);
        __builtin_amdgcn_global_load_lds((const unsigned*)(Bt + (long)r * ldb + kt * 64 + c * 8), (__attribute__((address_space(3))) unsigned*)(buf + 16384 + b), 16, 0, 0);
    }
}
__device__ __forceinline__ void gemm_acc(const bf16_t* __restrict__ A, long lda, const bf16_t* __restrict__ Bt, long ldb, int K, f32x4 (&acc)[4][4], char* lds) {
    const int tid = tid_(), wid = tid >> 6, lane = tid & 63, wr = wid >> 1, wc = wid & 1, fr = lane & 15, fq = lane >> 4;
    const int nk = K >> 6;
    gemm_stage(A, lda, Bt, ldb, 0, lds, tid);
    asm volatile("s_waitcnt vmcnt(0)" ::: "memory");
    __syncthreads();
    for (int kt = 0; kt < nk; ++kt) {
        char* cur = lds + (kt & 1) * 32768;
        if (kt + 1 < nk) gemm_stage(A, lda, Bt, ldb, kt + 1, lds + ((kt + 1) & 1) * 32768, tid);
#pragma unroll
        for (int ks = 0; ks < 2; ++ks) {
            bf16x8 af[4], bfr[4];
#pragma unroll
            for (int m = 0; m < 4; ++m) { const int row = wr * 64 + m * 16 + fr; af[m] = *reinterpret_cast<const bf16x8*>(cur + row * 128 + (((ks * 4 + fq) ^ (row & 7)) << 4)); }
#pragma unroll
            for (int n = 0; n < 4; ++n) { const int row = wc * 64 + n * 16 + fr; bfr[n] = *reinterpret_cast<const bf16x8*>(cur + 16384 + row * 128 + (((ks * 4 + fq) ^ (row & 7)) << 4)); }
            __builtin_amdgcn_s_setprio(1);
#pragma unroll
            for (int m = 0; m < 4; ++m)
#pragma unroll
                for (int n = 0; n < 4; ++n) acc[m][n] = mfma16(bfr[n], af[m], acc[m][n]);
            __builtin_amdgcn_s_setprio(0);
        }
        asm volatile("s_waitcnt vmcnt(0)" ::: "memory");
        __syncthreads();
    }
}
__device__ __forceinline__ void gemm2_stage(const bf16_t* __restrict__ A, long lda, const bf16_t* __restrict__ Bt, long ldb, int kt, char* buf, int tid) {
#pragma unroll
    for (int i = 0; i < 4; ++i) {
        const int b = tid * 16 + i * 4096, r = b >> 6, c = ((b & 63) >> 4) ^ ((r >> 2) & 3);
        __builtin_amdgcn_global_load_lds((const unsigned*)(A + (long)r * lda + kt * 32 + c * 8), (__attribute__((address_space(3))) unsigned*)(buf + b), 16, 0, 0);
    }
#pragma unroll
    for (int i = 0; i < 2; ++i) {
        const int b = tid * 16 + i * 4096, r = b >> 6, c = ((b & 63) >> 4) ^ ((r >> 2) & 3);
        __builtin_amdgcn_global_load_lds((const unsigned*)(Bt + (long)r * ldb + kt * 32 + c * 8), (__attribute__((address_space(3))) unsigned*)(buf + 16384 + b), 16, 0, 0);
    }
}
__device__ __forceinline__ void gemm_acc2(const bf16_t* __restrict__ A, long lda, const bf16_t* __restrict__ Bt, long ldb, int K, f32x4 (&acc)[8][4], char* lds) {
    const int tid = tid_(), wid = tid >> 6, lane = tid & 63, wr = wid >> 1, wc = wid & 1, fr = lane & 15, fq = lane >> 4;
    const int nk = K >> 5;
    gemm2_stage(A, lda, Bt, ldb, 0, lds, tid);
    asm volatile("s_waitcnt vmcnt(0)" ::: "memory");
    __syncthreads();
    for (int kt = 0; kt < nk; ++kt) {
        char* cur = lds + (kt & 1) * 24576;
        if (kt + 1 < nk) gemm2_stage(A, lda, Bt, ldb, kt + 1, lds + ((kt + 1) & 1) * 24576, tid);
        bf16x8 bfr[4];
#pragma unroll
        for (int n = 0; n < 4; ++n) { const int row = wc * 64 + n * 16 + fr; bfr[n] = *reinterpret_cast<const bf16x8*>(cur + 16384 + row * 64 + ((fq ^ ((row >> 2) & 3)) << 4)); }
        bf16x8 af[8];
#pragma unroll
        for (int m = 0; m < 8; ++m) { const int row = wr * 128 + m * 16 + fr; af[m] = *reinterpret_cast<const bf16x8*>(cur + row * 64 + ((fq ^ ((row >> 2) & 3)) << 4)); }
        __builtin_amdgcn_s_setprio(1);
#pragma unroll
        for (int m = 0; m < 8; ++m)
#pragma unroll
            for (int n = 0; n < 4; ++n) acc[m][n] = mfma16(bfr[n], af[m], acc[m][n]);
        __builtin_amdgcn_s_setprio(0);
        asm volatile("s_waitcnt vmcnt(0)" ::: "memory");
        __syncthreads();
    }
}
__device__ __forceinline__ void zero_acc2(f32x4 (&acc)[8][4]) {
#pragma unroll
    for (int m = 0; m < 8; ++m)
#pragma unroll
        for (int n = 0; n < 4; ++n) acc[m][n] = (f32x4){0.f, 0.f, 0.f, 0.f};
}
__device__ __forceinline__ void zero_acc(f32x4 (&acc)[4][4]) {
#pragma unroll
    for (int m = 0; m < 4; ++m)
#pragma unroll
        for (int n = 0; n < 4; ++n) acc[m][n] = (f32x4){0.f, 0.f, 0.f, 0.f};
}

__device__ void ph_init(const Params& P, char* lds) {
    const int tid = tid_();
    {
        const f32x4* src = (const f32x4*)P.in[I_X]; f32x4* dst = (f32x4*)P.out;
        const long n4 = (long)TT * DM / 4;
        for (long i = (long)bid_() * NT + tid; i < n4; i += (long)gridDim.x * NT) dst[i] = src[i];
    }
    float* mod = (float*)(P.ws + OFF_MOD);
    float* lbo = (float*)(P.ws + OFF_LB);
    for (int item = bid_(); item < 385; item += gridDim.x) {
        if (item < 384) {
            const int l = item / 96, j0 = (item % 96) * 64;
            const int col = tid & 63, kg = tid >> 6;
            float* CS = (float*)lds;
            float* RED = CS + 4096;
            float acc[16];
#pragma unroll
            for (int b = 0; b < 16; ++b) acc[b] = 0.f;
            const float* Wl = P.in[I_ADAW] + (size_t)l * DM * 6144;
            for (int sub = 0; sub < 4; ++sub) {
                __syncthreads();
                for (int e = tid; e < 4096; e += NT) {
                    const int kk = e & 63, b = (e >> 6) & 15, g = e >> 10;
                    CS[e] = silu(P.in[I_C][b * DM + g * 256 + sub * 64 + kk]);
                }
                __syncthreads();
                for (int kk = 0; kk < 64; ++kk) {
                    const float w = Wl[(size_t)(kg * 256 + sub * 64 + kk) * 6144 + j0 + col];
#pragma unroll
                    for (int b = 0; b < 16; ++b) acc[b] += CS[(kg * 16 + b) * 64 + kk] * w;
                }
            }
#pragma unroll
            for (int b = 0; b < 16; ++b) RED[(kg * 64 + col) * 16 + b] = acc[b];
            __syncthreads();
            {
                const int bg = tid >> 6;
#pragma unroll
                for (int bb = 0; bb < 4; ++bb) {
                    const int b = bg * 4 + bb;
                    float s = RED[(0 * 64 + col) * 16 + b] + RED[(1 * 64 + col) * 16 + b] + RED[(2 * 64 + col) * 16 + b] + RED[(3 * 64 + col) * 16 + b];
                    mod[((size_t)l * 16 + b) * 6144 + j0 + col] = s + P.in[I_ADAB][l * 6144 + j0 + col];
                }
            }
            __syncthreads();
        } else {
            for (int e = tid; e < 1024; e += NT) {
                float x[4], mx = -1e30f;
#pragma unroll
                for (int l = 0; l < 4; ++l) { x[l] = P.in[I_HGLB][l * 1024 + e]; mx = fmaxf(mx, x[l]); }
                float s = 0.f;
#pragma unroll
                for (int l = 0; l < 4; ++l) { x[l] = __expf(x[l] - mx); s += x[l]; }
                const float inv = rcpf_(s);
                float cum = 0.f;
                lbo[0 * 1024 + e] = 0.f;
#pragma unroll
                for (int l = 1; l < 4; ++l) { cum += x[l] * inv; lbo[l * 1024 + e] = fminf(fmaxf(cum, 0.f), 1.f); }
            }
        }
    }
}

__device__ __forceinline__ void tr_tile(const float* __restrict__ src, int ld, int N, int k0, int n0, bf16_t* __restrict__ dst, int dld, int drow0, bool winmap, char* lds) {
    float* Tl = (float*)lds;
    const int tid = tid_();
    __syncthreads();
#pragma unroll
    for (int i = 0; i < 4; ++i) {
        const int kk = (tid >> 4) + 16 * i, nn = (tid & 15) * 4;
        f32x4 v = (f32x4){0.f, 0.f, 0.f, 0.f};
        if (n0 + nn < N) v = *(const f32x4*)(src + (size_t)(k0 + kk) * ld + n0 + nn);
        Tl[kk * 65 + nn] = v[0]; Tl[kk * 65 + nn + 1] = v[1]; Tl[kk * 65 + nn + 2] = v[2]; Tl[kk * 65 + nn + 3] = v[3];
    }
    __syncthreads();
    {
        const int nn = tid >> 2, kb = (tid & 3) * 16;
        if (n0 + nn < N) {
            int drow = drow0 + nn;
            if (winmap) { const int n = n0 + nn; drow = n + (n >= 3344 ? 112 : 0); }
            unsigned w[8];
#pragma unroll
            for (int j = 0; j < 8; ++j) w[j] = pack2(Tl[(kb + 2 * j) * 65 + nn], Tl[(kb + 2 * j + 1) * 65 + nn]);
            u32x4* d = (u32x4*)(dst + (size_t)drow * dld + k0 + kb);
            d[0] = (u32x4){w[0], w[1], w[2], w[3]}; d[1] = (u32x4){w[4], w[5], w[6], w[7]};
        }
    }
}
__device__ void ph_wt(const Params& P, int l, char* lds) {
    char* ws = P.ws;
    const int NI = 2768 + 512 + 256 + 1408 + 704 + 16 + 16 + 16 + 16 + 16 + 7;
    for (int item = bid_(); item < NI; item += gridDim.x) {
        int it = item;
        if (it < 2768) { const int kt = it / 173, nt = it % 173;
            tr_tile(P.in[I_WIN] + (size_t)l * 1024 * 11024, 11024, 11024, kt * 64, nt * 64, (bf16_t*)(ws + WT_WIN), 1024, 0, true, lds); continue; }
        it -= 2768;
        if (it < 512) { const int n = it / 128, r = it % 128, kt = r / 16, nt = r % 16;
            tr_tile(P.in[I_WBR] + ((size_t)l * 4 + n) * 512 * 1024, 1024, 1024, kt * 64, nt * 64, (bf16_t*)(ws + WT_WB) + (size_t)n * 1024 * 512, 512, nt * 64, false, lds); continue; }
        it -= 512;
        if (it < 256) { const int kt = it / 16, nt = it % 16;
            tr_tile(P.in[I_WOUT] + (size_t)l * 1024 * 1024, 1024, 1024, kt * 64, nt * 64, (bf16_t*)(ws + WT_WOUT), 1024, nt * 64, false, lds); continue; }
        it -= 256;
        if (it < 1408) { const int kt = it / 88, nt = it % 88;
            tr_tile(P.in[I_FUP] + (size_t)l * 1024 * 5632, 5632, 5632, kt * 64, nt * 64, (bf16_t*)(ws + WT_WUP), 1024, nt * 64, false, lds); continue; }
        it -= 1408;
        if (it < 704) { const int kt = it / 16, nt = it % 16;
            tr_tile(P.in[I_FDN] + (size_t)l * 2816 * 1024, 1024, 1024, kt * 64, nt * 64, (bf16_t*)(ws + WT_WDN), 2816, nt * 64, false, lds); continue; }
        it -= 704;
        if (it < 16) { const int kt = it / 8, nt = it % 8;
            tr_tile(P.in[I_G2] + (size_t)l * 128 * 512, 512, 512, kt * 64, nt * 64, (bf16_t*)(ws + WT_G2), 128, nt * 64, false, lds); continue; }
        it -= 16;
        if (it < 16) { const int d = it / 8, nt = it % 8;
            tr_tile(P.in[I_W2] + ((size_t)l * 2 + d) * 64 * 512, 512, 512, 0, nt * 64, (bf16_t*)(ws + WT_W2) + (size_t)d * 512 * 64, 64, nt * 64, false, lds); continue; }
        it -= 16;
        if (it < 16) { const int d = it / 8, nt = it % 8;
            tr_tile(P.in[I_A2] + ((size_t)l * 2 + d) * 64 * 512, 512, 512, 0, nt * 64, (bf16_t*)(ws + WT_A2) + (size_t)d * 512 * 64, 64, nt * 64, false, lds); continue; }
        it -= 16;
        if (it < 32) { const int mat = it / 16, d = (it % 16) / 8, g = it % 8;
            const float* src = P.in[mat ? I_LWX : I_LWA] + (((size_t)l * 2 + d) * 8 + g) * 64 * 64;
            tr_tile(src, 64, 64, 0, 0, (bf16_t*)(ws + WT_LRU) + (((size_t)d * 2 + mat) * 8 + g) * 64 * 64, 64, 0, false, lds); continue; }
        it -= 32;
        {
            u32x4* d = (u32x4*)((bf16_t*)(ws + WT_WIN) + (size_t)(3344 + it * 16) * 1024);
            for (int e = tid_(); e < 16 * 1024 / 8; e += NT) d[e] = (u32x4){0u, 0u, 0u, 0u};
        }
    }
}

__device__ void ph_norm(const Params& P, const float* __restrict__ g, const float* __restrict__ modl, int sh_off, int sc_off, bf16_t* __restrict__ dst, bool final_) {
    const int tid = tid_(), wid = tid >> 6, lane = tid & 63;
    for (int item = bid_(); item < TT / 16; item += gridDim.x) {
        const int row0 = item * 16 + wid * 4, b = row0 >> 11;
        f32x4 v[4][4];
#pragma unroll
        for (int r = 0; r < 4; ++r)
#pragma unroll
            for (int i = 0; i < 4; ++i) v[r][i] = *(const f32x4*)(P.out + (size_t)(row0 + r) * DM + i * 256 + lane * 4);
        f32x4 gv[4], sc[4], sh[4];
#pragma unroll
        for (int i = 0; i < 4; ++i) {
            const int c = i * 256 + lane * 4;
            gv[i] = *(const f32x4*)(g + c);
            if (!final_) { sc[i] = *(const f32x4*)(modl + (size_t)b * 6144 + sc_off + c); sh[i] = *(const f32x4*)(modl + (size_t)b * 6144 + sh_off + c); }
        }
#pragma unroll
        for (int r = 0; r < 4; ++r) {
            float ss = 0.f;
#pragma unroll
            for (int i = 0; i < 4; ++i) ss += v[r][i][0] * v[r][i][0] + v[r][i][1] * v[r][i][1] + v[r][i][2] * v[r][i][2] + v[r][i][3] * v[r][i][3];
            ss = wsum64(ss);
            const float rs = rsqrtf(ss * (1.f / DM) + 1e-6f);
            float* hr = P.out + (size_t)(row0 + r) * DM;
#pragma unroll
            for (int i = 0; i < 4; ++i) {
                const int c = i * 256 + lane * 4;
                if (final_) {
                    *(f32x4*)(hr + c) = v[r][i] * rs * gv[i];
                } else {
                    const f32x4 o = v[r][i] * rs * gv[i] * (sc[i] + 1.f) + sh[i];
                    *(u32x2*)(dst + (size_t)(row0 + r) * DM + c) = (u32x2){pack2(o[0], o[1]), pack2(o[2], o[3])};
                }
            }
        }
    }
}

__device__ __forceinline__ void store_tile_bf16(const f32x4 (&acc)[4][4], bf16_t* __restrict__ dst, long ld) {
    const int tid = tid_(), wid = tid >> 6, lane = tid & 63, wr = wid >> 1, wc = wid & 1, fr = lane & 15, fq = lane >> 4;
#pragma unroll
    for (int m = 0; m < 4; ++m)
#pragma unroll
        for (int n = 0; n < 4; ++n) {
            const f32x4 v = acc[m][n];
            *(u32x2*)(dst + (long)(wr * 64 + m * 16 + fr) * ld + wc * 64 + n * 16 + fq * 4) = (u32x2){pack2(v[0], v[1]), pack2(v[2], v[3])};
        }
}
__device__ __forceinline__ void resid_tile(const f32x4 (&acc)[4][4], float* __restrict__ h, int row0, int col0, const float* __restrict__ gate) {
    const int tid = tid_(), wid = tid >> 6, lane = tid & 63, wr = wid >> 1, wc = wid & 1, fr = lane & 15, fq = lane >> 4;
    const int b = row0 >> 11;
#pragma unroll
    for (int n = 0; n < 4; ++n) {
        const int col = col0 + wc * 64 + n * 16 + fq * 4;
        const f32x4 gv = *(const f32x4*)(gate + (size_t)b * 6144 + col);
#pragma unroll
        for (int m = 0; m < 4; ++m) {
            float* hp = h + (size_t)(row0 + wr * 64 + m * 16 + fr) * DM + col;
            const f32x4 o = *(const f32x4*)hp + gv * acc[m][n];
            *(f32x4*)hp = o;
        }
    }
}
__device__ __forceinline__ void store_tile2_bf16(const f32x4 (&acc)[8][4], bf16_t* __restrict__ dst, long ld) {
    const int tid = tid_(), wid = tid >> 6, lane = tid & 63, wr = wid >> 1, wc = wid & 1, fr = lane & 15, fq = lane >> 4;
#pragma unroll
    for (int m = 0; m < 8; ++m)
#pragma unroll
        for (int n = 0; n < 4; ++n) {
            const f32x4 v = acc[m][n];
            *(u32x2*)(dst + (long)(wr * 128 + m * 16 + fr) * ld + wc * 64 + n * 16 + fq * 4) = (u32x2){pack2(v[0], v[1]), pack2(v[2], v[3])};
        }
}
__device__ __forceinline__ void resid_tile2(const f32x4 (&acc)[8][4], float* __restrict__ h, int row0, int col0, const float* __restrict__ gate) {
    const int tid = tid_(), wid = tid >> 6, lane = tid & 63, wr = wid >> 1, wc = wid & 1, fr = lane & 15, fq = lane >> 4;
    const int b = row0 >> 11;
#pragma unroll
    for (int n = 0; n < 4; ++n) {
        const int col = col0 + wc * 64 + n * 16 + fq * 4;
        const f32x4 gv = *(const f32x4*)(gate + (size_t)b * 6144 + col);
#pragma unroll
        for (int m = 0; m < 8; ++m) {
            float* hp = h + (size_t)(row0 + wr * 128 + m * 16 + fr) * DM + col;
            const f32x4 o = *(const f32x4*)hp + gv * acc[m][n];
            *(f32x4*)hp = o;
        }
    }
}
__device__ void ph_gemm_p(const Params& P, char* lds) {
    const bf16_t* U = (const bf16_t*)(P.ws + OFF_U); const bf16_t* Wt = (const bf16_t*)(P.ws + WT_WIN);
    bf16_t* prw = (bf16_t*)(P.ws + OFF_PRW); bf16_t* prest = (bf16_t*)(P.ws + OFF_PREST);
    for (int item = bid_(); item < 128 * 55; item += gridDim.x) {
        const int mt = item / 55, nt = item % 55;
        f32x4 acc[8][4]; zero_acc2(acc);
        gemm_acc2(U + (size_t)mt * 256 * DM, DM, Wt + (size_t)nt * 128 * DM, DM, DM, acc, lds);
        if (nt < 14) store_tile2_bf16(acc, prw + (size_t)mt * 256 * PRW_LD + nt * 128, PRW_LD);
        else store_tile2_bf16(acc, prest + (size_t)mt * 256 * PREST_LD + (nt - 14) * 128, PREST_LD);
    }
}
__device__ void ph_gemm_merge(const Params& P, char* lds) {
    const bf16_t* U = (const bf16_t*)(P.ws + OFF_URE); const bf16_t* Wt = (const bf16_t*)(P.ws + WT_WIN); const bf16_t* Wb = (const bf16_t*)(P.ws + WT_WB);
    bf16_t* mg = (bf16_t*)(P.ws + OFF_MERGED);
    for (int item = bid_(); item < 256 * 8; item += gridDim.x) {
        const int mt = item / 8, nt = item % 8;
        unsigned mpk[4][4][2];
#pragma unroll
        for (int m = 0; m < 4; ++m)
#pragma unroll
            for (int q = 0; q < 4; ++q) { mpk[m][q][0] = 0u; mpk[m][q][1] = 0u; }
#pragma unroll 1
        for (int n = 0; n < 4; ++n) {
            unsigned gpk[4][4][2];
            {
                f32x4 acc[4][4]; zero_acc(acc);
                gemm_acc(U + (size_t)mt * 128 * DM, DM, Wt + (size_t)(GATE_ROW0 + n * 1024 + nt * 128) * DM, DM, DM, acc, lds);
#pragma unroll
                for (int m = 0; m < 4; ++m)
#pragma unroll
                    for (int q = 0; q < 4; ++q) { gpk[m][q][0] = pack2(sigm(acc[m][q][0]), sigm(acc[m][q][1])); gpk[m][q][1] = pack2(sigm(acc[m][q][2]), sigm(acc[m][q][3])); }
            }
            const size_t yoff = (n == 0) ? OFF_Y0 : (n == 1 ? OFF_YB : (n == 2 ? OFF_YC : OFF_YD));
            const bf16_t* Y = (const bf16_t*)(P.ws + yoff);
            f32x4 acc[4][4]; zero_acc(acc);
            gemm_acc(Y + (size_t)mt * 128 * 512, 512, Wb + ((size_t)n * 1024 + nt * 128) * 512, 512, 512, acc, lds);
#pragma unroll
            for (int m = 0; m < 4; ++m)
#pragma unroll
                for (int q = 0; q < 4; ++q) {
                    mpk[m][q][0] = pack2(lo2f(mpk[m][q][0]) + lo2f(gpk[m][q][0]) * acc[m][q][0], hi2f(mpk[m][q][0]) + hi2f(gpk[m][q][0]) * acc[m][q][1]);
                    mpk[m][q][1] = pack2(lo2f(mpk[m][q][1]) + lo2f(gpk[m][q][1]) * acc[m][q][2], hi2f(mpk[m][q][1]) + hi2f(gpk[m][q][1]) * acc[m][q][3]);
                }
        }
        {
            const int tid = tid_(), wid = tid >> 6, lane = tid & 63, wr = wid >> 1, wc = wid & 1, fr = lane & 15, fq = lane >> 4;
            bf16_t* dst = mg + (size_t)mt * 128 * DM + nt * 128;
#pragma unroll
            for (int m = 0; m < 4; ++m)
#pragma unroll
                for (int q = 0; q < 4; ++q) *(u32x2*)(dst + (long)(wr * 64 + m * 16 + fr) * DM + wc * 64 + q * 16 + fq * 4) = (u32x2){mpk[m][q][0], mpk[m][q][1]};
        }
    }
}
__device__ void ph_gemm_out(const Params& P, int l, char* lds) {
    const bf16_t* A = (const bf16_t*)(P.ws + OFF_MERGED); const bf16_t* Wt = (const bf16_t*)(P.ws + WT_WOUT);
    const float* gate = (const float*)(P.ws + OFF_MOD) + (size_t)l * 16 * 6144 + 2048;
    for (int item = bid_(); item < 256 * 8; item += gridDim.x) {
        const int mt = item / 8, nt = item % 8;
        f32x4 acc[4][4]; zero_acc(acc);
        gemm_acc(A + (size_t)mt * 128 * DM, DM, Wt + (size_t)nt * 128 * DM, DM, DM, acc, lds);
        resid_tile(acc, P.out, mt * 128, nt * 128, gate);
    }
}
__device__ void ph_gemm_up(const Params& P, char* lds) {
    const bf16_t* A = (const bf16_t*)(P.ws + OFF_U2); const bf16_t* Wt = (const bf16_t*)(P.ws + WT_WUP);
    bf16_t* Z = (bf16_t*)(P.ws + OFF_Z);
    for (int item = bid_(); item < 128 * 44; item += gridDim.x) {
        const int mt = item / 44, nt = item % 44;
        f32x4 acc[8][4]; zero_acc2(acc);
        gemm_acc2(A + (size_t)mt * 256 * DM, DM, Wt + (size_t)nt * 128 * DM, DM, DM, acc, lds);
        store_tile2_bf16(acc, Z + (size_t)mt * 256 * 5632 + nt * 128, 5632);
    }
}
__device__ void ph_gemm_down(const Params& P, int l, char* lds) {
    const bf16_t* A = (const bf16_t*)(P.ws + OFF_ACT); const bf16_t* Wt = (const bf16_t*)(P.ws + WT_WDN);
    const float* gate = (const float*)(P.ws + OFF_MOD) + (size_t)l * 16 * 6144 + 5120;
    for (int item = bid_(); item < 128 * 8; item += gridDim.x) {
        const int mt = item / 8, nt = item % 8;
        f32x4 acc[8][4]; zero_acc2(acc);
        gemm_acc2(A + (size_t)mt * 256 * DFF, DFF, Wt + (size_t)nt * 128 * DFF, DFF, DFF, acc, lds);
        resid_tile2(acc, P.out, mt * 256, nt * 128, gate);
    }
}
__device__ void ph_convact(const Params& P, int l) {
    const bf16_t* Z = (const bf16_t*)(P.ws + OFF_Z); bf16_t* ACT = (bf16_t*)(P.ws + OFF_ACT);
    const float* cw = P.in[I_FCW] + (size_t)l * 3 * 5632; const float* cb = P.in[I_FCB] + (size_t)l * 5632;
    const long ntask = (long)(TT / 64) * 352;
    for (long task = (long)bid_() * NT + tid_(); task < ntask; task += (long)gridDim.x * NT) {
        const int tile = (int)(task / 352), cgp = (int)(task % 352), c0 = cgp * 8;
        const int t0 = tile * 64, s0 = t0 & (SQ - 1);
        float wv[3][8], wg[3][8], bv[8], bg[8];
#pragma unroll
        for (int j = 0; j < 3; ++j)
#pragma unroll
            for (int e = 0; e < 8; ++e) { wv[j][e] = cw[j * 5632 + c0 + e]; wg[j][e] = cw[j * 5632 + DFF + c0 + e]; }
#pragma unroll
        for (int e = 0; e < 8; ++e) { bv[e] = cb[c0 + e]; bg[e] = cb[DFF + c0 + e]; }
        float pv[8], pg[8], cv[8], cg_[8], nv[8], ng[8];
        const u32x4 zero4 = (u32x4){0u, 0u, 0u, 0u};
        {
            u32x4 a = zero4, b = zero4;
            if (s0 > 0) { a = *(const u32x4*)(Z + (size_t)(t0 - 1) * 5632 + c0); b = *(const u32x4*)(Z + (size_t)(t0 - 1) * 5632 + DFF + c0); }
            unpack8(a, pv); unpack8(b, pg);
            a = *(const u32x4*)(Z + (size_t)t0 * 5632 + c0); b = *(const u32x4*)(Z + (size_t)t0 * 5632 + DFF + c0);
            unpack8(a, cv); unpack8(b, cg_);
        }
#pragma unroll 8
        for (int r = 0; r < 64; ++r) {
            const int t = t0 + r;
            u32x4 a = zero4, b = zero4;
            if (s0 + r + 1 < SQ) { a = *(const u32x4*)(Z + (size_t)(t + 1) * 5632 + c0); b = *(const u32x4*)(Z + (size_t)(t + 1) * 5632 + DFF + c0); }
            unpack8(a, nv); unpack8(b, ng);
            float o[8];
#pragma unroll
            for (int e = 0; e < 8; ++e) {
                const float v = wv[0][e] * pv[e] + wv[1][e] * cv[e] + wv[2][e] * nv[e] + bv[e];
                const float g = wg[0][e] * pg[e] + wg[1][e] * cg_[e] + wg[2][e] * ng[e] + bg[e];
                o[e] = v * silu(g);
                pv[e] = cv[e]; cv[e] = nv[e]; pg[e] = cg_[e]; cg_[e] = ng[e];
            }
            *(u32x4*)(ACT + (size_t)t * DFF + c0) = (u32x4){pack2(o[0], o[1]), pack2(o[2], o[3]), pack2(o[4], o[5]), pack2(o[6], o[7])};
        }
    }
}

__device__ void mx_rwkv(const Params& P, int l, int item, char* lds) {
    const int tid = tid_(), wid = tid >> 6, lane = tid & 63, fr = lane & 15, fq = lane >> 4;
    const int d = item & 1, h = (item >> 1) & 7, b = item >> 4;
    const bf16_t* prw = (const bf16_t*)(P.ws + OFF_PRW) + (size_t)b * SQ * PRW_LD;
    bf16_t* Yd = (bf16_t*)(P.ws + (d ? OFF_Y1 : OFF_Y0)) + (size_t)b * SQ * 512 + h * 64;
    float* beta = (float*)(P.ws + OFF_BETA) + ((size_t)d * TT + (size_t)b * SQ) * 8 + h;
    float* VA = (float*)lds; float* VWR = VA + 1024; float* VW = VWR + 1024; float* VB = VW + 1024; float* VK = VB + 1024; float* VV = VK + 1024; float* VG = VV + 1024;
    float* SC = VG + 1024;
    bf16_t* RAW = (bf16_t*)(SC + 32);
    bf16_t* AT = RAW + 18 * 320;
    const int s = tid >> 4, jg = tid & 15, j0 = jg * 4;
    float mu[5][4], kkc[4], kac[4], rkc[4];
#pragma unroll
    for (int sg = 0; sg < 5; ++sg) {
        const int base = (sg < 3) ? sg * 512 + h * 64 : 1536 + (sg - 3) * 64;
#pragma unroll
        for (int i = 0; i < 4; ++i) mu[sg][i] = P.in[I_MU][l * 1792 + base + j0 + i];
    }
#pragma unroll
    for (int i = 0; i < 4; ++i) { kkc[i] = P.in[I_KK][l * 512 + h * 64 + j0 + i]; kac[i] = P.in[I_KA][l * 512 + h * 64 + j0 + i]; rkc[i] = P.in[I_RK][l * 512 + h * 64 + j0 + i]; }
    const int mt = wid >> 1, ntb = (wid & 1) * 2;
    bf16x8 bw[2][2]; float bsv[2][4];
    {
        const bf16_t* WT2 = (const bf16_t*)(P.ws + (mt ? WT_A2 : WT_W2)) + (size_t)d * 512 * 64;
        const float* bias = P.in[mt ? I_A0 : I_W0] + (size_t)(l * 2 + d) * 512 + h * 64;
#pragma unroll
        for (int nt = 0; nt < 2; ++nt) {
#pragma unroll
            for (int ks = 0; ks < 2; ++ks) bw[nt][ks] = ldfrag(WT2 + (size_t)(h * 64 + (ntb + nt) * 16 + fr) * 64 + ks * 32 + fq * 8);
#pragma unroll
            for (int jj = 0; jj < 4; ++jj) bsv[nt][jj] = bias[(ntb + nt) * 16 + fq * 4 + jj];
        }
    }
    float S[4][4];
#pragma unroll
    for (int i = 0; i < 4; ++i)
#pragma unroll
        for (int j = 0; j < 4; ++j) S[i][j] = 0.f;
    u32x4 pre[3];
    auto load_raw = [&](int c) {
        const int t0 = d ? SQ - 16 * (c + 1) : 16 * c;
#pragma unroll
        for (int i = 0; i < 3; ++i) {
            const int vi = tid + 256 * i;
            pre[i] = (u32x4){0u, 0u, 0u, 0u};
            if (vi < 720) {
                const int rr = vi / 40, rem = vi % 40, sg = rem >> 3, e = rem & 7, t = t0 - 1 + rr;
                const int col = ((sg < 3) ? sg * 512 + h * 64 : 1536 + (sg - 3) * 64) + e * 8;
                if (t >= 0 && t < SQ) pre[i] = *(const u32x4*)(prw + (size_t)t * PRW_LD + col);
            }
        }
    };
    __syncthreads();
    load_raw(0);
#pragma unroll 1
    for (int c = 0; c < 128; ++c) {
        const int t0 = d ? SQ - 16 * (c + 1) : 16 * c;
#pragma unroll
        for (int i = 0; i < 3; ++i) {
            const int vi = tid + 256 * i;
            if (vi < 720) { const int rr = vi / 40, rem = vi % 40; *(u32x4*)(RAW + rr * 320 + rem * 8) = pre[i]; }
        }
        __syncthreads();
        if (c + 1 < 128) load_raw(c + 1);
        float rs[4], ks_[4], vs[4], kk[4];
        {
            float sh[5][4];
#pragma unroll
            for (int sg = 0; sg < 5; ++sg) {
                float fm[4], f0[4], fp[4];
                unpack4(*(const u32x2*)(RAW + s * 320 + sg * 64 + j0), fm);
                unpack4(*(const u32x2*)(RAW + (s + 1) * 320 + sg * 64 + j0), f0);
                unpack4(*(const u32x2*)(RAW + (s + 2) * 320 + sg * 64 + j0), fp);
#pragma unroll
                for (int i = 0; i < 4; ++i) sh[sg][i] = f0[i] + mu[sg][i] * (0.5f * (fm[i] + fp[i]) - f0[i]);
            }
            float ssq = 0.f, q[4];
#pragma unroll
            for (int i = 0; i < 4; ++i) { rs[i] = sh[0][i]; ks_[i] = sh[1][i]; vs[i] = sh[2][i]; q[i] = ks_[i] * kkc[i]; ssq += q[i] * q[i]; }
            *(u32x2*)(AT + s * 72 + j0) = (u32x2){pack2(tanh_f(sh[3][0]), tanh_f(sh[3][1])), pack2(tanh_f(sh[3][2]), tanh_f(sh[3][3]))};
            *(u32x2*)(AT + 16 * 72 + s * 72 + j0) = (u32x2){pack2(sh[4][0], sh[4][1]), pack2(sh[4][2], sh[4][3])};
            ssq = rowsum16(ssq);
            const float inv = __builtin_amdgcn_rsqf(fmaxf(ssq, 1e-24f));
#pragma unroll
            for (int i = 0; i < 4; ++i) kk[i] = q[i] * inv;
        }
        __syncthreads();
        {
            const bf16_t* At = AT + mt * 16 * 72;
            const bf16x8 a0 = ldfrag(At + fr * 72 + fq * 8), a1 = ldfrag(At + fr * 72 + 32 + fq * 8);
            float* dstv = mt ? VG : VW;
#pragma unroll
            for (int nt = 0; nt < 2; ++nt) {
                f32x4 acc = (f32x4){0.f, 0.f, 0.f, 0.f};
                acc = mfma16(bw[nt][0], a0, acc); acc = mfma16(bw[nt][1], a1, acc);
                f32x4 o;
#pragma unroll
                for (int jj = 0; jj < 4; ++jj) {
                    const float x = acc[jj] + bsv[nt][jj];
                    if (mt == 0) { const float wl = fminf(x, 0.f) - flog_(1.f + __expf(-fabsf(x))) - 0.5f; o[jj] = __expf(-__expf(wl)); }
                    else o[jj] = sigm(x);
                }
                *(f32x4*)(dstv + fr * 64 + (ntb + nt) * 16 + fq * 4) = o;
            }
        }
        __syncthreads();
        {
            const f32x4 w4 = *(const f32x4*)(VW + s * 64 + j0), g4 = *(const f32x4*)(VG + s * 64 + j0);
            f32x4 bb, kt, wr, na, vv;
            float pbr = 0.f, pkr = 0.f, pbe = 0.f;
#pragma unroll
            for (int i = 0; i < 4; ++i) {
                bb[i] = kk[i] * g4[i]; kt[i] = ks_[i] * (1.f + (g4[i] - 1.f) * kac[i]); wr[i] = w4[i] * rs[i]; na[i] = -kk[i]; vv[i] = vs[i];
                pbr += bb[i] * rs[i]; pkr += kt[i] * rs[i]; pbe += rs[i] * kt[i] * rkc[i];
            }
            pbr = rowsum16(pbr); pkr = rowsum16(pkr); pbe = rowsum16(pbe);
            *(f32x4*)(VA + s * 64 + j0) = na; *(f32x4*)(VWR + s * 64 + j0) = wr; *(f32x4*)(VB + s * 64 + j0) = bb; *(f32x4*)(VK + s * 64 + j0) = kt; *(f32x4*)(VV + s * 64 + j0) = vv;
            if (jg == 0) { SC[s * 2] = pbr; SC[s * 2 + 1] = pkr; beta[(size_t)(t0 + s) * 8] = pbe; }
        }
        __syncthreads();
#pragma unroll 1
        for (int st = 0; st < 16; ++st) {
            const int sp = d ? 15 - st : st;
            const f32x4 a4 = *(const f32x4*)(VA + sp * 64 + j0), wr4 = *(const f32x4*)(VWR + sp * 64 + j0), w4 = *(const f32x4*)(VW + sp * 64 + j0);
            const f32x4 b4 = *(const f32x4*)(VB + sp * 64 + j0), k4 = *(const f32x4*)(VK + sp * 64 + j0), v4 = *(const f32x4*)(VV + sp * 64 + s * 4);
            const float br = SC[sp * 2], kr = SC[sp * 2 + 1];
            float psa[4], py[4];
            typedef float f32x2 __attribute__((ext_vector_type(2)));
            const f32x2 a01 = {a4[0], a4[1]}, a23 = {a4[2], a4[3]}, r01 = {wr4[0], wr4[1]}, r23 = {wr4[2], wr4[3]};
#pragma unroll
            for (int i = 0; i < 4; ++i) {
                const f32x2 s01 = {S[i][0], S[i][1]}, s23 = {S[i][2], S[i][3]};
                f32x2 ta = s01 * a01; ta = s23 * a23 + ta;
                f32x2 ty = s01 * r01; ty = s23 * r23 + ty;
                psa[i] = ta.x + ta.y; py[i] = ty.x + ty.y;
            }
#define RS8(CTRL) asm volatile("s_nop 1\n\tv_add_f32_dpp %0, %0, %0 " CTRL " row_mask:0xf bank_mask:0xf\n\tv_add_f32_dpp %1, %1, %1 " CTRL " row_mask:0xf bank_mask:0xf\n\tv_add_f32_dpp %2, %2, %2 " CTRL " row_mask:0xf bank_mask:0xf\n\tv_add_f32_dpp %3, %3, %3 " CTRL " row_mask:0xf bank_mask:0xf\n\tv_add_f32_dpp %4, %4, %4 " CTRL " row_mask:0xf bank_mask:0xf\n\tv_add_f32_dpp %5, %5, %5 " CTRL " row_mask:0xf bank_mask:0xf\n\tv_add_f32_dpp %6, %6, %6 " CTRL " row_mask:0xf bank_mask:0xf\n\tv_add_f32_dpp %7, %7, %7 " CTRL " row_mask:0xf bank_mask:0xf" : "+v"(psa[0]), "+v"(psa[1]), "+v"(psa[2]), "+v"(psa[3]), "+v"(py[0]), "+v"(py[1]), "+v"(py[2]), "+v"(py[3]))
            RS8("row_ror:8"); RS8("row_ror:4"); RS8("row_ror:2"); RS8("row_ror:1");
            asm volatile("s_nop 1" ::: "memory");
            float y[4];
#pragma unroll
            for (int i = 0; i < 4; ++i) {
                y[i] = py[i] + psa[i] * br + v4[i] * kr;
#pragma unroll
                for (int j = 0; j < 4; ++j) S[i][j] = S[i][j] * w4[j] + (psa[i] * b4[j] + v4[i] * k4[j]);
            }
            if (jg == 0) *(u32x2*)(Yd + (size_t)(t0 + sp) * 512 + s * 4) = (u32x2){pack2(y[0], y[1]), pack2(y[2], y[3])};
        }
    }
    __syncthreads();
}

__device__ void mx_mlstm(const Params& P, int l, int item, char* lds) {
    const int tid = tid_(), wid = tid >> 6, lane = tid & 63, fr = lane & 15, fq = lane >> 4;
    const int b = item >> 3, h = (item >> 1) & 3, dsel = item & 1;
    const bf16_t* pr = (const bf16_t*)(P.ws + OFF_PREST) + (size_t)b * SQ * PREST_LD;
    bf16_t* YB = (bf16_t*)(P.ws + (dsel ? OFF_YB : OFF_Y1)) + (size_t)b * SQ * 512 + h * 128;
    bf16_t* Q = (bf16_t*)lds; bf16_t* KP = Q + 64 * 72; bf16_t* KWT = KP + 64 * 72; bf16_t* VT = KWT + 64 * 72; bf16_t* CT = VT + 128 * 72;
    float* NS = (float*)(CT + 128 * 72); float* E = NS + 64; float* MM = E + 64; float* SI = MM + 64; float* WI = SI + 64; float* FL = WI + 64; float* DEC = FL + 64;
    const int i = wid * 16 + fr;
#pragma unroll 1
    for (int d = dsel; d <= dsel; ++d) {
        f32x4 Cacc[8];
#pragma unroll
        for (int dt = 0; dt < 8; ++dt) Cacc[dt] = (f32x4){0.f, 0.f, 0.f, 0.f};
        __syncthreads();
        for (int e = tid; e < 128 * 72 / 2; e += NT) ((unsigned*)CT)[e] = 0u;
        if (tid < 64) NS[tid] = 0.f;
        float m_st = 0.f;
        const float ib = P.in[I_MLIB][(l * 2 + d) * 4 + h], fb = P.in[I_MLFB][(l * 2 + d) * 4 + h];
        __syncthreads();
#pragma unroll 1
        for (int c = 0; c < 32; ++c) {
            const int t0 = d ? SQ - 64 * (c + 1) : 64 * c;
#define TROW(ii) (d ? t0 + 63 - (ii) : t0 + (ii))
            if (wid == 0) {
                const int t = TROW(lane);
                const float fg = bf2f(pr[(size_t)t * PREST_LD + 1544 + d * 4 + h]) + fb, ig = bf2f(pr[(size_t)t * PREST_LD + 1536 + d * 4 + h]) + ib;
                float bc = logsig(fg);
#pragma unroll
                for (int o = 1; o < 64; o <<= 1) { const float x = bperm(bc, lane - o); if (lane >= o) bc += x; }
                const float e = ig - bc; float pm = e;
#pragma unroll
                for (int o = 1; o < 64; o <<= 1) { const float x = bperm(pm, lane - o); if (lane >= o) pm = fmaxf(pm, x); }
                const float gend = rdlane(bc, 63), pmax = rdlane(pm, 63);
                const float mnew = fmaxf(gend + m_st, gend + pmax);
                const float M = fmaxf(m_st, pm);
                E[lane] = e; MM[lane] = M; SI[lane] = __expf(m_st - M); WI[lane] = __expf(gend + e - mnew); FL[lane] = __expf(-(bc + M));
                if (lane == 0) DEC[0] = __expf(gend + m_st - mnew);
                m_st = mnew;
            }
            __syncthreads();
#pragma unroll
            for (int it = 0; it < 2; ++it) {
                const int vi = tid + 256 * it, ii = vi >> 3, e = vi & 7, t = TROW(ii);
                float f[8];
                unpack8(*(const u32x4*)(pr + (size_t)t * PREST_LD + h * 64 + e * 8), f);
                *(u32x4*)(Q + ii * 72 + e * 8) = (u32x4){pack2(f[0] * 0.125f, f[1] * 0.125f), pack2(f[2] * 0.125f, f[3] * 0.125f), pack2(f[4] * 0.125f, f[5] * 0.125f), pack2(f[6] * 0.125f, f[7] * 0.125f)};
                const u32x4 kv = *(const u32x4*)(pr + (size_t)t * PREST_LD + 256 + h * 64 + e * 8);
                *(u32x4*)(KP + ii * 72 + e * 8) = kv;
                unpack8(kv, f);
                const float wi = WI[ii];
#pragma unroll
                for (int x = 0; x < 8; ++x) KWT[(e * 8 + x) * 72 + ii] = f2bf(f[x] * wi);
            }
#pragma unroll
            for (int it = 0; it < 4; ++it) {
                const int vi = tid + 256 * it, ii = vi >> 4, e = vi & 15, t = TROW(ii);
                const u32x4 vv = *(const u32x4*)(pr + (size_t)t * PREST_LD + 512 + h * 128 + e * 8);
                VT[(e * 8 + 0) * 72 + ii] = (bf16_t)(vv.x & 0xffff); VT[(e * 8 + 1) * 72 + ii] = (bf16_t)(vv.x >> 16);
                VT[(e * 8 + 2) * 72 + ii] = (bf16_t)(vv.y & 0xffff); VT[(e * 8 + 3) * 72 + ii] = (bf16_t)(vv.y >> 16);
                VT[(e * 8 + 4) * 72 + ii] = (bf16_t)(vv.z & 0xffff); VT[(e * 8 + 5) * 72 + ii] = (bf16_t)(vv.z >> 16);
                VT[(e * 8 + 6) * 72 + ii] = (bf16_t)(vv.w & 0xffff); VT[(e * 8 + 7) * 72 + ii] = (bf16_t)(vv.w >> 16);
            }
            __syncthreads();
            f32x4 sacc[4];
#pragma unroll
            for (int st = 0; st < 4; ++st) sacc[st] = (f32x4){0.f, 0.f, 0.f, 0.f};
#pragma unroll
            for (int ks = 0; ks < 2; ++ks) {
                const bf16x8 qf = ldfrag(Q + i * 72 + ks * 32 + fq * 8);
#pragma unroll
                for (int st = 0; st < 4; ++st) sacc[st] = mfma16(ldfrag(KP + (st * 16 + fr) * 72 + ks * 32 + fq * 8), qf, sacc[st]);
            }
            const float Mi = MM[i], si = SI[i];
            float rsum = 0.f; unsigned pwp[4][2];
#pragma unroll
            for (int st = 0; st < 4; ++st) {
                float pw[4];
#pragma unroll
                for (int jj = 0; jj < 4; ++jj) { const int sx = st * 16 + fq * 4 + jj; pw[jj] = (sx <= i) ? __expf(E[sx] - Mi) * sacc[st][jj] : 0.f; rsum += pw[jj]; }
                pwp[st][0] = pack2(pw[0], pw[1]); pwp[st][1] = pack2(pw[2], pw[3]);
            }
            rsum = qsum(rsum, lane);
            float qn = 0.f;
            {
                float f[8];
                unpack8(*(const u32x4*)(Q + i * 72 + fq * 16), f);
#pragma unroll
                for (int x = 0; x < 8; ++x) qn += f[x] * NS[fq * 16 + x];
                unpack8(*(const u32x4*)(Q + i * 72 + fq * 16 + 8), f);
#pragma unroll
                for (int x = 0; x < 8; ++x) qn += f[x] * NS[fq * 16 + 8 + x];
            }
            qn = qsum(qn, lane);
            const float den = si * qn + rsum;
            const float rinv = rcpf_(fmaxf(fabsf(den), FL[i]));
            __syncthreads();
#pragma unroll
            for (int st = 0; st < 4; ++st) *(u32x2*)(KP + i * 72 + st * 16 + fq * 4) = (u32x2){pwp[st][0], pwp[st][1]};
            __syncthreads();
            f32x4 oacc[8];
#pragma unroll
            for (int dt = 0; dt < 8; ++dt) oacc[dt] = (f32x4){0.f, 0.f, 0.f, 0.f};
#pragma unroll
            for (int ks = 0; ks < 2; ++ks) {
                const bf16x8 qf = ldfrag(Q + i * 72 + ks * 32 + fq * 8);
#pragma unroll
                for (int dt = 0; dt < 8; ++dt) oacc[dt] = mfma16(ldfrag(CT + (dt * 16 + fr) * 72 + ks * 32 + fq * 8), qf, oacc[dt]);
            }
#pragma unroll
            for (int dt = 0; dt < 8; ++dt) oacc[dt] *= si;
#pragma unroll
            for (int ks = 0; ks < 2; ++ks) {
                const bf16x8 pf = ldfrag(KP + i * 72 + ks * 32 + fq * 8);
#pragma unroll
                for (int dt = 0; dt < 8; ++dt) oacc[dt] = mfma16(ldfrag(VT + (dt * 16 + fr) * 72 + ks * 32 + fq * 8), pf, oacc[dt]);
            }
            {
                const int t = TROW(i);
                bf16_t* yp = YB + (size_t)t * 512 + fq * 4;
                {
#pragma unroll
                    for (int dt = 0; dt < 8; ++dt) { const f32x4 v = oacc[dt] * rinv; *(u32x2*)(yp + dt * 16) = (u32x2){pack2(v[0], v[1]), pack2(v[2], v[3])}; }
                }
            }
            __syncthreads();
            {
                const float dec = DEC[0];
#pragma unroll
                for (int dt = 0; dt < 8; ++dt) Cacc[dt] *= dec;
#pragma unroll
                for (int ks = 0; ks < 2; ++ks) {
                    const bf16x8 kf = ldfrag(KWT + (wid * 16 + fr) * 72 + ks * 32 + fq * 8);
#pragma unroll
                    for (int dt = 0; dt < 8; ++dt) Cacc[dt] = mfma16(kf, ldfrag(VT + (dt * 16 + fr) * 72 + ks * 32 + fq * 8), Cacc[dt]);
                }
#pragma unroll
                for (int dt = 0; dt < 8; ++dt) *(u32x2*)(CT + (dt * 16 + fr) * 72 + wid * 16 + fq * 4) = (u32x2){pack2(Cacc[dt][0], Cacc[dt][1]), pack2(Cacc[dt][2], Cacc[dt][3])};
                if (tid < 64) {
                    float n = dec * NS[tid];
#pragma unroll
                    for (int x = 0; x < 8; ++x) { float f[8]; unpack8(*(const u32x4*)(KWT + tid * 72 + x * 8), f); n += ((f[0] + f[1]) + (f[2] + f[3])) + ((f[4] + f[5]) + (f[6] + f[7])); }
                    NS[tid] = n;
                }
            }
            __syncthreads();
        }
    }
}

__device__ void mx_hgrn(const Params& P, int l, int item, char* lds) {
    const int tid = tid_(), wid = tid >> 6, lane = tid & 63, fr = lane & 15, fq = lane >> 4;
    const int b = item >> 4, h = (item >> 2) & 3, half = (item >> 1) & 1, dsel = item & 1;
    const bf16_t* pr = (const bf16_t*)(P.ws + OFF_PREST) + (size_t)b * SQ * PREST_LD + HG_O;
    bf16_t* YD = (bf16_t*)(P.ws + (dsel ? OFF_YD : OFF_Y0)) + (size_t)b * SQ * 512 + h * 128 + half * 64;
    bf16_t* QT = (bf16_t*)lds; bf16_t* KT = QT + 64 * 136; bf16_t* ATT = KT + 128 * 72; bf16_t* VT = ATT + 64 * 72; bf16_t* ST = VT + 64 * 72;
    float* TOT = (float*)(ST + 64 * 136);
    const int dk = tid & 127, hf = tid >> 7;
    const int i = wid * 16 + fr;
#pragma unroll 1
    for (int d = dsel; d <= dsel; ++d) {
        const float lbv = ((const float*)(P.ws + OFF_LB))[(l * 2 + d) * 512 + h * 128 + dk], oml = 1.f - lbv;
        f32x4 Sacc[2][4];
#pragma unroll
        for (int a = 0; a < 2; ++a)
#pragma unroll
            for (int dt = 0; dt < 4; ++dt) Sacc[a][dt] = (f32x4){0.f, 0.f, 0.f, 0.f};
        __syncthreads();
        for (int e = tid; e < 64 * 136 / 2; e += NT) ((unsigned*)ST)[e] = 0u;
        __syncthreads();
        u32x4 pff[4], pfq[4], pfv[2];
        auto hg_load = [&](int cc) {
            const int t0 = d ? SQ - 64 * (cc + 1) : 64 * cc;
#pragma unroll
            for (int it = 0; it < 4; ++it) {
                const int vi = tid + 256 * it, ii = vi >> 4, e = vi & 15, t = TROW(ii);
                pff[it] = *(const u32x4*)(pr + (size_t)t * PREST_LD + 512 * (1 + d) + h * 128 + e * 8);
                pfq[it] = *(const u32x4*)(pr + (size_t)t * PREST_LD + h * 128 + e * 8);
            }
#pragma unroll
            for (int it = 0; it < 2; ++it) {
                const int vi = tid + 256 * it, ii = vi >> 3, e = vi & 7, t = TROW(ii);
                pfv[it] = *(const u32x4*)(pr + (size_t)t * PREST_LD + 1536 + h * 128 + half * 64 + e * 8);
            }
        };
        hg_load(0);
#pragma unroll 1
        for (int c = 0; c < 32; ++c) {
            const int t0 = d ? SQ - 64 * (c + 1) : 64 * c;
#pragma unroll
            for (int it = 0; it < 4; ++it) {
                const int vi = tid + 256 * it, ii = vi >> 4, e = vi & 15;
                *(u32x4*)(KT + ii * 136 + e * 8) = pff[it];
                *(u32x4*)(QT + ii * 136 + e * 8) = pfq[it];
            }
#pragma unroll
            for (int it = 0; it < 2; ++it) {
                const int vi = tid + 256 * it, ii = vi >> 3, e = vi & 7;
                const u32x4 vv = pfv[it];
                VT[(e * 8 + 0) * 72 + ii] = (bf16_t)(vv.x & 0xffff); VT[(e * 8 + 1) * 72 + ii] = (bf16_t)(vv.x >> 16);
                VT[(e * 8 + 2) * 72 + ii] = (bf16_t)(vv.y & 0xffff); VT[(e * 8 + 3) * 72 + ii] = (bf16_t)(vv.y >> 16);
                VT[(e * 8 + 4) * 72 + ii] = (bf16_t)(vv.z & 0xffff); VT[(e * 8 + 5) * 72 + ii] = (bf16_t)(vv.z >> 16);
                VT[(e * 8 + 6) * 72 + ii] = (bf16_t)(vv.w & 0xffff); VT[(e * 8 + 7) * 72 + ii] = (bf16_t)(vv.w >> 16);
            }
            if (c + 1 < 32) hg_load(c + 1);
            __syncthreads();
            bf16_t* kp = KT + hf * 32 * 136 + dk; bf16_t* qp = QT + hf * 32 * 136 + dk;
            {
                float run = 0.f;
#pragma unroll 8
                for (int r = 0; r < 32; ++r) { const bf16_t fb = f2bf(lbv + oml * sigm(bf2f(kp[r * 136]))); kp[r * 136] = fb; run += flog_(bf2f(fb)); }
                TOT[hf * 128 + dk] = run;
            }
            __syncthreads();
            const float R = TOT[dk], gmR = TOT[128 + dk];
            {
                float g = hf ? R : 0.f;
#pragma unroll 8
                for (int r = 0; r < 32; ++r) {
                    const float fv = bf2f(kp[r * 136]);
                    g += flog_(fv);
                    const float e1 = __expf(fminf(g - R, 80.f));
                    qp[r * 136] = f2bf(silu(bf2f(qp[r * 136])) * e1);
                    kp[r * 136] = f2bf((1.f - fv) * __expf(fminf(R - g, 80.f)));
                }
                const float eR = __expf(R);
                bf16_t* sp = ST + hf * 32 * 136 + dk;
#pragma unroll 8
                for (int r = 0; r < 32; ++r) sp[r * 136] = f2bf(bf2f(sp[r * 136]) * eR);
            }
            __syncthreads();
            f32x4 oacc[4];
            unsigned kw[16];
            {
                f32x4 aacc[4];
#pragma unroll
                for (int st = 0; st < 4; ++st) { aacc[st] = (f32x4){0.f, 0.f, 0.f, 0.f}; oacc[st] = (f32x4){0.f, 0.f, 0.f, 0.f}; }
#pragma unroll
                for (int ks = 0; ks < 4; ++ks) {
                    const bf16x8 qf = ldfrag(QT + i * 136 + ks * 32 + fq * 8);
#pragma unroll
                    for (int st = 0; st < 4; ++st) aacc[st] = mfma16(ldfrag(KT + (st * 16 + fr) * 136 + ks * 32 + fq * 8), qf, aacc[st]);
#pragma unroll
                    for (int dt = 0; dt < 4; ++dt) oacc[dt] = mfma16(ldfrag(ST + (dt * 16 + fr) * 136 + ks * 32 + fq * 8), qf, oacc[dt]);
                }
#pragma unroll
                for (int st = 0; st < 4; ++st) {
                    float a[4];
#pragma unroll
                    for (int jj = 0; jj < 4; ++jj) a[jj] = (st * 16 + fq * 4 + jj <= i) ? aacc[st][jj] : 0.f;
                    *(u32x2*)(ATT + i * 72 + st * 16 + fq * 4) = (u32x2){pack2(a[0], a[1]), pack2(a[2], a[3])};
                }
#pragma unroll
                for (int r = 0; r < 16; ++r) kw[r] = (unsigned)kp[(2 * r) * 136] | ((unsigned)kp[(2 * r + 1) * 136] << 16);
            }
            __syncthreads();
            {
                u32x4* dst = (u32x4*)(KT + dk * 72 + hf * 32);
                dst[0] = (u32x4){kw[0], kw[1], kw[2], kw[3]}; dst[1] = (u32x4){kw[4], kw[5], kw[6], kw[7]};
                dst[2] = (u32x4){kw[8], kw[9], kw[10], kw[11]}; dst[3] = (u32x4){kw[12], kw[13], kw[14], kw[15]};
            }
            __syncthreads();
            {
#pragma unroll
                for (int ks = 0; ks < 2; ++ks) {
                    const bf16x8 af = ldfrag(ATT + i * 72 + ks * 32 + fq * 8);
#pragma unroll
                    for (int dt = 0; dt < 4; ++dt) oacc[dt] = mfma16(ldfrag(VT + (dt * 16 + fr) * 72 + ks * 32 + fq * 8), af, oacc[dt]);
                }
                const int t = TROW(i);
                bf16_t* yp = YD + (size_t)t * 512 + fq * 4;
#pragma unroll
                for (int dt = 0; dt < 4; ++dt) {
                    f32x4 v = oacc[dt];
                    *(u32x2*)(yp + dt * 16) = (u32x2){pack2(v[0], v[1]), pack2(v[2], v[3])};
                }
            }
#pragma unroll
            for (int a = 0; a < 2; ++a) {
                const int ktile = 2 * wid + a;
                f32x4 e1, e2;
#pragma unroll
                for (int jj = 0; jj < 4; ++jj) { const int dkk = ktile * 16 + fq * 4 + jj; e1[jj] = __expf(TOT[dkk]); e2[jj] = __expf(TOT[128 + dkk]); }
#pragma unroll
                for (int dt = 0; dt < 4; ++dt) Sacc[a][dt] *= e1;
#pragma unroll
                for (int ks = 0; ks < 2; ++ks) {
                    const bf16x8 kf = ldfrag(KT + (ktile * 16 + fr) * 72 + ks * 32 + fq * 8);
#pragma unroll
                    for (int dt = 0; dt < 4; ++dt) Sacc[a][dt] = mfma16(kf, ldfrag(VT + (dt * 16 + fr) * 72 + ks * 32 + fq * 8), Sacc[a][dt]);
                }
#pragma unroll
                for (int dt = 0; dt < 4; ++dt) {
                    Sacc[a][dt] *= e2;
                    *(u32x2*)(ST + (dt * 16 + fr) * 136 + ktile * 16 + fq * 4) = (u32x2){pack2(Sacc[a][dt][0], Sacc[a][dt][1]), pack2(Sacc[a][dt][2], Sacc[a][dt][3])};
                }
            }
            __syncthreads();
        }
    }
}

__device__ void mx_lru(const Params& P, int l, int item, char* lds) {
    const int tid = tid_(), wid = tid >> 6, lane = tid & 63, fr = lane & 15, fq = lane >> 4;
    const int b = item >> 3, g = item & 7;
    const bf16_t* pr = (const bf16_t*)(P.ws + OFF_PREST) + (size_t)b * SQ * PREST_LD + LRU_O;
    bf16_t* YC = (bf16_t*)(P.ws + OFF_YC) + (size_t)b * SQ * 512 + g * 64;
    bf16_t* XC = (bf16_t*)lds; float* AA = (float*)(lds + 9216); float* BB = AA + 64 * 65; float* HH = BB + 64 * 65;
    const int ch = tid & 63, tq = tid >> 6;
    float cwv[4];
#pragma unroll
    for (int j = 0; j < 4; ++j) cwv[j] = P.in[I_LCW][(l * 4 + j) * 512 + g * 64 + ch];
    const float cbv = P.in[I_LCB][l * 512 + g * 64 + ch];
    const int i = wid * 16 + fr;
#pragma unroll 1
    for (int d = 0; d < 2; ++d) {
        bf16x8 waf[4][2], wxf[4][2]; f32x4 ba4[4], bx4[4], c8[4];
        {
            const bf16_t* Wa = (const bf16_t*)(P.ws + WT_LRU) + (((size_t)d * 2 + 0) * 8 + g) * 4096;
            const bf16_t* Wx = (const bf16_t*)(P.ws + WT_LRU) + (((size_t)d * 2 + 1) * 8 + g) * 4096;
#pragma unroll
            for (int jt = 0; jt < 4; ++jt) {
#pragma unroll
                for (int ks = 0; ks < 2; ++ks) { waf[jt][ks] = ldfrag(Wa + (jt * 16 + fr) * 64 + ks * 32 + fq * 8); wxf[jt][ks] = ldfrag(Wx + (jt * 16 + fr) * 64 + ks * 32 + fq * 8); }
                const int j = (l * 2 + d) * 512 + g * 64 + jt * 16 + fq * 4;
                ba4[jt] = *(const f32x4*)(P.in[I_LBA] + j); bx4[jt] = *(const f32x4*)(P.in[I_LBX] + j);
                const f32x4 lam = *(const f32x4*)(P.in[I_LLAM] + j);
#pragma unroll
                for (int jj = 0; jj < 4; ++jj) c8[jt][jj] = -8.f * (fmaxf(-lam[jj], 0.f) + flog_(1.f + __expf(-fabsf(lam[jj]))));
            }
        }
        float hst = 0.f;
        bf16_t xr[19];
        auto lru_load = [&](int cc) {
            const int t0 = d ? SQ - 64 * (cc + 1) : 64 * cc;
#pragma unroll
            for (int k = 0; k < 19; ++k) { const int t = t0 + tq * 16 - 1 + k; xr[k] = (t >= 0 && t < SQ) ? pr[(size_t)t * PREST_LD + g * 64 + ch] : (bf16_t)0; }
        };
        lru_load(0);
#pragma unroll 1
        for (int c = 0; c < 32; ++c) {
            const int t0 = d ? SQ - 64 * (c + 1) : 64 * c;
            {
                float xw[19];
#pragma unroll
                for (int k = 0; k < 19; ++k) xw[k] = bf2f(xr[k]);
                if (c + 1 < 32) lru_load(c + 1);
#pragma unroll
                for (int r = 0; r < 16; ++r) XC[(tq * 16 + r) * 72 + ch] = f2bf(cbv + cwv[0] * xw[r] + cwv[1] * xw[r + 1] + cwv[2] * xw[r + 2] + cwv[3] * xw[r + 3]);
            }
            __syncthreads();
            {
                f32x4 ra[4], rx[4];
#pragma unroll
                for (int jt = 0; jt < 4; ++jt) { ra[jt] = (f32x4){0.f, 0.f, 0.f, 0.f}; rx[jt] = (f32x4){0.f, 0.f, 0.f, 0.f}; }
#pragma unroll
                for (int ks = 0; ks < 2; ++ks) {
                    const bf16x8 xf = ldfrag(XC + i * 72 + ks * 32 + fq * 8);
#pragma unroll
                    for (int jt = 0; jt < 4; ++jt) { ra[jt] = mfma16(waf[jt][ks], xf, ra[jt]); rx[jt] = mfma16(wxf[jt][ks], xf, rx[jt]); }
                }
#pragma unroll
                for (int jt = 0; jt < 4; ++jt) {
                    float xc[4]; unpack4(*(const u32x2*)(XC + i * 72 + jt * 16 + fq * 4), xc);
#pragma unroll
                    for (int jj = 0; jj < 4; ++jj) {
                        const float la = c8[jt][jj] * sigm(ra[jt][jj] + ba4[jt][jj]);
                        const float av = __expf(la);
                        const float mult = __builtin_amdgcn_sqrtf(fmaxf(1.f - av * av, 0.f));
                        AA[i * 65 + jt * 16 + fq * 4 + jj] = av;
                        BB[i * 65 + jt * 16 + fq * 4 + jj] = mult * sigm(rx[jt][jj] + bx4[jt][jj]) * xc[jj];
                    }
                }
            }
            __syncthreads();
            if (tid < 64) {
#pragma unroll 1
                for (int r8 = 0; r8 < 8; ++r8) {
                    float av[8], bv[8];
#pragma unroll
                    for (int x = 0; x < 8; ++x) { const int r = d ? 63 - (r8 * 8 + x) : r8 * 8 + x; av[x] = AA[r * 65 + ch]; bv[x] = BB[r * 65 + ch]; }
#pragma unroll
                    for (int x = 0; x < 8; ++x) { const int r = d ? 63 - (r8 * 8 + x) : r8 * 8 + x; hst = av[x] * hst + bv[x]; HH[r * 65 + ch] = hst; }
                }
            }
            __syncthreads();
#pragma unroll
            for (int r = 0; r < 16; ++r) {
                const int ii = tq * 16 + r, t = t0 + ii;
                const float hv = HH[ii * 65 + ch];
                if (d == 0) YC[(size_t)t * 512 + ch] = f2bf(hv);
                else { const float prev = bf2f(YC[(size_t)t * 512 + ch]), gb = bf2f(pr[(size_t)t * PREST_LD + 512 + g * 64 + ch]); YC[(size_t)t * 512 + ch] = f2bf((prev + hv) * gelu_t(gb)); }
            }
        }
        __syncthreads();
    }
}

__device__ void dbg_zero(bf16_t* p, size_t n, int part, int nparts) {
    u32x4* q = (u32x4*)p; const size_t n8 = n / 8, per = (n8 + nparts - 1) / nparts, lo = per * part, hi = (lo + per < n8) ? lo + per : n8;
    for (size_t e = lo + tid_(); e < hi; e += NT) q[e] = (u32x4){0u, 0u, 0u, 0u};
}
__device__ void ph_mixers(const Params& P, int l, char* lds, int which) {
    const int nitems = 384;
    for (int item = bid_(); item < nitems; item += gridDim.x) {
        if (which) { if (item < 256) mx_rwkv(P, l, item, lds); else mx_lru(P, l, item - 256, lds); }
        else if (item < 256) mx_hgrn(P, l, item, lds);
        else mx_mlstm(P, l, item - 256, lds);
        __syncthreads();
    }
}

__device__ void ph_rwpost(const Params& P, int l, char* lds) {
    const int tid = tid_(), wid = tid >> 6, lane = tid & 63, fr = lane & 15, fq = lane >> 4;
    bf16_t* SG = (bf16_t*)lds; float* STAT = (float*)(lds + 64 * 136 * 2);
    const bf16_t* G2T = (const bf16_t*)(P.ws + WT_G2);
    const float* mu = P.in[I_MU] + l * 1792;
    for (int item = bid_(); item < TT / 64; item += gridDim.x) {
        const int tok0 = item * 64, s0 = tok0 & (SQ - 1);
        const bf16_t* prw = (const bf16_t*)(P.ws + OFF_PRW);
        bf16_t* Y0 = (bf16_t*)(P.ws + OFF_Y0); const bf16_t* Y1 = (const bf16_t*)(P.ws + OFF_Y1);
        const float* be0 = (const float*)(P.ws + OFF_BETA); const float* be1 = be0 + (size_t)TT * 8;
        __syncthreads();
        {
            const int r = tid >> 2, part = tid & 3, t = tok0 + r, sp = s0 + r;
#pragma unroll
            for (int v = 0; v < 4; ++v) {
                const int c = part * 32 + v * 8;
                float f0[8], fm[8], fp[8];
                unpack8(*(const u32x4*)(prw + (size_t)t * PRW_LD + 1664 + c), f0);
                if (sp > 0) unpack8(*(const u32x4*)(prw + (size_t)(t - 1) * PRW_LD + 1664 + c), fm); else { for (int x = 0; x < 8; ++x) fm[x] = 0.f; }
                if (sp < SQ - 1) unpack8(*(const u32x4*)(prw + (size_t)(t + 1) * PRW_LD + 1664 + c), fp); else { for (int x = 0; x < 8; ++x) fp[x] = 0.f; }
                float o[8];
#pragma unroll
                for (int x = 0; x < 8; ++x) o[x] = sigm(f0[x] + mu[1664 + c + x] * (0.5f * (fm[x] + fp[x]) - f0[x]));
                *(u32x4*)(SG + r * 136 + c) = (u32x4){pack2(o[0], o[1]), pack2(o[2], o[3]), pack2(o[4], o[5]), pack2(o[6], o[7])};
            }
#pragma unroll
            for (int hh = 0; hh < 2; ++hh) {
                const int head = part * 2 + hh;
                float sm = 0.f, sq = 0.f;
#pragma unroll
                for (int v = 0; v < 8; ++v) {
                    float a[8], bq[8];
                    unpack8(*(const u32x4*)(Y0 + (size_t)t * 512 + head * 64 + v * 8), a); unpack8(*(const u32x4*)(Y1 + (size_t)t * 512 + head * 64 + v * 8), bq);
#pragma unroll
                    for (int x = 0; x < 8; ++x) { const float y = a[x] + bq[x]; sm += y; sq += y * y; }
                }
                const float mean = sm * (1.f / 64.f), var = fmaxf(sq * (1.f / 64.f) - mean * mean, 0.f);
                STAT[(r * 8 + head) * 2] = mean; STAT[(r * 8 + head) * 2 + 1] = rsqrtf(var + 64e-5f);
            }
        }
        __syncthreads();
#pragma unroll 1
        for (int np = 0; np < 4; ++np) {
            const int nt0 = wid * 8 + np * 2;
            bf16x8 gb0[4], gb1[4];
#pragma unroll
            for (int ks = 0; ks < 4; ++ks) { gb0[ks] = ldfrag(G2T + (size_t)(nt0 * 16 + fr) * 128 + ks * 32 + fq * 8); gb1[ks] = ldfrag(G2T + (size_t)((nt0 + 1) * 16 + fr) * 128 + ks * 32 + fq * 8); }
#pragma unroll 1
            for (int tt = 0; tt < 4; ++tt) {
                f32x4 acc[2];
                acc[0] = (f32x4){0.f, 0.f, 0.f, 0.f}; acc[1] = (f32x4){0.f, 0.f, 0.f, 0.f};
#pragma unroll
                for (int ks = 0; ks < 4; ++ks) {
                    const bf16x8 af = ldfrag(SG + (tt * 16 + fr) * 136 + ks * 32 + fq * 8);
                    acc[0] = mfma16(gb0[ks], af, acc[0]); acc[1] = mfma16(gb1[ks], af, acc[1]);
                }
#pragma unroll
                for (int q = 0; q < 2; ++q) {
                    const int r = tt * 16 + fr, t = tok0 + r, sp = s0 + r, n = (nt0 + q) * 16 + fq * 4, head = n >> 6;
                    float y0[4], y1[4], v0[4], vm[4], vp[4];
                    unpack4(*(const u32x2*)(Y0 + (size_t)t * 512 + n), y0); unpack4(*(const u32x2*)(Y1 + (size_t)t * 512 + n), y1);
                    unpack4(*(const u32x2*)(prw + (size_t)t * PRW_LD + 1024 + n), v0);
                    if (sp > 0) unpack4(*(const u32x2*)(prw + (size_t)(t - 1) * PRW_LD + 1024 + n), vm); else { vm[0] = vm[1] = vm[2] = vm[3] = 0.f; }
                    if (sp < SQ - 1) unpack4(*(const u32x2*)(prw + (size_t)(t + 1) * PRW_LD + 1024 + n), vp); else { vp[0] = vp[1] = vp[2] = vp[3] = 0.f; }
                    const float mean = STAT[(r * 8 + head) * 2], rstd = STAT[(r * 8 + head) * 2 + 1];
                    const float be = 0.5f * (be0[(size_t)t * 8 + head] + be1[(size_t)t * 8 + head]);
                    const f32x4 lw = *(const f32x4*)(P.in[I_LNW] + l * 512 + n), lb = *(const f32x4*)(P.in[I_LNB] + l * 512 + n), m4 = *(const f32x4*)(mu + 1024 + n);
                    float o[4];
#pragma unroll
                    for (int jj = 0; jj < 4; ++jj) {
                        const float vs = v0[jj] + m4[jj] * (0.5f * (vm[jj] + vp[jj]) - v0[jj]);
                        o[jj] = (((y0[jj] + y1[jj]) - mean) * rstd * lw[jj] + lb[jj] + be * vs) * acc[q][jj];
                    }
                    *(u32x2*)(Y0 + (size_t)t * 512 + n) = (u32x2){pack2(o[0], o[1]), pack2(o[2], o[3])};
                }
            }
        }
    }
    __syncthreads();
}
template <bool ML> __device__ void ph_headpost(const Params& P, int l) {
    const int tid = tid_();
    bf16_t* YO = (bf16_t*)(P.ws + (ML ? OFF_YB : OFF_YD)); const bf16_t* SDF = (const bf16_t*)(P.ws + (ML ? OFF_Y1 : OFF_Y0));
    const bf16_t* pr = (const bf16_t*)(P.ws + OFF_PREST) + (ML ? 1024 : HG_O + 2048);
    const float* ng = P.in[ML ? I_MLN : I_HGN] + l * 512;
    for (int item = bid_(); item < TT / 64; item += gridDim.x) {
        const int t = item * 64 + (tid >> 2), part = tid & 3;
#pragma unroll 2
        for (int hh = 0; hh < 4; ++hh) {
            const int c0 = hh * 128 + part * 32;
            float v[32]; float ss = 0.f;
#pragma unroll
            for (int q = 0; q < 4; ++q) { float f[8], f2[8]; unpack8(*(const u32x4*)(YO + (size_t)t * 512 + c0 + q * 8), f); unpack8(*(const u32x4*)(SDF + (size_t)t * 512 + c0 + q * 8), f2);
#pragma unroll
                for (int x = 0; x < 8; ++x) { const float y = f[x] + f2[x]; v[q * 8 + x] = y; ss += y * y; } }
            ss += dppf<0xB1>(ss); ss += dppf<0x4E>(ss);
            const float rms = rsqrtf(ss * (1.f / 128.f) + 1e-6f);
#pragma unroll
            for (int q = 0; q < 4; ++q) {
                float gq[8]; unpack8(*(const u32x4*)(pr + (size_t)t * PREST_LD + c0 + q * 8), gq);
                float o[8];
#pragma unroll
                for (int x = 0; x < 8; ++x) o[x] = (ML ? sigm(gq[x]) : silu(gq[x])) * v[q * 8 + x] * rms * ng[c0 + q * 8 + x];
                *(u32x4*)(YO + (size_t)t * 512 + c0 + q * 8) = (u32x4){pack2(o[0], o[1]), pack2(o[2], o[3]), pack2(o[4], o[5]), pack2(o[6], o[7])};
            }
        }
    }
}

#define XB_TMO      128
#define XB_XCNT(j)  (256  + 64 * (j))
#define XB_XSUB(j)  (1280 + 64 * (j))
#define XB_XGEN(j)  (2304 + 64 * (j))
#define XB_TOP      3328
#define XB_TOPGEN   3392
#define XCD_BAR_WORDS 3456
#define XB_SPIN_CAP (1u << 18)
#define LAS __attribute__((address_space(3)))

__device__ __forceinline__ unsigned xb_ld(unsigned* p)              { return __hip_atomic_load(p, __ATOMIC_RELAXED, __HIP_MEMORY_SCOPE_AGENT); }
__device__ __forceinline__ unsigned xb_add(unsigned* p, unsigned v) { return __hip_atomic_fetch_add(p, v, __ATOMIC_RELAXED, __HIP_MEMORY_SCOPE_AGENT); }
__device__ __forceinline__ unsigned xb_xcc_id() { return (unsigned)__builtin_amdgcn_s_getreg((3 << 11) | 20) & 0xFu; }
#define XB_SPIN(cond, bar) do { unsigned _sp = 0; while (cond) { __builtin_amdgcn_s_sleep(1); \
    if ((++_sp & 255u) == 0u) { if (xb_ld(&(bar)[XB_TMO])) break; if (_sp > XB_SPIN_CAP) { atomicAdd(&(bar)[XB_TMO], 1u); break; } } } } while (0)

struct XcdBarrier {
    unsigned* bar; unsigned x;
    volatile LAS unsigned* st;
};

__device__ __forceinline__ XcdBarrier xcd_barrier_post(unsigned* bar, volatile LAS unsigned* st) {
    XcdBarrier b; b.bar = bar; b.x = xb_xcc_id(); b.st = st;
    if (threadIdx.x == 0) (void)xb_add(&bar[XB_XCNT(b.x)], 1u);
    return b;
}
__device__ __forceinline__ void xcd_barrier_complete(unsigned* bar, unsigned x, unsigned& nloc, unsigned& nx) {
    const unsigned G = gridDim.x * gridDim.y * gridDim.z;
    unsigned sum, cnt, mine, sp = 0u;
    for (;;) {
        sum = 0u; cnt = 0u; mine = 0u;
#pragma unroll
        for (unsigned j = 0; j < 16; ++j) { const unsigned c = xb_ld(&bar[XB_XCNT(j)]); sum += c; cnt += (c > 0u) ? 1u : 0u; mine = (j == x) ? c : mine; }
        if (sum == G) break;
        __builtin_amdgcn_s_sleep(1);
        if ((++sp & 255u) == 0u) { if (xb_ld(&bar[XB_TMO])) break; if (sp > XB_SPIN_CAP) { atomicAdd(&bar[XB_TMO], 1u); break; } }
    }
    nloc = mine > 0u ? mine : 1u; nx = cnt > 0u ? cnt : 1u;
}

__device__ __forceinline__ void xcd_barrier(const XcdBarrier& b) {
    asm volatile("s_waitcnt vmcnt(0)" ::: "memory");
    __syncthreads();
    if (threadIdx.x == 0) {
        unsigned* bar = b.bar;
        __builtin_amdgcn_s_waitcnt(0);
        unsigned nloc = b.st[0], nx = b.st[1];
        if (nloc == 0u) { xcd_barrier_complete(bar, b.x, nloc, nx); b.st[0] = nloc; b.st[1] = nx; }
        const unsigned old = xb_add(&bar[XB_XSUB(b.x)], 1u);
        const unsigned gen = old / nloc;
        if (old + 1u == (gen + 1u) * nloc) {
            __builtin_amdgcn_fence(__ATOMIC_RELEASE, "agent");
            asm volatile("s_waitcnt vmcnt(0)" ::: "memory");
            const unsigned og = xb_add(&bar[XB_TOP], 1u);
            const unsigned tg = og / nx;
            if (og + 1u == (tg + 1u) * nx) xb_add(&bar[XB_TOPGEN], 1u);
            else XB_SPIN(xb_ld(&bar[XB_TOPGEN]) == tg, bar);
            __builtin_amdgcn_fence(__ATOMIC_ACQUIRE, "agent");
            xb_add(&bar[XB_XGEN(b.x)], 1u);
            asm volatile("s_waitcnt vmcnt(0)" ::: "memory");
        } else {
            XB_SPIN(xb_ld(&bar[XB_XGEN(b.x)]) == gen, bar);
            __builtin_amdgcn_fence(__ATOMIC_ACQUIRE, "agent");
            asm volatile("s_waitcnt vmcnt(0)" ::: "memory");
        }
    }
    __syncthreads();
}


constexpr int N_PHASES = 2 + NL * 13;
__device__ void run_phase(const Params& P, int ph, char* lds) {
    if (ph == 0) { ph_init(P, lds); return; }
    if (ph == N_PHASES - 1) { ph_norm(P, P.in[I_FING], nullptr, 0, 0, nullptr, true); return; }
    const int l = (ph - 1) / 13; int sp = (ph - 1) % 13;
    const float* modl = (const float*)(P.ws + OFF_MOD) + (size_t)l * 16 * 6144;
    if (sp == 2) { ph_mixers(P, l, lds, 0); return; }
    if (sp == 3) { ph_headpost<false>(P, l); ph_headpost<true>(P, l); return; }
    if (sp == 4) { ph_mixers(P, l, lds, 1); return; }
    if (sp > 4) sp -= 2;
    switch (sp) {
        case 0: ph_wt(P, l, lds); ph_norm(P, P.in[I_N1G] + l * DM, modl, 0, 1024, (bf16_t*)(P.ws + OFF_U), false); break;
        case 1: ph_gemm_p(P, lds); break;
        case 3: ph_rwpost(P, l, lds); break;
        case 4: ph_norm(P, P.in[I_N1G] + l * DM, modl, 0, 1024, (bf16_t*)(P.ws + OFF_URE), false); break;
        case 5: ph_gemm_merge(P, lds); break;
        case 6: ph_gemm_out(P, l, lds); break;
        case 7: ph_norm(P, P.in[I_N2G] + l * DM, modl, 3072, 4096, (bf16_t*)(P.ws + OFF_U2), false); break;
        case 8: ph_gemm_up(P, lds); break;
        case 9: ph_convact(P, l); break;
        default: ph_gemm_down(P, l, lds); break;
    }
}

__global__ void __launch_bounds__(NT, 2) mega(Params P, int ph_lo, int ph_hi) {
    extern __shared__ __attribute__((aligned(16))) char smem[];
    cg::grid_group grid = cg::this_grid();
    volatile LAS unsigned* xst = (volatile LAS unsigned*)(smem + LDS_BYTES - 16);
    if (threadIdx.x == 0) { xst[0] = 0u; xst[1] = 0u; }
    __syncthreads();
    XcdBarrier xb = xcd_barrier_post((unsigned*)(P.ws + OFF_BAR), xst);
    for (int ph = ph_lo; ph < ph_hi; ++ph) {
        run_phase(P, ph, smem);
        if (ph + 1 < ph_hi) { if (ph == ph_lo) grid.sync(); else xcd_barrier(xb); }
    }
}

extern "C" void kernel_launch(void* const* d_in, const int* in_sizes, int n_in, void* d_out, int out_size, void* d_ws, size_t ws_size, hipStream_t stream) {
    static int grid_blocks = 0;
    if (grid_blocks == 0) {
        if (n_in != N_INPUTS || ws_size < WS_NEED || out_size != TT * DM) { fprintf(stderr, "kernel_launch: unexpected shapes (n_in %d ws %zu need %zu)\n", n_in, ws_size, (size_t)WS_NEED); grid_blocks = -1; return; }
        int dev = 0, cus = 0, per_cu = 0;
        hipGetDevice(&dev);
        hipDeviceGetAttribute(&cus, hipDeviceAttributeMultiprocessorCount, dev);
        if (hipFuncSetAttribute((const void*)mega, hipFuncAttributeMaxDynamicSharedMemorySize, LDS_BYTES) != hipSuccess) { fprintf(stderr, "kernel_launch: hipFuncSetAttribute failed\n"); grid_blocks = -1; return; }
        hipOccupancyMaxActiveBlocksPerMultiprocessor(&per_cu, (const void*)mega, NT, LDS_BYTES);
        if (per_cu < 1) per_cu = 1;
        if (per_cu > 2) per_cu = 2;
        grid_blocks = cus * per_cu;
    }
    if (grid_blocks < 0) return;
    if (hipMemsetAsync((char*)d_ws + OFF_BAR, 0, BAR_BYTES, stream) != hipSuccess) { fprintf(stderr, "kernel_launch: memset of the barrier words failed\n"); return; }
    Params p{};
    for (int i = 0; i < N_INPUTS; ++i) p.in[i] = (const float*)d_in[i];
    p.out = (float*)d_out; p.ws = (char*)d_ws;
#if MULTI_LAUNCH
    for (int ph = 0; ph < N_PHASES; ++ph) hipLaunchKernelGGL(mega, dim3(grid_blocks), dim3(NT), LDS_BYTES, stream, p, ph, ph + 1);
#else
    int lo = 0, hi = N_PHASES;
    void* args[] = {&p, &lo, &hi};
    hipError_t e = hipLaunchCooperativeKernel((const void*)mega, dim3(grid_blocks), dim3(NT), args, LDS_BYTES, stream);
    if (e != hipSuccess) fprintf(stderr, "cooperative launch failed: %s (grid %d)\n", hipGetErrorString(e), grid_blocks);
#endif
}
```

```cpp
#include <hip/hip_runtime.h>
#include <hip/hip_cooperative_groups.h>
#include <cstdio>
namespace cg = cooperative_groups;

typedef unsigned short bf16_t;
typedef short bf16x8 __attribute__((ext_vector_type(8)));
typedef float f32x4 __attribute__((ext_vector_type(4)));
typedef unsigned u32x4 __attribute__((ext_vector_type(4)));
typedef unsigned u32x2 __attribute__((ext_vector_type(2)));

#ifndef DBG_SKIP
#define DBG_SKIP 0
#endif
#ifndef DBG_NOFFN
#define DBG_NOFFN 0
#endif
#ifndef MULTI_LAUNCH
#define MULTI_LAUNCH 0
#endif

constexpr int NB = 16, SQ = 2048, DM = 1024, TT = NB * SQ, MW = 512, NL = 4;
constexpr int NT = 256;
constexpr int PRW_LD = 1792, PREST_LD = 5248;
constexpr int LRU_O = 1664, HG_O = 2688;
constexpr int GATE_ROW0 = 7040;
constexpr int DFF = 2816;
constexpr int LDS_BYTES = 73728;

constexpr size_t WT_WIN = 0;
constexpr size_t WT_WB = WT_WIN + (size_t)11136 * 1024 * 2;
constexpr size_t WT_WOUT = WT_WB + (size_t)4 * 1024 * 512 * 2;
constexpr size_t WT_WUP = WT_WOUT + (size_t)1024 * 1024 * 2;
constexpr size_t WT_WDN = WT_WUP + (size_t)5632 * 1024 * 2;
constexpr size_t WT_G2 = WT_WDN + (size_t)1024 * 2816 * 2;
constexpr size_t WT_W2 = WT_G2 + (size_t)512 * 128 * 2;
constexpr size_t WT_A2 = WT_W2 + (size_t)2 * 512 * 64 * 2;
constexpr size_t WT_LRU = WT_A2 + (size_t)2 * 512 * 64 * 2;
constexpr size_t WT_END = WT_LRU + (size_t)2 * 2 * 8 * 64 * 64 * 2;
constexpr size_t OFF_PRW = (size_t)48 << 20;
static_assert(WT_END <= OFF_PRW, "wt");
constexpr size_t OFF_PREST = OFF_PRW + (size_t)TT * PRW_LD * 2;
constexpr size_t OFF_Y = OFF_PREST + (size_t)TT * PREST_LD * 2;
constexpr size_t YSZ = (size_t)TT * 512 * 2;
constexpr size_t OFF_YB = OFF_Y, OFF_YC = OFF_Y + YSZ, OFF_YD = OFF_Y + 2 * YSZ, OFF_Y0 = OFF_Y + 3 * YSZ, OFF_Y1 = OFF_Y + 4 * YSZ;
constexpr size_t OFF_SMALL = OFF_Y + 5 * YSZ;
constexpr size_t OFF_MOD = OFF_SMALL;
constexpr size_t OFF_LB = OFF_MOD + (size_t)4 * 16 * 6144 * 4;
constexpr size_t OFF_BETA = OFF_LB + (size_t)4 * 2 * 512 * 4;
constexpr size_t OFF_BAR = OFF_BETA + (size_t)2 * TT * 8 * 4;
constexpr size_t BAR_BYTES = 16384;
constexpr size_t WS_NEED = OFF_BAR + BAR_BYTES;
constexpr size_t OFF_U = OFF_Y;
constexpr size_t OFF_URE = OFF_PREST;
constexpr size_t OFF_MERGED = OFF_PREST + (size_t)TT * 1024 * 2;
constexpr size_t OFF_U2 = OFF_Y;
constexpr size_t OFF_Z = OFF_PRW;
constexpr size_t OFF_ACT = OFF_PRW + (size_t)TT * 5632 * 2;
static_assert(OFF_ACT + (size_t)TT * 2816 * 2 <= OFF_SMALL, "act");

enum { I_X = 0, I_C, I_ADAW, I_ADAB, I_N1G, I_WIN, I_MU, I_W0, I_W2, I_A0, I_A2, I_G2, I_KK, I_KA, I_RK, I_LNW, I_LNB,
       I_MLIB, I_MLFB, I_MLN, I_LCW, I_LCB, I_LWA, I_LBA, I_LWX, I_LBX, I_LLAM, I_HGLB, I_HGN, I_WBR, I_WOUT, I_N2G,
       I_FUP, I_FCW, I_FCB, I_FDN, I_FING, N_INPUTS };

struct Params { const float* in[N_INPUTS]; float* out; char* ws; };

__device__ __forceinline__ int tid_() { int x = threadIdx.x; asm volatile("" : "+v"(x)); return x; }
__device__ __forceinline__ int bid_() { int x = blockIdx.x; asm volatile("" : "+s"(x)); return x; }
__device__ __forceinline__ bf16_t f2bf(float f) { const __bf16 h = (__bf16)f; return __builtin_bit_cast(unsigned short, h); }
__device__ __forceinline__ float bf2f(bf16_t h) { return __uint_as_float(((unsigned)h) << 16); }
typedef __bf16 bf16x2n __attribute__((ext_vector_type(2)));
typedef float f32x2n __attribute__((ext_vector_type(2)));
__device__ __forceinline__ unsigned pack2(float a, float b) { const f32x2n v = {a, b}; const bf16x2n h = __builtin_convertvector(v, bf16x2n); return __builtin_bit_cast(unsigned, h); }
__device__ __forceinline__ float lo2f(unsigned u) { return __uint_as_float(u << 16); }
__device__ __forceinline__ float hi2f(unsigned u) { return __uint_as_float(u & 0xffff0000u); }
__device__ __forceinline__ float rcpf_(float x) { return __builtin_amdgcn_rcpf(x); }
__device__ __forceinline__ float flog_(float x) { return __builtin_amdgcn_logf(x) * 0.69314718056f; }
__device__ __forceinline__ float sigm(float x) { return rcpf_(1.f + __expf(-x)); }
__device__ __forceinline__ float silu(float x) { return x * sigm(x); }
__device__ __forceinline__ float logsig(float x) { return fminf(x, 0.f) - flog_(1.f + __expf(-fabsf(x))); }
__device__ __forceinline__ float tanh_f(float x) { return 1.f - 2.f * rcpf_(1.f + __expf(2.f * x)); }
__device__ __forceinline__ float gelu_t(float x) { return 0.5f * x * (1.f + tanh_f(0.7978845608f * (x + 0.044715f * x * x * x))); }
template <int CTRL> __device__ __forceinline__ float dppf(float x) { return __int_as_float(__builtin_amdgcn_update_dpp(0, __float_as_int(x), CTRL, 0xF, 0xF, false)); }
__device__ __forceinline__ float rowsum16(float x) { x += dppf<0x128>(x); x += dppf<0x124>(x); x += dppf<0x122>(x); x += dppf<0x121>(x); return x; }
__device__ __forceinline__ float rdlane(float x, int l) { return __int_as_float(__builtin_amdgcn_readlane(__float_as_int(x), l)); }
__device__ __forceinline__ float wsum64(float x) { x = rowsum16(x); return (rdlane(x, 0) + rdlane(x, 16)) + (rdlane(x, 32) + rdlane(x, 48)); }
__device__ __forceinline__ float bperm(float x, int srclane) { return __int_as_float(__builtin_amdgcn_ds_bpermute(srclane << 2, __float_as_int(x))); }
__device__ __forceinline__ float qsum(float x, int lane) { x += bperm(x, lane ^ 16); x += bperm(x, lane ^ 32); return x; }
__device__ __forceinline__ void unpack8(u32x4 v, float (&f)[8]) {
    f[0] = lo2f(v.x); f[1] = hi2f(v.x); f[2] = lo2f(v.y); f[3] = hi2f(v.y); f[4] = lo2f(v.z); f[5] = hi2f(v.z); f[6] = lo2f(v.w); f[7] = hi2f(v.w); }
__device__ __forceinline__ void unpack4(u32x2 v, float (&f)[4]) { f[0] = lo2f(v.x); f[1] = hi2f(v.x); f[2] = lo2f(v.y); f[3] = hi2f(v.y); }
__device__ __forceinline__ f32x4 mfma16(bf16x8 a, bf16x8 b, f32x4 c) { return __builtin_amdgcn_mfma_f32_16x16x32_bf16(a, b, c, 0, 0, 0); }
__device__ __forceinline__ bf16x8 ldfrag(const bf16_t* p) { return *reinterpret_cast<const bf16x8*>(p); }

__device__ __forceinline__ void gemm_stage(const bf16_t* __restrict__ A, long lda, const bf16_t* __restrict__ Bt, long ldb, int kt, char* buf, int tid) {
#pragma unroll
    for (int i = 0; i < 4; ++i) {
        const int b = tid * 16 + i * 4096, r = b >> 7, c = ((b & 127) >> 4) ^ (r & 7);
        __builtin_amdgcn_global_load_lds((const unsigned*)(A + (long)r * lda + kt * 64 + c * 8), (__attribute__((address_space(3))) unsigned*)(buf + b), 16, 0, 0);
        __builtin_amdgcn_global_load_lds((const unsigned*)(Bt + (long)r * ldb + kt * 64 + c * 8), (__attribute__((address_space(3))) unsigned*)(buf + 16384 + b), 16, 0, 0);
    }
}
__device__ __forceinline__ void gemm_acc(const bf16_t* __restrict__ A, long lda, const bf16_t* __restrict__ Bt, long ldb, int K, f32x4 (&acc)[4][4], char* lds) {
    const int tid = tid_(), wid = tid >> 6, lane = tid & 63, wr = wid >> 1, wc = wid & 1, fr = lane & 15, fq = lane >> 4;
    const int nk = K >> 6;
    gemm_stage(A, lda, Bt, ldb, 0, lds, tid);
    asm volatile("s_waitcnt vmcnt(0)" ::: "memory");
    __syncthreads();
    for (int kt = 0; kt < nk; ++kt) {
        char* cur = lds + (kt & 1) * 32768;
        if (kt + 1 < nk) gemm_stage(A, lda, Bt, ldb, kt + 1, lds + ((kt + 1) & 1) * 32768, tid);
#pragma unroll
        for (int ks = 0; ks < 2; ++ks) {
            bf16x8 af[4], bfr[4];
#pragma unroll
            for (int m = 0; m < 4; ++m) { const int row = wr * 64 + m * 16 + fr; af[m] = *reinterpret_cast<const bf16x8*>(cur + row * 128 + (((ks * 4 + fq) ^ (row & 7)) << 4)); }
#pragma unroll
            for (int n = 0; n < 4; ++n) { const int row = wc * 64 + n * 16 + fr; bfr[n] = *reinterpret_cast<const bf16x8*>(cur + 16384 + row * 128 + (((ks * 4 + fq) ^ (row & 7)) << 4)); }
            __builtin_amdgcn_s_setprio(1);
#pragma unroll
            for (int m = 0; m < 4; ++m)
#pragma unroll
                for (int n = 0; n < 4; ++n) acc[m][n] = mfma16(bfr[n], af[m], acc[m][n]);
            __builtin_amdgcn_s_setprio(0);
        }
        asm volatile("s_waitcnt vmcnt(0)" ::: "memory");
        __syncthreads();
    }
}
__device__ __forceinline__ void gemm2_stage(const bf16_t* __restrict__ A, long lda, const bf16_t* __restrict__ Bt, long ldb, int kt, char* buf, int tid) {
#pragma unroll
    for (int i = 0; i < 4; ++i) {
        const int b = tid * 16 + i * 4096, r = b >> 6, c = ((b & 63) >> 4) ^ ((r >> 2) & 3);
        __builtin_amdgcn_global_load_lds((const unsigned*)(A + (long)r * lda + kt * 32 + c * 8), (__attribute__((address_space(3))) unsigned*)(buf + b), 16, 0, 0);
    }
#pragma unroll
    for (int i = 0; i < 2; ++i) {
        const int b = tid * 16 + i * 4096, r = b >> 6, c = ((b & 63) >> 4) ^ ((r >> 2) & 3);
        __builtin_amdgcn_global_load_lds((const unsigned*)(Bt + (long)r * ldb + kt * 32 + c * 8), (__attribute__((address_space(3))) unsigned*)(buf + 16384 + b), 16, 0, 0);
    }
}
__device__ __forceinline__ void gemm_acc2(const bf16_t* __restrict__ A, long lda, const bf16_t* __restrict__ Bt, long ldb, int K, f32x4 (&acc)[8][4], char* lds) {
    const int tid = tid_(), wid = tid >> 6, lane = tid & 63, wr = wid >> 1, wc = wid & 1, fr = lane & 15, fq = lane >> 4;
    const int nk = K >> 5;
    gemm2_stage(A, lda, Bt, ldb, 0, lds, tid);
    asm volatile("s_waitcnt vmcnt(0)" ::: "memory");
    __syncthreads();
    for (int kt = 0; kt < nk; ++kt) {
        char* cur = lds + (kt & 1) * 24576;
        if (kt + 1 < nk) gemm2_stage(A, lda, Bt, ldb, kt + 1, lds + ((kt + 1) & 1) * 24576, tid);
        bf16x8 bfr[4];
#pragma unroll
        for (int n = 0; n < 4; ++n) { const int row = wc * 64 + n * 16 + fr; bfr[n] = *reinterpret_cast<const bf16x8*>(cur + 16384 + row * 64 + ((fq ^ ((row >> 2) & 3)) << 4)); }
        bf16x8 af[8];
#pragma unroll
        for (int m = 0; m < 8; ++m) { const int row = wr * 128 + m * 16 + fr; af[m] = *reinterpret_cast<const bf16x8*>(cur + row * 64 + ((fq ^ ((row >> 2) & 3)) << 4)); }
        __builtin_amdgcn_s_setprio(1);
#pragma unroll
        for (int m = 0; m < 8; ++m)
#pragma unroll
            for (int n = 0; n < 4; ++n) acc[m][n] = mfma16(bfr[n], af[m], acc[m][n]);
        __builtin_amdgcn_s_setprio(0);
        asm volatile("s_waitcnt vmcnt(0)" ::: "memory");
        __syncthreads();
    }
}
__device__ __forceinline__ void zero_acc2(f32x4 (&acc)[8][4]) {
#pragma unroll
    for (int m = 0; m < 8; ++m)
#pragma unroll
        for (int n = 0; n < 4; ++n) acc[m][n] = (f32x4){0.f, 0.f, 0.f, 0.f};
}
__device__ __forceinline__ void zero_acc(f32x4 (&acc)[4][4]) {
#pragma unroll
    for (int m = 0; m < 4; ++m)
#pragma unroll
        for (int n = 0; n < 4; ++n) acc[m][n] = (f32x4){0.f, 0.f, 0.f, 0.f};
}

__device__ void ph_init(const Params& P, char* lds) {
    const int tid = tid_();
    {
        const f32x4* src = (const f32x4*)P.in[I_X]; f32x4* dst = (f32x4*)P.out;
        const long n4 = (long)TT * DM / 4;
        for (long i = (long)bid_() * NT + tid; i < n4; i += (long)gridDim.x * NT) dst[i] = src[i];
    }
    float* mod = (float*)(P.ws + OFF_MOD);
    float* lbo = (float*)(P.ws + OFF_LB);
    for (int item = bid_(); item < 385; item += gridDim.x) {
        if (item < 384) {
            const int l = item / 96, j0 = (item % 96) * 64;
            const int col = tid & 63, kg = tid >> 6;
            float* CS = (float*)lds;
            float* RED = CS + 4096;
            float acc[16];
#pragma unroll
            for (int b = 0; b < 16; ++b) acc[b] = 0.f;
            const float* Wl = P.in[I_ADAW] + (size_t)l * DM * 6144;
            for (int sub = 0; sub < 4; ++sub) {
                __syncthreads();
                for (int e = tid; e < 4096; e += NT) {
                    const int kk = e & 63, b = (e >> 6) & 15, g = e >> 10;
                    CS[e] = silu(P.in[I_C][b * DM + g * 256 + sub * 64 + kk]);
                }
                __syncthreads();
                for (int kk = 0; kk < 64; ++kk) {
                    const float w = Wl[(size_t)(kg * 256 + sub * 64 + kk) * 6144 + j0 + col];
#pragma unroll
                    for (int b = 0; b < 16; ++b) acc[b] += CS[(kg * 16 + b) * 64 + kk] * w;
                }
            }
#pragma unroll
            for (int b = 0; b < 16; ++b) RED[(kg * 64 + col) * 16 + b] = acc[b];
            __syncthreads();
            {
                const int bg = tid >> 6;
#pragma unroll
                for (int bb = 0; bb < 4; ++bb) {
                    const int b = bg * 4 + bb;
                    float s = RED[(0 * 64 + col) * 16 + b] + RED[(1 * 64 + col) * 16 + b] + RED[(2 * 64 + col) * 16 + b] + RED[(3 * 64 + col) * 16 + b];
                    mod[((size_t)l * 16 + b) * 6144 + j0 + col] = s + P.in[I_ADAB][l * 6144 + j0 + col];
                }
            }
            __syncthreads();
        } else {
            for (int e = tid; e < 1024; e += NT) {
                float x[4], mx = -1e30f;
#pragma unroll
                for (int l = 0; l < 4; ++l) { x[l] = P.in[I_HGLB][l * 1024 + e]; mx = fmaxf(mx, x[l]); }
                float s = 0.f;
#pragma unroll
                for (int l = 0; l < 4; ++l) { x[l] = __expf(x[l] - mx); s += x[l]; }
                const float inv = rcpf_(s);
                float cum = 0.f;
                lbo[0 * 1024 + e] = 0.f;
#pragma unroll
                for (int l = 1; l < 4; ++l) { cum += x[l] * inv; lbo[l * 1024 + e] = fminf(fmaxf(cum, 0.f), 1.f); }
            }
        }
    }
}

__device__ __forceinline__ void tr_tile(const float* __restrict__ src, int ld, int N, int k0, int n0, bf16_t* __restrict__ dst, int dld, int drow0, bool winmap, char* lds) {
    float* Tl = (float*)lds;
    const int tid = tid_();
    __syncthreads();
#pragma unroll
    for (int i = 0; i < 4; ++i) {
        const int kk = (tid >> 4) + 16 * i, nn = (tid & 15) * 4;
        f32x4 v = (f32x4){0.f, 0.f, 0.f, 0.f};
        if (n0 + nn < N) v = *(const f32x4*)(src + (size_t)(k0 + kk) * ld + n0 + nn);
        Tl[kk * 65 + nn] = v[0]; Tl[kk * 65 + nn + 1] = v[1]; Tl[kk * 65 + nn + 2] = v[2]; Tl[kk * 65 + nn + 3] = v[3];
    }
    __syncthreads();
    {
        const int nn = tid >> 2, kb = (tid & 3) * 16;
        if (n0 + nn < N) {
            int drow = drow0 + nn;
            if (winmap) { const int n = n0 + nn; drow = n + (n >= 3344 ? 112 : 0); }
            unsigned w[8];
#pragma unroll
            for (int j = 0; j < 8; ++j) w[j] = pack2(Tl[(kb + 2 * j) * 65 + nn], Tl[(kb + 2 * j + 1) * 65 + nn]);
            u32x4* d = (u32x4*)(dst + (size_t)drow * dld + k0 + kb);
            d[0] = (u32x4){w[0], w[1], w[2], w[3]}; d[1] = (u32x4){w[4], w[5], w[6], w[7]};
        }
    }
}
__device__ void ph_wt(const Params& P, int l, char* lds) {
    char* ws = P.ws;
    const int NI = 2768 + 512 + 256 + 1408 + 704 + 16 + 16 + 16 + 16 + 16 + 7;
    for (int item = bid_(); item < NI; item += gridDim.x) {
        int it = item;
        if (it < 2768) { const int kt = it / 173, nt = it % 173;
            tr_tile(P.in[I_WIN] + (size_t)l * 1024 * 11024, 11024, 11024, kt * 64, nt * 64, (bf16_t*)(ws + WT_WIN), 1024, 0, true, lds); continue; }
        it -= 2768;
        if (it < 512) { const int n = it / 128, r = it % 128, kt = r / 16, nt = r % 16;
            tr_tile(P.in[I_WBR] + ((size_t)l * 4 + n) * 512 * 1024, 1024, 1024, kt * 64, nt * 64, (bf16_t*)(ws + WT_WB) + (size_t)n * 1024 * 512, 512, nt * 64, false, lds); continue; }
        it -= 512;
        if (it < 256) { const int kt = it / 16, nt = it % 16;
            tr_tile(P.in[I_WOUT] + (size_t)l * 1024 * 1024, 1024, 1024, kt * 64, nt * 64, (bf16_t*)(ws + WT_WOUT), 1024, nt * 64, false, lds); continue; }
        it -= 256;
        if (it < 1408) { const int kt = it / 88, nt = it % 88;
            tr_tile(P.in[I_FUP] + (size_t)l * 1024 * 5632, 5632, 5632, kt * 64, nt * 64, (bf16_t*)(ws + WT_WUP), 1024, nt * 64, false, lds); continue; }
        it -= 1408;
        if (it < 704) { const int kt = it / 16, nt = it % 16;
            tr_tile(P.in[I_FDN] + (size_t)l * 2816 * 1024, 1024, 1024, kt * 64, nt * 64, (bf16_t*)(ws + WT_WDN), 2816, nt * 64, false, lds); continue; }
        it -= 704;
        if (it < 16) { const int kt = it / 8, nt = it % 8;
            tr_tile(P.in[I_G2] + (size_t)l * 128 * 512, 512, 512, kt * 64, nt * 64, (bf16_t*)(ws + WT_G2), 128, nt * 64, false, lds); continue; }
        it -= 16;
        if (it < 16) { const int d = it / 8, nt = it % 8;
            tr_tile(P.in[I_W2] + ((size_t)l * 2 + d) * 64 * 512, 512, 512, 0, nt * 64, (bf16_t*)(ws + WT_W2) + (size_t)d * 512 * 64, 64, nt * 64, false, lds); continue; }
        it -= 16;
        if (it < 16) { const int d = it / 8, nt = it % 8;
            tr_tile(P.in[I_A2] + ((size_t)l * 2 + d) * 64 * 512, 512, 512, 0, nt * 64, (bf16_t*)(ws + WT_A2) + (size_t)d * 512 * 64, 64, nt * 64, false, lds); continue; }
        it -= 16;
        if (it < 32) { const int mat = it / 16, d = (it % 16) / 8, g = it % 8;
            const float* src = P.in[mat ? I_LWX : I_LWA] + (((size_t)l * 2 + d) * 8 + g) * 64 * 64;
            tr_tile(src, 64, 64, 0, 0, (bf16_t*)(ws + WT_LRU) + (((size_t)d * 2 + mat) * 8 + g) * 64 * 64, 64, 0, false, lds); continue; }
        it -= 32;
        {
            u32x4* d = (u32x4*)((bf16_t*)(ws + WT_WIN) + (size_t)(3344 + it * 16) * 1024);
            for (int e = tid_(); e < 16 * 1024 / 8; e += NT) d[e] = (u32x4){0u, 0u, 0u, 0u};
        }
    }
}

__device__ void ph_norm(const Params& P, const float* __restrict__ g, const float* __restrict__ modl, int sh_off, int sc_off, bf16_t* __restrict__ dst, bool final_) {
    const int tid = tid_(), wid = tid >> 6, lane = tid & 63;
    for (int item = bid_(); item < TT / 16; item += gridDim.x) {
        const int row0 = item * 16 + wid * 4, b = row0 >> 11;
        f32x4 v[4][4];
#pragma unroll
        for (int r = 0; r < 4; ++r)
#pragma unroll
            for (int i = 0; i < 4; ++i) v[r][i] = *(const f32x4*)(P.out + (size_t)(row0 + r) * DM + i * 256 + lane * 4);
        f32x4 gv[4], sc[4], sh[4];
#pragma unroll
        for (int i = 0; i < 4; ++i) {
            const int c = i * 256 + lane * 4;
            gv[i] = *(const f32x4*)(g + c);
            if (!final_) { sc[i] = *(const f32x4*)(modl + (size_t)b * 6144 + sc_off + c); sh[i] = *(const f32x4*)(modl + (size_t)b * 6144 + sh_off + c); }
        }
#pragma unroll
        for (int r = 0; r < 4; ++r) {
            float ss = 0.f;
#pragma unroll
            for (int i = 0; i < 4; ++i) ss += v[r][i][0] * v[r][i][0] + v[r][i][1] * v[r][i][1] + v[r][i][2] * v[r][i][2] + v[r][i][3] * v[r][i][3];
            ss = wsum64(ss);
            const float rs = rsqrtf(ss * (1.f / DM) + 1e-6f);
            float* hr = P.out + (size_t)(row0 + r) * DM;
#pragma unroll
            for (int i = 0; i < 4; ++i) {
                const int c = i * 256 + lane * 4;
                if (final_) {
                    *(f32x4*)(hr + c) = v[r][i] * rs * gv[i];
                } else {
                    const f32x4 o = v[r][i] * rs * gv[i] * (sc[i] + 1.f) + sh[i];
                    *(u32x2*)(dst + (size_t)(row0 + r) * DM + c) = (u32x2){pack2(o[0], o[1]), pack2(o[2], o[3])};
                }
            }
        }
    }
}

__device__ __forceinline__ void store_tile_bf16(const f32x4 (&acc)[4][4], bf16_t* __restrict__ dst, long ld) {
    const int tid = tid_(), wid = tid >> 6, lane = tid & 63, wr = wid >> 1, wc = wid & 1, fr = lane & 15, fq = lane >> 4;
#pragma unroll
    for (int m = 0; m < 4; ++m)
#pragma unroll
        for (int n = 0; n < 4; ++n) {
            const f32x4 v = acc[m][n];
            *(u32x2*)(dst + (long)(wr * 64 + m * 16 + fr) * ld + wc * 64 + n * 16 + fq * 4) = (u32x2){pack2(v[0], v[1]), pack2(v[2], v[3])};
        }
}
__device__ __forceinline__ void resid_tile(const f32x4 (&acc)[4][4], float* __restrict__ h, int row0, int col0, const float* __restrict__ gate) {
    const int tid = tid_(), wid = tid >> 6, lane = tid & 63, wr = wid >> 1, wc = wid & 1, fr = lane & 15, fq = lane >> 4;
    const int b = row0 >> 11;
#pragma unroll
    for (int n = 0; n < 4; ++n) {
        const int col = col0 + wc * 64 + n * 16 + fq * 4;
        const f32x4 gv = *(const f32x4*)(gate + (size_t)b * 6144 + col);
#pragma unroll
        for (int m = 0; m < 4; ++m) {
            float* hp = h + (size_t)(row0 + wr * 64 + m * 16 + fr) * DM + col;
            const f32x4 o = *(const f32x4*)hp + gv * acc[m][n];
            *(f32x4*)hp = o;
        }
    }
}
__device__ __forceinline__ void store_tile2_bf16(const f32x4 (&acc)[8][4], bf16_t* __restrict__ dst, long ld) {
    const int tid = tid_(), wid = tid >> 6, lane = tid & 63, wr = wid >> 1, wc = wid & 1, fr = lane & 15, fq = lane >> 4;
#pragma unroll
    for (int m = 0; m < 8; ++m)
#pragma unroll
        for (int n = 0; n < 4; ++n) {
            const f32x4 v = acc[m][n];
            *(u32x2*)(dst + (long)(wr * 128 + m * 16 + fr) * ld + wc * 64 + n * 16 + fq * 4) = (u32x2){pack2(v[0], v[1]), pack2(v[2], v[3])};
        }
}
__device__ __forceinline__ void resid_tile2(const f32x4 (&acc)[8][4], float* __restrict__ h, int row0, int col0, const float* __restrict__ gate) {
    const int tid = tid_(), wid = tid >> 6, lane = tid & 63, wr = wid >> 1, wc = wid & 1, fr = lane & 15, fq = lane >> 4;
    const int b = row0 >> 11;
#pragma unroll
    for (int n = 0; n < 4; ++n) {
        const int col = col0 + wc * 64 + n * 16 + fq * 4;
        const f32x4 gv = *(const f32x4*)(gate + (size_t)b * 6144 + col);
#pragma unroll
        for (int m = 0; m < 8; ++m) {
            float* hp = h + (size_t)(row0 + wr * 128 + m * 16 + fr) * DM + col;
            const f32x4 o = *(const f32x4*)hp + gv * acc[m][n];
            *(f32x4*)hp = o;
        }
    }
}
__device__ void ph_gemm_p(const Params& P, char* lds) {
    const bf16_t* U = (const bf16_t*)(P.ws + OFF_U); const bf16_t* Wt = (const bf16_t*)(P.ws + WT_WIN);
    bf16_t* prw = (bf16_t*)(P.ws + OFF_PRW); bf16_t* prest = (bf16_t*)(P.ws + OFF_PREST);
    for (int item = bid_(); item < 128 * 55; item += gridDim.x) {
        const int mt = item / 55, nt = item % 55;
        f32x4 acc[8][4]; zero_acc2(acc);
        gemm_acc2(U + (size_t)mt * 256 * DM, DM, Wt + (size_t)nt * 128 * DM, DM, DM, acc, lds);
        if (nt < 14) store_tile2_bf16(acc, prw + (size_t)mt * 256 * PRW_LD + nt * 128, PRW_LD);
        else store_tile2_bf16(acc, prest + (size_t)mt * 256 * PREST_LD + (nt - 14) * 128, PREST_LD);
    }
}
__device__ void ph_gemm_merge(const Params& P, char* lds) {
    const bf16_t* U = (const bf16_t*)(P.ws + OFF_URE); const bf16_t* Wt = (const bf16_t*)(P.ws + WT_WIN); const bf16_t* Wb = (const bf16_t*)(P.ws + WT_WB);
    bf16_t* mg = (bf16_t*)(P.ws + OFF_MERGED);
    for (int item = bid_(); item < 256 * 8; item += gridDim.x) {
        const int mt = item / 8, nt = item % 8;
        unsigned mpk[4][4][2];
#pragma unroll
        for (int m = 0; m < 4; ++m)
#pragma unroll
            for (int q = 0; q < 4; ++q) { mpk[m][q][0] = 0u; mpk[m][q][1] = 0u; }
#pragma unroll 1
        for (int n = 0; n < 4; ++n) {
            unsigned gpk[4][4][2];
            {
                f32x4 acc[4][4]; zero_acc(acc);
                gemm_acc(U + (size_t)mt * 128 * DM, DM, Wt + (size_t)(GATE_ROW0 + n * 1024 + nt * 128) * DM, DM, DM, acc, lds);
#pragma unroll
                for (int m = 0; m < 4; ++m)
#pragma unroll
                    for (int q = 0; q < 4; ++q) { gpk[m][q][0] = pack2(sigm(acc[m][q][0]), sigm(acc[m][q][1])); gpk[m][q][1] = pack2(sigm(acc[m][q][2]), sigm(acc[m][q][3])); }
            }
            const size_t yoff = (n == 0) ? OFF_Y0 : (n == 1 ? OFF_YB : (n == 2 ? OFF_YC : OFF_YD));
            const bf16_t* Y = (const bf16_t*)(P.ws + yoff);
            f32x4 acc[4][4]; zero_acc(acc);
            gemm_acc(Y + (size_t)mt * 128 * 512, 512, Wb + ((size_t)n * 1024 + nt * 128) * 512, 512, 512, acc, lds);
#pragma unroll
            for (int m = 0; m < 4; ++m)
#pragma unroll
                for (int q = 0; q < 4; ++q) {
                    mpk[m][q][0] = pack2(lo2f(mpk[m][q][0]) + lo2f(gpk[m][q][0]) * acc[m][q][0], hi2f(mpk[m][q][0]) + hi2f(gpk[m][q][0]) * acc[m][q][1]);
                    mpk[m][q][1] = pack2(lo2f(mpk[m][q][1]) + lo2f(gpk[m][q][1]) * acc[m][q][2], hi2f(mpk[m][q][1]) + hi2f(gpk[m][q][1]) * acc[m][q][3]);
                }
        }
        {
            const int tid = tid_(), wid = tid >> 6, lane = tid & 63, wr = wid >> 1, wc = wid & 1, fr = lane & 15, fq = lane >> 4;
            bf16_t* dst = mg + (size_t)mt * 128 * DM + nt * 128;
#pragma unroll
            for (int m = 0; m < 4; ++m)
#pragma unroll
                for (int q = 0; q < 4; ++q) *(u32x2*)(dst + (long)(wr * 64 + m * 16 + fr) * DM + wc * 64 + q * 16 + fq * 4) = (u32x2){mpk[m][q][0], mpk[m][q][1]};
        }
    }
}
__device__ void ph_gemm_out(const Params& P, int l, char* lds) {
    const bf16_t* A = (const bf16_t*)(P.ws + OFF_MERGED); const bf16_t* Wt = (const bf16_t*)(P.ws + WT_WOUT);
    const float* gate = (const float*)(P.ws + OFF_MOD) + (size_t)l * 16 * 6144 + 2048;
    for (int item = bid_(); item < 256 * 8; item += gridDim.x) {
        const int mt = item / 8, nt = item % 8;
        f32x4 acc[4][4]; zero_acc(acc);
        gemm_acc(A + (size_t)mt * 128 * DM, DM, Wt + (size_t)nt * 128 * DM, DM, DM, acc, lds);
        resid_tile(acc, P.out, mt * 128, nt * 128, gate);
    }
}
__device__ void ph_gemm_up(const Params& P, char* lds) {
    const bf16_t* A = (const bf16_t*)(P.ws + OFF_U2); const bf16_t* Wt = (const bf16_t*)(P.ws + WT_WUP);
    bf16_t* Z = (bf16_t*)(P.ws + OFF_Z);
    for (int item = bid_(); item < 128 * 44; item += gridDim.x) {
        const int mt = item / 44, nt = item % 44;
        f32x4 acc[8][4]; zero_acc2(acc);
        gemm_acc2(A + (size_t)mt * 256 * DM, DM, Wt + (size_t)nt * 128 * DM, DM, DM, acc, lds);
        store_tile2_bf16(acc, Z + (size_t)mt * 256 * 5632 + nt * 128, 5632);
    }
}
__device__ void ph_gemm_down(const Params& P, int l, char* lds) {
    const bf16_t* A = (const bf16_t*)(P.ws + OFF_ACT); const bf16_t* Wt = (const bf16_t*)(P.ws + WT_WDN);
    const float* gate = (const float*)(P.ws + OFF_MOD) + (size_t)l * 16 * 6144 + 5120;
    for (int item = bid_(); item < 128 * 8; item += gridDim.x) {
        const int mt = item / 8, nt = item % 8;
        f32x4 acc[8][4]; zero_acc2(acc);
        gemm_acc2(A + (size_t)mt * 256 * DFF, DFF, Wt + (size_t)nt * 128 * DFF, DFF, DFF, acc, lds);
        resid_tile2(acc, P.out, mt * 256, nt * 128, gate);
    }
}
__device__ void ph_convact(const Params& P, int l) {
    const bf16_t* Z = (const bf16_t*)(P.ws + OFF_Z); bf16_t* ACT = (bf16_t*)(P.ws + OFF_ACT);
    const float* cw = P.in[I_FCW] + (size_t)l * 3 * 5632; const float* cb = P.in[I_FCB] + (size_t)l * 5632;
    const long ntask = (long)(TT / 64) * 352;
    for (long task = (long)bid_() * NT + tid_(); task < ntask; task += (long)gridDim.x * NT) {
        const int tile = (int)(task / 352), cgp = (int)(task % 352), c0 = cgp * 8;
        const int t0 = tile * 64, s0 = t0 & (SQ - 1);
        float wv[3][8], wg[3][8], bv[8], bg[8];
#pragma unroll
        for (int j = 0; j < 3; ++j)
#pragma unroll
            for (int e = 0; e < 8; ++e) { wv[j][e] = cw[j * 5632 + c0 + e]; wg[j][e] = cw[j * 5632 + DFF + c0 + e]; }
#pragma unroll
        for (int e = 0; e < 8; ++e) { bv[e] = cb[c0 + e]; bg[e] = cb[DFF + c0 + e]; }
        float pv[8], pg[8], cv[8], cg_[8], nv[8], ng[8];
        const u32x4 zero4 = (u32x4){0u, 0u, 0u, 0u};
        {
            u32x4 a = zero4, b = zero4;
            if (s0 > 0) { a = __builtin_nontemporal_load((const u32x4*)(Z + (size_t)(t0 - 1) * 5632 + c0)); b = __builtin_nontemporal_load((const u32x4*)(Z + (size_t)(t0 - 1) * 5632 + DFF + c0)); }
            unpack8(a, pv); unpack8(b, pg);
            a = __builtin_nontemporal_load((const u32x4*)(Z + (size_t)t0 * 5632 + c0)); b = __builtin_nontemporal_load((const u32x4*)(Z + (size_t)t0 * 5632 + DFF + c0));
            unpack8(a, cv); unpack8(b, cg_);
        }
#pragma unroll 8
        for (int r = 0; r < 64; ++r) {
            const int t = t0 + r;
            u32x4 a = zero4, b = zero4;
            if (s0 + r + 1 < SQ) { a = __builtin_nontemporal_load((const u32x4*)(Z + (size_t)(t + 1) * 5632 + c0)); b = __builtin_nontemporal_load((const u32x4*)(Z + (size_t)(t + 1) * 5632 + DFF + c0)); }
            unpack8(a, nv); unpack8(b, ng);
            float o[8];
#pragma unroll
            for (int e = 0; e < 8; ++e) {
                const float v = wv[0][e] * pv[e] + wv[1][e] * cv[e] + wv[2][e] * nv[e] + bv[e];
                const float g = wg[0][e] * pg[e] + wg[1][e] * cg_[e] + wg[2][e] * ng[e] + bg[e];
                o[e] = v * silu(g);
                pv[e] = cv[e]; cv[e] = nv[e]; pg[e] = cg_[e]; cg_[e] = ng[e];
            }
            *(u32x4*)(ACT + (size_t)t * DFF + c0) = (u32x4){pack2(o[0], o[1]), pack2(o[2], o[3]), pack2(o[4], o[5]), pack2(o[6], o[7])};
        }
    }
}

__device__ void mx_rwkv(const Params& P, int l, int item, char* lds) {
    const int tid = tid_(), wid = tid >> 6, lane = tid & 63, fr = lane & 15, fq = lane >> 4;
    const int d = item & 1, h = (item >> 1) & 7, b = item >> 4;
    const bf16_t* prw = (const bf16_t*)(P.ws + OFF_PRW) + (size_t)b * SQ * PRW_LD;
    bf16_t* Yd = (bf16_t*)(P.ws + (d ? OFF_Y1 : OFF_Y0)) + (size_t)b * SQ * 512 + h * 64;
    float* beta = (float*)(P.ws + OFF_BETA) + ((size_t)d * TT + (size_t)b * SQ) * 8 + h;
    float* VA = (float*)lds; float* VWR = VA + 1024; float* VW = VWR + 1024; float* VB = VW + 1024; float* VK = VB + 1024; float* VV = VK + 1024; float* VG = VV + 1024;
    float* SC = VG + 1024;
    bf16_t* RAW = (bf16_t*)(SC + 32);
    bf16_t* AT = RAW + 18 * 320;
    const int s = tid >> 4, jg = tid & 15, j0 = jg * 4;
    float mu[5][4], kkc[4], kac[4], rkc[4];
#pragma unroll
    for (int sg = 0; sg < 5; ++sg) {
        const int base = (sg < 3) ? sg * 512 + h * 64 : 1536 + (sg - 3) * 64;
#pragma unroll
        for (int i = 0; i < 4; ++i) mu[sg][i] = P.in[I_MU][l * 1792 + base + j0 + i];
    }
#pragma unroll
    for (int i = 0; i < 4; ++i) { kkc[i] = P.in[I_KK][l * 512 + h * 64 + j0 + i]; kac[i] = P.in[I_KA][l * 512 + h * 64 + j0 + i]; rkc[i] = P.in[I_RK][l * 512 + h * 64 + j0 + i]; }
    const int mt = wid >> 1, ntb = (wid & 1) * 2;
    bf16x8 bw[2][2]; float bsv[2][4];
    {
        const bf16_t* WT2 = (const bf16_t*)(P.ws + (mt ? WT_A2 : WT_W2)) + (size_t)d * 512 * 64;
        const float* bias = P.in[mt ? I_A0 : I_W0] + (size_t)(l * 2 + d) * 512 + h * 64;
#pragma unroll
        for (int nt = 0; nt < 2; ++nt) {
#pragma unroll
            for (int ks = 0; ks < 2; ++ks) bw[nt][ks] = ldfrag(WT2 + (size_t)(h * 64 + (ntb + nt) * 16 + fr) * 64 + ks * 32 + fq * 8);
#pragma unroll
            for (int jj = 0; jj < 4; ++jj) bsv[nt][jj] = bias[(ntb + nt) * 16 + fq * 4 + jj];
        }
    }
    float S[4][4];
#pragma unroll
    for (int i = 0; i < 4; ++i)
#pragma unroll
        for (int j = 0; j < 4; ++j) S[i][j] = 0.f;
    u32x4 pre[3];
    auto load_raw = [&](int c) {
        const int t0 = d ? SQ - 16 * (c + 1) : 16 * c;
#pragma unroll
        for (int i = 0; i < 3; ++i) {
            const int vi = tid + 256 * i;
            pre[i] = (u32x4){0u, 0u, 0u, 0u};
            if (vi < 720) {
                const int rr = vi / 40, rem = vi % 40, sg = rem >> 3, e = rem & 7, t = t0 - 1 + rr;
                const int col = ((sg < 3) ? sg * 512 + h * 64 : 1536 + (sg - 3) * 64) + e * 8;
                if (t >= 0 && t < SQ) pre[i] = *(const u32x4*)(prw + (size_t)t * PRW_LD + col);
            }
        }
    };
    __syncthreads();
    load_raw(0);
#pragma unroll 1
    for (int c = 0; c < 128; ++c) {
        const int t0 = d ? SQ - 16 * (c + 1) : 16 * c;
#pragma unroll
        for (int i = 0; i < 3; ++i) {
            const int vi = tid + 256 * i;
            if (vi < 720) { const int rr = vi / 40, rem = vi % 40; *(u32x4*)(RAW + rr * 320 + rem * 8) = pre[i]; }
        }
        __syncthreads();
        if (c + 1 < 128) load_raw(c + 1);
        float rs[4], ks_[4], vs[4], kk[4];
        {
            float sh[5][4];
#pragma unroll
            for (int sg = 0; sg < 5; ++sg) {
                float fm[4], f0[4], fp[4];
                unpack4(*(const u32x2*)(RAW + s * 320 + sg * 64 + j0), fm);
                unpack4(*(const u32x2*)(RAW + (s + 1) * 320 + sg * 64 + j0), f0);
                unpack4(*(const u32x2*)(RAW + (s + 2) * 320 + sg * 64 + j0), fp);
#pragma unroll
                for (int i = 0; i < 4; ++i) sh[sg][i] = f0[i] + mu[sg][i] * (0.5f * (fm[i] + fp[i]) - f0[i]);
            }
            float ssq = 0.f, q[4];
#pragma unroll
            for (int i = 0; i < 4; ++i) { rs[i] = sh[0][i]; ks_[i] = sh[1][i]; vs[i] = sh[2][i]; q[i] = ks_[i] * kkc[i]; ssq += q[i] * q[i]; }
            *(u32x2*)(AT + s * 72 + j0) = (u32x2){pack2(tanh_f(sh[3][0]), tanh_f(sh[3][1])), pack2(tanh_f(sh[3][2]), tanh_f(sh[3][3]))};
            *(u32x2*)(AT + 16 * 72 + s * 72 + j0) = (u32x2){pack2(sh[4][0], sh[4][1]), pack2(sh[4][2], sh[4][3])};
            ssq = rowsum16(ssq);
            const float inv = __builtin_amdgcn_rsqf(fmaxf(ssq, 1e-24f));
#pragma unroll
            for (int i = 0; i < 4; ++i) kk[i] = q[i] * inv;
        }
        __syncthreads();
        {
            const bf16_t* At = AT + mt * 16 * 72;
            const bf16x8 a0 = ldfrag(At + fr * 72 + fq * 8), a1 = ldfrag(At + fr * 72 + 32 + fq * 8);
            float* dstv = mt ? VG : VW;
#pragma unroll
            for (int nt = 0; nt < 2; ++nt) {
                f32x4 acc = (f32x4){0.f, 0.f, 0.f, 0.f};
                acc = mfma16(bw[nt][0], a0, acc); acc = mfma16(bw[nt][1], a1, acc);
                f32x4 o;
#pragma unroll
                for (int jj = 0; jj < 4; ++jj) {
                    const float x = acc[jj] + bsv[nt][jj];
                    if (mt == 0) { const float wl = fminf(x, 0.f) - flog_(1.f + __expf(-fabsf(x))) - 0.5f; o[jj] = __expf(-__expf(wl)); }
                    else o[jj] = sigm(x);
                }
                *(f32x4*)(dstv + fr * 64 + (ntb + nt) * 16 + fq * 4) = o;
            }
        }
        __syncthreads();
        {
            const f32x4 w4 = *(const f32x4*)(VW + s * 64 + j0), g4 = *(const f32x4*)(VG + s * 64 + j0);
            f32x4 bb, kt, wr, na, vv;
            float pbr = 0.f, pkr = 0.f, pbe = 0.f;
#pragma unroll
            for (int i = 0; i < 4; ++i) {
                bb[i] = kk[i] * g4[i]; kt[i] = ks_[i] * (1.f + (g4[i] - 1.f) * kac[i]); wr[i] = w4[i] * rs[i]; na[i] = -kk[i]; vv[i] = vs[i];
                pbr += bb[i] * rs[i]; pkr += kt[i] * rs[i]; pbe += rs[i] * kt[i] * rkc[i];
            }
            pbr = rowsum16(pbr); pkr = rowsum16(pkr); pbe = rowsum16(pbe);
            *(f32x4*)(VA + s * 64 + j0) = na; *(f32x4*)(VWR + s * 64 + j0) = wr; *(f32x4*)(VB + s * 64 + j0) = bb; *(f32x4*)(VK + s * 64 + j0) = kt; *(f32x4*)(VV + s * 64 + j0) = vv;
            if (jg == 0) { SC[s * 2] = pbr; SC[s * 2 + 1] = pkr; beta[(size_t)(t0 + s) * 8] = pbe; }
        }
        __syncthreads();
#pragma unroll 1
        for (int st = 0; st < 16; ++st) {
            const int sp = d ? 15 - st : st;
            const f32x4 a4 = *(const f32x4*)(VA + sp * 64 + j0), wr4 = *(const f32x4*)(VWR + sp * 64 + j0), w4 = *(const f32x4*)(VW + sp * 64 + j0);
            const f32x4 b4 = *(const f32x4*)(VB + sp * 64 + j0), k4 = *(const f32x4*)(VK + sp * 64 + j0), v4 = *(const f32x4*)(VV + sp * 64 + s * 4);
            const float br = SC[sp * 2], kr = SC[sp * 2 + 1];
            float psa[4], py[4];
            typedef float f32x2 __attribute__((ext_vector_type(2)));
            const f32x2 a01 = {a4[0], a4[1]}, a23 = {a4[2], a4[3]}, r01 = {wr4[0], wr4[1]}, r23 = {wr4[2], wr4[3]};
#pragma unroll
            for (int i = 0; i < 4; ++i) {
                const f32x2 s01 = {S[i][0], S[i][1]}, s23 = {S[i][2], S[i][3]};
                f32x2 ta = s01 * a01; ta = s23 * a23 + ta;
                f32x2 ty = s01 * r01; ty = s23 * r23 + ty;
                psa[i] = ta.x + ta.y; py[i] = ty.x + ty.y;
            }
#define RS8(CTRL) asm volatile("s_nop 1\n\tv_add_f32_dpp %0, %0, %0 " CTRL " row_mask:0xf bank_mask:0xf\n\tv_add_f32_dpp %1, %1, %1 " CTRL " row_mask:0xf bank_mask:0xf\n\tv_add_f32_dpp %2, %2, %2 " CTRL " row_mask:0xf bank_mask:0xf\n\tv_add_f32_dpp %3, %3, %3 " CTRL " row_mask:0xf bank_mask:0xf\n\tv_add_f32_dpp %4, %4, %4 " CTRL " row_mask:0xf bank_mask:0xf\n\tv_add_f32_dpp %5, %5, %5 " CTRL " row_mask:0xf bank_mask:0xf\n\tv_add_f32_dpp %6, %6, %6 " CTRL " row_mask:0xf bank_mask:0xf\n\tv_add_f32_dpp %7, %7, %7 " CTRL " row_mask:0xf bank_mask:0xf" : "+v"(psa[0]), "+v"(psa[1]), "+v"(psa[2]), "+v"(psa[3]), "+v"(py[0]), "+v"(py[1]), "+v"(py[2]), "+v"(py[3]))
            RS8("row_ror:8"); RS8("row_ror:4"); RS8("row_ror:2"); RS8("row_ror:1");
            asm volatile("s_nop 1" ::: "memory");
            float y[4];
#pragma unroll
            for (int i = 0; i < 4; ++i) {
                y[i] = py[i] + psa[i] * br + v4[i] * kr;
#pragma unroll
                for (int j = 0; j < 4; ++j) S[i][j] = S[i][j] * w4[j] + (psa[i] * b4[j] + v4[i] * k4[j]);
            }
            if (jg == 0) *(u32x2*)(Yd + (size_t)(t0 + sp) * 512 + s * 4) = (u32x2){pack2(y[0], y[1]), pack2(y[2], y[3])};
        }
    }
    __syncthreads();
}

__device__ void mx_mlstm(const Params& P, int l, int item, char* lds) {
    const int tid = tid_(), wid = tid >> 6, lane = tid & 63, fr = lane & 15, fq = lane >> 4;
    const int b = item >> 3, h = (item >> 1) & 3, dsel = item & 1;
    const bf16_t* pr = (const bf16_t*)(P.ws + OFF_PREST) + (size_t)b * SQ * PREST_LD;
    bf16_t* YB = (bf16_t*)(P.ws + (dsel ? OFF_YB : OFF_Y1)) + (size_t)b * SQ * 512 + h * 128;
    bf16_t* Q = (bf16_t*)lds; bf16_t* KP = Q + 64 * 72; bf16_t* KWT = KP + 64 * 72; bf16_t* VT = KWT + 64 * 72; bf16_t* CT = VT + 128 * 72;
    float* NS = (float*)(CT + 128 * 72); float* E = NS + 64; float* MM = E + 64; float* SI = MM + 64; float* WI = SI + 64; float* FL = WI + 64; float* DEC = FL + 64;
    const int i = wid * 16 + fr;
#pragma unroll 1
    for (int d = dsel; d <= dsel; ++d) {
        f32x4 Cacc[8];
#pragma unroll
        for (int dt = 0; dt < 8; ++dt) Cacc[dt] = (f32x4){0.f, 0.f, 0.f, 0.f};
        __syncthreads();
        for (int e = tid; e < 128 * 72 / 2; e += NT) ((unsigned*)CT)[e] = 0u;
        if (tid < 64) NS[tid] = 0.f;
        float m_st = 0.f;
        const float ib = P.in[I_MLIB][(l * 2 + d) * 4 + h], fb = P.in[I_MLFB][(l * 2 + d) * 4 + h];
        __syncthreads();
#pragma unroll 1
        for (int c = 0; c < 32; ++c) {
            const int t0 = d ? SQ - 64 * (c + 1) : 64 * c;
#define TROW(ii) (d ? t0 + 63 - (ii) : t0 + (ii))
            if (wid == 0) {
                const int t = TROW(lane);
                const float fg = bf2f(pr[(size_t)t * PREST_LD + 1544 + d * 4 + h]) + fb, ig = bf2f(pr[(size_t)t * PREST_LD + 1536 + d * 4 + h]) + ib;
                float bc = logsig(fg);
#pragma unroll
                for (int o = 1; o < 64; o <<= 1) { const float x = bperm(bc, lane - o); if (lane >= o) bc += x; }
                const float e = ig - bc; float pm = e;
#pragma unroll
                for (int o = 1; o < 64; o <<= 1) { const float x = bperm(pm, lane - o); if (lane >= o) pm = fmaxf(pm, x); }
                const float gend = rdlane(bc, 63), pmax = rdlane(pm, 63);
                const float mnew = fmaxf(gend + m_st, gend + pmax);
                const float M = fmaxf(m_st, pm);
                E[lane] = e; MM[lane] = M; SI[lane] = __expf(m_st - M); WI[lane] = __expf(gend + e - mnew); FL[lane] = __expf(-(bc + M));
                if (lane == 0) DEC[0] = __expf(gend + m_st - mnew);
                m_st = mnew;
            }
            __syncthreads();
#pragma unroll
            for (int it = 0; it < 2; ++it) {
                const int vi = tid + 256 * it, ii = vi >> 3, e = vi & 7, t = TROW(ii);
                float f[8];
                unpack8(*(const u32x4*)(pr + (size_t)t * PREST_LD + h * 64 + e * 8), f);
                *(u32x4*)(Q + ii * 72 + e * 8) = (u32x4){pack2(f[0] * 0.125f, f[1] * 0.125f), pack2(f[2] * 0.125f, f[3] * 0.125f), pack2(f[4] * 0.125f, f[5] * 0.125f), pack2(f[6] * 0.125f, f[7] * 0.125f)};
                const u32x4 kv = *(const u32x4*)(pr + (size_t)t * PREST_LD + 256 + h * 64 + e * 8);
                *(u32x4*)(KP + ii * 72 + e * 8) = kv;
                unpack8(kv, f);
                const float wi = WI[ii];
#pragma unroll
                for (int x = 0; x < 8; ++x) KWT[(e * 8 + x) * 72 + ii] = f2bf(f[x] * wi);
            }
#pragma unroll
            for (int it = 0; it < 4; ++it) {
                const int vi = tid + 256 * it, ii = vi >> 4, e = vi & 15, t = TROW(ii);
                const u32x4 vv = *(const u32x4*)(pr + (size_t)t * PREST_LD + 512 + h * 128 + e * 8);
                VT[(e * 8 + 0) * 72 + ii] = (bf16_t)(vv.x & 0xffff); VT[(e * 8 + 1) * 72 + ii] = (bf16_t)(vv.x >> 16);
                VT[(e * 8 + 2) * 72 + ii] = (bf16_t)(vv.y & 0xffff); VT[(e * 8 + 3) * 72 + ii] = (bf16_t)(vv.y >> 16);
                VT[(e * 8 + 4) * 72 + ii] = (bf16_t)(vv.z & 0xffff); VT[(e * 8 + 5) * 72 + ii] = (bf16_t)(vv.z >> 16);
                VT[(e * 8 + 6) * 72 + ii] = (bf16_t)(vv.w & 0xffff); VT[(e * 8 + 7) * 72 + ii] = (bf16_t)(vv.w >> 16);
            }
            __syncthreads();
            f32x4 sacc[4];
#pragma unroll
            for (int st = 0; st < 4; ++st) sacc[st] = (f32x4){0.f, 0.f, 0.f, 0.f};
#pragma unroll
            for (int ks = 0; ks < 2; ++ks) {
                const bf16x8 qf = ldfrag(Q + i * 72 + ks * 32 + fq * 8);
#pragma unroll
                for (int st = 0; st < 4; ++st) sacc[st] = mfma16(ldfrag(KP + (st * 16 + fr) * 72 + ks * 32 + fq * 8), qf, sacc[st]);
            }
            const float Mi = MM[i], si = SI[i];
            float rsum = 0.f; unsigned pwp[4][2];
#pragma unroll
            for (int st = 0; st < 4; ++st) {
                float pw[4];
#pragma unroll
                for (int jj = 0; jj < 4; ++jj) { const int sx = st * 16 + fq * 4 + jj; pw[jj] = (sx <= i) ? __expf(E[sx] - Mi) * sacc[st][jj] : 0.f; rsum += pw[jj]; }
                pwp[st][0] = pack2(pw[0], pw[1]); pwp[st][1] = pack2(pw[2], pw[3]);
            }
            rsum = qsum(rsum, lane);
            float qn = 0.f;
            {
                float f[8];
                unpack8(*(const u32x4*)(Q + i * 72 + fq * 16), f);
#pragma unroll
                for (int x = 0; x < 8; ++x) qn += f[x] * NS[fq * 16 + x];
                unpack8(*(const u32x4*)(Q + i * 72 + fq * 16 + 8), f);
#pragma unroll
                for (int x = 0; x < 8; ++x) qn += f[x] * NS[fq * 16 + 8 + x];
            }
            qn = qsum(qn, lane);
            const float den = si * qn + rsum;
            const float rinv = rcpf_(fmaxf(fabsf(den), FL[i]));
            __syncthreads();
#pragma unroll
            for (int st = 0; st < 4; ++st) *(u32x2*)(KP + i * 72 + st * 16 + fq * 4) = (u32x2){pwp[st][0], pwp[st][1]};
            __syncthreads();
            f32x4 oacc[8];
#pragma unroll
            for (int dt = 0; dt < 8; ++dt) oacc[dt] = (f32x4){0.f, 0.f, 0.f, 0.f};
#pragma unroll
            for (int ks = 0; ks < 2; ++ks) {
                const bf16x8 qf = ldfrag(Q + i * 72 + ks * 32 + fq * 8);
#pragma unroll
                for (int dt = 0; dt < 8; ++dt) oacc[dt] = mfma16(ldfrag(CT + (dt * 16 + fr) * 72 + ks * 32 + fq * 8), qf, oacc[dt]);
            }
#pragma unroll
            for (int dt = 0; dt < 8; ++dt) oacc[dt] *= si;
#pragma unroll
            for (int ks = 0; ks < 2; ++ks) {
                const bf16x8 pf = ldfrag(KP + i * 72 + ks * 32 + fq * 8);
#pragma unroll
                for (int dt = 0; dt < 8; ++dt) oacc[dt] = mfma16(ldfrag(VT + (dt * 16 + fr) * 72 + ks * 32 + fq * 8), pf, oacc[dt]);
            }
            {
                const int t = TROW(i);
                bf16_t* yp = YB + (size_t)t * 512 + fq * 4;
                {
#pragma unroll
                    for (int dt = 0; dt < 8; ++dt) { const f32x4 v = oacc[dt] * rinv; *(u32x2*)(yp + dt * 16) = (u32x2){pack2(v[0], v[1]), pack2(v[2], v[3])}; }
                }
            }
            __syncthreads();
            {
                const float dec = DEC[0];
#pragma unroll
                for (int dt = 0; dt < 8; ++dt) Cacc[dt] *= dec;
#pragma unroll
                for (int ks = 0; ks < 2; ++ks) {
                    const bf16x8 kf = ldfrag(KWT + (wid * 16 + fr) * 72 + ks * 32 + fq * 8);
#pragma unroll
                    for (int dt = 0; dt < 8; ++dt) Cacc[dt] = mfma16(kf, ldfrag(VT + (dt * 16 + fr) * 72 + ks * 32 + fq * 8), Cacc[dt]);
                }
#pragma unroll
                for (int dt = 0; dt < 8; ++dt) *(u32x2*)(CT + (dt * 16 + fr) * 72 + wid * 16 + fq * 4) = (u32x2){pack2(Cacc[dt][0], Cacc[dt][1]), pack2(Cacc[dt][2], Cacc[dt][3])};
                if (tid < 64) {
                    float n = dec * NS[tid];
#pragma unroll
                    for (int x = 0; x < 8; ++x) { float f[8]; unpack8(*(const u32x4*)(KWT + tid * 72 + x * 8), f); n += ((f[0] + f[1]) + (f[2] + f[3])) + ((f[4] + f[5]) + (f[6] + f[7])); }
                    NS[tid] = n;
                }
            }
            __syncthreads();
        }
    }
}

__device__ void mx_hgrn(const Params& P, int l, int item, char* lds) {
    const int tid = tid_(), wid = tid >> 6, lane = tid & 63, fr = lane & 15, fq = lane >> 4;
    const int b = item >> 4, h = (item >> 2) & 3, half = (item >> 1) & 1, dsel = item & 1;
    const bf16_t* pr = (const bf16_t*)(P.ws + OFF_PREST) + (size_t)b * SQ * PREST_LD + HG_O;
    bf16_t* YD = (bf16_t*)(P.ws + (dsel ? OFF_YD : OFF_Y0)) + (size_t)b * SQ * 512 + h * 128 + half * 64;
    bf16_t* QT = (bf16_t*)lds; bf16_t* KT = QT + 64 * 136; bf16_t* ATT = KT + 128 * 72; bf16_t* VT = ATT + 64 * 72; bf16_t* ST = VT + 64 * 72;
    float* TOT = (float*)(ST + 64 * 136);
    const int dk = tid & 127, hf = tid >> 7;
    const int i = wid * 16 + fr;
#pragma unroll 1
    for (int d = dsel; d <= dsel; ++d) {
        const float lbv = ((const float*)(P.ws + OFF_LB))[(l * 2 + d) * 512 + h * 128 + dk], oml = 1.f - lbv;
        f32x4 Sacc[2][4];
#pragma unroll
        for (int a = 0; a < 2; ++a)
#pragma unroll
            for (int dt = 0; dt < 4; ++dt) Sacc[a][dt] = (f32x4){0.f, 0.f, 0.f, 0.f};
        __syncthreads();
        for (int e = tid; e < 64 * 136 / 2; e += NT) ((unsigned*)ST)[e] = 0u;
        __syncthreads();
        u32x4 pff[4], pfq[4], pfv[2];
        auto hg_load = [&](int cc) {
            const int t0 = d ? SQ - 64 * (cc + 1) : 64 * cc;
#pragma unroll
            for (int it = 0; it < 4; ++it) {
                const int vi = tid + 256 * it, ii = vi >> 4, e = vi & 15, t = TROW(ii);
                pff[it] = *(const u32x4*)(pr + (size_t)t * PREST_LD + 512 * (1 + d) + h * 128 + e * 8);
                pfq[it] = *(const u32x4*)(pr + (size_t)t * PREST_LD + h * 128 + e * 8);
            }
#pragma unroll
            for (int it = 0; it < 2; ++it) {
                const int vi = tid + 256 * it, ii = vi >> 3, e = vi & 7, t = TROW(ii);
                pfv[it] = *(const u32x4*)(pr + (size_t)t * PREST_LD + 1536 + h * 128 + half * 64 + e * 8);
            }
        };
        hg_load(0);
#pragma unroll 1
        for (int c = 0; c < 32; ++c) {
            const int t0 = d ? SQ - 64 * (c + 1) : 64 * c;
#pragma unroll
            for (int it = 0; it < 4; ++it) {
                const int vi = tid + 256 * it, ii = vi >> 4, e = vi & 15;
                *(u32x4*)(KT + ii * 136 + e * 8) = pff[it];
                *(u32x4*)(QT + ii * 136 + e * 8) = pfq[it];
            }
#pragma unroll
            for (int it = 0; it < 2; ++it) {
                const int vi = tid + 256 * it, ii = vi >> 3, e = vi & 7;
                const u32x4 vv = pfv[it];
                VT[(e * 8 + 0) * 72 + ii] = (bf16_t)(vv.x & 0xffff); VT[(e * 8 + 1) * 72 + ii] = (bf16_t)(vv.x >> 16);
                VT[(e * 8 + 2) * 72 + ii] = (bf16_t)(vv.y & 0xffff); VT[(e * 8 + 3) * 72 + ii] = (bf16_t)(vv.y >> 16);
                VT[(e * 8 + 4) * 72 + ii] = (bf16_t)(vv.z & 0xffff); VT[(e * 8 + 5) * 72 + ii] = (bf16_t)(vv.z >> 16);
                VT[(e * 8 + 6) * 72 + ii] = (bf16_t)(vv.w & 0xffff); VT[(e * 8 + 7) * 72 + ii] = (bf16_t)(vv.w >> 16);
            }
            if (c + 1 < 32) hg_load(c + 1);
            __syncthreads();
            bf16_t* kp = KT + hf * 32 * 136 + dk; bf16_t* qp = QT + hf * 32 * 136 + dk;
            {
                float run = 0.f;
#pragma unroll 8
                for (int r = 0; r < 32; ++r) { const bf16_t fb = f2bf(lbv + oml * sigm(bf2f(kp[r * 136]))); kp[r * 136] = fb; run += flog_(bf2f(fb)); }
                TOT[hf * 128 + dk] = run;
            }
            __syncthreads();
            const float R = TOT[dk], gmR = TOT[128 + dk];
            {
                float g = hf ? R : 0.f;
#pragma unroll 8
                for (int r = 0; r < 32; ++r) {
                    const float fv = bf2f(kp[r * 136]);
                    g += flog_(fv);
                    const float e1 = __expf(fminf(g - R, 80.f));
                    qp[r * 136] = f2bf(silu(bf2f(qp[r * 136])) * e1);
                    kp[r * 136] = f2bf((1.f - fv) * __expf(fminf(R - g, 80.f)));
                }
                const float eR = __expf(R);
                bf16_t* sp = ST + hf * 32 * 136 + dk;
#pragma unroll 8
                for (int r = 0; r < 32; ++r) sp[r * 136] = f2bf(bf2f(sp[r * 136]) * eR);
            }
            __syncthreads();
            f32x4 oacc[4];
            unsigned kw[16];
            {
                f32x4 aacc[4];
#pragma unroll
                for (int st = 0; st < 4; ++st) { aacc[st] = (f32x4){0.f, 0.f, 0.f, 0.f}; oacc[st] = (f32x4){0.f, 0.f, 0.f, 0.f}; }
#pragma unroll
                for (int ks = 0; ks < 4; ++ks) {
                    const bf16x8 qf = ldfrag(QT + i * 136 + ks * 32 + fq * 8);
#pragma unroll
                    for (int st = 0; st < 4; ++st) aacc[st] = mfma16(ldfrag(KT + (st * 16 + fr) * 136 + ks * 32 + fq * 8), qf, aacc[st]);
#pragma unroll
                    for (int dt = 0; dt < 4; ++dt) oacc[dt] = mfma16(ldfrag(ST + (dt * 16 + fr) * 136 + ks * 32 + fq * 8), qf, oacc[dt]);
                }
#pragma unroll
                for (int st = 0; st < 4; ++st) {
                    float a[4];
#pragma unroll
                    for (int jj = 0; jj < 4; ++jj) a[jj] = (st * 16 + fq * 4 + jj <= i) ? aacc[st][jj] : 0.f;
                    *(u32x2*)(ATT + i * 72 + st * 16 + fq * 4) = (u32x2){pack2(a[0], a[1]), pack2(a[2], a[3])};
                }
#pragma unroll
                for (int r = 0; r < 16; ++r) kw[r] = (unsigned)kp[(2 * r) * 136] | ((unsigned)kp[(2 * r + 1) * 136] << 16);
            }
            __syncthreads();
            {
                u32x4* dst = (u32x4*)(KT + dk * 72 + hf * 32);
                dst[0] = (u32x4){kw[0], kw[1], kw[2], kw[3]}; dst[1] = (u32x4){kw[4], kw[5], kw[6], kw[7]};
                dst[2] = (u32x4){kw[8], kw[9], kw[10], kw[11]}; dst[3] = (u32x4){kw[12], kw[13], kw[14], kw[15]};
            }
            __syncthreads();
            {
#pragma unroll
                for (int ks = 0; ks < 2; ++ks) {
                    const bf16x8 af = ldfrag(ATT + i * 72 + ks * 32 + fq * 8);
#pragma unroll
                    for (int dt = 0; dt < 4; ++dt) oacc[dt] = mfma16(ldfrag(VT + (dt * 16 + fr) * 72 + ks * 32 + fq * 8), af, oacc[dt]);
                }
                const int t = TROW(i);
                bf16_t* yp = YD + (size_t)t * 512 + fq * 4;
#pragma unroll
                for (int dt = 0; dt < 4; ++dt) {
                    f32x4 v = oacc[dt];
                    *(u32x2*)(yp + dt * 16) = (u32x2){pack2(v[0], v[1]), pack2(v[2], v[3])};
                }
            }
#pragma unroll
            for (int a = 0; a < 2; ++a) {
                const int ktile = 2 * wid + a;
                f32x4 e1, e2;
#pragma unroll
                for (int jj = 0; jj < 4; ++jj) { const int dkk = ktile * 16 + fq * 4 + jj; e1[jj] = __expf(TOT[dkk]); e2[jj] = __expf(TOT[128 + dkk]); }
#pragma unroll
                for (int dt = 0; dt < 4; ++dt) Sacc[a][dt] *= e1;
#pragma unroll
                for (int ks = 0; ks < 2; ++ks) {
                    const bf16x8 kf = ldfrag(KT + (ktile * 16 + fr) * 72 + ks * 32 + fq * 8);
#pragma unroll
                    for (int dt = 0; dt < 4; ++dt) Sacc[a][dt] = mfma16(kf, ldfrag(VT + (dt * 16 + fr) * 72 + ks * 32 + fq * 8), Sacc[a][dt]);
                }
#pragma unroll
                for (int dt = 0; dt < 4; ++dt) {
                    Sacc[a][dt] *= e2;
                    *(u32x2*)(ST + (dt * 16 + fr) * 136 + ktile * 16 + fq * 4) = (u32x2){pack2(Sacc[a][dt][0], Sacc[a][dt][1]), pack2(Sacc[a][dt][2], Sacc[a][dt][3])};
                }
            }
            __syncthreads();
        }
    }
}

__device__ void mx_lru(const Params& P, int l, int item, char* lds) {
    const int tid = tid_(), wid = tid >> 6, lane = tid & 63, fr = lane & 15, fq = lane >> 4;
    const int b = item >> 3, g = item & 7;
    const bf16_t* pr = (const bf16_t*)(P.ws + OFF_PREST) + (size_t)b * SQ * PREST_LD + LRU_O;
    bf16_t* YC = (bf16_t*)(P.ws + OFF_YC) + (size_t)b * SQ * 512 + g * 64;
    bf16_t* XC = (bf16_t*)lds; float* AA = (float*)(lds + 9216); float* BB = AA + 64 * 65; float* HH = BB + 64 * 65;
    const int ch = tid & 63, tq = tid >> 6;
    float cwv[4];
#pragma unroll
    for (int j = 0; j < 4; ++j) cwv[j] = P.in[I_LCW][(l * 4 + j) * 512 + g * 64 + ch];
    const float cbv = P.in[I_LCB][l * 512 + g * 64 + ch];
    const int i = wid * 16 + fr;
#pragma unroll 1
    for (int d = 0; d < 2; ++d) {
        bf16x8 waf[4][2], wxf[4][2]; f32x4 ba4[4], bx4[4], c8[4];
        {
            const bf16_t* Wa = (const bf16_t*)(P.ws + WT_LRU) + (((size_t)d * 2 + 0) * 8 + g) * 4096;
            const bf16_t* Wx = (const bf16_t*)(P.ws + WT_LRU) + (((size_t)d * 2 + 1) * 8 + g) * 4096;
#pragma unroll
            for (int jt = 0; jt < 4; ++jt) {
#pragma unroll
                for (int ks = 0; ks < 2; ++ks) { waf[jt][ks] = ldfrag(Wa + (jt * 16 + fr) * 64 + ks * 32 + fq * 8); wxf[jt][ks] = ldfrag(Wx + (jt * 16 + fr) * 64 + ks * 32 + fq * 8); }
                const int j = (l * 2 + d) * 512 + g * 64 + jt * 16 + fq * 4;
                ba4[jt] = *(const f32x4*)(P.in[I_LBA] + j); bx4[jt] = *(const f32x4*)(P.in[I_LBX] + j);
                const f32x4 lam = *(const f32x4*)(P.in[I_LLAM] + j);
#pragma unroll
                for (int jj = 0; jj < 4; ++jj) c8[jt][jj] = -8.f * (fmaxf(-lam[jj], 0.f) + flog_(1.f + __expf(-fabsf(lam[jj]))));
            }
        }
        float hst = 0.f;
        bf16_t xr[19];
        auto lru_load = [&](int cc) {
            const int t0 = d ? SQ - 64 * (cc + 1) : 64 * cc;
#pragma unroll
            for (int k = 0; k < 19; ++k) { const int t = t0 + tq * 16 - 1 + k; xr[k] = (t >= 0 && t < SQ) ? pr[(size_t)t * PREST_LD + g * 64 + ch] : (bf16_t)0; }
        };
        lru_load(0);
#pragma unroll 1
        for (int c = 0; c < 32; ++c) {
            const int t0 = d ? SQ - 64 * (c + 1) : 64 * c;
            {
                float xw[19];
#pragma unroll
                for (int k = 0; k < 19; ++k) xw[k] = bf2f(xr[k]);
                if (c + 1 < 32) lru_load(c + 1);
#pragma unroll
                for (int r = 0; r < 16; ++r) XC[(tq * 16 + r) * 72 + ch] = f2bf(cbv + cwv[0] * xw[r] + cwv[1] * xw[r + 1] + cwv[2] * xw[r + 2] + cwv[3] * xw[r + 3]);
            }
            __syncthreads();
            {
                f32x4 ra[4], rx[4];
#pragma unroll
                for (int jt = 0; jt < 4; ++jt) { ra[jt] = (f32x4){0.f, 0.f, 0.f, 0.f}; rx[jt] = (f32x4){0.f, 0.f, 0.f, 0.f}; }
#pragma unroll
                for (int ks = 0; ks < 2; ++ks) {
                    const bf16x8 xf = ldfrag(XC + i * 72 + ks * 32 + fq * 8);
#pragma unroll
                    for (int jt = 0; jt < 4; ++jt) { ra[jt] = mfma16(waf[jt][ks], xf, ra[jt]); rx[jt] = mfma16(wxf[jt][ks], xf, rx[jt]); }
                }
#pragma unroll
                for (int jt = 0; jt < 4; ++jt) {
                    float xc[4]; unpack4(*(const u32x2*)(XC + i * 72 + jt * 16 + fq * 4), xc);
#pragma unroll
                    for (int jj = 0; jj < 4; ++jj) {
                        const float la = c8[jt][jj] * sigm(ra[jt][jj] + ba4[jt][jj]);
                        const float av = __expf(la);
                        const float mult = __builtin_amdgcn_sqrtf(fmaxf(1.f - av * av, 0.f));
                        AA[i * 65 + jt * 16 + fq * 4 + jj] = av;
                        BB[i * 65 + jt * 16 + fq * 4 + jj] = mult * sigm(rx[jt][jj] + bx4[jt][jj]) * xc[jj];
                    }
                }
            }
            __syncthreads();
            if (tid < 64) {
#pragma unroll 1
                for (int r8 = 0; r8 < 8; ++r8) {
                    float av[8], bv[8];
#pragma unroll
                    for (int x = 0; x < 8; ++x) { const int r = d ? 63 - (r8 * 8 + x) : r8 * 8 + x; av[x] = AA[r * 65 + ch]; bv[x] = BB[r * 65 + ch]; }
#pragma unroll
                    for (int x = 0; x < 8; ++x) { const int r = d ? 63 - (r8 * 8 + x) : r8 * 8 + x; hst = av[x] * hst + bv[x]; HH[r * 65 + ch] = hst; }
                }
            }
            __syncthreads();
#pragma unroll
            for (int r = 0; r < 16; ++r) {
                const int ii = tq * 16 + r, t = t0 + ii;
                const float hv = HH[ii * 65 + ch];
                if (d == 0) YC[(size_t)t * 512 + ch] = f2bf(hv);
                else { const float prev = bf2f(YC[(size_t)t * 512 + ch]), gb = bf2f(pr[(size_t)t * PREST_LD + 512 + g * 64 + ch]); YC[(size_t)t * 512 + ch] = f2bf((prev + hv) * gelu_t(gb)); }
            }
        }
        __syncthreads();
    }
}

__device__ void dbg_zero(bf16_t* p, size_t n, int part, int nparts) {
    u32x4* q = (u32x4*)p; const size_t n8 = n / 8, per = (n8 + nparts - 1) / nparts, lo = per * part, hi = (lo + per < n8) ? lo + per : n8;
    for (size_t e = lo + tid_(); e < hi; e += NT) q[e] = (u32x4){0u, 0u, 0u, 0u};
}
__device__ void ph_mixers(const Params& P, int l, char* lds, int which) {
    const int nitems = 384;
    for (int item = bid_(); item < nitems; item += gridDim.x) {
        if (which) { if (item < 256) mx_rwkv(P, l, item, lds); else mx_lru(P, l, item - 256, lds); }
        else if (item < 256) mx_hgrn(P, l, item, lds);
        else mx_mlstm(P, l, item - 256, lds);
        __syncthreads();
    }
}

__device__ void ph_rwpost(const Params& P, int l, char* lds) {
    const int tid = tid_(), wid = tid >> 6, lane = tid & 63, fr = lane & 15, fq = lane >> 4;
    bf16_t* SG = (bf16_t*)lds; float* STAT = (float*)(lds + 64 * 136 * 2);
    const bf16_t* G2T = (const bf16_t*)(P.ws + WT_G2);
    const float* mu = P.in[I_MU] + l * 1792;
    for (int item = bid_(); item < TT / 64; item += gridDim.x) {
        const int tok0 = item * 64, s0 = tok0 & (SQ - 1);
        const bf16_t* prw = (const bf16_t*)(P.ws + OFF_PRW);
        bf16_t* Y0 = (bf16_t*)(P.ws + OFF_Y0); const bf16_t* Y1 = (const bf16_t*)(P.ws + OFF_Y1);
        const float* be0 = (const float*)(P.ws + OFF_BETA); const float* be1 = be0 + (size_t)TT * 8;
        __syncthreads();
        {
            const int r = tid >> 2, part = tid & 3, t = tok0 + r, sp = s0 + r;
#pragma unroll
            for (int v = 0; v < 4; ++v) {
                const int c = part * 32 + v * 8;
                float f0[8], fm[8], fp[8];
                unpack8(*(const u32x4*)(prw + (size_t)t * PRW_LD + 1664 + c), f0);
                if (sp > 0) unpack8(*(const u32x4*)(prw + (size_t)(t - 1) * PRW_LD + 1664 + c), fm); else { for (int x = 0; x < 8; ++x) fm[x] = 0.f; }
                if (sp < SQ - 1) unpack8(*(const u32x4*)(prw + (size_t)(t + 1) * PRW_LD + 1664 + c), fp); else { for (int x = 0; x < 8; ++x) fp[x] = 0.f; }
                float o[8];
#pragma unroll
                for (int x = 0; x < 8; ++x) o[x] = sigm(f0[x] + mu[1664 + c + x] * (0.5f * (fm[x] + fp[x]) - f0[x]));
                *(u32x4*)(SG + r * 136 + c) = (u32x4){pack2(o[0], o[1]), pack2(o[2], o[3]), pack2(o[4], o[5]), pack2(o[6], o[7])};
            }
#pragma unroll
            for (int hh = 0; hh < 2; ++hh) {
                const int head = part * 2 + hh;
                float sm = 0.f, sq = 0.f;
#pragma unroll
                for (int v = 0; v < 8; ++v) {
                    float a[8], bq[8];
                    unpack8(*(const u32x4*)(Y0 + (size_t)t * 512 + head * 64 + v * 8), a); unpack8(*(const u32x4*)(Y1 + (size_t)t * 512 + head * 64 + v * 8), bq);
#pragma unroll
                    for (int x = 0; x < 8; ++x) { const float y = a[x] + bq[x]; sm += y; sq += y * y; }
                }
                const float mean = sm * (1.f / 64.f), var = fmaxf(sq * (1.f / 64.f) - mean * mean, 0.f);
                STAT[(r * 8 + head) * 2] = mean; STAT[(r * 8 + head) * 2 + 1] = rsqrtf(var + 64e-5f);
            }
        }
        __syncthreads();
#pragma unroll 1
        for (int np = 0; np < 4; ++np) {
            const int nt0 = wid * 8 + np * 2;
            bf16x8 gb0[4], gb1[4];
#pragma unroll
            for (int ks = 0; ks < 4; ++ks) { gb0[ks] = ldfrag(G2T + (size_t)(nt0 * 16 + fr) * 128 + ks * 32 + fq * 8); gb1[ks] = ldfrag(G2T + (size_t)((nt0 + 1) * 16 + fr) * 128 + ks * 32 + fq * 8); }
#pragma unroll 1
            for (int tt = 0; tt < 4; ++tt) {
                f32x4 acc[2];
                acc[0] = (f32x4){0.f, 0.f, 0.f, 0.f}; acc[1] = (f32x4){0.f, 0.f, 0.f, 0.f};
#pragma unroll
                for (int ks = 0; ks < 4; ++ks) {
                    const bf16x8 af = ldfrag(SG + (tt * 16 + fr) * 136 + ks * 32 + fq * 8);
                    acc[0] = mfma16(gb0[ks], af, acc[0]); acc[1] = mfma16(gb1[ks], af, acc[1]);
                }
#pragma unroll
                for (int q = 0; q < 2; ++q) {
                    const int r = tt * 16 + fr, t = tok0 + r, sp = s0 + r, n = (nt0 + q) * 16 + fq * 4, head = n >> 6;
                    float y0[4], y1[4], v0[4], vm[4], vp[4];
                    unpack4(*(const u32x2*)(Y0 + (size_t)t * 512 + n), y0); unpack4(*(const u32x2*)(Y1 + (size_t)t * 512 + n), y1);
                    unpack4(*(const u32x2*)(prw + (size_t)t * PRW_LD + 1024 + n), v0);
                    if (sp > 0) unpack4(*(const u32x2*)(prw + (size_t)(t - 1) * PRW_LD + 1024 + n), vm); else { vm[0] = vm[1] = vm[2] = vm[3] = 0.f; }
                    if (sp < SQ - 1) unpack4(*(const u32x2*)(prw + (size_t)(t + 1) * PRW_LD + 1024 + n), vp); else { vp[0] = vp[1] = vp[2] = vp[3] = 0.f; }
                    const float mean = STAT[(r * 8 + head) * 2], rstd = STAT[(r * 8 + head) * 2 + 1];
                    const float be = 0.5f * (be0[(size_t)t * 8 + head] + be1[(size_t)t * 8 + head]);
                    const f32x4 lw = *(const f32x4*)(P.in[I_LNW] + l * 512 + n), lb = *(const f32x4*)(P.in[I_LNB] + l * 512 + n), m4 = *(const f32x4*)(mu + 1024 + n);
                    float o[4];
#pragma unroll
                    for (int jj = 0; jj < 4; ++jj) {
                        const float vs = v0[jj] + m4[jj] * (0.5f * (vm[jj] + vp[jj]) - v0[jj]);
                        o[jj] = (((y0[jj] + y1[jj]) - mean) * rstd * lw[jj] + lb[jj] + be * vs) * acc[q][jj];
                    }
                    *(u32x2*)(Y0 + (size_t)t * 512 + n) = (u32x2){pack2(o[0], o[1]), pack2(o[2], o[3])};
                }
            }
        }
    }
    __syncthreads();
}
template <bool ML> __device__ void ph_headpost(const Params& P, int l) {
    const int tid = tid_();
    bf16_t* YO = (bf16_t*)(P.ws + (ML ? OFF_YB : OFF_YD)); const bf16_t* SDF = (const bf16_t*)(P.ws + (ML ? OFF_Y1 : OFF_Y0));
    const bf16_t* pr = (const bf16_t*)(P.ws + OFF_PREST) + (ML ? 1024 : HG_O + 2048);
    const float* ng = P.in[ML ? I_MLN : I_HGN] + l * 512;
    for (int item = bid_(); item < TT / 64; item += gridDim.x) {
        const int t = item * 64 + (tid >> 2), part = tid & 3;
#pragma unroll 2
        for (int hh = 0; hh < 4; ++hh) {
            const int c0 = hh * 128 + part * 32;
            float v[32]; float ss = 0.f;
#pragma unroll
            for (int q = 0; q < 4; ++q) { float f[8], f2[8]; unpack8(*(const u32x4*)(YO + (size_t)t * 512 + c0 + q * 8), f); unpack8(*(const u32x4*)(SDF + (size_t)t * 512 + c0 + q * 8), f2);
#pragma unroll
                for (int x = 0; x < 8; ++x) { const float y = f[x] + f2[x]; v[q * 8 + x] = y; ss += y * y; } }
            ss += dppf<0xB1>(ss); ss += dppf<0x4E>(ss);
            const float rms = rsqrtf(ss * (1.f / 128.f) + 1e-6f);
#pragma unroll
            for (int q = 0; q < 4; ++q) {
                float gq[8]; unpack8(*(const u32x4*)(pr + (size_t)t * PREST_LD + c0 + q * 8), gq);
                float o[8];
#pragma unroll
                for (int x = 0; x < 8; ++x) o[x] = (ML ? sigm(gq[x]) : silu(gq[x])) * v[q * 8 + x] * rms * ng[c0 + q * 8 + x];
                *(u32x4*)(YO + (size_t)t * 512 + c0 + q * 8) = (u32x4){pack2(o[0], o[1]), pack2(o[2], o[3]), pack2(o[4], o[5]), pack2(o[6], o[7])};
            }
        }
    }
}

#define XB_TMO      128
#define XB_XCNT(j)  (256  + 64 * (j))
#define XB_XSUB(j)  (1280 + 64 * (j))
#define XB_XGEN(j)  (2304 + 64 * (j))
#define XB_TOP      3328
#define XB_TOPGEN   3392
#define XCD_BAR_WORDS 3456
#define XB_SPIN_CAP (1u << 18)
#define LAS __attribute__((address_space(3)))

__device__ __forceinline__ unsigned xb_ld(unsigned* p)              { return __hip_atomic_load(p, __ATOMIC_RELAXED, __HIP_MEMORY_SCOPE_AGENT); }
__device__ __forceinline__ unsigned xb_add(unsigned* p, unsigned v) { return __hip_atomic_fetch_add(p, v, __ATOMIC_RELAXED, __HIP_MEMORY_SCOPE_AGENT); }
__device__ __forceinline__ unsigned xb_xcc_id() { return (unsigned)__builtin_amdgcn_s_getreg((3 << 11) | 20) & 0xFu; }
#define XB_SPIN(cond, bar) do { unsigned _sp = 0; while (cond) { __builtin_amdgcn_s_sleep(1); \
    if ((++_sp & 255u) == 0u) { if (xb_ld(&(bar)[XB_TMO])) break; if (_sp > XB_SPIN_CAP) { atomicAdd(&(bar)[XB_TMO], 1u); break; } } } } while (0)

struct XcdBarrier {
    unsigned* bar; unsigned x;
    volatile LAS unsigned* st;
};

__device__ __forceinline__ XcdBarrier xcd_barrier_post(unsigned* bar, volatile LAS unsigned* st) {
    XcdBarrier b; b.bar = bar; b.x = xb_xcc_id(); b.st = st;
    if (threadIdx.x == 0) (void)xb_add(&bar[XB_XCNT(b.x)], 1u);
    return b;
}
__device__ __forceinline__ void xcd_barrier_complete(unsigned* bar, unsigned x, unsigned& nloc, unsigned& nx) {
    const unsigned G = gridDim.x * gridDim.y * gridDim.z;
    unsigned sum, cnt, mine, sp = 0u;
    for (;;) {
        sum = 0u; cnt = 0u; mine = 0u;
#pragma unroll
        for (unsigned j = 0; j < 16; ++j) { const unsigned c = xb_ld(&bar[XB_XCNT(j)]); sum += c; cnt += (c > 0u) ? 1u : 0u; mine = (j == x) ? c : mine; }
        if (sum == G) break;
        __builtin_amdgcn_s_sleep(1);
        if ((++sp & 255u) == 0u) { if (xb_ld(&bar[XB_TMO])) break; if (sp > XB_SPIN_CAP) { atomicAdd(&bar[XB_TMO], 1u); break; } }
    }
    nloc = mine > 0u ? mine : 1u; nx = cnt > 0u ? cnt : 1u;
}

__device__ __forceinline__ void xcd_barrier(const XcdBarrier& b) {
    asm volatile("s_waitcnt vmcnt(0)" ::: "memory");
    __syncthreads();
    if (threadIdx.x == 0) {
        unsigned* bar = b.bar;
        __builtin_amdgcn_s_waitcnt(0);
        unsigned nloc = b.st[0], nx = b.st[1];
        if (nloc == 0u) { xcd_barrier_complete(bar, b.x, nloc, nx); b.st[0] = nloc; b.st[1] = nx; }
        const unsigned old = xb_add(&bar[XB_XSUB(b.x)], 1u);
        const unsigned gen = old / nloc;
        if (old + 1u == (gen + 1u) * nloc) {
            __builtin_amdgcn_fence(__ATOMIC_RELEASE, "agent");
            asm volatile("s_waitcnt vmcnt(0)" ::: "memory");
            const unsigned og = xb_add(&bar[XB_TOP], 1u);
            const unsigned tg = og / nx;
            if (og + 1u == (tg + 1u) * nx) xb_add(&bar[XB_TOPGEN], 1u);
            else XB_SPIN(xb_ld(&bar[XB_TOPGEN]) == tg, bar);
            __builtin_amdgcn_fence(__ATOMIC_ACQUIRE, "agent");
            xb_add(&bar[XB_XGEN(b.x)], 1u);
            asm volatile("s_waitcnt vmcnt(0)" ::: "memory");
        } else {
            XB_SPIN(xb_ld(&bar[XB_XGEN(b.x)]) == gen, bar);
            __builtin_amdgcn_fence(__ATOMIC_ACQUIRE, "agent");
            asm volatile("s_waitcnt vmcnt(0)" ::: "memory");
        }
    }
    __syncthreads();
}


constexpr int N_PHASES = 2 + NL * 13;
__device__ void run_phase(const Params& P, int ph, char* lds) {
    if (ph == 0) { ph_init(P, lds); return; }
    if (ph == N_PHASES - 1) { ph_norm(P, P.in[I_FING], nullptr, 0, 0, nullptr, true); return; }
    const int l = (ph - 1) / 13; int sp = (ph - 1) % 13;
    const float* modl = (const float*)(P.ws + OFF_MOD) + (size_t)l * 16 * 6144;
    if (sp == 2) { ph_mixers(P, l, lds, 0); return; }
    if (sp == 3) { ph_headpost<false>(P, l); ph_headpost<true>(P, l); return; }
    if (sp == 4) { ph_mixers(P, l, lds, 1); return; }
    if (sp > 4) sp -= 2;
    switch (sp) {
        case 0: ph_wt(P, l, lds); ph_norm(P, P.in[I_N1G] + l * DM, modl, 0, 1024, (bf16_t*)(P.ws + OFF_U), false); break;
        case 1: ph_gemm_p(P, lds); break;
        case 3: ph_rwpost(P, l, lds); break;
        case 4: ph_norm(P, P.in[I_N1G] + l * DM, modl, 0, 1024, (bf16_t*)(P.ws + OFF_URE), false); break;
        case 5: ph_gemm_merge(P, lds); break;
        case 6: ph_gemm_out(P, l, lds); break;
        case 7: ph_norm(P, P.in[I_N2G] + l * DM, modl, 3072, 4096, (bf16_t*)(P.ws + OFF_U2), false); break;
        case 8: ph_gemm_up(P, lds); break;
        case 9: ph_convact(P, l); break;
        default: ph_gemm_down(P, l, lds); break;
    }
}

__global__ void __launch_bounds__(NT, 2) mega(Params P, int ph_lo, int ph_hi) {
    extern __shared__ __attribute__((aligned(16))) char smem[];
    cg::grid_group grid = cg::this_grid();
    volatile LAS unsigned* xst = (volatile LAS unsigned*)(smem + LDS_BYTES - 16);
    if (threadIdx.x == 0) { xst[0] = 0u; xst[1] = 0u; }
    __syncthreads();
    XcdBarrier xb = xcd_barrier_post((unsigned*)(P.ws + OFF_BAR), xst);
    for (int ph = ph_lo; ph < ph_hi; ++ph) {
        run_phase(P, ph, smem);
        if (ph + 1 < ph_hi) { if (ph == ph_lo) grid.sync(); else xcd_barrier(xb); }
    }
}

extern "C" void kernel_launch(void* const* d_in, const int* in_sizes, int n_in, void* d_out, int out_size, void* d_ws, size_t ws_size, hipStream_t stream) {
    static int grid_blocks = 0;
    if (grid_blocks == 0) {
        if (n_in != N_INPUTS || ws_size < WS_NEED || out_size != TT * DM) { fprintf(stderr, "kernel_launch: unexpected shapes (n_in %d ws %zu need %zu)\n", n_in, ws_size, (size_t)WS_NEED); grid_blocks = -1; return; }
        int dev = 0, cus = 0, per_cu = 0;
        hipGetDevice(&dev);
        hipDeviceGetAttribute(&cus, hipDeviceAttributeMultiprocessorCount, dev);
        if (hipFuncSetAttribute((const void*)mega, hipFuncAttributeMaxDynamicSharedMemorySize, LDS_BYTES) != hipSuccess) { fprintf(stderr, "kernel_launch: hipFuncSetAttribute failed\n"); grid_blocks = -1; return; }
        hipOccupancyMaxActiveBlocksPerMultiprocessor(&per_cu, (const void*)mega, NT, LDS_BYTES);
        if (per_cu < 1) per_cu = 1;
        if (per_cu > 2) per_cu = 2;
        grid_blocks = cus * per_cu;
    }
    if (grid_blocks < 0) return;
    if (hipMemsetAsync((char*)d_ws + OFF_BAR, 0, BAR_BYTES, stream) != hipSuccess) { fprintf(stderr, "kernel_launch: memset of the barrier words failed\n"); return; }
    Params p{};
    for (int i = 0; i < N_INPUTS; ++i) p.in[i] = (const float*)d_in[i];
    p.out = (float*)d_out; p.ws = (char*)d_ws;
#if MULTI_LAUNCH
    for (int ph = 0; ph < N_PHASES; ++ph) hipLaunchKernelGGL(mega, dim3(grid_blocks), dim3(NT), LDS_BYTES, stream, p, ph, ph + 1);
#else
    int lo = 0, hi = N_PHASES;
    void* args[] = {&p, &lo, &hi};
    hipError_t e = hipLaunchCooperativeKernel((const void*)mega, dim3(grid_blocks), dim3(NT), args, LDS_BYTES, stream);
    if (e != hipSuccess) fprintf(stderr, "cooperative launch failed: %s (grid %d)\n", hipGetErrorString(e), grid_blocks);
#endif
}
```
